# Optimizing an MI355X kernel written in HIP

```python
import jax, jax.numpy as jnp
from jax import lax
import numpy as np

D_MODEL = 1024
BATCH = 2
SEQ = 16384
DEPTH = 1
DEC_BATCH = 128
DEC_SEQ = 1
PAST_LEN = 8192
PAGE_SIZE = 128

DIL_CONFIGS = ((128, 1), (512, 4), (2048, 16))
N_GROUPS = 3
HEADS_PER_GROUP = 4
N_HEADS_A = N_GROUPS * HEADS_PER_GROUP
HEAD_DIM_A = 64
DIL_BLOCK = 128
N_HEADS_B = 4
HEAD_K_B = 128
HEAD_V_B = 256
GATE_RANK = 16
GATE_TEMP = 16.0
GLA_CHUNK = 64
PEER_HEADS = 8
PEER_KEYS = 128
N_EXPERTS = PEER_KEYS * PEER_KEYS
PEER_QDIM = 256
PEER_TOPK = 16
PEER_BLOCK = 128
W_A = N_HEADS_A * HEAD_DIM_A
W_AO = HEADS_PER_GROUP * HEAD_DIM_A
W_BK = N_HEADS_B * HEAD_K_B
W_BV = N_HEADS_B * HEAD_V_B
IN_SIZES = (W_A, W_A, W_A, W_BK, W_BK, W_BV, W_BV, GATE_RANK, D_MODEL, D_MODEL)
IN_COLS = sum(IN_SIZES)
IN_SPLITS = tuple(int(o) for o in np.cumsum(IN_SIZES)[:-1])
DN_ALPHA = (2 * DEPTH) ** 0.25
DN_BETA = (8 * DEPTH) ** -0.25
LN_EPS = 1e-5

kernel_name = "hybrid_dilated_gla_peer_step"


def layer_norm(x, w=None, b=None):
    xf = x.astype(jnp.float32)
    mu = jnp.mean(xf, axis=-1, keepdims=True)
    var = jnp.mean(jnp.square(xf - mu), axis=-1, keepdims=True)
    y = (xf - mu) * lax.rsqrt(var + LN_EPS)
    if w is not None:
        y = y * w.astype(jnp.float32) + b.astype(jnp.float32)
    return y.astype(x.dtype)


def adaln(c, w_ada, b_ada):
    mod = jax.nn.silu(c) @ w_ada + b_ada
    return [m[:, None, :] for m in jnp.split(mod, 6, axis=-1)]


def modulate(x, shift, scale):
    return layer_norm(x) * (1 + scale) + shift


def alibi_slopes():
    h = jnp.arange(1, N_HEADS_A + 1, dtype=jnp.float32)
    return jnp.exp2(-8.0 * h / N_HEADS_A).reshape(N_GROUPS, HEADS_PER_GROUP)


def softmax_stats(s, valid):
    s = jnp.where(valid, s, -jnp.inf)
    m = jnp.max(s, axis=-1, keepdims=True)
    p = jnp.exp(s - m)
    z = jnp.sum(p, axis=-1, keepdims=True)
    return p / z, (m + jnp.log(z))[..., 0]


def dilated_prompt(q, k, v, slopes, window, dil):
    B, T, H, hd = q.shape
    span = dil * DIL_BLOCK
    t_pad = -(-T // span) * span
    L = t_pad // dil
    nb = L // DIL_BLOCK

    def to_phase(a):
        a = jnp.pad(a, ((0, 0), (0, t_pad - T), (0, 0), (0, 0)))
        a = jnp.transpose(a.reshape(B, L, dil, H, hd), (0, 2, 1, 3, 4))
        return a.reshape(B, dil, nb, DIL_BLOCK, H, hd)

    def with_prev(a):
        prev = jnp.pad(a, ((0, 0), (0, 0), (1, 0), (0, 0), (0, 0), (0, 0)))[:, :, :-1]
        return jnp.concatenate([prev, a], axis=3)

    qb = to_phase(q)
    kc = with_prev(to_phase(k))
    vc = with_prev(to_phase(v))
    s = jnp.einsum('brnqhd,brnkhd->brnhqk', qb, kc).astype(jnp.float32) * (hd ** -0.5)
    qi = jnp.arange(DIL_BLOCK)[:, None]
    ki = jnp.arange(2 * DIL_BLOCK)[None, :]
    steps = qi + DIL_BLOCK - ki
    in_band = (steps >= 0) & (steps <= window // dil)
    has_prev = jnp.arange(nb)[:, None, None] > 0
    valid = in_band[None] & (has_prev | (ki >= DIL_BLOCK)[None])
    bias = -slopes[:, None, None] * (steps * dil).astype(jnp.float32)[None]
    p, lse = softmax_stats(s + bias[None, None, None], valid[None, None, :, None])
    o = jnp.einsum('brnhqk,brnkhd->brnqhd', p.astype(v.dtype), vc)
    o = jnp.transpose(o.reshape(B, dil, L, H, hd), (0, 2, 1, 3, 4)).reshape(B, t_pad, H, hd)[:, :T]
    lse = jnp.transpose(lse, (0, 2, 4, 1, 3)).reshape(B, t_pad, H)[:, :T]
    return o, lse


def dilated_sample(q, k, v, buf, slopes, window, dil):
    S, hd = q.shape[1], q.shape[-1]
    W = buf.shape[1]
    kv_all = jnp.concatenate([buf, jnp.stack([k, v], axis=2)], axis=1)
    steps = jnp.arange(window // dil + 1)
    idx = W + jnp.arange(S)[:, None] - steps[None, :] * dil
    g = jnp.take(kv_all, jnp.maximum(idx, 0), axis=1)
    s = jnp.einsum('bshd,bskhd->bshk', q, g[:, :, :, 0]).astype(jnp.float32) * (hd ** -0.5)
    bias = -slopes[:, None] * (steps * dil).astype(jnp.float32)[None, :]
    p, lse = softmax_stats(s + bias, (idx >= 0)[None, :, None, :])
    o = jnp.einsum('bshk,bskhd->bshd', p.astype(v.dtype), g[:, :, :, 1])
    return o, lse, kv_all[:, S:]


def gla_chunk(S, q, k, v, g):
    q, k, v, g = (a.astype(jnp.float32) for a in (q, k, v, g))
    C = q.shape[1]
    b = jnp.cumsum(g, axis=1)
    causal = jnp.tril(jnp.ones((C, C), dtype=bool))
    diff = b[:, :, None] - b[:, None, :]
    decay = jnp.exp(jnp.where(causal[None, :, :, None, None], diff, -jnp.inf))
    scores = jnp.einsum('bthk,btshk,bshk->bhts', q, decay, k)
    o = jnp.einsum('bthk,bhkv->bthv', q * jnp.exp(b), S) + jnp.einsum('bhts,bshv->bthv', scores, v)
    b_last = b[:, -1]
    S_new = jnp.exp(b_last)[..., None] * S + jnp.einsum('bshk,bshv->bhkv', k * jnp.exp(b_last[:, None] - b), v)
    return o, S_new


def gla_prompt(q, k, v, g):
    B, T, H = q.shape[:3]
    n_chunks = T // GLA_CHUNK

    def to_chunks(a):
        return jnp.moveaxis(a.reshape(B, n_chunks, GLA_CHUNK, *a.shape[2:]), 1, 0)

    S0 = jnp.zeros((B, H, HEAD_K_B, HEAD_V_B), jnp.float32)

    def step(S, xs):
        o, S = gla_chunk(S, *xs)
        return S, o

    S_fin, o = lax.scan(step, S0, (to_chunks(q), to_chunks(k), to_chunks(v), to_chunks(g)))
    return jnp.moveaxis(o, 0, 1).reshape(B, T, H, HEAD_V_B), S_fin


def mixer_project(h, w_in, w_gla_up, b_gla):
    B, T = h.shape[:2]
    qa, ka, va, qb, kb, vb, rb, glr, ga, gb = jnp.split(h @ w_in, IN_SPLITS, axis=-1)
    heads_a = lambda a: a.reshape(B, T, N_HEADS_A, HEAD_DIM_A)
    qb = qb.reshape(B, T, N_HEADS_B, HEAD_K_B) * (HEAD_K_B ** -0.5)
    kb = kb.reshape(B, T, N_HEADS_B, HEAD_K_B)
    vb = vb.reshape(B, T, N_HEADS_B, HEAD_V_B)
    gdec = jax.nn.log_sigmoid((glr @ w_gla_up + b_gla).astype(jnp.float32)) / GATE_TEMP
    gdec = gdec.reshape(B, T, N_HEADS_B, HEAD_K_B)
    return heads_a(qa), heads_a(ka), heads_a(va), qb, kb, vb, gdec, rb, ga, gb


def mixer_merge(o_groups, lse_groups, o_gla, rb, ga, gb, gla_norm_w, w_br_a, w_br_b, w_out):
    B, T = rb.shape[:2]
    dt = rb.dtype
    wts = jax.nn.softmax(jnp.stack(lse_groups), axis=0)
    oa = jnp.sum(wts[..., None] * jnp.stack(o_groups).astype(jnp.float32), axis=0).reshape(B, T, W_AO)
    ob = o_gla * lax.rsqrt(jnp.mean(jnp.square(o_gla), axis=-1, keepdims=True) + LN_EPS)
    ob = ob.reshape(B, T, W_BV).astype(dt) * gla_norm_w * jax.nn.silu(rb)
    merged = jax.nn.sigmoid(ga) * (oa.astype(dt) @ w_br_a) + jax.nn.sigmoid(gb) * (ob @ w_br_b)
    return merged @ w_out


def mixer_prompt(h, w_in, w_gla_up, b_gla, gla_norm_w, w_br_a, w_br_b, w_out):
    qa, ka, va, qb, kb, vb, gdec, rb, ga, gb = mixer_project(h, w_in, w_gla_up, b_gla)
    slopes = alibi_slopes()
    T = h.shape[1]
    o_groups, lse_groups, bufs = [], [], []
    for gi, (window, dil) in enumerate(DIL_CONFIGS):
        hs = slice(gi * HEADS_PER_GROUP, (gi + 1) * HEADS_PER_GROUP)
        o, lse = dilated_prompt(qa[:, :, hs], ka[:, :, hs], va[:, :, hs], slopes[gi], window, dil)
        o_groups.append(o)
        lse_groups.append(lse)
        keep = min(window, T)
        bufs.append(jnp.stack([ka[:, T - keep:, hs], va[:, T - keep:, hs]], axis=2))
    o_gla, S_fin = gla_prompt(qb, kb, vb, gdec)
    out = mixer_merge(o_groups, lse_groups, o_gla, rb, ga, gb, gla_norm_w, w_br_a, w_br_b, w_out)
    return out, bufs, S_fin


def mixer_sample(h, bufs_in, S0, w_in, w_gla_up, b_gla, gla_norm_w, w_br_a, w_br_b, w_out):
    qa, ka, va, qb, kb, vb, gdec, rb, ga, gb = mixer_project(h, w_in, w_gla_up, b_gla)
    slopes = alibi_slopes()
    o_groups, lse_groups, bufs = [], [], []
    for gi, (window, dil) in enumerate(DIL_CONFIGS):
        hs = slice(gi * HEADS_PER_GROUP, (gi + 1) * HEADS_PER_GROUP)
        o, lse, nbuf = dilated_sample(qa[:, :, hs], ka[:, :, hs], va[:, :, hs], bufs_in[gi], slopes[gi], window, dil)
        o_groups.append(o)
        lse_groups.append(lse)
        bufs.append(nbuf)
    o_gla, S_new = gla_chunk(S0.astype(jnp.float32), qb, kb, vb, gdec)
    out = mixer_merge(o_groups, lse_groups, o_gla, rb, ga, gb, gla_norm_w, w_br_a, w_br_b, w_out)
    return out, bufs, S_new


def peer(h, w_pq, peer_k1, peer_k2, peer_u, peer_v):
    shp = h.shape
    hf = h.reshape(-1, D_MODEL)
    n = hf.shape[0]
    n_pad = -(-n // PEER_BLOCK) * PEER_BLOCK
    hb = jnp.pad(hf, ((0, n_pad - n), (0, 0))).reshape(-1, PEER_BLOCK, D_MODEL)
    half = PEER_QDIM // 2

    def one_block(xb):
        qv = (xb @ w_pq).reshape(PEER_BLOCK, PEER_HEADS, PEER_QDIM)
        s1 = jnp.einsum('thd,hkd->thk', qv[..., :half], peer_k1).astype(jnp.float32)
        s2 = jnp.einsum('thd,hkd->thk', qv[..., half:], peer_k2).astype(jnp.float32)
        v1, i1 = lax.top_k(s1, PEER_TOPK)
        v2, i2 = lax.top_k(s2, PEER_TOPK)
        cand = (v1[..., :, None] + v2[..., None, :]).reshape(PEER_BLOCK, PEER_HEADS, PEER_TOPK * PEER_TOPK)
        sc, ci = lax.top_k(cand, PEER_TOPK)
        e = (jnp.take_along_axis(i1, ci // PEER_TOPK, axis=-1) * PEER_KEYS
             + jnp.take_along_axis(i2, ci % PEER_TOPK, axis=-1))
        gw = jax.nn.softmax(sc, axis=-1)
        act = jax.nn.gelu(jnp.einsum('td,thkd->thk', xb, peer_u[e]), approximate=False)
        return jnp.einsum('thk,thkd->td', (gw * act).astype(xb.dtype), peer_v[e])

    y = lax.map(one_block, hb)
    return y.reshape(n_pad, D_MODEL)[:n].reshape(shp)


def decoder_layer(x, c, mixer_fn, w_ada, b_ada, ln1_w, ln1_b, w_pq, peer_k1, peer_k2, peer_u, peer_v, ln2_w, ln2_b):
    sh1, sc1, g1, sh2, sc2, g2 = adaln(c, w_ada, b_ada)
    mix, bufs, S = mixer_fn(modulate(x, sh1, sc1))
    x = layer_norm(DN_ALPHA * x + g1 * mix, ln1_w, ln1_b)
    ff = peer(modulate(x, sh2, sc2), w_pq, peer_k1, peer_k2, peer_u, peer_v)
    x = layer_norm(DN_ALPHA * x + g2 * ff, ln2_w, ln2_b)
    return x, bufs, S


def setup_inputs(seed: int = 0) -> dict:
    key = jax.random.key(seed)
    ks = list(jax.random.split(key, 40))

    def nrm(shape, scale):
        return jax.random.normal(ks.pop(), shape, jnp.float32) * scale

    def kv_cache(window):
        return nrm((DEPTH, DEC_BATCH, min(window, PAST_LEN), 2, HEADS_PER_GROUP, HEAD_DIM_A), 1.0)

    D = D_MODEL
    return {
        "x_prompt": nrm((BATCH, SEQ, D), 1.0),
        "x_sample": nrm((DEC_BATCH, DEC_SEQ, D), 1.0),
        "c_prompt": nrm((BATCH, D), 1.0),
        "c_sample": nrm((DEC_BATCH, D), 1.0),
        "cache_kv_w128": kv_cache(DIL_CONFIGS[0][0]),
        "cache_kv_w512": kv_cache(DIL_CONFIGS[1][0]),
        "cache_kv_w2048": kv_cache(DIL_CONFIGS[2][0]),
        "state_gla": nrm((DEPTH, DEC_BATCH, N_HEADS_B, HEAD_K_B, HEAD_V_B), 0.3),
        "w_ada": nrm((DEPTH, D, 6 * D), 0.5 * D ** -0.5),
        "b_ada": nrm((DEPTH, 6 * D), 0.02),
        "w_in": nrm((DEPTH, D, IN_COLS), D ** -0.5),
        "w_gla_up": nrm((DEPTH, GATE_RANK, W_BK), GATE_RANK ** -0.5),
        "b_gla": nrm((DEPTH, W_BK), 0.1),
        "gla_norm_w": 1.0 + nrm((DEPTH, W_BV), 0.02),
        "w_br_a": nrm((DEPTH, W_AO, D), W_AO ** -0.5),
        "w_br_b": nrm((DEPTH, W_BV, D), W_BV ** -0.5),
        "w_out": nrm((DEPTH, D, D), DN_BETA * D ** -0.5),
        "ln1_w": 1.0 + nrm((DEPTH, D), 0.02),
        "ln1_b": nrm((DEPTH, D), 0.02),
        "w_pq": nrm((DEPTH, D, PEER_HEADS * PEER_QDIM), D ** -0.5),
        "peer_k1": nrm((DEPTH, PEER_HEADS, PEER_KEYS, PEER_QDIM // 2), (PEER_QDIM // 2) ** -0.5),
        "peer_k2": nrm((DEPTH, PEER_HEADS, PEER_KEYS, PEER_QDIM // 2), (PEER_QDIM // 2) ** -0.5),
        "peer_u": nrm((DEPTH, N_EXPERTS, D), D ** -0.5),
        "peer_v": nrm((DEPTH, N_EXPERTS, D), DN_BETA * (PEER_HEADS * PEER_TOPK) ** -0.5),
        "ln2_w": 1.0 + nrm((DEPTH, D), 0.02),
        "ln2_b": nrm((DEPTH, D), 0.02),
    }


def reference(x_prompt, x_sample, c_prompt, c_sample, cache_kv_w128, cache_kv_w512, cache_kv_w2048, state_gla,
              w_ada, b_ada, w_in, w_gla_up, b_gla, gla_norm_w, w_br_a, w_br_b, w_out, ln1_w, ln1_b,
              w_pq, peer_k1, peer_k2, peer_u, peer_v, ln2_w, ln2_b):
    yp, ys = x_prompt, x_sample
    p128, p512, p2048, pgla = [], [], [], []
    s128, s512, s2048, sgla = [], [], [], []
    for l in range(DEPTH):
        mix_w = (w_in[l], w_gla_up[l], b_gla[l], gla_norm_w[l], w_br_a[l], w_br_b[l], w_out[l])
        rest_w = (w_ada[l], b_ada[l], ln1_w[l], ln1_b[l], w_pq[l], peer_k1[l], peer_k2[l],
                  peer_u[l], peer_v[l], ln2_w[l], ln2_b[l])
        yp, bufs_p, S_p = decoder_layer(yp, c_prompt, lambda h: mixer_prompt(h, *mix_w), *rest_w)
        caches_l = (cache_kv_w128[l], cache_kv_w512[l], cache_kv_w2048[l])
        ys, bufs_s, S_s = decoder_layer(ys, c_sample, lambda h: mixer_sample(h, caches_l, state_gla[l], *mix_w), *rest_w)
        p128.append(bufs_p[0]); p512.append(bufs_p[1]); p2048.append(bufs_p[2]); pgla.append(S_p)
        s128.append(bufs_s[0]); s512.append(bufs_s[1]); s2048.append(bufs_s[2]); sgla.append(S_s)
    kv_w128_prompt = jnp.stack(p128)
    kv_w512_prompt = jnp.stack(p512)
    kv_w2048_prompt = jnp.stack(p2048)
    gla_prompt_state = jnp.stack(pgla)
    kv_w128_sample = jnp.stack(s128)
    kv_w512_sample = jnp.stack(s512)
    kv_w2048_sample = jnp.stack(s2048)
    gla_sample_state = jnp.stack(sgla)
    return (yp, ys, kv_w128_prompt, kv_w512_prompt, kv_w2048_prompt, gla_prompt_state,
            kv_w128_sample, kv_w512_sample, kv_w2048_sample, gla_sample_state)
```

```cpp
#define DBG_MODE 3
#include <hip/hip_runtime.h>
#include <stdint.h>
#include <stdio.h>
#include <string.h>
namespace pg8 {
#define PG8_LAS __attribute__((address_space(3)))
typedef unsigned short bf16_t;
typedef short bf16x8 __attribute__((ext_vector_type(8)));
typedef float f32x4 __attribute__((ext_vector_type(4)));
typedef unsigned u32x4 __attribute__((ext_vector_type(4)));
constexpr int BM = 256, BK = 64, HALF = 128, HTB = HALF * BK * 2  , STAGE_BYTES = 8 * HTB, NXCD = 8, WGM = 8;

__host__ __device__ __forceinline__ int lds_byte(int r, int c) { const int st = (r >> 4) * 2 + (c >> 5), rr = r & 15, cc = c & 31, ob = rr * 64 + cc * 2; return st * 1024 + (ob ^ (((ob >> 9) & 1) << 5)); }
__host__ __device__ __forceinline__ void stage_rc(int b, int& R, int& C) { const int st = b / 1024, sb = b % 1024, swz = sb ^ (((sb >> 9) & 1) << 5); R = (st >> 1) * 16 + swz / 64; C = (st & 1) * 32 + (swz % 64) / 2; }
__host__ __device__ __forceinline__ int perm32(int rho) { const int n = rho >> 4, i = rho & 15; return 8 * (i >> 2) + 4 * n + (i & 3); }

struct Unit { int pm, pn; };
struct Gemm { const bf16_t* A; const bf16_t* Bt; int M, N, K; };

struct StaticOrder {
    int nM, nN, nwg, G, c;
    __host__ __device__ void init(int M, int N, int G_, int c_) { nM = M / BM; nN = N / BM; nwg = nM * nN; G = G_; c = c_; }
    __host__ __device__ bool next(int i, Unit& u) const {
        const long L = (long)i * G + c; if (L >= nwg) return false;
        int wgid = (int)L; { const int q = nwg / NXCD, r = nwg % NXCD, xcd = wgid % NXCD, off = wgid / NXCD; wgid = (xcd < r ? xcd * (q + 1) : r * (q + 1) + (xcd - r) * q) + off; }
        const int nig = WGM * nN, gid = wgid / nig, fm = gid * WGM, gsz = (nM - fm) < WGM ? (nM - fm) : WGM;
        u.pm = fm + ((wgid % nig) % gsz); u.pn = (wgid % nig) / gsz; return true;
    }
    __device__ __forceinline__ void a_ready(const Unit&) const {}
    __device__ __forceinline__ void done(const Unit&) const {}
};
__device__ __forceinline__ unsigned cvt_pk_bf16(float lo, float hi) { unsigned r; asm volatile("v_cvt_pk_bf16_f32 %0, %1, %2" : "=v"(r) : "v"(lo), "v"(hi)); return r; }
typedef float f32x2 __attribute__((ext_vector_type(2)));
struct EpiF32 {
    static constexpr bool PERM = false, AFTER_DRAIN = false;
    float* C; int ldc; const float* bias;
    __device__ __forceinline__ void operator()(const f32x4 (&acc)[2][2][4][2], const Unit& u, int wr, int wc, int fr, int fq) const {
        const int row0 = u.pm * BM + wr * 64 + fr, col0 = u.pn * BM + wc * 32 + 4 * fq;
        f32x4 bv[2][2];
#pragma unroll
        for (int bj = 0; bj < 2; ++bj)
#pragma unroll
            for (int n = 0; n < 2; ++n) bv[bj][n] = bias ? *(const f32x4*)(bias + col0 + bj * HALF + n * 16) : (f32x4){0.f, 0.f, 0.f, 0.f};
#pragma unroll
        for (int ai = 0; ai < 2; ++ai)
#pragma unroll
            for (int m = 0; m < 4; ++m) { float* rowp = C + (size_t)(row0 + ai * HALF + m * 16) * ldc + col0;
#pragma unroll
                for (int bj = 0; bj < 2; ++bj)
#pragma unroll
                    for (int n = 0; n < 2; ++n) *(f32x4*)(rowp + bj * HALF + n * 16) = acc[ai][bj][m][n] + bv[bj][n]; }
    }
};
template <class Epi, class Sched, bool STAMP = false>
__device__ __forceinline__ void gemm_phase(PG8_LAS unsigned char* lds, const Gemm g, const Sched& S, const Epi& E, unsigned long long* stamps) {
    const int tid = threadIdx.x, wid = __builtin_amdgcn_readfirstlane(tid >> 6), lane = tid & 63, wr = wid >> 2, wc = wid & 3, fr = lane & 15, fq = lane >> 4;
    const int K = g.K, nt = K / BK;
    int ts_lo = 0, ts_hi = 0, nts = 0; const unsigned long long rt_entry = STAMP ? (unsigned long long)wall_clock64() : 0ull;
#define PG8_STAMP() do { if (STAMP && wid == 0 && nts < 64) { const unsigned long long _c = (unsigned long long)clock64(); \
        ts_lo = (lane == nts) ? (int)(unsigned)_c : ts_lo; ts_hi = (lane == nts) ? (int)(unsigned)(_c >> 32) : ts_hi; ++nts; } } while (0)
    PG8_STAMP();
    unsigned voffA[2], voffB[2];
#pragma unroll
    for (int i = 0; i < 2; ++i) { int R, C; stage_rc(tid * 16 + i * 8192, R, C); const int Rb = Epi::PERM ? ((R & ~31) + perm32(R & 31)) : R;
        voffA[i] = (unsigned)(R * K + C) * 2u; voffB[i] = (unsigned)(Rb * K + C) * 2u; }
    const size_t kstep = (size_t)(BK * 2);
    const size_t hstep = (size_t)HALF * K * 2;
    const size_t tstep = 2 * hstep;
    const unsigned ldsw = (unsigned)wid * 1024u;
    const int aoff = lds_byte(wr * 64 + fr, fq * 8), boff = lds_byte(wc * 32 + fr, fq * 8);
#define PG8_SA(b, h) (((b) * 2 + (h)) * HTB)
#define PG8_SB(b, h) ((4 + (b) * 2 + (h)) * HTB)
#define PG8_STAGE(bufoff, gbase, voff) do { _Pragma("unroll") for (int _i = 0; _i < 2; ++_i) \
        __builtin_amdgcn_global_load_lds((const unsigned*)((const char*)(gbase) + (voff)[_i]), (PG8_LAS unsigned*)(lds + (bufoff) + ldsw + _i * 8192), 16, 0, 0); } while (0)
#define PG8_LDA(dst, b, h) do { _Pragma("unroll") for (int m = 0; m < 4; ++m) _Pragma("unroll") for (int k = 0; k < 2; ++k) dst[m][k] = *(const PG8_LAS bf16x8*)(lds + PG8_SA(b, h) + aoff + m * 2048 + k * 1024); } while (0)
#define PG8_LDB(dst, b, h) do { _Pragma("unroll") for (int n = 0; n < 2; ++n) _Pragma("unroll") for (int k = 0; k < 2; ++k) dst[n][k] = *(const PG8_LAS bf16x8*)(lds + PG8_SB(b, h) + boff + n * 2048 + k * 1024); } while (0)
#define PG8_MMA(ai, bj, At, Bt) do { __builtin_amdgcn_s_setprio(1); _Pragma("unroll") for (int m = 0; m < 4; ++m) _Pragma("unroll") for (int n = 0; n < 2; ++n) _Pragma("unroll") for (int k = 0; k < 2; ++k) \
        acc[ai][bj][m][n] = __builtin_amdgcn_mfma_f32_16x16x32_bf16(Bt[n][k], At[m][k], acc[ai][bj][m][n], 0, 0, 0); __builtin_amdgcn_s_setprio(0); } while (0)
#define PG8_WAIT_V(n) asm volatile("s_waitcnt vmcnt(" #n ")" ::: "memory")
#define PG8_WAIT_L(n) asm volatile("s_waitcnt lgkmcnt(" #n ")" ::: "memory")
#define PG8_BAR __builtin_amdgcn_s_barrier()
#define PG8_SCHED __builtin_amdgcn_sched_barrier(0)
    Unit cur, nxt; int ui = 0;
    if (!S.next(0, cur)) return;
    f32x4 acc[2][2][4][2];
#pragma unroll
    for (int a = 0; a < 2; ++a)
#pragma unroll
        for (int b = 0; b < 2; ++b)
#pragma unroll
            for (int m = 0; m < 4; ++m)
#pragma unroll
                for (int n = 0; n < 2; ++n) acc[a][b][m][n] = (f32x4){0.f, 0.f, 0.f, 0.f};
    bf16x8 At[4][2], B0[2][2], B1[2][2];
    const char* cA = (const char*)g.A + (size_t)cur.pm * tstep; const char* cB = (const char*)g.Bt + (size_t)cur.pn * tstep;
    S.a_ready(cur);
    PG8_STAGE(PG8_SB(0, 0), cB, voffB); PG8_STAGE(PG8_SA(0, 0), cA, voffA); PG8_STAGE(PG8_SB(0, 1), cB + hstep, voffB); PG8_STAGE(PG8_SA(0, 1), cA + hstep, voffA);
    if (wr == 1) PG8_BAR;
    PG8_WAIT_V(4); PG8_BAR;
    PG8_STAGE(PG8_SB(1, 0), cB + kstep, voffB); PG8_STAGE(PG8_SA(1, 0), cA + kstep, voffA); PG8_STAGE(PG8_SB(1, 1), cB + hstep + kstep, voffB);
    PG8_WAIT_V(6); PG8_BAR;
    PG8_STAMP();
    for (;;) {
        const bool has_next = S.next(ui + 1, nxt);
        const char* nA = has_next ? (const char*)g.A + (size_t)nxt.pm * tstep : cA; const char* nB = has_next ? (const char*)g.Bt + (size_t)nxt.pn * tstep : cB;
        for (int t = 0; t < nt; t += 2) {
            const bool last = (t == nt - 2);
            const char* a1 = cA + (size_t)(t + 1) * kstep;
            const char* a2 = last ? nA : cA + (size_t)(t + 2) * kstep; const char* b2 = last ? nB : cB + (size_t)(t + 2) * kstep;
            const char* a3 = a2 + kstep; const char* b3 = b2 + kstep;
            if (last && has_next) S.a_ready(nxt);
            PG8_LDB(B0, 0, 0); PG8_SCHED; PG8_LDA(At, 0, 0); PG8_STAGE(PG8_SA(1, 1), a1 + hstep, voffA);
            PG8_WAIT_L(8); PG8_BAR; PG8_WAIT_L(0); PG8_MMA(0, 0, At, B0); PG8_BAR; PG8_SCHED;
            PG8_LDB(B1, 0, 1); PG8_STAGE(PG8_SB(0, 0), b2, voffB);
            PG8_BAR; PG8_WAIT_L(0); PG8_MMA(0, 1, At, B1); PG8_BAR;
            PG8_LDA(At, 0, 1); PG8_STAGE(PG8_SA(0, 0), a2, voffA);
            PG8_BAR; PG8_WAIT_L(0); PG8_MMA(1, 0, At, B0); PG8_BAR; PG8_SCHED;
            PG8_STAGE(PG8_SB(0, 1), b2 + hstep, voffB);
            PG8_WAIT_V(6); PG8_BAR; PG8_MMA(1, 1, At, B1); PG8_BAR;
            PG8_LDB(B0, 1, 0); PG8_SCHED; PG8_LDA(At, 1, 0); PG8_STAGE(PG8_SA(0, 1), a2 + hstep, voffA);
            PG8_WAIT_L(8); PG8_BAR; PG8_WAIT_L(0); PG8_MMA(0, 0, At, B0); PG8_BAR; PG8_SCHED;
            PG8_LDB(B1, 1, 1); PG8_STAGE(PG8_SB(1, 0), b3, voffB);
            PG8_BAR; PG8_WAIT_L(0); PG8_MMA(0, 1, At, B1); PG8_BAR;
            PG8_LDA(At, 1, 1); PG8_STAGE(PG8_SA(1, 0), a3, voffA);
            PG8_BAR; PG8_WAIT_L(0); PG8_MMA(1, 0, At, B0); PG8_BAR; PG8_SCHED;
            PG8_STAGE(PG8_SB(1, 1), b3 + hstep, voffB);
            PG8_WAIT_V(6); PG8_BAR; PG8_MMA(1, 1, At, B1); PG8_BAR;
        }
        PG8_STAMP();
        if constexpr (!Epi::AFTER_DRAIN) { E(acc, cur, wr, wc, fr, fq); S.done(cur); }
        PG8_STAMP();
        if (!has_next) break;
#pragma unroll
        for (int a = 0; a < 2; ++a)
#pragma unroll
            for (int b = 0; b < 2; ++b)
#pragma unroll
                for (int m = 0; m < 4; ++m)
#pragma unroll
                    for (int n = 0; n < 2; ++n) acc[a][b][m][n] = (f32x4){0.f, 0.f, 0.f, 0.f};
        cur = nxt; cA = nA; cB = nB; ++ui;
    }
    PG8_WAIT_V(0);
    if (wr == 0) PG8_BAR;
    PG8_BAR;
    if constexpr (Epi::AFTER_DRAIN) { E.fused(acc, cur, wr, wc, fr, fq, lds, wid, lane); S.done(cur); }
    PG8_STAMP();
    if (STAMP && wid == 0) { stamps[lane] = lane < nts ? (((unsigned long long)(unsigned)ts_hi << 32) | (unsigned)ts_lo) : 0ull;
        if (lane == 62) stamps[62] = rt_entry; if (lane == 63) stamps[63] = (unsigned long long)wall_clock64(); }
#undef PG8_STAMP
#undef PG8_SA
#undef PG8_SB
#undef PG8_STAGE
#undef PG8_LDA
#undef PG8_LDB
#undef PG8_MMA
#undef PG8_WAIT_V
#undef PG8_WAIT_L
#undef PG8_BAR
#undef PG8_SCHED
}
}

typedef unsigned short bf16_t;
typedef float f32x4 __attribute__((ext_vector_type(4)));
typedef float f32x16 __attribute__((ext_vector_type(16)));
typedef short bf16x8 __attribute__((ext_vector_type(8)));
typedef unsigned u32x4 __attribute__((ext_vector_type(4)));
typedef unsigned u32x2 __attribute__((ext_vector_type(2)));
#define LAS __attribute__((address_space(3)))

constexpr int D = 1024, BP = 2, T = 16384, NTP = BP * T  , NS = 128, NT = NTP + NS  , MP = 33024  ;
constexpr int NPROJ = 7680;
constexpr int NTHREADS = 512;
constexpr int LDS_BYTES = 155648;
constexpr float LN_EPS = 1e-5f;
constexpr float DN_ALPHA = 1.189207115002721f;

constexpr size_t OFF_YP = 0;
constexpr size_t OFF_YS = OFF_YP + (size_t)NTP * D;
constexpr size_t OFF_KVP0 = OFF_YS + (size_t)NS * D;
constexpr size_t OFF_KVP1 = OFF_KVP0 + (size_t)BP * 128 * 512;
constexpr size_t OFF_KVP2 = OFF_KVP1 + (size_t)BP * 512 * 512;
constexpr size_t OFF_GLAP = OFF_KVP2 + (size_t)BP * 2048 * 512;
constexpr size_t OFF_KVS0 = OFF_GLAP + (size_t)BP * 4 * 128 * 256;
constexpr size_t OFF_KVS1 = OFF_KVS0 + (size_t)NS * 128 * 512;
constexpr size_t OFF_KVS2 = OFF_KVS1 + (size_t)NS * 512 * 512;
constexpr size_t OFF_GLAS = OFF_KVS2 + (size_t)NS * 2048 * 512;
constexpr size_t OUT_TOTAL = OFF_GLAS + (size_t)NS * 4 * 128 * 256;

struct Params {
    const float *x_prompt, *x_sample, *c_prompt, *c_sample, *cache128, *cache512, *cache2048, *state_gla;
    const float *w_ada, *b_ada, *w_in, *w_gla_up, *b_gla, *gla_norm_w, *w_br_a, *w_br_b, *w_out, *ln1_w, *ln1_b;
    const float *w_pq, *peer_k1, *peer_k2, *peer_u, *peer_v, *ln2_w, *ln2_b;
    float* out;
    unsigned* bar;
    float* MOD; bf16_t* SC; bf16_t* WADA_T; bf16_t* WIN_T; bf16_t* WBRA_T; bf16_t* WBRB_T; bf16_t* WOUT_T; bf16_t* WPQ_T;
    bf16_t* K1B; bf16_t* K2B; bf16_t* UB; bf16_t* VB;
    bf16_t* H; bf16_t* QKVA; bf16_t* QKB; bf16_t* VBB; bf16_t* RB; bf16_t* GA; bf16_t* GB; float* GLR;
    bf16_t* OG; float* LSE; bf16_t* QE; bf16_t* KE; bf16_t* KDT; float* DL; float* LT; bf16_t* SPT; bf16_t* OGLA;
    bf16_t* OA; bf16_t* OB; bf16_t* TMP1; bf16_t* MERGED; float* Z1; float* X1; bf16_t* QV; int* EIDX; float* EGW;
};

__device__ __forceinline__ float bf2f(bf16_t v) { return __uint_as_float(((unsigned)v) << 16); }
__device__ __forceinline__ float bflo(unsigned w) { return __uint_as_float(w << 16); }
__device__ __forceinline__ float bfhi(unsigned w) { return __uint_as_float(w & 0xffff0000u); }
typedef __bf16 v2bf_t __attribute__((ext_vector_type(2)));
typedef float v2f_t __attribute__((ext_vector_type(2)));
__device__ __forceinline__ unsigned pack2(float lo, float hi) { const v2f_t f = {lo, hi}; const v2bf_t b = __builtin_convertvector(f, v2bf_t); return __builtin_bit_cast(unsigned, b); }
__device__ __forceinline__ bf16_t f2bf(float f) { return (bf16_t)(pack2(f, 0.f) & 0xffffu); }
__device__ __forceinline__ float wave_sum(float v) {
#pragma unroll
    for (int o = 32; o >= 1; o >>= 1) v += __shfl_xor(v, o);
    return v;
}
__device__ __forceinline__ float wave_max(float v) {
#pragma unroll
    for (int o = 32; o >= 1; o >>= 1) v = fmaxf(v, __shfl_xor(v, o));
    return v;
}
__device__ __forceinline__ float sigmoidf_(float x) { return 1.0f / (1.0f + __expf(-x)); }
__device__ __forceinline__ float siluf_(float x) { return x / (1.0f + __expf(-x)); }

__device__ __forceinline__ int win_cmap(int n) {
    if (n < 5376) return n;
    if (n < 6400) return n + 16;
    if (n < 7424) return n + 16;
    if (n < 7440) return n - 7424 + 5376;
    return -1;
}
__device__ __forceinline__ void tconv_tile(const float* __restrict__ src, int ldsrc, int K, bf16_t* __restrict__ dst, int tk, int tn, bool win, LAS float* tile) {
    const int nl = threadIdx.x & 63, kl0 = threadIdx.x >> 6;
    const int n = tn * 64 + nl;
    const int sc = win ? win_cmap(n) : n;
#pragma unroll
    for (int i = 0; i < 8; ++i) { const int k = kl0 + 8 * i; tile[k * 65 + nl] = sc >= 0 ? src[(size_t)(tk * 64 + k) * ldsrc + sc] : 0.f; }
    __syncthreads();
    const int n2 = threadIdx.x >> 3, kc = (threadIdx.x & 7) * 8;
    u32x4 w;
    w.x = pack2(tile[(kc + 0) * 65 + n2], tile[(kc + 1) * 65 + n2]);
    w.y = pack2(tile[(kc + 2) * 65 + n2], tile[(kc + 3) * 65 + n2]);
    w.z = pack2(tile[(kc + 4) * 65 + n2], tile[(kc + 5) * 65 + n2]);
    w.w = pack2(tile[(kc + 6) * 65 + n2], tile[(kc + 7) * 65 + n2]);
    *(u32x4*)(dst + (size_t)(tn * 64 + n2) * K + tk * 64 + kc) = w;
    __syncthreads();
}
__device__ __forceinline__ void conv_chunk(const float* __restrict__ src, bf16_t* __restrict__ dst, size_t chunk) {
    const size_t e = chunk * 4096 + (size_t)threadIdx.x * 8;
    const f32x4 a = *(const f32x4*)(src + e), b = *(const f32x4*)(src + e + 4);
    u32x4 w; w.x = pack2(a[0], a[1]); w.y = pack2(a[2], a[3]); w.z = pack2(b[0], b[1]); w.w = pack2(b[2], b[3]);
    *(u32x4*)(dst + e) = w;
}
__device__ void phase_prologue(const Params& p, int bid, int nb, LAS unsigned char* lds) {
    LAS float* tile = (LAS float*)lds;
    constexpr int J0 = 16 * 120, J1 = J0 + 16 * 96, J2 = J1 + 16 * 32, J3 = J2 + 256, J4 = J3 + 256, J5 = J4 + 64, J6 = J5 + 4096, J7 = J6 + 4096, J8 = J7 + 32, J9 = J8 + 32, J10 = J9 + 64;
    for (int j = bid; j < J10; j += nb) {
        if (j < J0) { tconv_tile(p.w_in, 7440, 1024, p.WIN_T, j % 16, j / 16, true, tile); }
        else if (j < J1) { const int q = j - J0; tconv_tile(p.w_ada, 6144, 1024, p.WADA_T, q % 16, q / 16, false, tile); }
        else if (j < J2) { const int q = j - J1; tconv_tile(p.w_pq, 2048, 1024, p.WPQ_T, q % 16, q / 16, false, tile); }
        else if (j < J3) { const int q = j - J2; tconv_tile(p.w_br_b, 1024, 1024, p.WBRB_T, q % 16, q / 16, false, tile); }
        else if (j < J4) { const int q = j - J3; tconv_tile(p.w_out, 1024, 1024, p.WOUT_T, q % 16, q / 16, false, tile); }
        else if (j < J5) { const int q = j - J4; tconv_tile(p.w_br_a, 1024, 256, p.WBRA_T, q % 4, q / 4, false, tile); }
        else if (j < J6) { conv_chunk(p.peer_u, p.UB, (size_t)(j - J5)); }
        else if (j < J7) { conv_chunk(p.peer_v, p.VB, (size_t)(j - J6)); }
        else if (j < J8) { conv_chunk(p.peer_k1, p.K1B, (size_t)(j - J7)); }
        else if (j < J9) { conv_chunk(p.peer_k2, p.K2B, (size_t)(j - J8)); }
        else {
            const size_t e = (size_t)(j - J9) * 4096 + (size_t)threadIdx.x * 8;
            const int row = (int)(e >> 10), col = (int)(e & 1023);
            float v[8];
#pragma unroll
            for (int i = 0; i < 8; ++i) v[i] = 0.f;
            if (row < 130) {
                const float* c = row < 2 ? p.c_prompt + (size_t)row * 1024 + col : p.c_sample + (size_t)(row - 2) * 1024 + col;
#pragma unroll
                for (int i = 0; i < 8; ++i) v[i] = siluf_(c[i]);
            }
            u32x4 w; w.x = pack2(v[0], v[1]); w.y = pack2(v[2], v[3]); w.z = pack2(v[4], v[5]); w.w = pack2(v[6], v[7]);
            *(u32x4*)(p.SC + e) = w;
        }
    }
}

__device__ __forceinline__ void row_stats(const float (&v)[16], float& mean, float& rstd) {
    float s = 0.f;
#pragma unroll
    for (int i = 0; i < 16; ++i) s += v[i];
    s = wave_sum(s);
    mean = s * (1.0f / 1024.0f);
    float q = 0.f;
#pragma unroll
    for (int i = 0; i < 16; ++i) { const float d = v[i] - mean; q += d * d; }
    q = wave_sum(q);
    rstd = rsqrtf(q * (1.0f / 1024.0f) + LN_EPS);
}
__device__ __forceinline__ void load_row16(const float* __restrict__ r, int lane, float (&v)[16]) {
    const f32x4 a = *(const f32x4*)(r + 8 * lane), b = *(const f32x4*)(r + 8 * lane + 4), c = *(const f32x4*)(r + 512 + 8 * lane), d = *(const f32x4*)(r + 512 + 8 * lane + 4);
#pragma unroll
    for (int i = 0; i < 4; ++i) { v[i] = a[i]; v[4 + i] = b[i]; v[8 + i] = c[i]; v[12 + i] = d[i]; }
}
__device__ __forceinline__ void store_row16_bf16(bf16_t* __restrict__ r, int lane, const float (&v)[16]) {
    u32x4 w0, w1;
    w0.x = pack2(v[0], v[1]); w0.y = pack2(v[2], v[3]); w0.z = pack2(v[4], v[5]); w0.w = pack2(v[6], v[7]);
    w1.x = pack2(v[8], v[9]); w1.y = pack2(v[10], v[11]); w1.z = pack2(v[12], v[13]); w1.w = pack2(v[14], v[15]);
    *(u32x4*)(r + 8 * lane) = w0; *(u32x4*)(r + 512 + 8 * lane) = w1;
}
__device__ __forceinline__ void store_row16_f32(float* __restrict__ r, int lane, const float (&v)[16]) {
    *(f32x4*)(r + 8 * lane) = (f32x4){v[0], v[1], v[2], v[3]}; *(f32x4*)(r + 8 * lane + 4) = (f32x4){v[4], v[5], v[6], v[7]};
    *(f32x4*)(r + 512 + 8 * lane) = (f32x4){v[8], v[9], v[10], v[11]}; *(f32x4*)(r + 512 + 8 * lane + 4) = (f32x4){v[12], v[13], v[14], v[15]};
}
__device__ __forceinline__ const float* x_row(const Params& p, int row) { return row < NTP ? p.x_prompt + (size_t)row * D : p.x_sample + (size_t)(row - NTP) * D; }
__device__ __forceinline__ int seq_of(int row) { return row < NTP ? (row >> 14) : 2 + (row - NTP); }

__device__ void phase_lnmod1(const Params& p, int bid, int nb) {
    const int wave = threadIdx.x >> 6, lane = threadIdx.x & 63;
    for (int row = bid * 8 + wave; row < MP; row += nb * 8) {
        float v[16];
        if (row >= NT) {
#pragma unroll
            for (int i = 0; i < 16; ++i) v[i] = 0.f;
        } else {
            load_row16(x_row(p, row), lane, v);
            float mean, rstd; row_stats(v, mean, rstd);
            const float* mod = p.MOD + (size_t)seq_of(row) * 6144;
            float sh[16], sc[16];
            load_row16(mod, lane, sh); load_row16(mod + 1024, lane, sc);
#pragma unroll
            for (int i = 0; i < 16; ++i) v[i] = (v[i] - mean) * rstd * (1.0f + sc[i]) + sh[i];
        }
        store_row16_bf16(p.H + (size_t)row * D, lane, v);
    }
}

struct EpiProj {
    static constexpr bool PERM = true, AFTER_DRAIN = false;
    bf16_t *QKVA, *QKB, *VBB, *RB, *GA, *GB; float* GLR; float* out;
    __device__ __forceinline__ void operator()(const pg8::f32x4 (&acc)[2][2][4][2], const pg8::Unit& u, int wr, int wc, int fr, int fq) const {
        const int pn = u.pn;
        bf16_t* dst; int ld = 1024, c0; float scale = 1.0f;
        if (pn < 9) { dst = QKVA; ld = 2304; c0 = pn * 256; }
        else if (pn < 13) { dst = QKB; c0 = (pn - 9) * 256; if (pn < 11) scale = 0.08838834764831845f; }
        else if (pn < 17) { dst = VBB; c0 = (pn - 13) * 256; }
        else if (pn < 21) { dst = RB; c0 = (pn - 17) * 256; }
        else if (pn < 25) { dst = GA; c0 = (pn - 21) * 256; }
        else if (pn < 29) { dst = GB; c0 = (pn - 25) * 256; }
        else { dst = nullptr; c0 = 0; }
        const bool kvt = pn >= 3 && pn < 9;
        const int g = kvt ? (pn - 3) % 3 : 0, kv = kvt ? (pn - 3) / 3 : 0;
        const int W = 128 << (2 * g);
        const size_t offp = g == 0 ? OFF_KVP0 : (g == 1 ? OFF_KVP1 : OFF_KVP2);
        const size_t offs = g == 0 ? OFF_KVS0 : (g == 1 ? OFF_KVS1 : OFF_KVS2);
        const int row0 = u.pm * 256 + wr * 64 + fr, colw = wc * 32 + 8 * fq;
#pragma unroll
        for (int ai = 0; ai < 2; ++ai)
#pragma unroll
            for (int m = 0; m < 4; ++m) {
                const int row = row0 + ai * 128 + m * 16;
#pragma unroll
                for (int bj = 0; bj < 2; ++bj) {
                    const int cc = bj * 128 + colw;
                    const pg8::f32x4 v0 = acc[ai][bj][m][0], v1 = acc[ai][bj][m][1];
                    if (dst) {
                        u32x4 w; w.x = pack2(v0[0] * scale, v0[1] * scale); w.y = pack2(v0[2] * scale, v0[3] * scale); w.z = pack2(v1[0] * scale, v1[1] * scale); w.w = pack2(v1[2] * scale, v1[3] * scale);
                        *(u32x4*)(dst + (size_t)row * ld + c0 + cc) = w;
                    } else if (cc < 16) {
                        *(pg8::f32x4*)(GLR + (size_t)row * 16 + cc) = v0; *(pg8::f32x4*)(GLR + (size_t)row * 16 + cc + 4) = v1;
                    }
                    if (kvt) {
                        if (row < NTP) {
                            const int b = row >> 14, t = row & (T - 1);
                            if (t >= T - W) { float* o = out + offp + ((size_t)(b * W + (t - (T - W))) * 2 + kv) * 256 + cc; *(pg8::f32x4*)o = v0; *(pg8::f32x4*)(o + 4) = v1; }
                        } else if (row < NT) {
                            const int s = row - NTP;
                            float* o = out + offs + ((size_t)(s * W + (W - 1)) * 2 + kv) * 256 + cc; *(pg8::f32x4*)o = v0; *(pg8::f32x4*)(o + 4) = v1;
                        }
                    }
                }
            }
    }
};

__device__ void phase_cache_copy(const Params& p, int bid, int nb) {
    const size_t tid = (size_t)bid * NTHREADS + threadIdx.x, nth = (size_t)nb * NTHREADS;
#pragma unroll
    for (int g = 0; g < 3; ++g) {
        const int W = 128 << (2 * g);
        const float* src = g == 0 ? p.cache128 : (g == 1 ? p.cache512 : p.cache2048);
        float* dst = p.out + (g == 0 ? OFF_KVS0 : (g == 1 ? OFF_KVS1 : OFF_KVS2));
        const size_t per = (size_t)(W - 1) * 128, total = per * NS;
        for (size_t i = tid; i < total; i += nth) {
            const size_t s = i / per, rem = i - s * per;
            const f32x4 v = __builtin_nontemporal_load((const f32x4*)(src + (s * W + 1) * 512) + rem);
            __builtin_nontemporal_store(v, (f32x4*)(dst + s * W * 512) + rem);
        }
    }
}

__device__ __forceinline__ f32x16 mfma32(bf16x8 a, bf16x8 b, f32x16 c) { return __builtin_amdgcn_mfma_f32_32x32x16_bf16(a, b, c, 0, 0, 0); }
__device__ __forceinline__ f32x16 zero16() { f32x16 z; for (int i = 0; i < 16; ++i) z[i] = 0.f; return z; }
__device__ __forceinline__ bf16x8 ld_frag_g(const bf16_t* p) { return *(const bf16x8*)p; }
__device__ __forceinline__ bf16x8 ld_frag_l(const LAS bf16_t* p) { return *(const LAS bf16x8*)p; }
__device__ __forceinline__ int crow(int reg, int hh) { return (reg & 3) + 8 * (reg >> 2) + 4 * hh; }
__device__ __forceinline__ float log_sigmoidf_(float z) { return fminf(z, 0.f) - log1pf(__expf(-fabsf(z))); }

constexpr int KDT_PITCH = 72;
__device__ void phase_gla_prep(const Params& p, int bid, int nb, LAS unsigned char* lds) {
    LAS float* s_glr = (LAS float*)lds;
    LAS float* s_tot = s_glr + 64 * 16;
    LAS bf16_t* s_kdt = (LAS bf16_t*)(s_tot + 4 * 128);
    const int kd = threadIdx.x & 127, q4 = threadIdx.x >> 7;
    for (int u = bid; u < 2048; u += nb) {
        const int bh = u >> 8, c = u & 255, b = bh >> 2, h = bh & 3;
        const int row0 = b * T + c * 64;
        if (threadIdx.x < 256) *(LAS f32x4*)(s_glr + threadIdx.x * 4) = *(const f32x4*)(p.GLR + (size_t)row0 * 16 + threadIdx.x * 4);
        float wup[16];
#pragma unroll
        for (int j = 0; j < 16; ++j) wup[j] = p.w_gla_up[j * 512 + h * 128 + kd];
        const float bg = p.b_gla[h * 128 + kd];
        __syncthreads();
        float pre[16]; float run = 0.f;
#pragma unroll
        for (int i = 0; i < 16; ++i) {
            const int t = q4 * 16 + i; float z = bg;
#pragma unroll
            for (int j = 0; j < 16; ++j) z += s_glr[t * 16 + j] * wup[j];
            run += log_sigmoidf_(z) * (1.0f / 16.0f); pre[i] = run;
        }
        s_tot[q4 * 128 + kd] = run;
        __syncthreads();
        float offs = 0.f, blast = 0.f;
#pragma unroll
        for (int q = 0; q < 4; ++q) { const float tq = s_tot[q * 128 + kd]; if (q < q4) offs += tq; blast += tq; }
#pragma unroll
        for (int i = 0; i < 16; ++i) {
            const int t = q4 * 16 + i; const float bt = offs + pre[i];
            const size_t row = (size_t)(row0 + t);
            const float q = bf2f(p.QKB[row * 1024 + h * 128 + kd]), k = bf2f(p.QKB[row * 1024 + 512 + h * 128 + kd]);
            const size_t o = ((size_t)bh * T + c * 64 + t) * 128 + kd;
            p.QE[o] = f2bf(q * __expf(bt));
            p.KE[o] = f2bf(k * __expf(-bt));
            s_kdt[kd * KDT_PITCH + t] = f2bf(k * __expf(blast - bt));
        }
        if (q4 == 0) p.DL[(size_t)u * 128 + kd] = __expf(blast);
        __syncthreads();
#pragma unroll
        for (int i = 0; i < 2; ++i) { const int q = threadIdx.x + 512 * i, r = q >> 3, ch = q & 7;
            *(u32x4*)(p.KDT + ((size_t)u * 128 + r) * 64 + ch * 8) = *(const LAS u32x4*)(s_kdt + r * KDT_PITCH + ch * 8); }
        __syncthreads();
    }
}

constexpr int VT_PITCH = 72;
__device__ __forceinline__ void stage_vt_chunk(const Params& p, int row0, int h, LAS bf16_t* s_vt) {
#pragma unroll
    for (int i = 0; i < 4; ++i) {
        const int q = threadIdx.x + 512 * i, t = q >> 5, dc = q & 31;
        const u32x4 w = *(const u32x4*)(p.VBB + (size_t)(row0 + t) * 1024 + h * 256 + dc * 8);
        const unsigned ww[4] = {w.x, w.y, w.z, w.w};
#pragma unroll
        for (int e = 0; e < 4; ++e) { s_vt[(dc * 8 + 2 * e) * VT_PITCH + t] = (bf16_t)(ww[e] & 0xffffu); s_vt[(dc * 8 + 2 * e + 1) * VT_PITCH + t] = (bf16_t)(ww[e] >> 16); }
    }
}

__device__ void phase_gla_local(const Params& p, int bid, int nb, LAS unsigned char* lds) {
    LAS bf16_t* s_vt = (LAS bf16_t*)lds;
    const int wave = threadIdx.x >> 6, lane = threadIdx.x & 63, r = lane & 31, hh = lane >> 5;
    const int ni = wave & 3, mg = wave >> 2;
    for (int u = bid; u < 2048; u += nb) {
        const int bh = u >> 8, c = u & 255, b = bh >> 2, h = bh & 3;
        const int row0 = b * T + c * 64;
        stage_vt_chunk(p, row0, h, s_vt);
        __syncthreads();
        bf16x8 bfr[4];
#pragma unroll
        for (int ks = 0; ks < 4; ++ks) bfr[ks] = ld_frag_g(p.KDT + ((size_t)u * 128 + 32 * ni + r) * 64 + 16 * ks + 8 * hh);
#pragma unroll
        for (int mi4 = 0; mi4 < 4; ++mi4) {
            const int mi = mg * 4 + mi4;
            f32x16 acc = zero16();
#pragma unroll
            for (int ks = 0; ks < 4; ++ks) acc = mfma32(ld_frag_l(s_vt + (32 * mi + r) * VT_PITCH + 16 * ks + 8 * hh), bfr[ks], acc);
#pragma unroll
            for (int reg = 0; reg < 16; ++reg) p.LT[((size_t)u * 256 + 32 * mi + crow(reg, hh)) * 128 + 32 * ni + r] = acc[reg];
        }
        __syncthreads();
    }
}

__device__ void phase_gla_scan(const Params& p, int bid, int nb) {
    const int nth = nb * NTHREADS;
    for (int e = bid * NTHREADS + threadIdx.x; e < 8 * 32768; e += nth) {
        const int bh = e >> 15, rem = e & 32767, kd = rem & 127, dv = rem >> 7;
        float S = 0.f;
        for (int c0 = 0; c0 < 256; c0 += 8) {
            float l[8], dl[8];
#pragma unroll
            for (int i = 0; i < 8; ++i) { const size_t u = (size_t)bh * 256 + c0 + i; l[i] = p.LT[u * 32768 + rem]; dl[i] = p.DL[u * 128 + kd]; }
#pragma unroll
            for (int i = 0; i < 8; ++i) { const size_t u = (size_t)bh * 256 + c0 + i; p.SPT[u * 32768 + rem] = f2bf(S); S = dl[i] * S + l[i]; }
        }
        p.out[OFF_GLAP + ((size_t)bh * 128 + kd) * 256 + dv] = S;
    }
}

constexpr int P_PITCH = 72;
__device__ void phase_gla_out(const Params& p, int bid, int nb, LAS unsigned char* lds) {
    LAS bf16_t* s_vt = (LAS bf16_t*)lds;
    LAS bf16_t* s_p = s_vt + 256 * VT_PITCH;
    const int wave = threadIdx.x >> 6, lane = threadIdx.x & 63, r = lane & 31, hh = lane >> 5;
    for (int u = bid; u < 2048; u += nb) {
        const int bh = u >> 8, c = u & 255, b = bh >> 2, h = bh & 3;
        const int row0 = b * T + c * 64;
        const size_t qk0 = ((size_t)bh * T + c * 64) * 128;
        stage_vt_chunk(p, row0, h, s_vt);
        if (wave < 4) {
            const int mi = wave >> 1, ni = wave & 1;
            f32x16 acc = zero16();
#pragma unroll
            for (int ks = 0; ks < 8; ++ks)
                acc = mfma32(ld_frag_g(p.QE + qk0 + (size_t)(32 * mi + r) * 128 + 16 * ks + 8 * hh), ld_frag_g(p.KE + qk0 + (size_t)(32 * ni + r) * 128 + 16 * ks + 8 * hh), acc);
#pragma unroll
            for (int reg = 0; reg < 16; ++reg) { const int t = 32 * mi + crow(reg, hh), s = 32 * ni + r; s_p[t * P_PITCH + s] = f2bf(s <= t ? acc[reg] : 0.f); }
        }
        __syncthreads();
        const int ni = wave;
#pragma unroll
        for (int mi = 0; mi < 2; ++mi) {
            f32x16 acc = zero16();
#pragma unroll
            for (int ks = 0; ks < 4; ++ks) acc = mfma32(ld_frag_l(s_p + (32 * mi + r) * P_PITCH + 16 * ks + 8 * hh), ld_frag_l(s_vt + (32 * ni + r) * VT_PITCH + 16 * ks + 8 * hh), acc);
#pragma unroll
            for (int ks = 0; ks < 8; ++ks)
                acc = mfma32(ld_frag_g(p.QE + qk0 + (size_t)(32 * mi + r) * 128 + 16 * ks + 8 * hh), ld_frag_g(p.SPT + ((size_t)u * 256 + 32 * ni + r) * 128 + 16 * ks + 8 * hh), acc);
#pragma unroll
            for (int reg = 0; reg < 16; ++reg) p.OGLA[(size_t)(row0 + 32 * mi + crow(reg, hh)) * 1024 + h * 256 + 32 * ni + r] = f2bf(acc[reg]);
        }
        __syncthreads();
    }
}

__device__ void phase_gla_sample(const Params& p, int bid, int nb, LAS unsigned char* lds) {
    LAS float* s_eg = (LAS float*)lds;
    LAS float* s_q = s_eg + 128;
    LAS float* s_k = s_q + 128;
    LAS float* s_o = s_k + 128;
    const int dv = threadIdx.x & 255, half = threadIdx.x >> 8;
    for (int u = bid; u < NS * 4; u += nb) {
        const int s = u >> 2, h = u & 3;
        const size_t row = (size_t)(NTP + s);
        if (threadIdx.x < 128) {
            const int kd = threadIdx.x; float z = p.b_gla[h * 128 + kd];
#pragma unroll
            for (int j = 0; j < 16; ++j) z += p.GLR[row * 16 + j] * p.w_gla_up[j * 512 + h * 128 + kd];
            s_eg[kd] = __expf(log_sigmoidf_(z) * (1.0f / 16.0f));
            s_q[kd] = bf2f(p.QKB[row * 1024 + h * 128 + kd]);
            s_k[kd] = bf2f(p.QKB[row * 1024 + 512 + h * 128 + kd]);
        }
        __syncthreads();
        const float v = bf2f(p.VBB[row * 1024 + h * 256 + dv]);
        const float* S0 = p.state_gla + ((size_t)s * 4 + h) * 32768;
        float* Sn = p.out + OFF_GLAS + ((size_t)s * 4 + h) * 32768;
        float o = 0.f;
#pragma unroll 8
        for (int i = 0; i < 64; ++i) { const int kd = half * 64 + i; const float Sv = s_eg[kd] * S0[kd * 256 + dv] + s_k[kd] * v; Sn[kd * 256 + dv] = Sv; o += s_q[kd] * Sv; }
        if (half == 1) s_o[dv] = o;
        __syncthreads();
        if (half == 0) p.OGLA[row * 1024 + h * 256 + dv] = f2bf(o + s_o[dv]);
        __syncthreads();
    }
}

constexpr int AVT_PITCH = 264;
__device__ __forceinline__ float alibi_slope(int g, int j) { return exp2f(-8.0f * (float)(g * 4 + j + 1) / 12.0f); }

__device__ void phase_attn_prompt(const Params& p, int bid, int nb_, LAS unsigned char* lds) {
    LAS bf16_t* s_vt = (LAS bf16_t*)lds;
    const int wave = threadIdx.x >> 6, lane = threadIdx.x & 63, r = lane & 31, hh = lane >> 5;
    const int jj = wave >> 2, qs = wave & 3;
    for (int u = bid; u < 1536; u += nb_) {
        const int hp = u & 1, nbq = (u >> 1) & 127, bg = u >> 8, g = bg % 3, b = bg / 3;
        const int d = 1 << (2 * g), nbk = 128 >> (2 * g);
        const int ph = nbq / nbk, nb = nbq % nbk;
#pragma unroll
        for (int i = 0; i < 8; ++i) {
            const int q = threadIdx.x + 512 * i, hj = q >> 11, key = (q >> 3) & 255, dc = q & 7;
            int lp = 128 * (nb - 1) + key; lp = lp < 0 ? 0 : lp;
            const size_t row = (size_t)b * T + (size_t)lp * d + ph;
            const u32x4 w = *(const u32x4*)(p.QKVA + row * 2304 + 1536 + g * 256 + (2 * hp + hj) * 64 + dc * 8);
            const unsigned ww[4] = {w.x, w.y, w.z, w.w};
            LAS bf16_t* dst = s_vt + hj * 64 * AVT_PITCH + key;
#pragma unroll
            for (int e = 0; e < 4; ++e) { dst[(dc * 8 + 2 * e) * AVT_PITCH] = (bf16_t)(ww[e] & 0xffffu); dst[(dc * 8 + 2 * e + 1) * AVT_PITCH] = (bf16_t)(ww[e] >> 16); }
        }
        __syncthreads();
        const int j = 2 * hp + jj;
        const float slope_d = alibi_slope(g, j) * (float)d;
        const int qi = 32 * qs + r;
        const size_t rowq = (size_t)b * T + (size_t)(128 * nb + qi) * d + ph;
        bf16x8 qf[4];
#pragma unroll
        for (int ks = 0; ks < 4; ++ks) qf[ks] = ld_frag_g(p.QKVA + rowq * 2304 + g * 256 + j * 64 + 16 * ks + 8 * hh);
        float sc[5][16];
#pragma unroll
        for (int kt = 0; kt < 5; ++kt) {
            const int ki = 32 * qs + 32 * kt + r;
            int lp = 128 * (nb - 1) + ki; lp = lp < 0 ? 0 : lp;
            const size_t rowk = (size_t)b * T + (size_t)lp * d + ph;
            f32x16 acc = zero16();
#pragma unroll
            for (int ks = 0; ks < 4; ++ks) acc = mfma32(ld_frag_g(p.QKVA + rowk * 2304 + 768 + g * 256 + j * 64 + 16 * ks + 8 * hh), qf[ks], acc);
#pragma unroll
            for (int reg = 0; reg < 16; ++reg) sc[kt][reg] = acc[reg];
            __builtin_amdgcn_sched_barrier(0);
        }
        float m = -3.0e38f;
        float fb = (float)(r - 4 * hh + 128);
        asm volatile("" : "+v"(fb));
        const float fsmax = nb > 0 ? 128.0f : (float)qi;
#pragma unroll
        for (int kt = 0; kt < 5; ++kt)
#pragma unroll
            for (int reg = 0; reg < 16; ++reg) {
                const float fs = fb - (float)(32 * kt + (reg & 3) + 8 * (reg >> 2));
                const bool valid = fs >= 0.f && fs <= fsmax;
                const float v = valid ? sc[kt][reg] * 0.125f - slope_d * fs : -3.0e38f;
                sc[kt][reg] = v; m = fmaxf(m, v);
            }
        m = fmaxf(m, __shfl_xor(m, 32));
        float z = 0.f;
#pragma unroll
        for (int kt = 0; kt < 5; ++kt)
#pragma unroll
            for (int reg = 0; reg < 16; ++reg) { const float v = sc[kt][reg]; const float e = v > -1.0e38f ? __expf(v - m) : 0.f; sc[kt][reg] = e; z += e; if (reg == 15) __builtin_amdgcn_sched_barrier(0); }
        z += __shfl_xor(z, 32);
        const float rz = 1.0f / z;
        f32x16 o0 = zero16(), o1 = zero16();
        const LAS bf16_t* vt = s_vt + jj * 64 * AVT_PITCH;
#pragma unroll
        for (int kt = 0; kt < 5; ++kt)
#pragma unroll
            for (int s2 = 0; s2 < 2; ++s2) {
                union { bf16x8 v; unsigned w[4]; } pb;
#pragma unroll
                for (int e = 0; e < 4; ++e) pb.w[e] = pack2(sc[kt][8 * s2 + 2 * e] * rz, sc[kt][8 * s2 + 2 * e + 1] * rz);
                const int kbase = 32 * qs + 32 * kt + 16 * s2 + 4 * hh;
#pragma unroll
                for (int dt = 0; dt < 2; ++dt) {
                    union { bf16x8 v; u32x2 h2[2]; } va;
                    va.h2[0] = *(const LAS u32x2*)(vt + (32 * dt + r) * AVT_PITCH + kbase);
                    va.h2[1] = *(const LAS u32x2*)(vt + (32 * dt + r) * AVT_PITCH + kbase + 8);
                    if (dt == 0) o0 = mfma32(va.v, pb.v, o0); else o1 = mfma32(va.v, pb.v, o1);
                }
                __builtin_amdgcn_sched_barrier(0);
            }
        bf16_t* og = p.OG + rowq * 768 + g * 256 + j * 64;
#pragma unroll
        for (int rg = 0; rg < 4; ++rg) {
            u32x2 w0, w1;
            w0.x = pack2(o0[4 * rg + 0], o0[4 * rg + 1]); w0.y = pack2(o0[4 * rg + 2], o0[4 * rg + 3]);
            w1.x = pack2(o1[4 * rg + 0], o1[4 * rg + 1]); w1.y = pack2(o1[4 * rg + 2], o1[4 * rg + 3]);
            *(u32x2*)(og + 8 * rg + 4 * hh) = w0; *(u32x2*)(og + 32 + 8 * rg + 4 * hh) = w1;
        }
        if (hh == 0) p.LSE[rowq * 12 + g * 4 + j] = m + __logf(z);
        __syncthreads();
    }
}

__device__ void phase_attn_sample(const Params& p, int bid, int nb_, LAS unsigned char* lds) {
    LAS float* s_q = (LAS float*)lds;
    LAS float* s_sc = s_q + 256;
    LAS float* s_o = s_sc + 4 * 132;
    const int wave = threadIdx.x >> 6, lane = threadIdx.x & 63;
    for (int u = bid; u < NS * 3; u += nb_) {
        const int s = u / 3, g = u % 3, d = 1 << (2 * g), W = 128 << (2 * g);
        const size_t row = (size_t)(NTP + s);
        const float* cache = (g == 0 ? p.cache128 : (g == 1 ? p.cache512 : p.cache2048)) + (size_t)s * W * 512;
        if (threadIdx.x < 256) s_q[threadIdx.x] = bf2f(p.QKVA[row * 2304 + g * 256 + threadIdx.x]);
        __syncthreads();
        for (int k = wave; k <= 128; k += 8) {
            f32x4 kv;
            if (k == 0) { const u32x2 w = *(const u32x2*)(p.QKVA + row * 2304 + 768 + g * 256 + 4 * lane); kv = (f32x4){bflo(w.x), bfhi(w.x), bflo(w.y), bfhi(w.y)}; }
            else kv = *(const f32x4*)(cache + ((size_t)(W - k * d) * 2 + 0) * 256 + 4 * lane);
            float dot = kv[0] * s_q[4 * lane] + kv[1] * s_q[4 * lane + 1] + kv[2] * s_q[4 * lane + 2] + kv[3] * s_q[4 * lane + 3];
            dot += __shfl_xor(dot, 1); dot += __shfl_xor(dot, 2); dot += __shfl_xor(dot, 4); dot += __shfl_xor(dot, 8);
            if ((lane & 15) == 0) { const int hd = lane >> 4; s_sc[hd * 132 + k] = dot * 0.125f - alibi_slope(g, hd) * (float)(k * d); }
        }
        __syncthreads();
        if (wave < 4) {
            const int hd = wave;
            const float a0 = s_sc[hd * 132 + lane], a1 = s_sc[hd * 132 + 64 + lane], a2 = lane == 0 ? s_sc[hd * 132 + 128] : -3.0e38f;
            const float m = wave_max(fmaxf(fmaxf(a0, a1), a2));
            const float e0 = __expf(a0 - m), e1 = __expf(a1 - m), e2 = lane == 0 ? __expf(a2 - m) : 0.f;
            const float z = wave_sum(e0 + e1 + e2), rz = 1.0f / z;
            s_sc[hd * 132 + lane] = e0 * rz; s_sc[hd * 132 + 64 + lane] = e1 * rz; if (lane == 0) { s_sc[hd * 132 + 128] = e2 * rz; p.LSE[row * 12 + g * 4 + hd] = m + __logf(z); }
        }
        __syncthreads();
        {
            const int col = threadIdx.x & 255, half = threadIdx.x >> 8, hd = col >> 6;
            float o = 0.f;
            for (int k = half; k <= 128; k += 2) {
                const float v = k == 0 ? bf2f(p.QKVA[row * 2304 + 1536 + g * 256 + col]) : cache[((size_t)(W - k * d) * 2 + 1) * 256 + col];
                o += s_sc[hd * 132 + k] * v;
            }
            if (half == 1) s_o[col] = o;
            __syncthreads();
            if (half == 0) p.OG[row * 768 + g * 256 + col] = f2bf(o + s_o[col]);
        }
        __syncthreads();
    }
}

__device__ void phase_merge_prep(const Params& p, int bid, int nb) {
    const int wave = threadIdx.x >> 6, lane = threadIdx.x & 63;
    for (int row = bid * 8 + wave; row < MP; row += nb * 8) {
        const size_t R = (size_t)row;
        if (row >= NT) {
            *(u32x2*)(p.OA + R * 256 + 4 * lane) = (u32x2){0u, 0u};
            *(u32x4*)(p.OB + R * 1024 + 8 * lane) = (u32x4){0u, 0u, 0u, 0u}; *(u32x4*)(p.OB + R * 1024 + 512 + 8 * lane) = (u32x4){0u, 0u, 0u, 0u};
            continue;
        }
        {
            const int j = lane >> 4;
            const float l0 = p.LSE[R * 12 + j], l1 = p.LSE[R * 12 + 4 + j], l2 = p.LSE[R * 12 + 8 + j];
            const float m = fmaxf(l0, fmaxf(l1, l2));
            float w0 = __expf(l0 - m), w1 = __expf(l1 - m), w2 = __expf(l2 - m);
            const float rs = 1.0f / (w0 + w1 + w2); w0 *= rs; w1 *= rs; w2 *= rs;
            const u32x2 a = *(const u32x2*)(p.OG + R * 768 + 4 * lane), b = *(const u32x2*)(p.OG + R * 768 + 256 + 4 * lane), c = *(const u32x2*)(p.OG + R * 768 + 512 + 4 * lane);
            u32x2 o;
            o.x = pack2(w0 * bflo(a.x) + w1 * bflo(b.x) + w2 * bflo(c.x), w0 * bfhi(a.x) + w1 * bfhi(b.x) + w2 * bfhi(c.x));
            o.y = pack2(w0 * bflo(a.y) + w1 * bflo(b.y) + w2 * bflo(c.y), w0 * bfhi(a.y) + w1 * bfhi(b.y) + w2 * bfhi(c.y));
            *(u32x2*)(p.OA + R * 256 + 4 * lane) = o;
        }
        {
#pragma unroll
            for (int part = 0; part < 2; ++part) {
                const int col = part * 512 + 8 * lane;
                const u32x4 ow = *(const u32x4*)(p.OGLA + R * 1024 + col), rw = *(const u32x4*)(p.RB + R * 1024 + col);
                float o[8] = {bflo(ow.x), bfhi(ow.x), bflo(ow.y), bfhi(ow.y), bflo(ow.z), bfhi(ow.z), bflo(ow.w), bfhi(ow.w)};
                const float rb[8] = {bflo(rw.x), bfhi(rw.x), bflo(rw.y), bfhi(rw.y), bflo(rw.z), bfhi(rw.z), bflo(rw.w), bfhi(rw.w)};
                float ss = 0.f;
#pragma unroll
                for (int i = 0; i < 8; ++i) ss += o[i] * o[i];
                ss += __shfl_xor(ss, 1); ss += __shfl_xor(ss, 2); ss += __shfl_xor(ss, 4); ss += __shfl_xor(ss, 8); ss += __shfl_xor(ss, 16);
                const float rn = rsqrtf(ss * (1.0f / 256.0f) + LN_EPS);
                const f32x4 g0 = *(const f32x4*)(p.gla_norm_w + col), g1 = *(const f32x4*)(p.gla_norm_w + col + 4);
                const float gw[8] = {g0[0], g0[1], g0[2], g0[3], g1[0], g1[1], g1[2], g1[3]};
#pragma unroll
                for (int i = 0; i < 8; ++i) o[i] = o[i] * rn * gw[i] * siluf_(rb[i]);
                u32x4 w; w.x = pack2(o[0], o[1]); w.y = pack2(o[2], o[3]); w.z = pack2(o[4], o[5]); w.w = pack2(o[6], o[7]);
                *(u32x4*)(p.OB + R * 1024 + col) = w;
            }
        }
    }
}

__device__ __forceinline__ void unpack8(const u32x4 w, float (&o)[8]) { o[0] = bflo(w.x); o[1] = bfhi(w.x); o[2] = bflo(w.y); o[3] = bfhi(w.y); o[4] = bflo(w.z); o[5] = bfhi(w.z); o[6] = bflo(w.w); o[7] = bfhi(w.w); }
template <int MODE> struct EpiGate {
    static constexpr bool PERM = true, AFTER_DRAIN = false;
    bf16_t* O; const bf16_t* G; const bf16_t* ADD; int ld;
    __device__ __forceinline__ void operator()(const pg8::f32x4 (&acc)[2][2][4][2], const pg8::Unit& u, int wr, int wc, int fr, int fq) const {
        const int row0 = u.pm * 256 + wr * 64 + fr, col0 = u.pn * 256 + wc * 32 + 8 * fq;
#pragma unroll
        for (int ai = 0; ai < 2; ++ai)
#pragma unroll
            for (int m = 0; m < 4; ++m) {
                const size_t row = (size_t)(row0 + ai * 128 + m * 16);
#pragma unroll
                for (int bj = 0; bj < 2; ++bj) {
                    const size_t o = row * ld + col0 + bj * 128;
                    const pg8::f32x4 v0 = acc[ai][bj][m][0], v1 = acc[ai][bj][m][1];
                    float v[8] = {v0[0], v0[1], v0[2], v0[3], v1[0], v1[1], v1[2], v1[3]};
                    if (MODE != 2) {
                        float gg[8]; unpack8(*(const u32x4*)(G + o), gg);
#pragma unroll
                        for (int i = 0; i < 8; ++i) v[i] *= sigmoidf_(gg[i]);
                    }
                    if (MODE == 1) {
                        float aa[8]; unpack8(*(const u32x4*)(ADD + o), aa);
#pragma unroll
                        for (int i = 0; i < 8; ++i) v[i] += aa[i];
                    }
                    u32x4 w; w.x = pack2(v[0], v[1]); w.y = pack2(v[2], v[3]); w.z = pack2(v[4], v[5]); w.w = pack2(v[6], v[7]);
                    *(u32x4*)(O + o) = w;
                }
            }
    }
};
struct EpiOut {
    static constexpr bool PERM = false, AFTER_DRAIN = false;
    float* Z1; const float* x_prompt; const float* x_sample; const float* MOD;
    __device__ __forceinline__ void operator()(const pg8::f32x4 (&acc)[2][2][4][2], const pg8::Unit& u, int wr, int wc, int fr, int fq) const {
        const int row0 = u.pm * 256 + wr * 64 + fr, col0 = u.pn * 256 + wc * 32 + 4 * fq;
#pragma unroll
        for (int ai = 0; ai < 2; ++ai)
#pragma unroll
            for (int m = 0; m < 4; ++m) {
                const int row = row0 + ai * 128 + m * 16;
                if (row >= NT) continue;
                const float* xr = row < NTP ? x_prompt + (size_t)row * D : x_sample + (size_t)(row - NTP) * D;
                const float* g1 = MOD + (size_t)seq_of(row) * 6144 + 2048;
#pragma unroll
                for (int bj = 0; bj < 2; ++bj)
#pragma unroll
                    for (int n = 0; n < 2; ++n) {
                        const int col = col0 + bj * 128 + n * 16;
                        const pg8::f32x4 xv = *(const pg8::f32x4*)(xr + col), gv = *(const pg8::f32x4*)(g1 + col);
                        *(pg8::f32x4*)(Z1 + (size_t)row * D + col) = xv * DN_ALPHA + gv * acc[ai][bj][m][n];
                    }
            }
    }
};

__device__ void phase_ln1(const Params& p, int bid, int nb) {
    const int wave = threadIdx.x >> 6, lane = threadIdx.x & 63;
    for (int row = bid * 8 + wave; row < MP; row += nb * 8) {
        float v[16];
        if (row >= NT) {
#pragma unroll
            for (int i = 0; i < 16; ++i) v[i] = 0.f;
        } else {
            load_row16(p.Z1 + (size_t)row * D, lane, v);
            float mean, rstd; row_stats(v, mean, rstd);
            float w[16], bb[16];
            load_row16(p.ln1_w, lane, w); load_row16(p.ln1_b, lane, bb);
#pragma unroll
            for (int i = 0; i < 16; ++i) v[i] = (v[i] - mean) * rstd * w[i] + bb[i];
            store_row16_f32(p.X1 + (size_t)row * D, lane, v);
            row_stats(v, mean, rstd);
            const float* mod = p.MOD + (size_t)seq_of(row) * 6144;
            load_row16(mod + 3072, lane, bb); load_row16(mod + 4096, lane, w);
#pragma unroll
            for (int i = 0; i < 16; ++i) v[i] = (v[i] - mean) * rstd * (1.0f + w[i]) + bb[i];
        }
        store_row16_bf16(p.H + (size_t)row * D, lane, v);
    }
}

__device__ __forceinline__ unsigned fkey(float f) { const unsigned u = __float_as_uint(f); return (u & 0x80000000u) ? ~u : (u | 0x80000000u); }
__device__ __forceinline__ float keyf(unsigned k) { return __uint_as_float((k & 0x80000000u) ? (k & 0x7fffffffu) : ~k); }
constexpr int SK_PITCH = 129;
__device__ void phase_peer_select(const Params& p, int bid, int nb, LAS unsigned char* lds) {
    LAS unsigned* s_key = (LAS unsigned*)lds;
    LAS unsigned* s_top = s_key + 4 * 64 * SK_PITCH;
    const int wave = threadIdx.x >> 6, lane = threadIdx.x & 63, r = lane & 31, hh = lane >> 5;
    for (int u = bid; u < NT / 64; u += nb) {
        const int row0 = u * 64;
        for (int hp = 0; hp < 4; ++hp) {
#pragma unroll
            for (int jb = 0; jb < 4; ++jb) {
                const int job = wave * 4 + jb, hl = job >> 4, half = (job >> 3) & 1, ti = (job >> 2) & 1, ni = job & 3;
                const int h = 2 * hp + hl;
                const bf16_t* A = p.QV + (size_t)(row0 + 32 * ti + r) * 2048 + h * 256 + half * 128 + 8 * hh;
                const bf16_t* B = (half ? p.K2B : p.K1B) + ((size_t)h * 128 + 32 * ni + r) * 128 + 8 * hh;
                f32x16 acc = zero16();
#pragma unroll
                for (int ks = 0; ks < 8; ++ks) acc = mfma32(ld_frag_g(A + 16 * ks), ld_frag_g(B + 16 * ks), acc);
                LAS unsigned* dst = s_key + ((hl * 2 + half) * 64 + 32 * ti) * SK_PITCH + 32 * ni + r;
                const unsigned tag = 127u - (unsigned)(32 * ni + r);
#pragma unroll
                for (int reg = 0; reg < 16; ++reg) dst[crow(reg, hh) * SK_PITCH] = (fkey(acc[reg]) & ~127u) | tag;
            }
            __syncthreads();
            if (threadIdx.x < 256) {
                const LAS unsigned* k = s_key + threadIdx.x * SK_PITCH;
                unsigned prev = 0xffffffffu;
                for (int pass = 0; pass < 16; ++pass) {
                    unsigned best = 0u;
#pragma unroll 16
                    for (int i = 0; i < 128; ++i) { const unsigned kk = k[i]; best = max(best, kk < prev ? kk : 0u); }
                    s_top[threadIdx.x * 16 + pass] = best; prev = best;
                }
            }
            __syncthreads();
            if (threadIdx.x < 128) {
                const int hl = threadIdx.x >> 6, tok = threadIdx.x & 63;
                const LAS unsigned* t1 = s_top + ((hl * 2 + 0) * 64 + tok) * 16;
                const LAS unsigned* t2 = s_top + ((hl * 2 + 1) * 64 + tok) * 16;
                float v1[16], v2[16];
#pragma unroll
                for (int i = 0; i < 16; ++i) { v1[i] = keyf(t1[i] & ~127u); v2[i] = keyf(t2[i] & ~127u); }
                unsigned ck[50]; int nck = 0;
#pragma unroll
                for (int i = 0; i < 16; ++i)
#pragma unroll
                    for (int j = 0; j < 16; ++j)
                        if ((i + 1) * (j + 1) <= 16) { ck[nck] = (fkey(v1[i] + v2[j]) & ~255u) | (255u - (unsigned)(i * 16 + j)); ++nck; }
                const int row = row0 + tok, h = 2 * hp + hl;
                unsigned prev = 0xffffffffu; float sc0 = 0.f, ssum = 0.f; float ev[16]; int ei[16];
#pragma unroll
                for (int pass = 0; pass < 16; ++pass) {
                    unsigned best = 0u;
#pragma unroll
                    for (int c = 0; c < 50; ++c) best = max(best, ck[c] < prev ? ck[c] : 0u);
                    prev = best;
                    const int ci = 255 - (int)(best & 255u), i1 = ci >> 4, i2 = ci & 15;
                    const float sc = keyf(t1[i1] & ~127u) + keyf(t2[i2] & ~127u);
                    if (pass == 0) sc0 = sc;
                    const float e = __expf(sc - sc0); ev[pass] = e; ssum += e;
                    ei[pass] = (127 - (int)(t1[i1] & 127u)) * 128 + (127 - (int)(t2[i2] & 127u));
                }
                const float rs = 1.0f / ssum;
#pragma unroll
                for (int k4 = 0; k4 < 4; ++k4) {
                    *(int4*)(p.EIDX + (size_t)row * 128 + h * 16 + 4 * k4) = make_int4(ei[4 * k4], ei[4 * k4 + 1], ei[4 * k4 + 2], ei[4 * k4 + 3]);
                    *(f32x4*)(p.EGW + (size_t)row * 128 + h * 16 + 4 * k4) = (f32x4){ev[4 * k4] * rs, ev[4 * k4 + 1] * rs, ev[4 * k4 + 2] * rs, ev[4 * k4 + 3] * rs};
                }
            }
            __syncthreads();
        }
    }
}

__device__ __forceinline__ float gelu_erf(float x) { return 0.5f * x * (1.0f + erff(x * 0.70710678118654752f)); }
__device__ void phase_peer_gather(const Params& p, int bid, int nb, int skip_ff = 0) {
    const int wave = threadIdx.x >> 6, lane = threadIdx.x & 63;
    for (int row = bid * 8 + wave; row < NT; row += nb * 8) {
        const size_t R = (size_t)row;
        float hv[16];
        { float t8[8]; unpack8(*(const u32x4*)(p.H + R * D + 8 * lane), t8);
#pragma unroll
          for (int i = 0; i < 8; ++i) hv[i] = t8[i];
          unpack8(*(const u32x4*)(p.H + R * D + 512 + 8 * lane), t8);
#pragma unroll
          for (int i = 0; i < 8; ++i) hv[8 + i] = t8[i]; }
        float acc[16];
#pragma unroll
        for (int i = 0; i < 16; ++i) acc[i] = 0.f;
        for (int k0 = skip_ff ? 128 : 0; k0 < 128; k0 += 4) {
            int e[4]; float gw[4], dot[4];
#pragma unroll
            for (int q = 0; q < 4; ++q) { e[q] = __builtin_amdgcn_readfirstlane(p.EIDX[R * 128 + k0 + q]); gw[q] = p.EGW[R * 128 + k0 + q]; }
            u32x4 ua[4], ub[4];
#pragma unroll
            for (int q = 0; q < 4; ++q) { const bf16_t* ur = p.UB + (size_t)e[q] * D; ua[q] = *(const u32x4*)(ur + 8 * lane); ub[q] = *(const u32x4*)(ur + 512 + 8 * lane); }
#pragma unroll
            for (int q = 0; q < 4; ++q) {
                float a8[8], b8[8]; unpack8(ua[q], a8); unpack8(ub[q], b8);
                float s = 0.f;
#pragma unroll
                for (int i = 0; i < 8; ++i) s += a8[i] * hv[i] + b8[i] * hv[8 + i];
                dot[q] = s;
            }
#pragma unroll
            for (int o = 32; o >= 1; o >>= 1) {
#pragma unroll
                for (int q = 0; q < 4; ++q) dot[q] += __shfl_xor(dot[q], o);
            }
#pragma unroll
            for (int q = 0; q < 4; ++q) { const bf16_t* vr = p.VB + (size_t)e[q] * D; ua[q] = *(const u32x4*)(vr + 8 * lane); ub[q] = *(const u32x4*)(vr + 512 + 8 * lane); }
#pragma unroll
            for (int q = 0; q < 4; ++q) {
                const float w = gw[q] * gelu_erf(dot[q]);
                float a8[8], b8[8]; unpack8(ua[q], a8); unpack8(ub[q], b8);
#pragma unroll
                for (int i = 0; i < 8; ++i) { acc[i] += w * a8[i]; acc[8 + i] += w * b8[i]; }
            }
        }
        float x1[16], g2[16];
        load_row16(p.X1 + R * D, lane, x1);
        load_row16(p.MOD + (size_t)seq_of(row) * 6144 + 5120, lane, g2);
#pragma unroll
        for (int i = 0; i < 16; ++i) acc[i] = DN_ALPHA * x1[i] + g2[i] * acc[i];
        float mean, rstd; row_stats(acc, mean, rstd);
        load_row16(p.ln2_w, lane, x1); load_row16(p.ln2_b, lane, g2);
#pragma unroll
        for (int i = 0; i < 16; ++i) acc[i] = (acc[i] - mean) * rstd * x1[i] + g2[i];
        float* yo = row < NTP ? p.out + OFF_YP + R * D : p.out + OFF_YS + (size_t)(row - NTP) * D;
        store_row16_f32(yo, lane, acc);
    }
}

__device__ void phase_z1_bypass(const Params& p, int bid, int nb) {
    const int wave = threadIdx.x >> 6, lane = threadIdx.x & 63;
    for (int row = bid * 8 + wave; row < NT; row += nb * 8) {
        float v[16]; load_row16(x_row(p, row), lane, v);
#pragma unroll
        for (int i = 0; i < 16; ++i) v[i] *= DN_ALPHA;
        store_row16_f32(p.Z1 + (size_t)row * D, lane, v);
    }
}

#define DYN_LDS extern __shared__ __attribute__((aligned(16))) unsigned char shm_[]; LAS unsigned char* lds = (LAS unsigned char*)shm_;

__global__ void __launch_bounds__(NTHREADS, 2) k_prologue(Params p) { DYN_LDS; phase_prologue(p, blockIdx.x, gridDim.x, lds); }
__global__ void __launch_bounds__(NTHREADS, 2) k_adaln(Params p) {
    DYN_LDS;
    pg8::StaticOrder S; S.init(256, 6144, (int)gridDim.x, (int)blockIdx.x);
    pg8::Gemm g{p.SC, p.WADA_T, 256, 6144, 1024};
    pg8::EpiF32 E{p.MOD, 6144, p.b_ada};
    pg8::gemm_phase<pg8::EpiF32, pg8::StaticOrder, false>(lds, g, S, E, nullptr);
}
__global__ void __launch_bounds__(NTHREADS, 2) k_lnmod1(Params p) { phase_lnmod1(p, blockIdx.x, gridDim.x); }
__global__ void __launch_bounds__(NTHREADS, 2) k_proj(Params p) {
    DYN_LDS;
    pg8::StaticOrder S; S.init(MP, NPROJ, (int)gridDim.x, (int)blockIdx.x);
    pg8::Gemm g{p.H, p.WIN_T, MP, NPROJ, 1024};
    EpiProj E{p.QKVA, p.QKB, p.VBB, p.RB, p.GA, p.GB, p.GLR, p.out};
    pg8::gemm_phase<EpiProj, pg8::StaticOrder, false>(lds, g, S, E, nullptr);
}
__global__ void __launch_bounds__(NTHREADS, 2) k_cache_copy(Params p) { phase_cache_copy(p, blockIdx.x, gridDim.x); }


#define SIMPLE_K(name, call) __global__ void __launch_bounds__(NTHREADS, 2) name(Params p) { DYN_LDS; (void)lds; call; }
SIMPLE_K(k_gla_prep, phase_gla_prep(p, blockIdx.x, gridDim.x, lds))
SIMPLE_K(k_gla_local, phase_gla_local(p, blockIdx.x, gridDim.x, lds))
SIMPLE_K(k_gla_scan, phase_gla_scan(p, blockIdx.x, gridDim.x))
SIMPLE_K(k_gla_out, phase_gla_out(p, blockIdx.x, gridDim.x, lds))
SIMPLE_K(k_gla_sample, phase_gla_sample(p, blockIdx.x, gridDim.x, lds))
SIMPLE_K(k_attn_prompt, phase_attn_prompt(p, blockIdx.x, gridDim.x, lds))
SIMPLE_K(k_attn_sample, phase_attn_sample(p, blockIdx.x, gridDim.x, lds))
SIMPLE_K(k_merge_prep, phase_merge_prep(p, blockIdx.x, gridDim.x))
SIMPLE_K(k_ln1, phase_ln1(p, blockIdx.x, gridDim.x))
SIMPLE_K(k_peer_select, phase_peer_select(p, blockIdx.x, gridDim.x, lds))
SIMPLE_K(k_peer_gather, phase_peer_gather(p, blockIdx.x, gridDim.x))
SIMPLE_K(k_peer_gather_noff, phase_peer_gather(p, blockIdx.x, gridDim.x, 1))
SIMPLE_K(k_z1_bypass, phase_z1_bypass(p, blockIdx.x, gridDim.x))
template <class Epi> __device__ __forceinline__ void run_gemm(LAS unsigned char* lds, const bf16_t* A, const bf16_t* Bt, int M, int N, int K, const Epi& E) {
    pg8::StaticOrder S; S.init(M, N, (int)gridDim.x, (int)blockIdx.x);
    pg8::Gemm g{A, Bt, M, N, K};
    pg8::gemm_phase<Epi, pg8::StaticOrder, false>(lds, g, S, E, nullptr);
}
__global__ void __launch_bounds__(NTHREADS, 2) k_bra(Params p) { DYN_LDS; run_gemm(lds, p.OA, p.WBRA_T, MP, 1024, 256, EpiGate<0>{p.TMP1, p.GA, nullptr, 1024}); }
__global__ void __launch_bounds__(NTHREADS, 2) k_brb(Params p) { DYN_LDS; run_gemm(lds, p.OB, p.WBRB_T, MP, 1024, 1024, EpiGate<1>{p.MERGED, p.GB, p.TMP1, 1024}); }
__global__ void __launch_bounds__(NTHREADS, 2) k_wout(Params p) { DYN_LDS; run_gemm(lds, p.MERGED, p.WOUT_T, MP, 1024, 1024, EpiOut{p.Z1, p.x_prompt, p.x_sample, p.MOD}); }
__global__ void __launch_bounds__(NTHREADS, 2) k_pq(Params p) { DYN_LDS; run_gemm(lds, p.H, p.WPQ_T, MP, 2048, 1024, EpiGate<2>{p.QV, nullptr, nullptr, 2048}); }
static inline size_t align_up(size_t v, size_t a) { return (v + a - 1) / a * a; }

extern "C" void kernel_launch(void* const* d_in, const int* in_sizes, int n_in, void* d_out, int out_size, void* d_ws, size_t ws_size, hipStream_t stream) {
    (void)in_sizes; (void)n_in; (void)out_size;
    Params p; memset(&p, 0, sizeof(p));
    const float* const* in = (const float* const*)d_in;
    p.x_prompt = in[0]; p.x_sample = in[1]; p.c_prompt = in[2]; p.c_sample = in[3]; p.cache128 = in[4]; p.cache512 = in[5]; p.cache2048 = in[6]; p.state_gla = in[7];
    p.w_ada = in[8]; p.b_ada = in[9]; p.w_in = in[10]; p.w_gla_up = in[11]; p.b_gla = in[12]; p.gla_norm_w = in[13]; p.w_br_a = in[14]; p.w_br_b = in[15]; p.w_out = in[16];
    p.ln1_w = in[17]; p.ln1_b = in[18]; p.w_pq = in[19]; p.peer_k1 = in[20]; p.peer_k2 = in[21]; p.peer_u = in[22]; p.peer_v = in[23]; p.ln2_w = in[24]; p.ln2_b = in[25];
    p.out = (float*)d_out;
    size_t off = 0; char* ws = (char*)d_ws;
#define CARVE(field, type, count) do { p.field = (type*)(ws + off); off = align_up(off + (size_t)(count) * sizeof(type), 256); } while (0)
    CARVE(bar, unsigned, 4096);
    CARVE(MOD, float, 256 * 6144); CARVE(SC, bf16_t, 256 * 1024); CARVE(WADA_T, bf16_t, 6144 * 1024); CARVE(WIN_T, bf16_t, (size_t)NPROJ * 1024);
    CARVE(WBRA_T, bf16_t, 1024 * 256); CARVE(WBRB_T, bf16_t, 1024 * 1024); CARVE(WOUT_T, bf16_t, 1024 * 1024); CARVE(WPQ_T, bf16_t, 2048 * 1024);
    CARVE(K1B, bf16_t, 8 * 128 * 128); CARVE(K2B, bf16_t, 8 * 128 * 128); CARVE(UB, bf16_t, (size_t)16384 * 1024); CARVE(VB, bf16_t, (size_t)16384 * 1024);
    CARVE(H, bf16_t, (size_t)MP * 1024); CARVE(QKVA, bf16_t, (size_t)MP * 2304); CARVE(QKB, bf16_t, (size_t)MP * 1024); CARVE(VBB, bf16_t, (size_t)MP * 1024);
    CARVE(RB, bf16_t, (size_t)MP * 1024); CARVE(GA, bf16_t, (size_t)MP * 1024); CARVE(GB, bf16_t, (size_t)MP * 1024); CARVE(GLR, float, (size_t)MP * 16);
    CARVE(OG, bf16_t, (size_t)MP * 768); CARVE(LSE, float, (size_t)MP * 12);
    CARVE(QE, bf16_t, (size_t)8 * T * 128); CARVE(KE, bf16_t, (size_t)8 * T * 128); CARVE(KDT, bf16_t, (size_t)8 * T * 128); CARVE(DL, float, (size_t)8 * 256 * 128);
    CARVE(LT, float, (size_t)2048 * 256 * 128); CARVE(SPT, bf16_t, (size_t)2048 * 256 * 128); CARVE(OGLA, bf16_t, (size_t)MP * 1024);
    CARVE(OA, bf16_t, (size_t)MP * 256); CARVE(OB, bf16_t, (size_t)MP * 1024); CARVE(TMP1, bf16_t, (size_t)MP * 1024); CARVE(MERGED, bf16_t, (size_t)MP * 1024);
    CARVE(Z1, float, (size_t)MP * 1024); CARVE(X1, float, (size_t)MP * 1024); CARVE(QV, bf16_t, (size_t)MP * 2048); CARVE(EIDX, int, (size_t)MP * 128); CARVE(EGW, float, (size_t)MP * 128);
    if (off > ws_size) { fprintf(stderr, "kernel_launch: workspace too small: need %zu, have %zu\n", off, ws_size); return; }

    static int grid = 0;
    if (!grid) {
        int dev = 0, cus = 0; (void)hipGetDevice(&dev); (void)hipDeviceGetAttribute(&cus, hipDeviceAttributeMultiprocessorCount, dev);
        grid = cus > 0 ? cus : 256;
        const void* ks[] = {(const void*)k_prologue, (const void*)k_adaln, (const void*)k_lnmod1, (const void*)k_proj, (const void*)k_cache_copy, (const void*)k_gla_prep, (const void*)k_gla_local,
            (const void*)k_gla_scan, (const void*)k_gla_out, (const void*)k_gla_sample, (const void*)k_attn_prompt, (const void*)k_attn_sample, (const void*)k_merge_prep, (const void*)k_ln1,
            (const void*)k_peer_select, (const void*)k_peer_gather, (const void*)k_peer_gather_noff, (const void*)k_z1_bypass, (const void*)k_bra, (const void*)k_brb, (const void*)k_wout, (const void*)k_pq};
        for (const void* k : ks) (void)hipFuncSetAttribute(k, hipFuncAttributeMaxDynamicSharedMemorySize, LDS_BYTES);
    }
#define LAUNCH(k) hipLaunchKernelGGL(k, dim3(grid), dim3(NTHREADS), LDS_BYTES, stream, p)
#ifndef DBG_MODE
#define DBG_MODE 3
#endif
    LAUNCH(k_prologue); LAUNCH(k_adaln); LAUNCH(k_lnmod1); LAUNCH(k_proj); LAUNCH(k_cache_copy);
    LAUNCH(k_gla_prep); LAUNCH(k_gla_local); LAUNCH(k_gla_scan); LAUNCH(k_gla_out); LAUNCH(k_gla_sample);
    LAUNCH(k_attn_prompt); LAUNCH(k_attn_sample); LAUNCH(k_merge_prep);
    LAUNCH(k_bra); LAUNCH(k_brb); LAUNCH(k_wout);
    if (DBG_MODE == 1) LAUNCH(k_z1_bypass);
    LAUNCH(k_ln1); LAUNCH(k_pq); LAUNCH(k_peer_select);
    if (DBG_MODE == 3) LAUNCH(k_peer_gather); else LAUNCH(k_peer_gather_noff);
}
```

```cpp
#include <hip/hip_runtime.h>
#include <stdint.h>
#include <stdio.h>
#include <string.h>
#include <type_traits>
namespace pg8 {
#define PG8_LAS __attribute__((address_space(3)))
typedef unsigned short bf16_t;
typedef short bf16x8 __attribute__((ext_vector_type(8)));
typedef float f32x4 __attribute__((ext_vector_type(4)));
typedef unsigned u32x4 __attribute__((ext_vector_type(4)));
constexpr int BM = 256, BK = 64, HALF = 128, HTB = HALF * BK * 2  , STAGE_BYTES = 8 * HTB, NXCD = 8, WGM = 8;

__host__ __device__ __forceinline__ int lds_byte(int r, int c) { const int st = (r >> 4) * 2 + (c >> 5), rr = r & 15, cc = c & 31, ob = rr * 64 + cc * 2; return st * 1024 + (ob ^ (((ob >> 9) & 1) << 5)); }
__host__ __device__ __forceinline__ void stage_rc(int b, int& R, int& C) { const int st = b / 1024, sb = b % 1024, swz = sb ^ (((sb >> 9) & 1) << 5); R = (st >> 1) * 16 + swz / 64; C = (st & 1) * 32 + (swz % 64) / 2; }
__host__ __device__ __forceinline__ int perm32(int rho) { const int n = rho >> 4, i = rho & 15; return 8 * (i >> 2) + 4 * n + (i & 3); }

struct Unit { int pm, pn; };
struct Gemm { const bf16_t* A; const bf16_t* Bt; int M, N, K; };

struct StaticOrder {
    int nM, nN, nwg, G, c;
    __host__ __device__ void init(int M, int N, int G_, int c_) { nM = M / BM; nN = N / BM; nwg = nM * nN; G = G_; c = c_; }
    __host__ __device__ bool next(int i, Unit& u) const {
        const long L = (long)i * G + c; if (L >= nwg) return false;
        int wgid = (int)L; { const int q = nwg / NXCD, r = nwg % NXCD, xcd = wgid % NXCD, off = wgid / NXCD; wgid = (xcd < r ? xcd * (q + 1) : r * (q + 1) + (xcd - r) * q) + off; }
        const int nig = WGM * nN, gid = wgid / nig, fm = gid * WGM, gsz = (nM - fm) < WGM ? (nM - fm) : WGM;
        u.pm = fm + ((wgid % nig) % gsz); u.pn = (wgid % nig) / gsz; return true;
    }
    __device__ __forceinline__ void a_ready(const Unit&) const {}
    __device__ __forceinline__ void done(const Unit&) const {}
};
__device__ __forceinline__ unsigned cvt_pk_bf16(float lo, float hi) { unsigned r; asm volatile("v_cvt_pk_bf16_f32 %0, %1, %2" : "=v"(r) : "v"(lo), "v"(hi)); return r; }
typedef float f32x2 __attribute__((ext_vector_type(2)));
struct EpiF32 {
    static constexpr bool PERM = false, AFTER_DRAIN = false;
    float* C; int ldc; const float* bias;
    __device__ __forceinline__ void operator()(const f32x4 (&acc)[2][2][4][2], const Unit& u, int wr, int wc, int fr, int fq) const {
        const int row0 = u.pm * BM + wr * 64 + fr, col0 = u.pn * BM + wc * 32 + 4 * fq;
        f32x4 bv[2][2];
#pragma unroll
        for (int bj = 0; bj < 2; ++bj)
#pragma unroll
            for (int n = 0; n < 2; ++n) bv[bj][n] = bias ? *(const f32x4*)(bias + col0 + bj * HALF + n * 16) : (f32x4){0.f, 0.f, 0.f, 0.f};
#pragma unroll
        for (int ai = 0; ai < 2; ++ai)
#pragma unroll
            for (int m = 0; m < 4; ++m) { float* rowp = C + (size_t)(row0 + ai * HALF + m * 16) * ldc + col0;
#pragma unroll
                for (int bj = 0; bj < 2; ++bj)
#pragma unroll
                    for (int n = 0; n < 2; ++n) *(f32x4*)(rowp + bj * HALF + n * 16) = acc[ai][bj][m][n] + bv[bj][n]; }
    }
};
template <class Epi, class Sched, bool STAMP = false>
__device__ __forceinline__ void gemm_phase(PG8_LAS unsigned char* lds, const Gemm g, const Sched& S, const Epi& E, unsigned long long* stamps) {
    int tid_o = threadIdx.x; asm volatile("" : "+v"(tid_o));
    const int tid = tid_o, wid = __builtin_amdgcn_readfirstlane(tid >> 6), lane = tid & 63, wr = wid >> 2, wc = wid & 3, fr = lane & 15, fq = lane >> 4;
    const int K = g.K, nt = K / BK;
    int ts_lo = 0, ts_hi = 0, nts = 0; const unsigned long long rt_entry = STAMP ? (unsigned long long)wall_clock64() : 0ull;
#define PG8_STAMP() do { if (STAMP && wid == 0 && nts < 64) { const unsigned long long _c = (unsigned long long)clock64(); \
        ts_lo = (lane == nts) ? (int)(unsigned)_c : ts_lo; ts_hi = (lane == nts) ? (int)(unsigned)(_c >> 32) : ts_hi; ++nts; } } while (0)
    PG8_STAMP();
    unsigned voffA[2], voffB[2];
#pragma unroll
    for (int i = 0; i < 2; ++i) { int R, C; stage_rc(tid * 16 + i * 8192, R, C); const int Rb = Epi::PERM ? ((R & ~31) + perm32(R & 31)) : R;
        voffA[i] = (unsigned)(R * K + C) * 2u; voffB[i] = (unsigned)(Rb * K + C) * 2u; }
    const size_t kstep = (size_t)(BK * 2);
    const size_t hstep = (size_t)HALF * K * 2;
    const size_t tstep = 2 * hstep;
    const unsigned ldsw = (unsigned)wid * 1024u;
    const int aoff = lds_byte(wr * 64 + fr, fq * 8), boff = lds_byte(wc * 32 + fr, fq * 8);
#define PG8_SA(b, h) (((b) * 2 + (h)) * HTB)
#define PG8_SB(b, h) ((4 + (b) * 2 + (h)) * HTB)
#define PG8_STAGE(bufoff, gbase, voff) do { _Pragma("unroll") for (int _i = 0; _i < 2; ++_i) \
        __builtin_amdgcn_global_load_lds((const unsigned*)((const char*)(gbase) + (voff)[_i]), (PG8_LAS unsigned*)(lds + (bufoff) + ldsw + _i * 8192), 16, 0, 0); } while (0)
#define PG8_LDA(dst, b, h) do { _Pragma("unroll") for (int m = 0; m < 4; ++m) _Pragma("unroll") for (int k = 0; k < 2; ++k) dst[m][k] = *(const PG8_LAS bf16x8*)(lds + PG8_SA(b, h) + aoff + m * 2048 + k * 1024); } while (0)
#define PG8_LDB(dst, b, h) do { _Pragma("unroll") for (int n = 0; n < 2; ++n) _Pragma("unroll") for (int k = 0; k < 2; ++k) dst[n][k] = *(const PG8_LAS bf16x8*)(lds + PG8_SB(b, h) + boff + n * 2048 + k * 1024); } while (0)
#define PG8_MMA(ai, bj, At, Bt) do { __builtin_amdgcn_s_setprio(1); _Pragma("unroll") for (int m = 0; m < 4; ++m) _Pragma("unroll") for (int n = 0; n < 2; ++n) _Pragma("unroll") for (int k = 0; k < 2; ++k) \
        acc[ai][bj][m][n] = __builtin_amdgcn_mfma_f32_16x16x32_bf16(Bt[n][k], At[m][k], acc[ai][bj][m][n], 0, 0, 0); __builtin_amdgcn_s_setprio(0); } while (0)
#define PG8_WAIT_V(n) asm volatile("s_waitcnt vmcnt(" #n ")" ::: "memory")
#define PG8_WAIT_L(n) asm volatile("s_waitcnt lgkmcnt(" #n ")" ::: "memory")
#define PG8_BAR __builtin_amdgcn_s_barrier()
#define PG8_SCHED __builtin_amdgcn_sched_barrier(0)
    Unit cur, nxt; int ui = 0;
    if (!S.next(0, cur)) return;
    f32x4 acc[2][2][4][2];
#pragma unroll
    for (int a = 0; a < 2; ++a)
#pragma unroll
        for (int b = 0; b < 2; ++b)
#pragma unroll
            for (int m = 0; m < 4; ++m)
#pragma unroll
                for (int n = 0; n < 2; ++n) acc[a][b][m][n] = (f32x4){0.f, 0.f, 0.f, 0.f};
    bf16x8 At[4][2], B0[2][2], B1[2][2];
    const char* cA = (const char*)g.A + (size_t)cur.pm * tstep; const char* cB = (const char*)g.Bt + (size_t)cur.pn * tstep;
    S.a_ready(cur);
    PG8_STAGE(PG8_SB(0, 0), cB, voffB); PG8_STAGE(PG8_SA(0, 0), cA, voffA); PG8_STAGE(PG8_SB(0, 1), cB + hstep, voffB); PG8_STAGE(PG8_SA(0, 1), cA + hstep, voffA);
    if (wr == 1) PG8_BAR;
    PG8_WAIT_V(4); PG8_BAR;
    PG8_STAGE(PG8_SB(1, 0), cB + kstep, voffB); PG8_STAGE(PG8_SA(1, 0), cA + kstep, voffA); PG8_STAGE(PG8_SB(1, 1), cB + hstep + kstep, voffB);
    PG8_WAIT_V(6); PG8_BAR;
    PG8_STAMP();
    for (;;) {
        const bool has_next = S.next(ui + 1, nxt);
        const char* nA = has_next ? (const char*)g.A + (size_t)nxt.pm * tstep : cA; const char* nB = has_next ? (const char*)g.Bt + (size_t)nxt.pn * tstep : cB;
        for (int t = 0; t < nt; t += 2) {
            const bool last = (t == nt - 2);
            const char* a1 = cA + (size_t)(t + 1) * kstep;
            const char* a2 = last ? nA : cA + (size_t)(t + 2) * kstep; const char* b2 = last ? nB : cB + (size_t)(t + 2) * kstep;
            const char* a3 = a2 + kstep; const char* b3 = b2 + kstep;
            if (last && has_next) S.a_ready(nxt);
            PG8_LDB(B0, 0, 0); PG8_SCHED; PG8_LDA(At, 0, 0); PG8_STAGE(PG8_SA(1, 1), a1 + hstep, voffA);
            PG8_WAIT_L(8); PG8_BAR; PG8_WAIT_L(0); PG8_MMA(0, 0, At, B0); PG8_BAR; PG8_SCHED;
            PG8_LDB(B1, 0, 1); PG8_STAGE(PG8_SB(0, 0), b2, voffB);
            PG8_BAR; PG8_WAIT_L(0); PG8_MMA(0, 1, At, B1); PG8_BAR;
            PG8_LDA(At, 0, 1); PG8_STAGE(PG8_SA(0, 0), a2, voffA);
            PG8_BAR; PG8_WAIT_L(0); PG8_MMA(1, 0, At, B0); PG8_BAR; PG8_SCHED;
            PG8_STAGE(PG8_SB(0, 1), b2 + hstep, voffB);
            PG8_WAIT_V(6); PG8_BAR; PG8_MMA(1, 1, At, B1); PG8_BAR;
            PG8_LDB(B0, 1, 0); PG8_SCHED; PG8_LDA(At, 1, 0); PG8_STAGE(PG8_SA(0, 1), a2 + hstep, voffA);
            PG8_WAIT_L(8); PG8_BAR; PG8_WAIT_L(0); PG8_MMA(0, 0, At, B0); PG8_BAR; PG8_SCHED;
            PG8_LDB(B1, 1, 1); PG8_STAGE(PG8_SB(1, 0), b3, voffB);
            PG8_BAR; PG8_WAIT_L(0); PG8_MMA(0, 1, At, B1); PG8_BAR;
            PG8_LDA(At, 1, 1); PG8_STAGE(PG8_SA(1, 0), a3, voffA);
            PG8_BAR; PG8_WAIT_L(0); PG8_MMA(1, 0, At, B0); PG8_BAR; PG8_SCHED;
            PG8_STAGE(PG8_SB(1, 1), b3 + hstep, voffB);
            PG8_WAIT_V(6); PG8_BAR; PG8_MMA(1, 1, At, B1); PG8_BAR;
        }
        PG8_STAMP();
        if constexpr (!Epi::AFTER_DRAIN) { E(acc, cur, wr, wc, fr, fq); S.done(cur); }
        PG8_STAMP();
        if (!has_next) break;
#pragma unroll
        for (int a = 0; a < 2; ++a)
#pragma unroll
            for (int b = 0; b < 2; ++b)
#pragma unroll
                for (int m = 0; m < 4; ++m)
#pragma unroll
                    for (int n = 0; n < 2; ++n) acc[a][b][m][n] = (f32x4){0.f, 0.f, 0.f, 0.f};
        cur = nxt; cA = nA; cB = nB; ++ui;
    }
    PG8_WAIT_V(0);
    if (wr == 0) PG8_BAR;
    PG8_BAR;
    if constexpr (Epi::AFTER_DRAIN) { E.fused(acc, cur, wr, wc, fr, fq, lds, wid, lane); S.done(cur); }
    PG8_STAMP();
    if (STAMP && wid == 0) { stamps[lane] = lane < nts ? (((unsigned long long)(unsigned)ts_hi << 32) | (unsigned)ts_lo) : 0ull;
        if (lane == 62) stamps[62] = rt_entry; if (lane == 63) stamps[63] = (unsigned long long)wall_clock64(); }
#undef PG8_STAMP
#undef PG8_SA
#undef PG8_SB
#undef PG8_STAGE
#undef PG8_LDA
#undef PG8_LDB
#undef PG8_MMA
#undef PG8_WAIT_V
#undef PG8_WAIT_L
#undef PG8_BAR
#undef PG8_SCHED
}
}

typedef unsigned short bf16_t;
typedef float f32x4 __attribute__((ext_vector_type(4)));
typedef float f32x16 __attribute__((ext_vector_type(16)));
typedef short bf16x8 __attribute__((ext_vector_type(8)));
typedef unsigned u32x4 __attribute__((ext_vector_type(4)));
typedef unsigned u32x2 __attribute__((ext_vector_type(2)));
#define LAS __attribute__((address_space(3)))

constexpr int D = 1024, BP = 2, T = 16384, NTP = BP * T  , NS = 128, NT = NTP + NS  , MP = 33024  ;
constexpr int NPROJ = 7680;
constexpr int NTHREADS = 512;
constexpr int LDS_BYTES = 155648;
constexpr float LN_EPS = 1e-5f;
constexpr float DN_ALPHA = 1.189207115002721f;

constexpr size_t OFF_YP = 0;
constexpr size_t OFF_YS = OFF_YP + (size_t)NTP * D;
constexpr size_t OFF_KVP0 = OFF_YS + (size_t)NS * D;
constexpr size_t OFF_KVP1 = OFF_KVP0 + (size_t)BP * 128 * 512;
constexpr size_t OFF_KVP2 = OFF_KVP1 + (size_t)BP * 512 * 512;
constexpr size_t OFF_GLAP = OFF_KVP2 + (size_t)BP * 2048 * 512;
constexpr size_t OFF_KVS0 = OFF_GLAP + (size_t)BP * 4 * 128 * 256;
constexpr size_t OFF_KVS1 = OFF_KVS0 + (size_t)NS * 128 * 512;
constexpr size_t OFF_KVS2 = OFF_KVS1 + (size_t)NS * 512 * 512;
constexpr size_t OFF_GLAS = OFF_KVS2 + (size_t)NS * 2048 * 512;
constexpr size_t OUT_TOTAL = OFF_GLAS + (size_t)NS * 4 * 128 * 256;

struct Params {
    const float *x_prompt, *x_sample, *c_prompt, *c_sample, *cache128, *cache512, *cache2048, *state_gla;
    const float *w_ada, *b_ada, *w_in, *w_gla_up, *b_gla, *gla_norm_w, *w_br_a, *w_br_b, *w_out, *ln1_w, *ln1_b;
    const float *w_pq, *peer_k1, *peer_k2, *peer_u, *peer_v, *ln2_w, *ln2_b;
    float* out;
    unsigned* bar;
    float* MOD; bf16_t* SC; bf16_t* WADA_T; bf16_t* WIN_T; bf16_t* WBRA_T; bf16_t* WBRB_T; bf16_t* WOUT_T; bf16_t* WPQ_T;
    bf16_t* KF; unsigned char* U8; unsigned char* V8; float* SU; float* SV;
    bf16_t* H; bf16_t* QKVA; bf16_t* QKB; bf16_t* VBB; bf16_t* RB; bf16_t* GA; bf16_t* GB; float* GLR;
    bf16_t* OG; float* LSE; float* LSEG; float* DSEG; float* SSEG; bf16_t* OGLA;
    bf16_t* OA; bf16_t* OB; bf16_t* TMP1; bf16_t* MERGED; float* Z1; float* LNST; bf16_t* QV; int* EIDX; float* EGW; float* ESU; float* EW; unsigned char* H8; float* HS;
};

__device__ __forceinline__ float bf2f(bf16_t v) { return __uint_as_float(((unsigned)v) << 16); }
__device__ __forceinline__ float bflo(unsigned w) { return __uint_as_float(w << 16); }
__device__ __forceinline__ float bfhi(unsigned w) { return __uint_as_float(w & 0xffff0000u); }
typedef __bf16 v2bf_t __attribute__((ext_vector_type(2)));
typedef float v2f_t __attribute__((ext_vector_type(2)));
__device__ __forceinline__ unsigned pack2(float lo, float hi) { const v2f_t f = {lo, hi}; const v2bf_t b = __builtin_convertvector(f, v2bf_t); return __builtin_bit_cast(unsigned, b); }
__device__ __forceinline__ bf16_t f2bf(float f) { return (bf16_t)(pack2(f, 0.f) & 0xffffu); }
__device__ __forceinline__ void unpack8(const u32x4 w, float (&o)[8]) { o[0] = bflo(w.x); o[1] = bfhi(w.x); o[2] = bflo(w.y); o[3] = bfhi(w.y); o[4] = bflo(w.z); o[5] = bfhi(w.z); o[6] = bflo(w.w); o[7] = bfhi(w.w); }
__device__ __forceinline__ float wave_sum(float v) {
#pragma unroll
    for (int o = 32; o >= 1; o >>= 1) v += __shfl_xor(v, o);
    return v;
}
__device__ __forceinline__ float wave_max(float v) {
#pragma unroll
    for (int o = 32; o >= 1; o >>= 1) v = fmaxf(v, __shfl_xor(v, o));
    return v;
}
#define DPP_ROR_F(v, n) __builtin_bit_cast(float, __builtin_amdgcn_update_dpp(0, __builtin_bit_cast(int, (v)), 0x120 + (n), 0xf, 0xf, true))
__device__ __forceinline__ float dpp_row_sum(float v) {
    v += DPP_ROR_F(v, 8); v += DPP_ROR_F(v, 4); v += DPP_ROR_F(v, 2); v += DPP_ROR_F(v, 1); return v;
}
__device__ __forceinline__ float sigmoidf_(float x) { return __builtin_amdgcn_rcpf(1.0f + __expf(-x)); }
__device__ __forceinline__ float siluf_(float x) { return x * __builtin_amdgcn_rcpf(1.0f + __expf(-x)); }
#define XB_TMO      128
#define XB_XCNT(j)  (256  + 64 * (j))
#define XB_XSUB(j)  (1280 + 64 * (j))
#define XB_XGEN(j)  (2304 + 64 * (j))
#define XB_TOP      3328
#define XB_TOPGEN   3392
#define XCD_BAR_WORDS 3456
#define XB_SPIN_CAP (1u << 22)

__device__ __forceinline__ unsigned xb_ld(unsigned* p)              { return __hip_atomic_load(p, __ATOMIC_RELAXED, __HIP_MEMORY_SCOPE_AGENT); }
__device__ __forceinline__ unsigned xb_add(unsigned* p, unsigned v) { return __hip_atomic_fetch_add(p, v, __ATOMIC_RELAXED, __HIP_MEMORY_SCOPE_AGENT); }
__device__ __forceinline__ unsigned xb_xcc_id() { return (unsigned)__builtin_amdgcn_s_getreg((3 << 11) | 20) & 0xFu; }
#define XB_SPIN(cond, bar) do { unsigned _sp = 0; while (cond) { __builtin_amdgcn_s_sleep(1); \
    if ((++_sp & 255u) == 0u) { if (xb_ld(&(bar)[XB_TMO])) break; if (_sp > XB_SPIN_CAP) { atomicAdd(&(bar)[XB_TMO], 1u); break; } } } } while (0)

struct XcdBarrier {
    unsigned* bar; unsigned x;
    volatile LAS unsigned* st;
};

__device__ __forceinline__ XcdBarrier xcd_barrier_post(unsigned* bar, volatile LAS unsigned* st) {
    XcdBarrier b; b.bar = bar; b.x = xb_xcc_id(); b.st = st;
    if (threadIdx.x == 0) (void)xb_add(&bar[XB_XCNT(b.x)], 1u);
    return b;
}
__device__ __forceinline__ void xcd_barrier_complete(unsigned* bar, unsigned x, unsigned& nloc, unsigned& nx) {
    const unsigned G = gridDim.x * gridDim.y * gridDim.z;
    unsigned sum, cnt, mine, sp = 0u;
    for (;;) {
        sum = 0u; cnt = 0u; mine = 0u;
#pragma unroll
        for (unsigned j = 0; j < 16; ++j) { const unsigned c = xb_ld(&bar[XB_XCNT(j)]); sum += c; cnt += (c > 0u) ? 1u : 0u; mine = (j == x) ? c : mine; }
        if (sum == G) break;
        __builtin_amdgcn_s_sleep(1);
        if ((++sp & 255u) == 0u) { if (xb_ld(&bar[XB_TMO])) break; if (sp > XB_SPIN_CAP) { atomicAdd(&bar[XB_TMO], 1u); break; } }
    }
    nloc = mine > 0u ? mine : 1u; nx = cnt > 0u ? cnt : 1u;
}

__device__ __forceinline__ void xcd_barrier(const XcdBarrier& b) {
    asm volatile("s_waitcnt vmcnt(0)" ::: "memory");
    __syncthreads();
    if (threadIdx.x == 0) {
        unsigned* bar = b.bar;
        __builtin_amdgcn_s_waitcnt(0);
        unsigned nloc = b.st[0], nx = b.st[1];
        if (nloc == 0u) { xcd_barrier_complete(bar, b.x, nloc, nx); b.st[0] = nloc; b.st[1] = nx; }
        const unsigned old = xb_add(&bar[XB_XSUB(b.x)], 1u);
        const unsigned gen = old / nloc;
        if (old + 1u == (gen + 1u) * nloc) {
            __builtin_amdgcn_fence(__ATOMIC_RELEASE, "agent");
            asm volatile("s_waitcnt vmcnt(0)" ::: "memory");
            const unsigned og = xb_add(&bar[XB_TOP], 1u);
            const unsigned tg = og / nx;
            if (og + 1u == (tg + 1u) * nx) xb_add(&bar[XB_TOPGEN], 1u);
            else XB_SPIN(xb_ld(&bar[XB_TOPGEN]) == tg, bar);
            __builtin_amdgcn_fence(__ATOMIC_ACQUIRE, "agent");
            xb_add(&bar[XB_XGEN(b.x)], 1u);
            asm volatile("s_waitcnt vmcnt(0)" ::: "memory");
        } else {
            XB_SPIN(xb_ld(&bar[XB_XGEN(b.x)]) == gen, bar);
            __builtin_amdgcn_fence(__ATOMIC_ACQUIRE, "agent");
            asm volatile("s_waitcnt vmcnt(0)" ::: "memory");
        }
    }
    __syncthreads();
}

__device__ __forceinline__ int win_cmap(int n) {
    if (n < 5376) return n;
    if (n < 6400) return n + 16;
    if (n < 7424) return n + 16;
    if (n < 7440) return n - 7424 + 5376;
    return -1;
}
__device__ __forceinline__ void tconv_tile(const float* __restrict__ src, int ldsrc, int K, bf16_t* __restrict__ dst, int tk, int tn, bool win, LAS float* tile) {
    int tid_ = threadIdx.x; asm volatile("" : "+v"(tid_));
    const int nl = tid_ & 63, kl0 = tid_ >> 6;
    const int n = tn * 64 + nl;
    const int sc = win ? win_cmap(n) : n;
#pragma unroll
    for (int i = 0; i < 8; ++i) { const int k = kl0 + 8 * i; tile[k * 65 + nl] = sc >= 0 ? src[(size_t)(tk * 64 + k) * ldsrc + sc] : 0.f; }
    __syncthreads();
    const int n2 = tid_ >> 3, kc = (tid_ & 7) * 8;
    u32x4 w;
    w.x = pack2(tile[(kc + 0) * 65 + n2], tile[(kc + 1) * 65 + n2]);
    w.y = pack2(tile[(kc + 2) * 65 + n2], tile[(kc + 3) * 65 + n2]);
    w.z = pack2(tile[(kc + 4) * 65 + n2], tile[(kc + 5) * 65 + n2]);
    w.w = pack2(tile[(kc + 6) * 65 + n2], tile[(kc + 7) * 65 + n2]);
    *(u32x4*)(dst + (size_t)(tn * 64 + n2) * K + tk * 64 + kc) = w;
    __syncthreads();
}
__device__ __forceinline__ void conv_chunk(const float* __restrict__ src, bf16_t* __restrict__ dst, size_t chunk) {
    int tid_ = threadIdx.x; asm volatile("" : "+v"(tid_));
    const size_t e = chunk * 4096 + (size_t)tid_ * 8;
    const f32x4 a = *(const f32x4*)(src + e), b = *(const f32x4*)(src + e + 4);
    u32x4 w; w.x = pack2(a[0], a[1]); w.y = pack2(a[2], a[3]); w.z = pack2(b[0], b[1]); w.w = pack2(b[2], b[3]);
    *(u32x4*)(dst + e) = w;
}

__device__ __forceinline__ void quant_rows8(const float* __restrict__ src, unsigned char* __restrict__ dst  , float* __restrict__ scl, int job) {
    int tid_ = threadIdx.x; asm volatile("" : "+v"(tid_));
    const int wave = tid_ >> 6, lane = tid_ & 63;
    const size_t row = (size_t)job * 8 + wave;
    const float* r = src + row * 1024 + 16 * lane;
    f32x4 x[4];
#pragma unroll
    for (int i = 0; i < 4; ++i) x[i] = *(const f32x4*)(r + 4 * i);
    float m = 0.f;
#pragma unroll
    for (int i = 0; i < 4; ++i) m = fmaxf(m, fmaxf(fmaxf(fabsf(x[i][0]), fabsf(x[i][1])), fmaxf(fabsf(x[i][2]), fabsf(x[i][3]))));
    m = wave_max(m);
    const float inv = m > 0.f ? 448.0f / m : 1.0f, sc = m > 0.f ? m * (1.0f / 448.0f) : 1.0f;
    u32x4 w;
#pragma unroll
    for (int i = 0; i < 4; ++i) {
        int d = 0;
        d = __builtin_amdgcn_cvt_pk_fp8_f32(x[i][0] * inv, x[i][1] * inv, d, false);
        d = __builtin_amdgcn_cvt_pk_fp8_f32(x[i][2] * inv, x[i][3] * inv, d, true);
        w[i] = (unsigned)d;
    }
    *(u32x4*)(dst + row * 2048 + 16 * lane) = w;
    if (lane == 0) scl[row] = sc;
}

__device__ __forceinline__ void kfrag_chunk(const float* __restrict__ k1, const float* __restrict__ k2, bf16_t* __restrict__ dst, int job) {
    int tid_ = threadIdx.x; asm volatile("" : "+v"(tid_));
    const int c = job * 512 + tid_, lane = c & 63, ks = (c >> 6) & 7, ni = (c >> 9) & 3, half = (c >> 11) & 1, h = c >> 12;
    const float* s = (half ? k2 : k1) + ((size_t)h * 128 + 32 * ni + (lane & 31)) * 128 + 16 * ks + 8 * (lane >> 5);
    const f32x4 a = *(const f32x4*)s, b = *(const f32x4*)(s + 4);
    u32x4 w; w.x = pack2(a[0], a[1]); w.y = pack2(a[2], a[3]); w.z = pack2(b[0], b[1]); w.w = pack2(b[2], b[3]);
    *(u32x4*)(dst + (size_t)c * 8) = w;
}
template <int STAGE> __device__ __forceinline__ void phase_prologue(const Params& p, int bid, int nb, LAS unsigned char* lds, int skip0) {
    int tid_ = threadIdx.x; asm volatile("" : "+v"(tid_));
    LAS float* tile = (LAS float*)lds;
    constexpr int J0 = 16 * 120, J1 = J0 + 16 * 96, J2 = J1 + 16 * 32, J3 = J2 + 256, J4 = J3 + 256, J5 = J4 + 64, J6 = J5 + 2048, J7 = J6 + 2048, J8 = J7 + 32, J9 = J8 + 32, J10 = J9 + 64;
    (void)J8;
    const int njobs = STAGE == 0 ? J1 + (J10 - J9) : J9 - J1;
    const int first = STAGE == 0 ? bid : bid - skip0, stride = STAGE == 0 ? nb : nb - skip0;
    if (first < 0 || stride <= 0) return;
    for (int jj = first; jj < njobs; jj += stride) {
        const int j = STAGE == 0 ? (jj < J1 ? jj : J9 + (jj - J1)) : J1 + jj;
        if (j < J0) { tconv_tile(p.w_in, 7440, 1024, p.WIN_T, j % 16, j / 16, true, tile); }
        else if (j < J1) { const int q = j - J0; tconv_tile(p.w_ada, 6144, 1024, p.WADA_T, q % 16, q / 16, false, tile); }
        else if (j < J2) { const int q = j - J1; tconv_tile(p.w_pq, 2048, 1024, p.WPQ_T, q % 16, q / 16, false, tile); }
        else if (j < J3) { const int q = j - J2; tconv_tile(p.w_br_b, 1024, 1024, p.WBRB_T, q % 16, q / 16, false, tile); }
        else if (j < J4) { const int q = j - J3; tconv_tile(p.w_out, 1024, 1024, p.WOUT_T, q % 16, q / 16, false, tile); }
        else if (j < J5) { const int q = j - J4; tconv_tile(p.w_br_a, 1024, 256, p.WBRA_T, q % 4, q / 4, false, tile); }
        else if (j < J6) { quant_rows8(p.peer_u, p.U8, p.SU, j - J5); }
        else if (j < J7) { quant_rows8(p.peer_v, p.U8 + 1024, p.SV, j - J6); }
        else if (j < J9) { kfrag_chunk(p.peer_k1, p.peer_k2, p.KF, j - J7); }
        else {
            const size_t e = (size_t)(j - J9) * 4096 + (size_t)tid_ * 8;
            const int row = (int)(e >> 10), col = (int)(e & 1023);
            float v[8];
#pragma unroll
            for (int i = 0; i < 8; ++i) v[i] = 0.f;
            if (row < 130) {
                const float* c = row < 2 ? p.c_prompt + (size_t)row * 1024 + col : p.c_sample + (size_t)(row - 2) * 1024 + col;
#pragma unroll
                for (int i = 0; i < 8; ++i) v[i] = siluf_(c[i]);
            }
            u32x4 w; w.x = pack2(v[0], v[1]); w.y = pack2(v[2], v[3]); w.z = pack2(v[4], v[5]); w.w = pack2(v[6], v[7]);
            *(u32x4*)(p.SC + e) = w;
        }
    }
}

__device__ __forceinline__ void row_stats(const float (&v)[16], float& mean, float& rstd) {
    float s = 0.f;
#pragma unroll
    for (int i = 0; i < 16; ++i) s += v[i];
    s = wave_sum(s);
    mean = s * (1.0f / 1024.0f);
    float q = 0.f;
#pragma unroll
    for (int i = 0; i < 16; ++i) { const float d = v[i] - mean; q += d * d; }
    q = wave_sum(q);
    rstd = rsqrtf(q * (1.0f / 1024.0f) + LN_EPS);
}
__device__ __forceinline__ void load_row16(const float* __restrict__ r, int lane, float (&v)[16]) {
    const f32x4 a = *(const f32x4*)(r + 8 * lane), b = *(const f32x4*)(r + 8 * lane + 4), c = *(const f32x4*)(r + 512 + 8 * lane), d = *(const f32x4*)(r + 512 + 8 * lane + 4);
#pragma unroll
    for (int i = 0; i < 4; ++i) { v[i] = a[i]; v[4 + i] = b[i]; v[8 + i] = c[i]; v[12 + i] = d[i]; }
}
__device__ __forceinline__ void store_row16_bf16(bf16_t* __restrict__ r, int lane, const float (&v)[16]) {
    u32x4 w0, w1;
    w0.x = pack2(v[0], v[1]); w0.y = pack2(v[2], v[3]); w0.z = pack2(v[4], v[5]); w0.w = pack2(v[6], v[7]);
    w1.x = pack2(v[8], v[9]); w1.y = pack2(v[10], v[11]); w1.z = pack2(v[12], v[13]); w1.w = pack2(v[14], v[15]);
    *(u32x4*)(r + 8 * lane) = w0; *(u32x4*)(r + 512 + 8 * lane) = w1;
}
__device__ __forceinline__ void store_row16_f32(float* __restrict__ r, int lane, const float (&v)[16]) {
    *(f32x4*)(r + 8 * lane) = (f32x4){v[0], v[1], v[2], v[3]}; *(f32x4*)(r + 8 * lane + 4) = (f32x4){v[4], v[5], v[6], v[7]};
    *(f32x4*)(r + 512 + 8 * lane) = (f32x4){v[8], v[9], v[10], v[11]}; *(f32x4*)(r + 512 + 8 * lane + 4) = (f32x4){v[12], v[13], v[14], v[15]};
}
__device__ __forceinline__ const float* x_row(const Params& p, int row) { return row < NTP ? p.x_prompt + (size_t)row * D : p.x_sample + (size_t)(row - NTP) * D; }
__device__ __forceinline__ int seq_of(int row) { return row < NTP ? (row >> 14) : 2 + (row - NTP); }

__device__ __forceinline__ void phase_lnmod1(const Params& p, int bid, int nb) {
    int tid_ = threadIdx.x; asm volatile("" : "+v"(tid_));
    const int wave = tid_ >> 6, lane = tid_ & 63;
    int row = bid * 8 + wave;
    float nx[16];
    if (row < NT) load_row16(x_row(p, row), lane, nx);
    for (; row < NT; row += nb * 8) {
        float v[16];
#pragma unroll
        for (int i = 0; i < 16; ++i) v[i] = nx[i];
        const int nrow = row + nb * 8;
        if (nrow < NT) load_row16(x_row(p, nrow), lane, nx);
        const float* mod = p.MOD + (size_t)seq_of(row) * 6144;
        float sh[16], sc[16];
        load_row16(mod, lane, sh); load_row16(mod + 1024, lane, sc);
        float mean, rstd; row_stats(v, mean, rstd);
#pragma unroll
        for (int i = 0; i < 16; ++i) v[i] = (v[i] - mean) * rstd * (1.0f + sc[i]) + sh[i];
        store_row16_bf16(p.H + (size_t)row * D, lane, v);
    }
}

struct EpiProj {
    static constexpr bool PERM = true, AFTER_DRAIN = false;
    bf16_t *QKVA, *QKB, *VBB, *RB, *GA, *GB; float* GLR; float* out;
    __device__ __forceinline__ void operator()(const pg8::f32x4 (&acc)[2][2][4][2], const pg8::Unit& u, int wr, int wc, int fr, int fq) const {
        const int pn = u.pn;
        bf16_t* dst; int ld = 1024, c0; float scale = 1.0f;
        if (pn < 9) { dst = QKVA; ld = 2304; c0 = pn * 256; }
        else if (pn < 13) { dst = QKB; c0 = (pn - 9) * 256; if (pn < 11) scale = 0.08838834764831845f; }
        else if (pn < 17) { dst = VBB; c0 = (pn - 13) * 256; }
        else if (pn < 21) { dst = RB; c0 = (pn - 17) * 256; }
        else if (pn < 25) { dst = GA; c0 = (pn - 21) * 256; }
        else if (pn < 29) { dst = GB; c0 = (pn - 25) * 256; }
        else { dst = nullptr; c0 = 0; }
        const bool kvt = pn >= 3 && pn < 9;
        const int g = kvt ? (pn - 3) % 3 : 0, kv = kvt ? (pn - 3) / 3 : 0;
        const int W = 128 << (2 * g);
        const size_t offp = g == 0 ? OFF_KVP0 : (g == 1 ? OFF_KVP1 : OFF_KVP2);
        const size_t offs = g == 0 ? OFF_KVS0 : (g == 1 ? OFF_KVS1 : OFF_KVS2);
        const int row0 = u.pm * 256 + wr * 64 + fr, colw = wc * 32 + 8 * fq;
#pragma unroll
        for (int ai = 0; ai < 2; ++ai)
#pragma unroll
            for (int m = 0; m < 4; ++m) {
                const int row = row0 + ai * 128 + m * 16;
#pragma unroll
                for (int bj = 0; bj < 2; ++bj) {
                    const int cc = bj * 128 + colw;
                    const pg8::f32x4 v0 = acc[ai][bj][m][0], v1 = acc[ai][bj][m][1];
                    if (dst) {
                        u32x4 w; w.x = pack2(v0[0] * scale, v0[1] * scale); w.y = pack2(v0[2] * scale, v0[3] * scale); w.z = pack2(v1[0] * scale, v1[1] * scale); w.w = pack2(v1[2] * scale, v1[3] * scale);
                        *(u32x4*)(dst + (size_t)row * ld + c0 + cc) = w;
                    } else if (cc < 16) {
                        *(pg8::f32x4*)(GLR + (size_t)row * 16 + cc) = v0; *(pg8::f32x4*)(GLR + (size_t)row * 16 + cc + 4) = v1;
                    }
                    if (kvt) {
                        if (row < NTP) {
                            const int b = row >> 14, t = row & (T - 1);
                            if (t >= T - W) { float* o = out + offp + ((size_t)(b * W + (t - (T - W))) * 2 + kv) * 256 + cc; *(pg8::f32x4*)o = v0; *(pg8::f32x4*)(o + 4) = v1; }
                        } else if (row < NT) {
                            const int s = row - NTP;
                            float* o = out + offs + ((size_t)(s * W + (W - 1)) * 2 + kv) * 256 + cc; *(pg8::f32x4*)o = v0; *(pg8::f32x4*)(o + 4) = v1;
                        }
                    }
                }
            }
    }
    __device__ __forceinline__ void emit16(int row, int col, const float (&v)[16]) const {
        const int pn = col >> 8, cc = col & 255;
        bf16_t* dst; int ld = 1024, c0; float scale = 1.0f;
        if (pn < 9) { dst = QKVA; ld = 2304; c0 = pn * 256; }
        else if (pn < 13) { dst = QKB; c0 = (pn - 9) * 256; if (pn < 11) scale = 0.08838834764831845f; }
        else if (pn < 17) { dst = VBB; c0 = (pn - 13) * 256; }
        else if (pn < 21) { dst = RB; c0 = (pn - 17) * 256; }
        else if (pn < 25) { dst = GA; c0 = (pn - 21) * 256; }
        else if (pn < 29) { dst = GB; c0 = (pn - 25) * 256; }
        else { dst = nullptr; c0 = 0; }
        if (dst) {
            u32x4 w0, w1;
            w0.x = pack2(v[0] * scale, v[1] * scale); w0.y = pack2(v[2] * scale, v[3] * scale); w0.z = pack2(v[4] * scale, v[5] * scale); w0.w = pack2(v[6] * scale, v[7] * scale);
            w1.x = pack2(v[8] * scale, v[9] * scale); w1.y = pack2(v[10] * scale, v[11] * scale); w1.z = pack2(v[12] * scale, v[13] * scale); w1.w = pack2(v[14] * scale, v[15] * scale);
            *(u32x4*)(dst + (size_t)row * ld + c0 + cc) = w0; *(u32x4*)(dst + (size_t)row * ld + c0 + cc + 8) = w1;
        } else if (cc == 0) {
#pragma unroll
            for (int i = 0; i < 4; ++i) *(f32x4*)(GLR + (size_t)row * 16 + 4 * i) = (f32x4){v[4 * i], v[4 * i + 1], v[4 * i + 2], v[4 * i + 3]};
        }
        if (pn >= 3 && pn < 9 && row >= NTP && row < NT) {
            const int g = (pn - 3) % 3, kv = (pn - 3) / 3, W = 128 << (2 * g), s = row - NTP;
            float* o = out + (g == 0 ? OFF_KVS0 : (g == 1 ? OFF_KVS1 : OFF_KVS2)) + ((size_t)(s * W + (W - 1)) * 2 + kv) * 256 + cc;
#pragma unroll
            for (int i = 0; i < 4; ++i) *(f32x4*)(o + 4 * i) = (f32x4){v[4 * i], v[4 * i + 1], v[4 * i + 2], v[4 * i + 3]};
        }
    }
};

__device__ __forceinline__ void phase_cache_copy(const Params& p, int bid, int nb) {
    int tid_ = threadIdx.x; asm volatile("" : "+v"(tid_));
    const size_t tid = (size_t)bid * NTHREADS + tid_, nth = (size_t)nb * NTHREADS;
#pragma unroll
    for (int g = 0; g < 3; ++g) {
        const int W = 128 << (2 * g);
        const float* src = g == 0 ? p.cache128 : (g == 1 ? p.cache512 : p.cache2048);
        float* dst = p.out + (g == 0 ? OFF_KVS0 : (g == 1 ? OFF_KVS1 : OFF_KVS2));
        const size_t per = (size_t)(W - 1) * 128, total = per * NS;
        for (size_t i = tid; i < total; i += nth) {
            const size_t s = i / per, rem = i - s * per;
            const f32x4 v = __builtin_nontemporal_load((const f32x4*)(src + (s * W + 1) * 512) + rem);
            __builtin_nontemporal_store(v, (f32x4*)(dst + s * W * 512) + rem);
        }
    }
}

__device__ __forceinline__ f32x16 mfma32(bf16x8 a, bf16x8 b, f32x16 c) { return __builtin_amdgcn_mfma_f32_32x32x16_bf16(a, b, c, 0, 0, 0); }
__device__ __forceinline__ f32x16 zero16() { f32x16 z; for (int i = 0; i < 16; ++i) z[i] = 0.f; return z; }
__device__ __forceinline__ bf16x8 ld_frag_g(const bf16_t* p) { return *(const bf16x8*)p; }
__device__ __forceinline__ bf16x8 ld_frag_l(const LAS bf16_t* p) { return *(const LAS bf16x8*)p; }
__device__ __forceinline__ int crow(int reg, int hh) { return (reg & 3) + 8 * (reg >> 2) + 4 * hh; }
__device__ __forceinline__ float log_sigmoidf_(float z) { return fminf(z, 0.f) - log1pf(__expf(-fabsf(z))); }

__device__ __forceinline__ void phase_gla_sample(const Params& p, int bid, int nb, LAS unsigned char* lds) {
    int tid_ = threadIdx.x; asm volatile("" : "+v"(tid_));
    LAS float* s_eg = (LAS float*)lds;
    LAS float* s_q = s_eg + 128;
    LAS float* s_k = s_q + 128;
    LAS float* s_o = s_k + 128;
    const int dv4 = tid_ & 63, kg = tid_ >> 6;
    for (int u = bid; u < NS * 4; u += nb) {
        const int s = u >> 2, h = u & 3;
        const size_t row = (size_t)(NTP + s);
        const float* S0 = p.state_gla + ((size_t)s * 4 + h) * 32768 + (size_t)(16 * kg) * 256 + 4 * dv4;
        float* Sn = p.out + OFF_GLAS + ((size_t)s * 4 + h) * 32768 + (size_t)(16 * kg) * 256 + 4 * dv4;
        f32x4 st[16];
#pragma unroll
        for (int i = 0; i < 16; ++i) st[i] = __builtin_nontemporal_load((const f32x4*)(S0 + i * 256));
        if (tid_ < 128) {
            const int kd = tid_; float z = p.b_gla[h * 128 + kd];
#pragma unroll
            for (int j = 0; j < 16; ++j) z += p.GLR[row * 16 + j] * p.w_gla_up[j * 512 + h * 128 + kd];
            s_eg[kd] = __expf(log_sigmoidf_(z) * (1.0f / 16.0f));
            s_q[kd] = bf2f(p.QKB[row * 1024 + h * 128 + kd]);
            s_k[kd] = bf2f(p.QKB[row * 1024 + 512 + h * 128 + kd]);
        }
        const u32x2 vw = *(const u32x2*)(p.VBB + row * 1024 + h * 256 + 4 * dv4);
        const f32x4 v4 = {bflo(vw.x), bfhi(vw.x), bflo(vw.y), bfhi(vw.y)};
        __syncthreads();
        f32x4 o = {0.f, 0.f, 0.f, 0.f};
#pragma unroll
        for (int i = 0; i < 16; ++i) {
            const int kd = 16 * kg + i;
            const f32x4 sv = st[i] * s_eg[kd] + v4 * s_k[kd];
            __builtin_nontemporal_store(sv, (f32x4*)(Sn + i * 256));
            o += sv * s_q[kd];
        }
        *(LAS f32x4*)(s_o + kg * 256 + 4 * dv4) = o;
        __syncthreads();
        float t = 0.f;
        if (tid_ < 256) {
#pragma unroll
            for (int w = 0; w < 8; ++w) t += s_o[w * 256 + tid_];
        }
        const float sq = wave_sum(t * t);
        __syncthreads();
        if ((tid_ & 63) == 0) s_o[tid_ >> 6] = sq;
        __syncthreads();
        if (tid_ < 256) {
            const float rn = rsqrtf((s_o[0] + s_o[1] + s_o[2] + s_o[3]) * (1.0f / 256.0f) + LN_EPS);
            p.OB[row * 1024 + h * 256 + tid_] = f2bf(t * rn * p.gla_norm_w[h * 256 + tid_] * siluf_(bf2f(p.RB[row * 1024 + h * 256 + tid_])));
        }
        __syncthreads();
    }
}

constexpr int G2_QP = 136;
constexpr int G2_TP = 72;
constexpr int G2_VP = 264;
typedef short v4s2_t __attribute__((ext_vector_type(4)));
constexpr int G2_BP = 132;
struct Gla2Lds {
    LAS float* glr; LAS float* tot; LAS float* dl; LAS float* bl; LAS float* bt; LAS bf16_t* qe; LAS bf16_t* ke; LAS bf16_t* kdt; LAS bf16_t* vt; LAS bf16_t* pp; LAS float* ss;
    __device__ __forceinline__ void carve(LAS unsigned char* lds) {
        glr = (LAS float*)lds; tot = glr + 1024; dl = tot + 512; bl = dl + 128; bt = bl + 128;
        qe = (LAS bf16_t*)(bt + 64 * G2_BP); ke = qe + 64 * G2_QP; kdt = ke + 64 * G2_QP; vt = kdt + 64 * G2_QP; pp = vt + 64 * G2_VP; ss = (LAS float*)(pp + 64 * G2_TP);
    }
};
struct Gla2Regs { f32x4 glr; u32x4 v[4], k[2], q[2]; };
__device__ __forceinline__ void gla2_load_chunk(const Params& p, Gla2Regs& R, int tid_, int b, int h, int c, bool need_qk) {
    const size_t row0 = (size_t)b * T + (size_t)c * 64;
    R.glr = *(const f32x4*)(p.GLR + row0 * 16 + (tid_ & 255) * 4);
#pragma unroll
    for (int i = 0; i < 4; ++i) { const int q = tid_ + 512 * i, t = q >> 5, dc = q & 31; R.v[i] = *(const u32x4*)(p.VBB + (row0 + t) * 1024 + h * 256 + dc * 8); }
#pragma unroll
    for (int i = 0; i < 2; ++i) { const int it = tid_ + 512 * i, t = it >> 4, kg = it & 15;
        R.k[i] = *(const u32x4*)(p.QKB + (row0 + t) * 1024 + 512 + h * 128 + kg * 8);
        if (need_qk) R.q[i] = *(const u32x4*)(p.QKB + (row0 + t) * 1024 + h * 128 + kg * 8); }
}
__device__ __forceinline__ float gla2_stage_chunk(const Gla2Lds& L, const Gla2Regs& R, int tid_, const float (&wup)[16], float bg, bool need_qk) {
    const int kd = tid_ >> 2, q4 = tid_ & 3;
    if (tid_ < 256) *(LAS f32x4*)(L.glr + tid_ * 4) = R.glr;
#pragma unroll
    for (int i = 0; i < 4; ++i) { const int q = tid_ + 512 * i, t = q >> 5, dc = q & 31; *(LAS u32x4*)(L.vt + t * G2_VP + dc * 8) = R.v[i]; }
    __syncthreads();
    float pre[16]; float run = 0.f;
#pragma unroll
    for (int i = 0; i < 16; ++i) {
        const int t = q4 * 16 + i; float z = bg;
#pragma unroll
        for (int j4 = 0; j4 < 4; ++j4) { const f32x4 gq = *(const LAS f32x4*)(L.glr + t * 16 + 4 * j4); z += gq[0] * wup[4 * j4] + gq[1] * wup[4 * j4 + 1] + gq[2] * wup[4 * j4 + 2] + gq[3] * wup[4 * j4 + 3]; }
        const float ls = fminf(z, 0.f) - __logf(1.0f + __expf(-fabsf(z)));
        run += ls * (1.0f / 16.0f); pre[i] = run;
    }
    const float t0 = __builtin_bit_cast(float, __builtin_amdgcn_update_dpp(0, __builtin_bit_cast(int, run), 0x00, 0xf, 0xf, true));
    const float t1 = __builtin_bit_cast(float, __builtin_amdgcn_update_dpp(0, __builtin_bit_cast(int, run), 0x55, 0xf, 0xf, true));
    const float t2 = __builtin_bit_cast(float, __builtin_amdgcn_update_dpp(0, __builtin_bit_cast(int, run), 0xaa, 0xf, 0xf, true));
    const float t3 = __builtin_bit_cast(float, __builtin_amdgcn_update_dpp(0, __builtin_bit_cast(int, run), 0xff, 0xf, 0xf, true));
    const float offs = (q4 > 0 ? t0 : 0.f) + (q4 > 1 ? t1 : 0.f) + (q4 > 2 ? t2 : 0.f), blast = (t0 + t1) + (t2 + t3);
#pragma unroll
    for (int i = 0; i < 16; ++i) L.bt[(q4 * 16 + i) * G2_BP + kd] = offs + pre[i];
    const float edl = __expf(blast);
    if (q4 == 0) { L.dl[kd] = edl; L.bl[kd] = blast; }
    __syncthreads();
#pragma unroll
    for (int i = 0; i < 2; ++i) {
        const int it = tid_ + 512 * i, t = it >> 4, kg = it & 15;
        const f32x4 b0 = *(const LAS f32x4*)(L.bt + t * G2_BP + 8 * kg), b1 = *(const LAS f32x4*)(L.bt + t * G2_BP + 8 * kg + 4);
        const f32x4 l0 = *(const LAS f32x4*)(L.bl + 8 * kg), l1 = *(const LAS f32x4*)(L.bl + 8 * kg + 4);
        const float bv[8] = {b0[0], b0[1], b0[2], b0[3], b1[0], b1[1], b1[2], b1[3]}, lv[8] = {l0[0], l0[1], l0[2], l0[3], l1[0], l1[1], l1[2], l1[3]};
        float k8[8]; unpack8(R.k[i], k8);
        { float kd8[8];
#pragma unroll
          for (int e = 0; e < 8; ++e) kd8[e] = k8[e] * __expf(lv[e] - bv[e]);
          u32x4 wd; wd.x = pack2(kd8[0], kd8[1]); wd.y = pack2(kd8[2], kd8[3]); wd.z = pack2(kd8[4], kd8[5]); wd.w = pack2(kd8[6], kd8[7]);
          *(LAS u32x4*)(L.kdt + t * G2_QP + 8 * kg) = wd; }
        if (need_qk) {
            float q8[8], qo[8], ko[8]; unpack8(R.q[i], q8);
#pragma unroll
            for (int e = 0; e < 8; ++e) { const float eb = __expf(bv[e]); qo[e] = q8[e] * eb; ko[e] = k8[e] * __builtin_amdgcn_rcpf(eb); }
            u32x4 wq, wk;
            wq.x = pack2(qo[0], qo[1]); wq.y = pack2(qo[2], qo[3]); wq.z = pack2(qo[4], qo[5]); wq.w = pack2(qo[6], qo[7]);
            wk.x = pack2(ko[0], ko[1]); wk.y = pack2(ko[2], ko[3]); wk.z = pack2(ko[4], ko[5]); wk.w = pack2(ko[6], ko[7]);
            *(LAS u32x4*)(L.qe + t * G2_QP + 8 * kg) = wq; *(LAS u32x4*)(L.ke + t * G2_QP + 8 * kg) = wk;
        }
    }
    __syncthreads();
    return edl;
}
__device__ __forceinline__ bf16x8 ld_frag_tr(const LAS bf16_t* img, int pitch, int row0, int col0, int lane) {
    const int i16 = lane & 15, hh = lane >> 5;
    const LAS bf16_t* ap = img + (row0 + 8 * hh + (i16 >> 2)) * pitch + col0 + 16 * ((lane >> 4) & 1) + 4 * (i16 & 3);
    union { bf16x8 v; v4s2_t h2[2]; } f;
    f.h2[0] = __builtin_amdgcn_ds_read_tr16_b64_v4i16((LAS v4s2_t*)ap);
    f.h2[1] = __builtin_amdgcn_ds_read_tr16_b64_v4i16((LAS v4s2_t*)(ap + 4 * pitch));
    return f.v;
}
__device__ __forceinline__ void gla2_update_state(const Gla2Lds& L, f32x16 (&S)[4], int wave, int lane) {
    const int hh = lane >> 5;
    bf16x8 vf[4];
#pragma unroll
    for (int ks = 0; ks < 4; ++ks) vf[ks] = ld_frag_tr(L.vt, G2_VP, 16 * ks, 32 * wave, lane);
#pragma unroll
    for (int mi = 0; mi < 4; ++mi) {
#pragma unroll
        for (int g4 = 0; g4 < 4; ++g4) {
            const f32x4 d = *(const LAS f32x4*)(L.dl + 32 * mi + 8 * g4 + 4 * hh);
#pragma unroll
            for (int j = 0; j < 4; ++j) S[mi][4 * g4 + j] *= d[j];
        }
#pragma unroll
        for (int ks = 0; ks < 4; ++ks) S[mi] = mfma32(ld_frag_tr(L.kdt, G2_QP, 16 * ks, 32 * mi, lane), vf[ks], S[mi]);
    }
}
__device__ __forceinline__ void phase_gla2_passA(const Params& p, int bid, int nb, LAS unsigned char* lds) {
    int tid_ = threadIdx.x; asm volatile("" : "+v"(tid_));
    Gla2Lds L; L.carve(lds);
    const int wave = tid_ >> 6, lane = tid_ & 63;
    for (int u = bid; u < 256; u += nb) {
        const int bh = u >> 5, seg = u & 31, b = bh >> 2, h = bh & 3;
        float wup[16];
#pragma unroll
        for (int j = 0; j < 16; ++j) wup[j] = p.w_gla_up[j * 512 + h * 128 + (tid_ >> 2)];
        const float bg = p.b_gla[h * 128 + (tid_ >> 2)];
        f32x16 S[4];
#pragma unroll
        for (int mi = 0; mi < 4; ++mi) S[mi] = zero16();
        float dprod = 1.0f;
        Gla2Regs R; gla2_load_chunk(p, R, tid_, b, h, seg * 8, false);
        for (int cc = 0; cc < 8; ++cc) {
            int tq = tid_; asm volatile("" : "+v"(tq));
            dprod *= gla2_stage_chunk(L, R, tq, wup, bg, false);
            if (cc < 7) gla2_load_chunk(p, R, tq, b, h, seg * 8 + cc + 1, false);
            gla2_update_state(L, S, wave, tq & 63);
            __syncthreads();
        }
        float* dst = p.LSEG + (size_t)u * 32768 + (size_t)wave * 4096 + lane;
#pragma unroll
        for (int mi = 0; mi < 4; ++mi)
#pragma unroll
            for (int reg = 0; reg < 16; ++reg) dst[(mi * 16 + reg) * 64] = S[mi][reg];
        if ((tid_ & 3) == 0) p.DSEG[(size_t)u * 128 + (tid_ >> 2)] = dprod;
    }
}
__device__ __forceinline__ void phase_gla2_scan(const Params& p, int bid, int nb) {
    int tid_ = threadIdx.x; asm volatile("" : "+v"(tid_));
    for (int e = bid * NTHREADS + tid_; e < 8 * 32768; e += nb * NTHREADS) {
        const int bh = e >> 15, idx = e & 32767, w = idx >> 12, rem = idx & 4095, mr = rem >> 6, ln = rem & 63, mi = mr >> 4, reg = mr & 15;
        const int kd = 32 * mi + crow(reg, ln >> 5), dv = 32 * w + (ln & 31);
        float S = 0.f;
        for (int s0 = 0; s0 < 32; s0 += 8) {
            float l[8], d[8];
#pragma unroll
            for (int i = 0; i < 8; ++i) { const size_t u = (size_t)bh * 32 + s0 + i; l[i] = p.LSEG[u * 32768 + idx]; d[i] = p.DSEG[u * 128 + kd]; }
#pragma unroll
            for (int i = 0; i < 8; ++i) { const size_t u = (size_t)bh * 32 + s0 + i; p.SSEG[u * 32768 + idx] = S; S = d[i] * S + l[i]; }
        }
        p.out[OFF_GLAP + ((size_t)bh * 128 + kd) * 256 + dv] = S;
    }
}
__device__ __forceinline__ void phase_gla2_passC(const Params& p, int bid, int nb, LAS unsigned char* lds) {
    int tid_ = threadIdx.x; asm volatile("" : "+v"(tid_));
    Gla2Lds L; L.carve(lds);
    const int wave = tid_ >> 6, lane = tid_ & 63;
    for (int u = bid; u < 256; u += nb) {
        const int bh = u >> 5, seg = u & 31, b = bh >> 2, h = bh & 3;
        float wup[16];
#pragma unroll
        for (int j = 0; j < 16; ++j) wup[j] = p.w_gla_up[j * 512 + h * 128 + (tid_ >> 2)];
        const float bg = p.b_gla[h * 128 + (tid_ >> 2)];
        Gla2Regs R; gla2_load_chunk(p, R, tid_, b, h, seg * 8, true);
        f32x16 S[4];
        {
            const float* src = p.SSEG + (size_t)u * 32768 + (size_t)wave * 4096 + lane;
#pragma unroll
            for (int mi = 0; mi < 4; ++mi)
#pragma unroll
                for (int reg = 0; reg < 16; ++reg) S[mi][reg] = src[(mi * 16 + reg) * 64];
        }
        for (int cc = 0; cc < 8; ++cc) {
            const int c = seg * 8 + cc, row0 = b * T + c * 64;
            int tq = tid_; asm volatile("" : "+v"(tq));
            const int r = tq & 31, hh = (tq >> 5) & 1;
            gla2_stage_chunk(L, R, tq, wup, bg, true);
            if (cc < 7) gla2_load_chunk(p, R, tq, b, h, c + 1, true);
            if (wave < 4) {
                const int mi = wave >> 1, ni = wave & 1;
                f32x16 acc = zero16();
#pragma unroll
                for (int ks = 0; ks < 8; ++ks) acc = mfma32(ld_frag_l(L.ke + (32 * ni + r) * G2_QP + 16 * ks + 8 * hh), ld_frag_l(L.qe + (32 * mi + r) * G2_QP + 16 * ks + 8 * hh), acc);
                const int t = 32 * mi + r;
#pragma unroll
                for (int rg = 0; rg < 4; ++rg) {
                    const int s0 = 32 * ni + 8 * rg + 4 * hh;
                    u32x2 w;
                    w.x = pack2(s0 + 0 <= t ? acc[4 * rg + 0] : 0.f, s0 + 1 <= t ? acc[4 * rg + 1] : 0.f);
                    w.y = pack2(s0 + 2 <= t ? acc[4 * rg + 2] : 0.f, s0 + 3 <= t ? acc[4 * rg + 3] : 0.f);
                    *(LAS u32x2*)(L.pp + t * G2_TP + s0) = w;
                }
            }
            union { bf16x8 v; unsigned w[4]; } sb[4][2];
#pragma unroll
            for (int mi = 0; mi < 4; ++mi)
#pragma unroll
                for (int s2 = 0; s2 < 2; ++s2)
#pragma unroll
                    for (int e = 0; e < 4; ++e) sb[mi][s2].w[e] = pack2(S[mi][8 * s2 + 2 * e], S[mi][8 * s2 + 2 * e + 1]);
            __syncthreads();
            f32x16 oacc[2];
#pragma unroll
            for (int tt = 0; tt < 2; ++tt) {
                f32x16 acc = zero16();
#pragma unroll
                for (int ks = 0; ks < 4; ++ks) acc = mfma32(ld_frag_tr(L.vt, G2_VP, 16 * ks, 32 * wave, tq & 63), ld_frag_l(L.pp + (32 * tt + r) * G2_TP + 16 * ks + 8 * hh), acc);
#pragma unroll
                for (int mi = 0; mi < 4; ++mi)
#pragma unroll
                    for (int s2 = 0; s2 < 2; ++s2) {
                        union { bf16x8 v; u32x2 h2[2]; } qa;
                        const LAS bf16_t* qp = L.qe + (32 * tt + r) * G2_QP + 32 * mi + 16 * s2 + 4 * hh;
                        qa.h2[0] = *(const LAS u32x2*)qp; qa.h2[1] = *(const LAS u32x2*)(qp + 8);
                        acc = mfma32(sb[mi][s2].v, qa.v, acc);
                    }
                float sq = 0.f;
#pragma unroll
                for (int i = 0; i < 16; ++i) sq += acc[i] * acc[i];
                sq += __shfl_xor(sq, 32);
                if (hh == 0) L.ss[wave * 64 + 32 * tt + r] = sq;
                oacc[tt] = acc;
            }
            gla2_update_state(L, S, wave, tq & 63);
            __syncthreads();
#pragma unroll
            for (int tt = 0; tt < 2; ++tt) {
                float tot = 0.f;
#pragma unroll
                for (int w = 0; w < 8; ++w) tot += L.ss[w * 64 + 32 * tt + r];
                const float rn = rsqrtf(tot * (1.0f / 256.0f) + LN_EPS);
                const size_t ro = (size_t)(row0 + 32 * tt + r) * 1024 + h * 256 + 32 * wave + 4 * hh;
                const float* gw = p.gla_norm_w + h * 256 + 32 * wave + 4 * hh;
#pragma unroll
                for (int rg = 0; rg < 4; ++rg) {
                    const u32x2 rw = *(const u32x2*)(p.RB + ro + 8 * rg);
                    const f32x4 g4 = *(const f32x4*)(gw + 8 * rg);
                    const float o0 = oacc[tt][4 * rg + 0] * rn * g4[0] * siluf_(bflo(rw.x)), o1 = oacc[tt][4 * rg + 1] * rn * g4[1] * siluf_(bfhi(rw.x));
                    const float o2 = oacc[tt][4 * rg + 2] * rn * g4[2] * siluf_(bflo(rw.y)), o3 = oacc[tt][4 * rg + 3] * rn * g4[3] * siluf_(bfhi(rw.y));
                    u32x2 w; w.x = pack2(o0, o1); w.y = pack2(o2, o3);
                    *(u32x2*)(p.OB + ro + 8 * rg) = w;
                }
            }
            __syncthreads();
        }
    }
}

constexpr int AKV_PITCH = 72;
typedef short v4s_t __attribute__((ext_vector_type(4)));
__device__ __forceinline__ float alibi_slope(int g, int j) { return exp2f(-8.0f * (float)(g * 4 + j + 1) / 12.0f); }

__device__ __forceinline__ void phase_attn_prompt(const Params& p, int bid, int nb_, LAS unsigned char* lds) {
    int tid_ = threadIdx.x; asm volatile("" : "+v"(tid_));
    LAS bf16_t* s_k = (LAS bf16_t*)lds;
    LAS bf16_t* s_v = s_k + 2 * 256 * AKV_PITCH;
    const int wave = tid_ >> 6, lane = tid_ & 63, r = lane & 31, hh = lane >> 5;
    const int jj = wave >> 2, qs = wave & 3;
    for (int u = bid; u < 1536; u += nb_) {
        const int hp = u & 1, nbq = (u >> 1) & 127, bg = u >> 8, g = bg % 3, b = bg / 3;
        const int d = 1 << (2 * g), nbk = 128 >> (2 * g);
        const int ph = nbq / nbk, nb = nbq % nbk;
#pragma unroll
        for (int half = 0; half < 2; ++half) {
            u32x4 w[8];
#pragma unroll
            for (int i = 0; i < 8; ++i) {
                const int q = tid_ + 512 * i, hj = q >> 11, key = (q >> 3) & 255, dc = q & 7;
                int lp = 128 * (nb - 1) + key; lp = lp < 0 ? 0 : lp;
                const size_t row = (size_t)b * T + (size_t)lp * d + ph;
                w[i] = *(const u32x4*)(p.QKVA + row * 2304 + (half ? 1536 : 768) + g * 256 + (2 * hp + hj) * 64 + dc * 8);
            }
#pragma unroll
            for (int i = 0; i < 8; ++i) {
                const int q = tid_ + 512 * i, hj = q >> 11, key = (q >> 3) & 255, dc = q & 7;
                *(LAS u32x4*)((half ? s_v : s_k) + (hj * 256 + key) * AKV_PITCH + dc * 8) = w[i];
            }
        }
        const int j = 2 * hp + jj;
        const float slope_d = alibi_slope(g, j) * (float)d;
        const int qi = 32 * qs + r;
        const size_t rowq = (size_t)b * T + (size_t)(128 * nb + qi) * d + ph;
        bf16x8 qf[4];
#pragma unroll
        for (int ks = 0; ks < 4; ++ks) qf[ks] = ld_frag_g(p.QKVA + rowq * 2304 + g * 256 + j * 64 + 16 * ks + 8 * hh);
        __syncthreads();
        float sc[5][16];
        const LAS bf16_t* kb = s_k + (jj * 256 + 32 * qs + r) * AKV_PITCH + 8 * hh;
#pragma unroll
        for (int kt = 0; kt < 5; ++kt) {
            f32x16 acc = zero16();
#pragma unroll
            for (int ks = 0; ks < 4; ++ks) acc = mfma32(ld_frag_l(kb + (32 * kt) * AKV_PITCH + 16 * ks), qf[ks], acc);
#pragma unroll
            for (int reg = 0; reg < 16; ++reg) sc[kt][reg] = acc[reg];
        }
        float m = -3.0e38f;
        float fb = (float)(r - 4 * hh + 128);
        asm volatile("" : "+v"(fb));
        const float fsmax = nb > 0 ? 128.0f : (float)qi;
#pragma unroll
        for (int kt = 0; kt < 5; ++kt)
#pragma unroll
            for (int reg = 0; reg < 16; ++reg) {
                const float fs = fb - (float)(32 * kt + (reg & 3) + 8 * (reg >> 2));
                const bool valid = fs >= 0.f && fs <= fsmax;
                const float v = valid ? sc[kt][reg] * 0.125f - slope_d * fs : -3.0e38f;
                sc[kt][reg] = v; m = fmaxf(m, v);
            }
        m = fmaxf(m, __shfl_xor(m, 32));
        float z = 0.f;
#pragma unroll
        for (int kt = 0; kt < 5; ++kt)
#pragma unroll
            for (int reg = 0; reg < 16; ++reg) { const float v = sc[kt][reg]; const float e = v > -1.0e38f ? __expf(v - m) : 0.f; sc[kt][reg] = e; z += e; if (reg == 15) __builtin_amdgcn_sched_barrier(0); }
        z += __shfl_xor(z, 32);
        const float rz = 1.0f / z;
        f32x16 o0 = zero16(), o1 = zero16();
        const int i16 = lane & 15;
        const LAS bf16_t* vb = s_v + (jj * 256 + 32 * qs + 4 * hh + (i16 >> 2)) * AKV_PITCH + 16 * ((lane >> 4) & 1) + 4 * (i16 & 3);
#pragma unroll
        for (int kt = 0; kt < 5; ++kt)
#pragma unroll
            for (int s2 = 0; s2 < 2; ++s2) {
                union { bf16x8 v; unsigned w[4]; } pb;
#pragma unroll
                for (int e = 0; e < 4; ++e) pb.w[e] = pack2(sc[kt][8 * s2 + 2 * e] * rz, sc[kt][8 * s2 + 2 * e + 1] * rz);
#pragma unroll
                for (int dt = 0; dt < 2; ++dt) {
                    union { bf16x8 v; v4s_t h2[2]; } va;
                    const LAS bf16_t* ap = vb + (32 * kt + 16 * s2) * AKV_PITCH + 32 * dt;
                    va.h2[0] = __builtin_amdgcn_ds_read_tr16_b64_v4i16((LAS v4s_t*)ap);
                    va.h2[1] = __builtin_amdgcn_ds_read_tr16_b64_v4i16((LAS v4s_t*)(ap + 8 * AKV_PITCH));
                    if (dt == 0) o0 = mfma32(va.v, pb.v, o0); else o1 = mfma32(va.v, pb.v, o1);
                }
                __builtin_amdgcn_sched_barrier(0);
            }
        bf16_t* og = p.OG + rowq * 768 + g * 256 + j * 64;
#pragma unroll
        for (int rg = 0; rg < 4; ++rg) {
            u32x2 w0, w1;
            w0.x = pack2(o0[4 * rg + 0], o0[4 * rg + 1]); w0.y = pack2(o0[4 * rg + 2], o0[4 * rg + 3]);
            w1.x = pack2(o1[4 * rg + 0], o1[4 * rg + 1]); w1.y = pack2(o1[4 * rg + 2], o1[4 * rg + 3]);
            *(u32x2*)(og + 8 * rg + 4 * hh) = w0; *(u32x2*)(og + 32 + 8 * rg + 4 * hh) = w1;
        }
        if (hh == 0) p.LSE[rowq * 12 + g * 4 + j] = m + __logf(z);
        __syncthreads();
    }
}

__device__ __forceinline__ void phase_attn_sample(const Params& p, int bid, int nb_, LAS unsigned char* lds) {
    int tid_ = threadIdx.x; asm volatile("" : "+v"(tid_));
    LAS float* s_sc = (LAS float*)lds;
    LAS float* s_o = s_sc + 4 * 132;
    const int wave = tid_ >> 6, lane = tid_ & 63, hd = lane >> 4;
    for (int u = bid; u < NS * 3; u += nb_) {
        const int s = u / 3, g = u % 3, d = 1 << (2 * g), W = 128 << (2 * g);
        const size_t row = (size_t)(NTP + s);
        const float* cache = (g == 0 ? p.cache128 : (g == 1 ? p.cache512 : p.cache2048)) + (size_t)s * W * 512;
        const int nk = wave == 0 ? 17 : 16;
        f32x4 kr[17];
#pragma unroll
        for (int i = 0; i < 17; ++i) {
            const int k = wave + 8 * i;
            if (i < nk) {
                if (k == 0) { const u32x2 w = *(const u32x2*)(p.QKVA + row * 2304 + 768 + g * 256 + 4 * lane); kr[i] = (f32x4){bflo(w.x), bfhi(w.x), bflo(w.y), bfhi(w.y)}; }
                else kr[i] = *(const f32x4*)(cache + ((size_t)(W - k * d) * 2 + 0) * 256 + 4 * lane);
            } else kr[i] = (f32x4){0.f, 0.f, 0.f, 0.f};
        }
        const u32x2 qw = *(const u32x2*)(p.QKVA + row * 2304 + g * 256 + 4 * lane);
        const f32x4 q4 = {bflo(qw.x), bfhi(qw.x), bflo(qw.y), bfhi(qw.y)};
        const float slope = alibi_slope(g, hd);
#pragma unroll
        for (int i = 0; i < 17; ++i) {
            const int k = wave + 8 * i;
            float dot = kr[i][0] * q4[0] + kr[i][1] * q4[1] + kr[i][2] * q4[2] + kr[i][3] * q4[3];
            dot = dpp_row_sum(dot);
            if (i < nk && (lane & 15) == 0) s_sc[hd * 132 + k] = dot * 0.125f - slope * (float)(k * d);
        }
        f32x4 vr[17];
#pragma unroll
        for (int i = 0; i < 17; ++i) {
            const int k = wave + 8 * i;
            if (i < nk) {
                if (k == 0) { const u32x2 w = *(const u32x2*)(p.QKVA + row * 2304 + 1536 + g * 256 + 4 * lane); vr[i] = (f32x4){bflo(w.x), bfhi(w.x), bflo(w.y), bfhi(w.y)}; }
                else vr[i] = *(const f32x4*)(cache + ((size_t)(W - k * d) * 2 + 1) * 256 + 4 * lane);
            } else vr[i] = (f32x4){0.f, 0.f, 0.f, 0.f};
        }
        __syncthreads();
        if (wave < 4) {
            const int h2 = wave;
            const float a0 = s_sc[h2 * 132 + lane], a1 = s_sc[h2 * 132 + 64 + lane], a2 = lane == 0 ? s_sc[h2 * 132 + 128] : -3.0e38f;
            const float m = wave_max(fmaxf(fmaxf(a0, a1), a2));
            const float e0 = __expf(a0 - m), e1 = __expf(a1 - m), e2 = lane == 0 ? __expf(a2 - m) : 0.f;
            const float z = wave_sum(e0 + e1 + e2), rz = 1.0f / z;
            s_sc[h2 * 132 + lane] = e0 * rz; s_sc[h2 * 132 + 64 + lane] = e1 * rz; if (lane == 0) { s_sc[h2 * 132 + 128] = e2 * rz; p.LSE[row * 12 + g * 4 + h2] = m + __logf(z); }
        }
        __syncthreads();
        f32x4 o = {0.f, 0.f, 0.f, 0.f};
#pragma unroll
        for (int i = 0; i < 17; ++i) { const int k = wave + 8 * i; if (i < nk) o += vr[i] * s_sc[hd * 132 + k]; }
        *(LAS f32x4*)(s_o + wave * 256 + 4 * lane) = o;
        __syncthreads();
        if (tid_ < 256) {
            float t2 = 0.f;
#pragma unroll
            for (int w = 0; w < 8; ++w) t2 += s_o[w * 256 + tid_];
            p.OG[row * 768 + g * 256 + tid_] = f2bf(t2);
        }
        __syncthreads();
    }
}

__device__ __forceinline__ void phase_merge_prep(const Params& p, int bid, int nb) {
    int tid_ = threadIdx.x; asm volatile("" : "+v"(tid_));
    const int wave = tid_ >> 6, lane = tid_ & 63;
    for (int row = bid * 8 + wave; row < NT; row += nb * 8) {
        const size_t R = (size_t)row;
        {
            const int j = lane >> 4;
            const float l0 = p.LSE[R * 12 + j], l1 = p.LSE[R * 12 + 4 + j], l2 = p.LSE[R * 12 + 8 + j];
            const float m = fmaxf(l0, fmaxf(l1, l2));
            float w0 = __expf(l0 - m), w1 = __expf(l1 - m), w2 = __expf(l2 - m);
            const float rs = 1.0f / (w0 + w1 + w2); w0 *= rs; w1 *= rs; w2 *= rs;
            const u32x2 a = *(const u32x2*)(p.OG + R * 768 + 4 * lane), b = *(const u32x2*)(p.OG + R * 768 + 256 + 4 * lane), c = *(const u32x2*)(p.OG + R * 768 + 512 + 4 * lane);
            u32x2 o;
            o.x = pack2(w0 * bflo(a.x) + w1 * bflo(b.x) + w2 * bflo(c.x), w0 * bfhi(a.x) + w1 * bfhi(b.x) + w2 * bfhi(c.x));
            o.y = pack2(w0 * bflo(a.y) + w1 * bflo(b.y) + w2 * bflo(c.y), w0 * bfhi(a.y) + w1 * bfhi(b.y) + w2 * bfhi(c.y));
            *(u32x2*)(p.OA + R * 256 + 4 * lane) = o;
        }
    }
}

template <int MODE> struct EpiGate {
    static constexpr bool PERM = true, AFTER_DRAIN = false;
    bf16_t* O; const bf16_t* G; const bf16_t* ADD; int ld;
    __device__ __forceinline__ void operator()(const pg8::f32x4 (&acc)[2][2][4][2], const pg8::Unit& u, int wr, int wc, int fr, int fq) const {
        const int row0 = u.pm * 256 + wr * 64 + fr, col0 = u.pn * 256 + wc * 32 + 8 * fq;
#pragma unroll
        for (int ai = 0; ai < 2; ++ai) {
            u32x4 gq[8], aq[8];
#pragma unroll
            for (int m = 0; m < 4; ++m)
#pragma unroll
                for (int bj = 0; bj < 2; ++bj) {
                    const size_t o = (size_t)(row0 + ai * 128 + m * 16) * ld + col0 + bj * 128;
                    if (MODE != 2) gq[m * 2 + bj] = *(const u32x4*)(G + o);
                    if (MODE == 1) aq[m * 2 + bj] = *(const u32x4*)(ADD + o);
                }
#pragma unroll
            for (int m = 0; m < 4; ++m)
#pragma unroll
                for (int bj = 0; bj < 2; ++bj) {
                    const size_t o = (size_t)(row0 + ai * 128 + m * 16) * ld + col0 + bj * 128;
                    const pg8::f32x4 v0 = acc[ai][bj][m][0], v1 = acc[ai][bj][m][1];
                    float v[8] = {v0[0], v0[1], v0[2], v0[3], v1[0], v1[1], v1[2], v1[3]};
                    if (MODE != 2) { float gg[8]; unpack8(gq[m * 2 + bj], gg);
#pragma unroll
                        for (int i = 0; i < 8; ++i) v[i] *= sigmoidf_(gg[i]); }
                    if (MODE == 1) { float aa[8]; unpack8(aq[m * 2 + bj], aa);
#pragma unroll
                        for (int i = 0; i < 8; ++i) v[i] += aa[i]; }
                    u32x4 w; w.x = pack2(v[0], v[1]); w.y = pack2(v[2], v[3]); w.z = pack2(v[4], v[5]); w.w = pack2(v[6], v[7]);
                    *(u32x4*)(O + o) = w;
                }
        }
    }
    __device__ __forceinline__ void emit16(int row, int col, const float (&vin)[16]) const {
#pragma unroll
        for (int hf = 0; hf < 2; ++hf) {
            const size_t o = (size_t)row * ld + col + 8 * hf;
            float v[8];
#pragma unroll
            for (int i = 0; i < 8; ++i) v[i] = vin[8 * hf + i];
            if (MODE != 2) { float gg[8]; unpack8(*(const u32x4*)(G + o), gg);
#pragma unroll
                for (int i = 0; i < 8; ++i) v[i] *= sigmoidf_(gg[i]); }
            if (MODE == 1) { float aa[8]; unpack8(*(const u32x4*)(ADD + o), aa);
#pragma unroll
                for (int i = 0; i < 8; ++i) v[i] += aa[i]; }
            u32x4 w; w.x = pack2(v[0], v[1]); w.y = pack2(v[2], v[3]); w.z = pack2(v[4], v[5]); w.w = pack2(v[6], v[7]);
            *(u32x4*)(O + o) = w;
        }
    }
};
struct EpiOut {
    static constexpr bool PERM = false, AFTER_DRAIN = false;
    float* Z1; const float* x_prompt; const float* x_sample; const float* MOD;
    __device__ __forceinline__ void operator()(const pg8::f32x4 (&acc)[2][2][4][2], const pg8::Unit& u, int wr, int wc, int fr, int fq) const {
        const int row0 = u.pm * 256 + wr * 64 + fr, col0 = u.pn * 256 + wc * 32 + 4 * fq;
        const float* g1 = MOD + (size_t)(row0 >> 14) * 6144 + 2048 + col0;
        pg8::f32x4 gv[2][2];
#pragma unroll
        for (int bj = 0; bj < 2; ++bj)
#pragma unroll
            for (int n = 0; n < 2; ++n) gv[bj][n] = *(const pg8::f32x4*)(g1 + bj * 128 + n * 16);
#pragma unroll
        for (int ai = 0; ai < 2; ++ai) {
            pg8::f32x4 xv[4][2][2];
#pragma unroll
            for (int m = 0; m < 4; ++m)
#pragma unroll
                for (int bj = 0; bj < 2; ++bj)
#pragma unroll
                    for (int n = 0; n < 2; ++n) xv[m][bj][n] = *(const pg8::f32x4*)(x_prompt + (size_t)(row0 + ai * 128 + m * 16) * D + col0 + bj * 128 + n * 16);
#pragma unroll
            for (int m = 0; m < 4; ++m)
#pragma unroll
                for (int bj = 0; bj < 2; ++bj)
#pragma unroll
                    for (int n = 0; n < 2; ++n)
                        *(pg8::f32x4*)(Z1 + (size_t)(row0 + ai * 128 + m * 16) * D + col0 + bj * 128 + n * 16) = xv[m][bj][n] * DN_ALPHA + gv[bj][n] * acc[ai][bj][m][n];
        }
    }
    __device__ __forceinline__ void emit16(int row, int col, const float (&v)[16]) const {
        if (row >= NT) return;
        const float* xr = row < NTP ? x_prompt + (size_t)row * D : x_sample + (size_t)(row - NTP) * D;
        const float* g1 = MOD + (size_t)seq_of(row) * 6144 + 2048;
#pragma unroll
        for (int i = 0; i < 4; ++i) {
            const f32x4 xv = *(const f32x4*)(xr + col + 4 * i), gv = *(const f32x4*)(g1 + col + 4 * i);
            *(f32x4*)(Z1 + (size_t)row * D + col + 4 * i) = xv * DN_ALPHA + gv * (f32x4){v[4 * i], v[4 * i + 1], v[4 * i + 2], v[4 * i + 3]};
        }
    }
};

__device__ __forceinline__ size_t qvf_index(int row, int c0) {
    return ((((((size_t)(row >> 5) * 8 + (c0 >> 8)) * 2 + ((c0 >> 7) & 1)) * 8 + ((c0 & 127) >> 4)) * 64) + (((c0 >> 3) & 1) * 32 + (row & 31))) * 8;
}
struct EpiQvf {
    static constexpr bool PERM = true, AFTER_DRAIN = false;
    bf16_t* O;
    __device__ __forceinline__ void operator()(const pg8::f32x4 (&acc)[2][2][4][2], const pg8::Unit& u, int wr, int wc, int fr, int fq) const {
        const int row0 = u.pm * 256 + wr * 64 + fr, col0 = u.pn * 256 + wc * 32 + 8 * fq;
#pragma unroll
        for (int ai = 0; ai < 2; ++ai)
#pragma unroll
            for (int m = 0; m < 4; ++m)
#pragma unroll
                for (int bj = 0; bj < 2; ++bj) {
                    const pg8::f32x4 v0 = acc[ai][bj][m][0], v1 = acc[ai][bj][m][1];
                    u32x4 w; w.x = pack2(v0[0], v0[1]); w.y = pack2(v0[2], v0[3]); w.z = pack2(v1[0], v1[1]); w.w = pack2(v1[2], v1[3]);
                    *(u32x4*)(O + qvf_index(row0 + ai * 128 + m * 16, col0 + bj * 128)) = w;
                }
    }
    __device__ __forceinline__ void emit16(int row, int col, const float (&v)[16]) const {
        u32x4 w0, w1;
        w0.x = pack2(v[0], v[1]); w0.y = pack2(v[2], v[3]); w0.z = pack2(v[4], v[5]); w0.w = pack2(v[6], v[7]);
        w1.x = pack2(v[8], v[9]); w1.y = pack2(v[10], v[11]); w1.z = pack2(v[12], v[13]); w1.w = pack2(v[14], v[15]);
        *(u32x4*)(O + qvf_index(row, col)) = w0; *(u32x4*)(O + qvf_index(row, col + 8)) = w1;
    }
};

__device__ __forceinline__ void phase_ln1(const Params& p, int bid, int nb) {
    int tid_ = threadIdx.x; asm volatile("" : "+v"(tid_));
    const int wave = tid_ >> 6, lane = tid_ & 63;
    float lw[16], lb[16];
    load_row16(p.ln1_w, lane, lw); load_row16(p.ln1_b, lane, lb);
    int row = bid * 8 + wave;
    float nx[16];
    if (row < NT) load_row16(p.Z1 + (size_t)row * D, lane, nx);
    for (; row < NT; row += nb * 8) {
        float v[16];
#pragma unroll
        for (int i = 0; i < 16; ++i) v[i] = nx[i];
        const int nrow = row + nb * 8;
        if (nrow < NT) load_row16(p.Z1 + (size_t)nrow * D, lane, nx);
        const float* mod = p.MOD + (size_t)seq_of(row) * 6144;
        float sh[16], sc[16];
        load_row16(mod + 3072, lane, sh); load_row16(mod + 4096, lane, sc);
        float mean, rstd; row_stats(v, mean, rstd);
        if (lane == 0) { p.LNST[(size_t)row * 2] = mean; p.LNST[(size_t)row * 2 + 1] = rstd; }
#pragma unroll
        for (int i = 0; i < 16; ++i) v[i] = (v[i] - mean) * rstd * lw[i] + lb[i];
        row_stats(v, mean, rstd);
#pragma unroll
        for (int i = 0; i < 16; ++i) v[i] = (v[i] - mean) * rstd * (1.0f + sc[i]) + sh[i];
        store_row16_bf16(p.H + (size_t)row * D, lane, v);
        float am = 0.f;
#pragma unroll
        for (int i = 0; i < 16; ++i) am = fmaxf(am, fabsf(v[i]));
        am = wave_max(am);
        const float inv = am > 0.f ? 448.0f / am : 1.0f;
        u32x4 w8;
#pragma unroll
        for (int i = 0; i < 4; ++i) {
            int d = 0;
            d = __builtin_amdgcn_cvt_pk_fp8_f32(v[4 * i] * inv, v[4 * i + 1] * inv, d, false);
            d = __builtin_amdgcn_cvt_pk_fp8_f32(v[4 * i + 2] * inv, v[4 * i + 3] * inv, d, true);
            w8[i] = (unsigned)d;
        }
        *(u32x4*)(p.H8 + (size_t)row * 1024 + 16 * lane) = w8;
        if (lane == 0) p.HS[row] = am > 0.f ? am * (1.0f / 448.0f) : 1.0f;
    }
}

__device__ __forceinline__ unsigned fkey(float f) { const unsigned u = __float_as_uint(f); return (u & 0x80000000u) ? ~u : (u | 0x80000000u); }
__device__ __forceinline__ float keyf(unsigned k) { return __uint_as_float((k & 0x80000000u) ? (k & 0x7fffffffu) : ~k); }

constexpr int CC_R0 = 128 * 127, CC_R1 = CC_R0 + 128 * 511, CC_ROWS = CC_R1 + 128 * 2047;
constexpr int CC_PER = 2, CC_STEPS = 84;
static_assert(CC_PER * CC_STEPS * 2048 >= CC_ROWS, "copy coverage");
template <int W> __device__ __forceinline__ void cc_addr_w(const float* s, float* d, int i, const float*& src, float*& dst) {
    const int seq = i / (W - 1), rr = i - seq * (W - 1);
    src = s + ((size_t)seq * W + rr + 1) * 512; dst = d + ((size_t)seq * W + rr) * 512;
}
__device__ __forceinline__ bool cc_addr(const Params& p, int row_, const float*& src, float*& dst) {
    const int rowu = __builtin_amdgcn_readfirstlane(row_);
    const bool ok = rowu < CC_ROWS;
    const int row = ok ? rowu : CC_ROWS - 1;
    if (row < CC_R0) cc_addr_w<128>(p.cache128, p.out + OFF_KVS0, row, src, dst);
    else if (row < CC_R1) cc_addr_w<512>(p.cache512, p.out + OFF_KVS1, row - CC_R0, src, dst);
    else cc_addr_w<2048>(p.cache2048, p.out + OFF_KVS2, row - CC_R1, src, dst);
    return ok;
}
struct CacheCopier {
    static constexpr int CAP = CC_PER * CC_STEPS;
    int row0, lane4, knext, kh0, kh1; f32x4 b0[2 * CC_PER], b1[2 * CC_PER];
    __device__ __forceinline__ void init(int bid, int tid) { row0 = __builtin_amdgcn_readfirstlane(bid * 8 + (tid >> 6)); lane4 = (tid & 63) * 4; knext = 0; kh0 = CAP; kh1 = CAP; }
    template <int W> __device__ __forceinline__ void store_part(const Params& p) {
        const int k0 = W ? kh1 : kh0;
#pragma unroll
        for (int j = 0; j < CC_PER; ++j) { const float* s; float* d; if (cc_addr(p, row0 + (k0 + j) * 2048, s, d)) {
            __builtin_nontemporal_store((W ? b1 : b0)[2 * j], (f32x4*)(d + lane4)); __builtin_nontemporal_store((W ? b1 : b0)[2 * j + 1], (f32x4*)(d + 256 + lane4)); } }
    }
    template <int W> __device__ __forceinline__ void load_part(const Params& p) {
        (W ? kh1 : kh0) = knext;
#pragma unroll
        for (int j = 0; j < CC_PER; ++j) { const float* s; float* d; (void)cc_addr(p, row0 + (knext + j) * 2048, s, d);
            (W ? b1 : b0)[2 * j] = __builtin_nontemporal_load((const f32x4*)(s + lane4)); (W ? b1 : b0)[2 * j + 1] = __builtin_nontemporal_load((const f32x4*)(s + 256 + lane4)); }
        knext = knext + CC_PER < CAP ? knext + CC_PER : CAP;
    }
    template <int W> __device__ __forceinline__ void step(const Params& p) { store_part<W>(p); load_part<W>(p); }
    __device__ __forceinline__ void flush(const Params& p) { while (kh0 < CAP || kh1 < CAP) { step<0>(p); step<1>(p); } }
};
constexpr int SK_PITCH = 132;
#define DPP_ROR(v, n) ((unsigned)__builtin_amdgcn_update_dpp(0, (int)(v), 0x120 + (n), 0xf, 0xf, true))
__device__ __forceinline__ unsigned row_max_u32(unsigned v) {
    v = max(v, DPP_ROR(v, 8)); v = max(v, DPP_ROR(v, 4)); v = max(v, DPP_ROR(v, 2)); v = max(v, DPP_ROR(v, 1)); return v;
}
#define CE_DESC(a, b) do { const unsigned hi_ = max(a, b), lo_ = min(a, b); a = hi_; b = lo_; } while (0)
__device__ __forceinline__ void phase_peer_select(const Params& p, int bid, int nb, LAS unsigned char* lds) {
    int tid_ = threadIdx.x; asm volatile("" : "+v"(tid_));
    LAS unsigned* s_key = (LAS unsigned*)lds;
    LAS unsigned* s_top = s_key + 256 * SK_PITCH;
    const int wave = tid_ >> 6, lane = tid_ & 63, r = lane & 31, hh = lane >> 5;
    const int li = tid_ & 15, rowid = tid_ >> 4;
    int cand_i[4], cand_j[4]; bool cand_ok[4];
#pragma unroll
    for (int s = 0; s < 4; ++s) {
        int i = 0, rem = 4 * li + s;
        while (i < 16 && rem >= 16 / (i + 1)) { rem -= 16 / (i + 1); ++i; }
        cand_ok[s] = i < 16; cand_i[s] = i < 16 ? i : 0; cand_j[s] = i < 16 ? rem : 0;
    }
    CacheCopier cc; cc.init(bid, tid_);
    for (int b = bid; b < 256; b += nb) {
        for (int tile = 0; tile < 5; ++tile) {
            const int nvalid = tile < 4 ? 32 : (b < NS ? 1 : 0);
            if (nvalid == 0) break;
            const int row0 = tile < 4 ? b * 128 + tile * 32 : NTP + b;
            for (int hq = 0; hq < 2; ++hq) {
#pragma unroll
                for (int jb = 0; jb < 4; ++jb) {
                    const int job = wave * 4 + jb, hl = job >> 3, half = (job >> 2) & 1, ni = job & 3;
                    const int h = 4 * hq + hl;
                    const int tix = tile < 4 ? b * 4 + tile : (NTP >> 5) + (b >> 5), rsel = tile < 4 ? r : (b & 31);
                    const bf16_t* A = p.QV + ((((size_t)tix * 8 + h) * 2 + half) * 8 * 64 + (hh * 32 + rsel)) * 8;
                    const bf16_t* B = p.KF + ((((size_t)h * 2 + half) * 4 + ni) * 8 * 64 + lane) * 8;
                    if (jb & 1) cc.store_part<1>(p); else cc.store_part<0>(p);
                    bf16x8 af[8], bfr[8];
#pragma unroll
                    for (int ks = 0; ks < 8; ++ks) { af[ks] = ld_frag_g(A + ks * 512); bfr[ks] = ld_frag_g(B + ks * 512); }
                    if (jb & 1) cc.load_part<1>(p); else cc.load_part<0>(p);
                    f32x16 acc = zero16();
#pragma unroll
                    for (int ks = 0; ks < 8; ++ks) acc = mfma32(af[ks], bfr[ks], acc);
                    LAS unsigned* dst = s_key + ((hl * 2 + half) * 32) * SK_PITCH + 32 * ni + r;
                    const unsigned tag = 127u - (unsigned)(32 * ni + r);
#pragma unroll
                    for (int reg = 0; reg < 16; ++reg) dst[crow(reg, hh) * SK_PITCH] = (fkey(acc[reg]) & ~127u) | tag;
                }
                __syncthreads();
                {
                    auto stage1 = [&](int it) {
                        unsigned k[2][8], res[2];
#pragma unroll
                        for (int z = 0; z < 2; ++z) {
                            const int q = (it + 4 * z) * 32 + rowid;
                            const u32x4 ka = *(const LAS u32x4*)(s_key + q * SK_PITCH + 8 * li), kb = *(const LAS u32x4*)(s_key + q * SK_PITCH + 8 * li + 4);
                            k[z][0] = ka.x; k[z][1] = ka.y; k[z][2] = ka.z; k[z][3] = ka.w; k[z][4] = kb.x; k[z][5] = kb.y; k[z][6] = kb.z; k[z][7] = kb.w; res[z] = 0u;
                        }
#pragma unroll
                        for (int z = 0; z < 2; ++z) {
                            CE_DESC(k[z][0], k[z][1]); CE_DESC(k[z][2], k[z][3]); CE_DESC(k[z][4], k[z][5]); CE_DESC(k[z][6], k[z][7]);
                            CE_DESC(k[z][0], k[z][2]); CE_DESC(k[z][1], k[z][3]); CE_DESC(k[z][4], k[z][6]); CE_DESC(k[z][5], k[z][7]);
                            CE_DESC(k[z][1], k[z][2]); CE_DESC(k[z][5], k[z][6]);
                            CE_DESC(k[z][0], k[z][4]); CE_DESC(k[z][1], k[z][5]); CE_DESC(k[z][2], k[z][6]); CE_DESC(k[z][3], k[z][7]);
                            CE_DESC(k[z][2], k[z][4]); CE_DESC(k[z][3], k[z][5]);
                            CE_DESC(k[z][1], k[z][2]); CE_DESC(k[z][3], k[z][4]); CE_DESC(k[z][5], k[z][6]);
                        }
#pragma unroll
                        for (int ps = 0; ps < 16; ++ps) {
#pragma unroll
                            for (int z = 0; z < 2; ++z) {
                                const unsigned mx = row_max_u32(k[z][0]);
                                res[z] = li == ps ? mx : res[z];
                                const bool pop = k[z][0] == mx;
#pragma unroll
                                for (int e = 0; e < 7; ++e) k[z][e] = pop ? k[z][e + 1] : k[z][e];
                                k[z][7] = pop ? 0u : k[z][7];
                            }
                        }
#pragma unroll
                        for (int z = 0; z < 2; ++z) s_top[((it + 4 * z) * 32 + rowid) * 16 + li] = res[z];
                    };
                    for (int it = 0; it < 4; it += 2) { cc.step<0>(p); if (rowid < nvalid) stage1(it); cc.step<1>(p); if (rowid < nvalid) stage1(it + 1); }
                }
                __syncthreads();
                {
                    auto stage2 = [&](int hl0) {
                        unsigned c[2][4], res[2];
#pragma unroll
                        for (int z = 0; z < 2; ++z) {
                            const int hl = hl0 + 2 * z;
                            const LAS unsigned* t1 = s_top + ((hl * 2 + 0) * 32 + rowid) * 16;
                            const LAS unsigned* t2 = s_top + ((hl * 2 + 1) * 32 + rowid) * 16;
#pragma unroll
                            for (int s = 0; s < 4; ++s) {
                                const float v = keyf(t1[cand_i[s]] & ~127u) + keyf(t2[cand_j[s]] & ~127u);
                                c[z][s] = cand_ok[s] ? ((fkey(v) & ~255u) | (255u - (unsigned)(cand_i[s] * 16 + cand_j[s]))) : 0u;
                            }
                            CE_DESC(c[z][0], c[z][1]); CE_DESC(c[z][2], c[z][3]); CE_DESC(c[z][0], c[z][2]); CE_DESC(c[z][1], c[z][3]); CE_DESC(c[z][1], c[z][2]);
                            res[z] = 0u;
                        }
#pragma unroll
                        for (int ps = 0; ps < 16; ++ps) {
#pragma unroll
                            for (int z = 0; z < 2; ++z) {
                                const unsigned mx = row_max_u32(c[z][0]);
                                res[z] = li == ps ? mx : res[z];
                                const bool pop = c[z][0] == mx;
                                c[z][0] = pop ? c[z][1] : c[z][0]; c[z][1] = pop ? c[z][2] : c[z][1]; c[z][2] = pop ? c[z][3] : c[z][2]; c[z][3] = pop ? 0u : c[z][3];
                            }
                        }
#pragma unroll
                        for (int z = 0; z < 2; ++z) {
                            const int hl = hl0 + 2 * z;
                            const LAS unsigned* t1 = s_top + ((hl * 2 + 0) * 32 + rowid) * 16;
                            const LAS unsigned* t2 = s_top + ((hl * 2 + 1) * 32 + rowid) * 16;
                            const int cidx = 255 - (int)(res[z] & 255u), i1 = cidx >> 4, i2 = cidx & 15;
                            const unsigned a1 = t1[i1], a2 = t2[i2];
                            const float sc = keyf(a1 & ~127u) + keyf(a2 & ~127u);
                            float mxs = sc;
                            mxs = fmaxf(mxs, DPP_ROR_F(mxs, 8)); mxs = fmaxf(mxs, DPP_ROR_F(mxs, 4)); mxs = fmaxf(mxs, DPP_ROR_F(mxs, 2)); mxs = fmaxf(mxs, DPP_ROR_F(mxs, 1));
                            const float ex = __expf(sc - mxs);
                            const float gw = ex / dpp_row_sum(ex);
                            const int ei = (127 - (int)(a1 & 127u)) * 128 + (127 - (int)(a2 & 127u));
                            const size_t o = (size_t)(row0 + rowid) * 128 + (4 * hq + hl) * 16 + li;
                            p.EIDX[o] = ei; p.EGW[o] = gw * p.SV[ei];
                        }
                    };
                    cc.step<0>(p); if (rowid < nvalid) stage2(0); cc.step<1>(p); if (rowid < nvalid) stage2(1);
                }
                __syncthreads();
            }
        }
    }
    cc.flush(p);
}

__device__ __forceinline__ float gelu_erf(float x) { return 0.5f * x * (1.0f + erff(x * 0.70710678118654752f)); }
__device__ __forceinline__ float wave_total_from_rows(float v) {
    return (__builtin_bit_cast(float, __builtin_amdgcn_readlane(__builtin_bit_cast(int, v), 0)) + __builtin_bit_cast(float, __builtin_amdgcn_readlane(__builtin_bit_cast(int, v), 16)))
         + (__builtin_bit_cast(float, __builtin_amdgcn_readlane(__builtin_bit_cast(int, v), 32)) + __builtin_bit_cast(float, __builtin_amdgcn_readlane(__builtin_bit_cast(int, v), 48)));
}
__device__ __forceinline__ void fp8x16_to_f32(const u32x4 w, float (&o)[16]) {
#pragma unroll
    for (int i = 0; i < 4; ++i) {
        const v2f_t lo = __builtin_amdgcn_cvt_pk_f32_fp8((int)w[i], false), hi = __builtin_amdgcn_cvt_pk_f32_fp8((int)w[i], true);
        o[4 * i] = lo.x; o[4 * i + 1] = lo.y; o[4 * i + 2] = hi.x; o[4 * i + 3] = hi.y;
    }
}
typedef long i64x2_t __attribute__((ext_vector_type(2)));
typedef int i32x2_t __attribute__((ext_vector_type(2)));
#define UP_PITCH 1040
__device__ __forceinline__ void up_tile_put(const u32x4 (&rows)[16], LAS unsigned char* tile, int lane16) {
#pragma unroll
    for (int q = 0; q < 16; ++q) *(LAS u32x4*)(tile + q * UP_PITCH + lane16) = rows[q];
}
__device__ __forceinline__ float up_tile_dots(const LAS unsigned char* tile, const LAS unsigned char* hrow, int pr, int kg16) {
    f32x4 c0 = {0.f, 0.f, 0.f, 0.f}, c1 = c0;
    u32x4 hf[2][2], uf[2][2];
    auto rd = [&](int st, int s) {
#pragma unroll
        for (int i = 0; i < 2; ++i) { hf[s][i] = *(const LAS u32x4*)(hrow + 128 * st + 64 * i + kg16); uf[s][i] = *(const LAS u32x4*)(tile + pr * UP_PITCH + 128 * st + 64 * i + kg16); }
    };
    auto mm = [&](int s) {
#pragma unroll
        for (int i = 0; i < 2; ++i) {
            const i64x2_t a = __builtin_bit_cast(i64x2_t, hf[s][i]), b = __builtin_bit_cast(i64x2_t, uf[s][i]);
            c0 = __builtin_amdgcn_mfma_f32_16x16x32_fp8_fp8(a[0], b[0], c0, 0, 0, 0);
            c1 = __builtin_amdgcn_mfma_f32_16x16x32_fp8_fp8(a[1], b[1], c1, 0, 0, 0);
        }
    };
    rd(0, 0);
#pragma unroll
    for (int st = 0; st < 8; ++st) {
        if (st + 1 < 8) rd(st + 1, (st + 1) & 1);
        __builtin_amdgcn_sched_barrier(0);
        mm(st & 1);
        __builtin_amdgcn_sched_barrier(0);
    }
    return c0[0] + c1[0];
}

template <int V = 0>
__device__ __forceinline__ void phase_peer_upass(const Params& p, int bid, int nb, LAS unsigned char* lds, float* __restrict__ ewout) {
    int tid_ = threadIdx.x; asm volatile("" : "+v"(tid_));
    const int wave = tid_ >> 6, lane = tid_ & 63;
    constexpr int WSTR = 16 * UP_PITCH + 2048 + 64;
    LAS unsigned char* tile = lds + wave * WSTR;
    LAS int* lst = (LAS int*)tile;
    LAS unsigned char* hb = tile + 16 * UP_PITCH;
    LAS float* hsl = (LAS float*)(tile + 16 * UP_PITCH + 2048);
    static_assert(8 * WSTR <= LDS_BYTES - 16, "LDS carve of the expert-activation phase");
    const __amdgpu_buffer_rsrc_t ures = __builtin_amdgcn_make_buffer_rsrc((void*)p.U8, 0, 16384 * 2048, 0x00020000);
    const int pr = lane & 15, kg16 = (lane >> 4) * 16, lane16 = lane * 16;
    constexpr int TPB = NT / 32;
    static_assert(TPB * 32 == NT, "token ranges");
    struct TokIn { u32x4 h8; int ia, ib; float hs; };
    struct Tok { int t, n, e0, e1, k0, k1; float su0, su1; };
    for (int vb = bid; vb < 256; vb += nb) {
        const int x = vb & 7, t0 = (vb >> 3) * TPB, tend = t0 + TPB;
        {
        auto fetch_tok = [&](int t2, TokIn& ti) {
            t2 = t2 < tend ? t2 : tend - 1;
            const size_t R2 = (size_t)t2;
            ti.h8 = *(const u32x4*)(p.H8 + R2 * 1024 + 16 * lane); ti.hs = p.HS[R2];
            ti.ia = p.EIDX[R2 * 128 + lane]; ti.ib = p.EIDX[R2 * 128 + 64 + lane];
        };
        auto prep = [&](int t, TokIn& in, Tok& o, u32x4 (&buf)[16], int par) {
            const int ia = in.ia, ib = in.ib;
            o.t = t;
            *(LAS u32x4*)(hb + par * 1024 + 16 * lane) = in.h8; hsl[par] = in.hs;
            const bool inA = (ia >> 11) == x, inB = (ib >> 11) == x;
            const unsigned long long mA = __builtin_amdgcn_ballot_w64(inA), mB = __builtin_amdgcn_ballot_w64(inB);
            const int cntA = __builtin_popcountll(mA), n = cntA + __builtin_popcountll(mB);
            const int rankA = (int)__builtin_amdgcn_mbcnt_hi((unsigned)(mA >> 32), __builtin_amdgcn_mbcnt_lo((unsigned)mA, 0u));
            const int rankB = cntA + (int)__builtin_amdgcn_mbcnt_hi((unsigned)(mB >> 32), __builtin_amdgcn_mbcnt_lo((unsigned)mB, 0u));
            LAS int* L = lst;
            if (inA) { L[rankA] = ia; L[128 + rankA] = lane; }
            if (inB) { L[rankB] = ib; L[128 + rankB] = 64 + lane; }
            asm volatile("s_waitcnt lgkmcnt(0)" ::: "memory");
            o.n = n;
            o.e0 = lane < n ? L[lane] : (x << 11); o.e1 = 64 + lane < n ? L[64 + lane] : (x << 11);
            o.k0 = L[128 + lane]; o.k1 = L[192 + lane];
            o.su0 = p.SU[o.e0]; o.su1 = p.SU[o.e1];
#pragma unroll
            for (int q = 0; q < 16; ++q) { const int e = __builtin_amdgcn_readlane(o.e0, q); buf[q] = __builtin_amdgcn_raw_buffer_load_b128(ures, lane16, e << 11, 0); }
            fetch_tok(t + 16, in);
        };
        auto finish = [&](Tok& c, u32x4 (&buf)[16], int par) {
            const LAS unsigned char* hrow = hb + par * 1024; const float hs = hsl[par];
            __builtin_amdgcn_sched_barrier(0);
            __builtin_amdgcn_s_waitcnt(0x4F76);
            __builtin_amdgcn_sched_barrier(0);
            float dot0 = 0.f, dot1 = 0.f;
            for (int base = 0; base < 16 || base < c.n; base += 16) {
                up_tile_put(buf, tile, lane16);
                if (base + 16 < c.n) {
                    const int nb16 = base + 16, ev = nb16 < 64 ? c.e0 : c.e1;
#pragma unroll
                    for (int q = 0; q < 16; ++q) { const int e = __builtin_amdgcn_readlane(ev, (nb16 & 63) + q); buf[q] = __builtin_amdgcn_raw_buffer_load_b128(ures, lane16, e << 11, 0); }
                }
                __builtin_amdgcn_sched_barrier(0);
                const float d = up_tile_dots(tile, hrow, pr, kg16);
                if ((lane >> 4) == ((base >> 4) & 3)) { if (base < 64) dot0 = d; else dot1 = d; }
                if (base + 16 < c.n) {
                    __builtin_amdgcn_sched_barrier(0);
                    __builtin_amdgcn_s_waitcnt(0x0F70);
                    __builtin_amdgcn_sched_barrier(0);
                }
            }
            const size_t R = (size_t)c.t;
            if (lane < c.n) ewout[R * 128 + c.k0] = gelu_erf(c.su0 * hs * dot0);
            if (64 + lane < c.n) ewout[R * 128 + c.k1] = gelu_erf(c.su1 * hs * dot1);
        };
        TokIn iA, iB; Tok kA, kB; u32x4 bX[16], bY[16];
        fetch_tok(t0 + wave, iA); fetch_tok(t0 + wave + 8, iB);
        prep(t0 + wave, iA, kA, bX, 0);
        for (int t = t0 + wave; t < tend; t += 16) {
            prep(t + 8 < tend ? t + 8 : tend - 1, iB, kB, bY, 1);
            finish(kA, bX, 0);
            prep(t + 16 < tend ? t + 16 : tend - 1, iA, kA, bX, 0);
            finish(kB, bY, 1);
        }
        __builtin_amdgcn_s_waitcnt(0x0F70);
        }
    }
}

__device__ __forceinline__ void phase_peer_gather(const Params& p, int bid, int nb, LAS unsigned char* lds, int skip_ff = 0) {
    int tid_ = threadIdx.x; asm volatile("" : "+v"(tid_));
    const int wave = tid_ >> 6, lane = tid_ & 63;
    LAS float* s_ff = (LAS float*)lds;
    const __amdgpu_buffer_rsrc_t vres = __builtin_amdgcn_make_buffer_rsrc((void*)p.U8, 0, 16384 * 2048, 0x00020000);
    const int lane16v = lane * 16 + 1024;
    const int n_vb = (256 - bid + nb - 1) / nb;
    for (int it = 0; it < n_vb * 17; ++it) {
        const int vb = bid + (it / 17) * nb, sub = it % 17;
        const bool coop = sub == 16;
        if (coop && vb >= NS) continue;
        const int row = coop ? NTP + vb : vb * 128 + wave + 8 * sub;
        const int g0 = skip_ff ? 8 : (coop ? wave : 0), g1 = coop ? wave + 1 : 8;
        const size_t R = (size_t)row;
        v2f_t acc2[8];
#pragma unroll
        for (int i = 0; i < 8; ++i) acc2[i] = (v2f_t){0.f, 0.f};
        const int ia = p.EIDX[R * 128 + lane], ib = p.EIDX[R * 128 + 64 + lane];
        const float wa = p.EW[R * 128 + lane] * p.EGW[R * 128 + lane], wb = p.EW[R * 128 + 64 + lane] * p.EGW[R * 128 + 64 + lane];
        f32x4 zr[4];
#pragma unroll
        for (int i = 0; i < 4; ++i) zr[i] = *(const f32x4*)(p.Z1 + R * D + 16 * lane + 4 * i);
        const float mean1 = p.LNST[R * 2], rstd1 = p.LNST[R * 2 + 1];
        for (int grp = g0; grp < g1; ++grp) {
            const int iv = grp < 4 ? ia : ib; const float wv = grp < 4 ? wa : wb;
            const int l0 = (grp & 3) * 16;
            u32x4 vb16[16];
#pragma unroll
            for (int q = 0; q < 16; ++q) { const int e = __builtin_amdgcn_readlane(iv, l0 + q); vb16[q] = __builtin_amdgcn_raw_buffer_load_b128(vres, lane16v, e << 11, 0); }
#pragma unroll
            for (int q = 0; q < 16; ++q) {
                const float w = __builtin_bit_cast(float, __builtin_amdgcn_readlane(__builtin_bit_cast(int, wv), l0 + q));
                const v2f_t w2 = {w, w};
#pragma unroll
                for (int i = 0; i < 4; ++i) {
                    const v2f_t lo = __builtin_amdgcn_cvt_pk_f32_fp8((int)vb16[q][i], false), hi = __builtin_amdgcn_cvt_pk_f32_fp8((int)vb16[q][i], true);
                    acc2[2 * i] += w2 * lo; acc2[2 * i + 1] += w2 * hi;
                }
            }
        }
        float acc[16];
#pragma unroll
        for (int i = 0; i < 8; ++i) { acc[2 * i] = acc2[i].x; acc[2 * i + 1] = acc2[i].y; }
        if (coop) {
#pragma unroll
            for (int i = 0; i < 4; ++i) *(LAS f32x4*)(s_ff + wave * 1024 + 16 * lane + 4 * i) = (f32x4){acc[4 * i], acc[4 * i + 1], acc[4 * i + 2], acc[4 * i + 3]};
            __syncthreads();
            if (wave == 0) {
#pragma unroll
                for (int i = 0; i < 16; ++i) acc[i] = 0.f;
#pragma unroll
                for (int w = 0; w < 8; ++w)
#pragma unroll
                    for (int i = 0; i < 4; ++i) { const f32x4 t = *(const LAS f32x4*)(s_ff + w * 1024 + 16 * lane + 4 * i); acc[4 * i] += t[0]; acc[4 * i + 1] += t[1]; acc[4 * i + 2] += t[2]; acc[4 * i + 3] += t[3]; }
            }
        }
        if (!coop || wave == 0) {
            float x1[16], g2[16];
            const float* gr = p.MOD + (size_t)seq_of(row) * 6144 + 5120 + 16 * lane;
#pragma unroll
            for (int i = 0; i < 4; ++i) { const f32x4 a = zr[i], b = *(const f32x4*)(gr + 4 * i);
                const f32x4 lw = *(const f32x4*)(p.ln1_w + 16 * lane + 4 * i), lb = *(const f32x4*)(p.ln1_b + 16 * lane + 4 * i);
#pragma unroll
                for (int j = 0; j < 4; ++j) { x1[4 * i + j] = (a[j] - mean1) * rstd1 * lw[j] + lb[j]; g2[4 * i + j] = b[j]; } }
#pragma unroll
            for (int i = 0; i < 16; ++i) acc[i] = DN_ALPHA * x1[i] + g2[i] * acc[i];
            float mean, rstd; row_stats(acc, mean, rstd);
            float* yo = (row < NTP ? p.out + OFF_YP + R * D : p.out + OFF_YS + (size_t)(row - NTP) * D) + 16 * lane;
#pragma unroll
            for (int i = 0; i < 4; ++i) { const f32x4 w = *(const f32x4*)(p.ln2_w + 16 * lane + 4 * i), b = *(const f32x4*)(p.ln2_b + 16 * lane + 4 * i);
                f32x4 o;
#pragma unroll
                for (int j = 0; j < 4; ++j) o[j] = (acc[4 * i + j] - mean) * rstd * w[j] + b[j];
                *(f32x4*)(yo + 4 * i) = o; }
        }
        if (coop) __syncthreads();
    }
}

__device__ __forceinline__ void phase_z1_bypass(const Params& p, int bid, int nb) {
    int tid_ = threadIdx.x; asm volatile("" : "+v"(tid_));
    const int wave = tid_ >> 6, lane = tid_ & 63;
    for (int row = bid * 8 + wave; row < NT; row += nb * 8) {
        float v[16]; load_row16(x_row(p, row), lane, v);
#pragma unroll
        for (int i = 0; i < 16; ++i) v[i] *= DN_ALPHA;
        store_row16_f32(p.Z1 + (size_t)row * D, lane, v);
    }
}

#define DYN_LDS extern __shared__ __attribute__((aligned(16))) unsigned char shm_[]; LAS unsigned char* lds = (LAS unsigned char*)shm_;
template <class Epi> __device__ __forceinline__ void run_gemm(LAS unsigned char* lds, const bf16_t* A, const bf16_t* Bt, int M, int N, int K, const Epi& E) {
    int Ko = K; asm volatile("" : "+s"(Ko));
    pg8::StaticOrder S; S.init(M, N, (int)gridDim.x, (int)blockIdx.x);
    pg8::Gemm g{A, Bt, M, N, Ko};
    pg8::gemm_phase<Epi, pg8::StaticOrder, false>(lds, g, S, E, nullptr);
    __syncthreads();
}

template <class Epi> __device__ __forceinline__ void skinny_gemm(const bf16_t* __restrict__ A, const bf16_t* __restrict__ Bt, int N, int K, const Epi& E, int ushift) {
    int tid_ = threadIdx.x; asm volatile("" : "+v"(tid_));
    const int wave = tid_ >> 6, lane = tid_ & 63, r = lane & 31, hh = lane >> 5, rt = wave & 3, ct = wave >> 2;
    const int nb = (int)gridDim.x, vb = ((int)blockIdx.x + nb - (ushift % nb)) % nb;
    const int perm = 16 * ((r >> 2) & 1) + 4 * (r >> 3) + (r & 3);
    for (int u = vb; u < N / 64; u += nb) {
        int arow = NTP + 32 * rt + r; asm volatile("" : "+v"(arow));
        const bf16_t* ap = A + (size_t)arow * K + 8 * hh;
        const bf16_t* bp = Bt + (size_t)(u * 64 + 32 * ct + perm) * K + 8 * hh;
        f32x16 acc = zero16();
        for (int k0 = 0; k0 < K / 16; k0 += 8) {
            bf16x8 wa[8], xa[8];
#pragma unroll
            for (int i = 0; i < 8; ++i) { wa[i] = ld_frag_g(bp + 16 * (k0 + i)); xa[i] = ld_frag_g(ap + 16 * (k0 + i)); }
            __builtin_amdgcn_sched_barrier(0);
#pragma unroll
            for (int i = 0; i < 8; ++i) acc = mfma32(wa[i], xa[i], acc);
            __builtin_amdgcn_sched_barrier(0);
        }
        float v[16];
#pragma unroll
        for (int i = 0; i < 16; ++i) v[i] = acc[i];
        E.emit16(NTP + 32 * rt + r, u * 64 + 32 * ct + 16 * hh, v);
    }
}
__global__ void __launch_bounds__(NTHREADS, 2) k_mega(Params p) {
    DYN_LDS;
    volatile LAS unsigned* st = (volatile LAS unsigned*)(lds + LDS_BYTES - 16);
    if (threadIdx.x == 0) { st[0] = 0u; st[1] = 0u; st[2] = 0u; st[3] = 0u; }
    __syncthreads();
    const XcdBarrier bar = xcd_barrier_post(p.bar, st);
    const int bid = blockIdx.x, nb = gridDim.x;
    phase_prologue<0>(p, bid, nb, lds, 0);
    xcd_barrier(bar);
    run_gemm(lds, p.SC, p.WADA_T, 256, 6144, 1024, pg8::EpiF32{p.MOD, 6144, p.b_ada});
    phase_prologue<1>(p, bid, nb, lds, nb > 48 ? 24 : 0);
    xcd_barrier(bar);
    phase_lnmod1(p, bid, nb);
    xcd_barrier(bar);
    { const EpiProj E{p.QKVA, p.QKB, p.VBB, p.RB, p.GA, p.GB, p.GLR, p.out}; run_gemm(lds, p.H, p.WIN_T, NTP, NPROJ, 1024, E); skinny_gemm(p.H, p.WIN_T, NPROJ, 1024, E, 0); }
    xcd_barrier(bar);
    phase_gla2_passA(p, bid, nb, lds);
    phase_attn_prompt(p, bid, nb, lds);
    phase_attn_sample(p, bid, nb, lds);
    phase_gla_sample(p, bid, nb, lds);
    xcd_barrier(bar);
    phase_gla2_scan(p, bid, nb);
    xcd_barrier(bar);
    phase_gla2_passC(p, bid, nb, lds);
    phase_merge_prep(p, bid, nb);
    xcd_barrier(bar);
    { const EpiGate<0> E{p.TMP1, p.GA, nullptr, 1024}; run_gemm(lds, p.OA, p.WBRA_T, NTP, 1024, 256, E); skinny_gemm(p.OA, p.WBRA_T, 1024, 256, E, 0); }
    xcd_barrier(bar);
    { const EpiGate<1> E{p.MERGED, p.GB, p.TMP1, 1024}; run_gemm(lds, p.OB, p.WBRB_T, NTP, 1024, 1024, E); skinny_gemm(p.OB, p.WBRB_T, 1024, 1024, E, 64); }
    xcd_barrier(bar);
    { const EpiOut E{p.Z1, p.x_prompt, p.x_sample, p.MOD}; run_gemm(lds, p.MERGED, p.WOUT_T, NTP, 1024, 1024, E); skinny_gemm(p.MERGED, p.WOUT_T, 1024, 1024, E, 128); }
    xcd_barrier(bar);
    phase_ln1(p, bid, nb);
    xcd_barrier(bar);
    { const EpiQvf E{p.QV}; run_gemm(lds, p.H, p.WPQ_T, NTP, 2048, 1024, E); skinny_gemm(p.H, p.WPQ_T, 2048, 1024, E, 192); }
    xcd_barrier(bar);
    phase_peer_select(p, bid, nb, lds);
    xcd_barrier(bar);
    phase_peer_upass<0>(p, bid, nb, lds, p.EW);
#ifdef UP_PROBE
    xcd_barrier(bar);
    phase_peer_upass<UP_PROBE>(p, bid, nb, lds, (float*)p.TMP1);
#endif
    xcd_barrier(bar);
    phase_peer_gather(p, bid, nb, lds);
}

static inline size_t align_up(size_t v, size_t a) { return (v + a - 1) / a * a; }

extern "C" void kernel_launch(void* const* d_in, const int* in_sizes, int n_in, void* d_out, int out_size, void* d_ws, size_t ws_size, hipStream_t stream) {
    (void)in_sizes; (void)n_in; (void)out_size;
    Params p; memset(&p, 0, sizeof(p));
    const float* const* in = (const float* const*)d_in;
    p.x_prompt = in[0]; p.x_sample = in[1]; p.c_prompt = in[2]; p.c_sample = in[3]; p.cache128 = in[4]; p.cache512 = in[5]; p.cache2048 = in[6]; p.state_gla = in[7];
    p.w_ada = in[8]; p.b_ada = in[9]; p.w_in = in[10]; p.w_gla_up = in[11]; p.b_gla = in[12]; p.gla_norm_w = in[13]; p.w_br_a = in[14]; p.w_br_b = in[15]; p.w_out = in[16];
    p.ln1_w = in[17]; p.ln1_b = in[18]; p.w_pq = in[19]; p.peer_k1 = in[20]; p.peer_k2 = in[21]; p.peer_u = in[22]; p.peer_v = in[23]; p.ln2_w = in[24]; p.ln2_b = in[25];
    p.out = (float*)d_out;
    size_t off = 0; char* ws = (char*)d_ws;
#define CARVE(field, type, count) do { p.field = (type*)(ws + off); off = align_up(off + (size_t)(count) * sizeof(type), 256); } while (0)
    CARVE(bar, unsigned, 4096);
    CARVE(MOD, float, 256 * 6144); CARVE(SC, bf16_t, 256 * 1024); CARVE(WADA_T, bf16_t, 6144 * 1024); CARVE(WIN_T, bf16_t, (size_t)NPROJ * 1024);
    CARVE(WBRA_T, bf16_t, 1024 * 256); CARVE(WBRB_T, bf16_t, 1024 * 1024); CARVE(WOUT_T, bf16_t, 1024 * 1024); CARVE(WPQ_T, bf16_t, 2048 * 1024);
    CARVE(KF, bf16_t, 2 * 8 * 128 * 128); CARVE(U8, unsigned char, (size_t)16384 * 2048); p.V8 = p.U8 + 1024; CARVE(SU, float, 16384); CARVE(SV, float, 16384);
    CARVE(H, bf16_t, (size_t)MP * 1024); CARVE(QKVA, bf16_t, (size_t)MP * 2304); CARVE(QKB, bf16_t, (size_t)MP * 1024); CARVE(VBB, bf16_t, (size_t)MP * 1024);
    CARVE(RB, bf16_t, (size_t)MP * 1024); CARVE(GA, bf16_t, (size_t)MP * 1024); CARVE(GB, bf16_t, (size_t)MP * 1024); CARVE(GLR, float, (size_t)MP * 16);
    CARVE(OG, bf16_t, (size_t)MP * 768); CARVE(LSE, float, (size_t)MP * 12);
    CARVE(LSEG, float, (size_t)256 * 32768); CARVE(SSEG, float, (size_t)256 * 32768); CARVE(DSEG, float, (size_t)256 * 128); CARVE(OGLA, bf16_t, (size_t)MP * 1024);
    CARVE(OA, bf16_t, (size_t)MP * 256); CARVE(OB, bf16_t, (size_t)MP * 1024); CARVE(TMP1, bf16_t, (size_t)MP * 1024); CARVE(MERGED, bf16_t, (size_t)MP * 1024);
    CARVE(Z1, float, (size_t)MP * 1024); CARVE(LNST, float, (size_t)MP * 2); CARVE(QV, bf16_t, (size_t)MP * 2048); CARVE(EIDX, int, (size_t)MP * 128); CARVE(EGW, float, (size_t)MP * 128); CARVE(ESU, float, (size_t)MP * 128); CARVE(EW, float, (size_t)MP * 128); CARVE(H8, unsigned char, (size_t)MP * 1024); CARVE(HS, float, (size_t)MP);
    if (off > ws_size) { fprintf(stderr, "kernel_launch: workspace too small: need %zu, have %zu\n", off, ws_size); return; }

    static int grid = 0;
    if (!grid) {
        int dev = 0, cus = 0; (void)hipGetDevice(&dev); (void)hipDeviceGetAttribute(&cus, hipDeviceAttributeMultiprocessorCount, dev);
        grid = cus > 0 ? cus : 256;
        (void)hipFuncSetAttribute((const void*)k_mega, hipFuncAttributeMaxDynamicSharedMemorySize, LDS_BYTES);
        int per_cu = 0;
        if (hipOccupancyMaxActiveBlocksPerMultiprocessor(&per_cu, (const void*)k_mega, NTHREADS, LDS_BYTES) != hipSuccess || per_cu < 1)
            fprintf(stderr, "kernel_launch: occupancy query reports %d workgroups per CU for the persistent kernel\n", per_cu);
    }
    (void)hipMemsetAsync(p.bar, 0, 4096 * sizeof(unsigned), stream);
    hipLaunchKernelGGL(k_mega, dim3(grid), dim3(NTHREADS), LDS_BYTES, stream, p);
}
```

```cpp
#include <hip/hip_runtime.h>
#include <stdint.h>
#include <stdio.h>
#include <string.h>
#include <type_traits>
namespace pg8 {
#define PG8_LAS __attribute__((address_space(3)))
typedef unsigned short bf16_t;
typedef short bf16x8 __attribute__((ext_vector_type(8)));
typedef float f32x4 __attribute__((ext_vector_type(4)));
typedef unsigned u32x4 __attribute__((ext_vector_type(4)));
constexpr int BM = 256, BK = 64, HALF = 128, HTB = HALF * BK * 2  , STAGE_BYTES = 8 * HTB, NXCD = 8, WGM = 8;

__host__ __device__ __forceinline__ int lds_byte(int r, int c) { const int st = (r >> 4) * 2 + (c >> 5), rr = r & 15, cc = c & 31, ob = rr * 64 + cc * 2; return st * 1024 + (ob ^ (((ob >> 9) & 1) << 5)); }
__host__ __device__ __forceinline__ void stage_rc(int b, int& R, int& C) { const int st = b / 1024, sb = b % 1024, swz = sb ^ (((sb >> 9) & 1) << 5); R = (st >> 1) * 16 + swz / 64; C = (st & 1) * 32 + (swz % 64) / 2; }
__host__ __device__ __forceinline__ int perm32(int rho) { const int n = rho >> 4, i = rho & 15; return 8 * (i >> 2) + 4 * n + (i & 3); }

struct Unit { int pm, pn; };
struct Gemm { const bf16_t* A; const bf16_t* Bt; int M, N, K; };

struct StaticOrder {
    int nM, nN, nwg, G, c;
    __host__ __device__ void init(int M, int N, int G_, int c_) { nM = M / BM; nN = N / BM; nwg = nM * nN; G = G_; c = c_; }
    __host__ __device__ bool next(int i, Unit& u) const {
        const long L = (long)i * G + c; if (L >= nwg) return false;
        int wgid = (int)L; { const int q = nwg / NXCD, r = nwg % NXCD, xcd = wgid % NXCD, off = wgid / NXCD; wgid = (xcd < r ? xcd * (q + 1) : r * (q + 1) + (xcd - r) * q) + off; }
        const int nig = WGM * nN, gid = wgid / nig, fm = gid * WGM, gsz = (nM - fm) < WGM ? (nM - fm) : WGM;
        u.pm = fm + ((wgid % nig) % gsz); u.pn = (wgid % nig) / gsz; return true;
    }
    __device__ __forceinline__ void a_ready(const Unit&) const {}
    __device__ __forceinline__ void done(const Unit&) const {}
};
__device__ __forceinline__ unsigned cvt_pk_bf16(float lo, float hi) { unsigned r; asm volatile("v_cvt_pk_bf16_f32 %0, %1, %2" : "=v"(r) : "v"(lo), "v"(hi)); return r; }
typedef float f32x2 __attribute__((ext_vector_type(2)));
struct EpiF32 {
    static constexpr bool PERM = false, AFTER_DRAIN = false;
    float* C; int ldc; const float* bias;
    __device__ __forceinline__ void operator()(const f32x4 (&acc)[2][2][4][2], const Unit& u, int wr, int wc, int fr, int fq) const {
        const int row0 = u.pm * BM + wr * 64 + fr, col0 = u.pn * BM + wc * 32 + 4 * fq;
        f32x4 bv[2][2];
#pragma unroll
        for (int bj = 0; bj < 2; ++bj)
#pragma unroll
            for (int n = 0; n < 2; ++n) bv[bj][n] = bias ? *(const f32x4*)(bias + col0 + bj * HALF + n * 16) : (f32x4){0.f, 0.f, 0.f, 0.f};
#pragma unroll
        for (int ai = 0; ai < 2; ++ai)
#pragma unroll
            for (int m = 0; m < 4; ++m) { float* rowp = C + (size_t)(row0 + ai * HALF + m * 16) * ldc + col0;
#pragma unroll
                for (int bj = 0; bj < 2; ++bj)
#pragma unroll
                    for (int n = 0; n < 2; ++n) *(f32x4*)(rowp + bj * HALF + n * 16) = acc[ai][bj][m][n] + bv[bj][n]; }
    }
};
template <class Epi, class Sched, bool STAMP = false>
__device__ __forceinline__ void gemm_phase(PG8_LAS unsigned char* lds, const Gemm g, const Sched& S, const Epi& E, unsigned long long* stamps) {
    int tid_o = threadIdx.x; asm volatile("" : "+v"(tid_o));
    const int tid = tid_o, wid = __builtin_amdgcn_readfirstlane(tid >> 6), lane = tid & 63, wr = wid >> 2, wc = wid & 3, fr = lane & 15, fq = lane >> 4;
    const int K = g.K, nt = K / BK;
    int ts_lo = 0, ts_hi = 0, nts = 0; const unsigned long long rt_entry = STAMP ? (unsigned long long)wall_clock64() : 0ull;
#define PG8_STAMP() do { if (STAMP && wid == 0 && nts < 64) { const unsigned long long _c = (unsigned long long)clock64(); \
        ts_lo = (lane == nts) ? (int)(unsigned)_c : ts_lo; ts_hi = (lane == nts) ? (int)(unsigned)(_c >> 32) : ts_hi; ++nts; } } while (0)
    PG8_STAMP();
    unsigned voffA[2], voffB[2];
#pragma unroll
    for (int i = 0; i < 2; ++i) { int R, C; stage_rc(tid * 16 + i * 8192, R, C); const int Rb = Epi::PERM ? ((R & ~31) + perm32(R & 31)) : R;
        voffA[i] = (unsigned)(R * K + C) * 2u; voffB[i] = (unsigned)(Rb * K + C) * 2u; }
    const size_t kstep = (size_t)(BK * 2);
    const size_t hstep = (size_t)HALF * K * 2;
    const size_t tstep = 2 * hstep;
    const unsigned ldsw = (unsigned)wid * 1024u;
    const int aoff = lds_byte(wr * 64 + fr, fq * 8), boff = lds_byte(wc * 32 + fr, fq * 8);
#define PG8_SA(b, h) (((b) * 2 + (h)) * HTB)
#define PG8_SB(b, h) ((4 + (b) * 2 + (h)) * HTB)
#define PG8_STAGE(bufoff, gbase, voff) do { _Pragma("unroll") for (int _i = 0; _i < 2; ++_i) \
        __builtin_amdgcn_global_load_lds((const unsigned*)((const char*)(gbase) + (voff)[_i]), (PG8_LAS unsigned*)(lds + (bufoff) + ldsw + _i * 8192), 16, 0, 0); } while (0)
#define PG8_LDA(dst, b, h) do { _Pragma("unroll") for (int m = 0; m < 4; ++m) _Pragma("unroll") for (int k = 0; k < 2; ++k) dst[m][k] = *(const PG8_LAS bf16x8*)(lds + PG8_SA(b, h) + aoff + m * 2048 + k * 1024); } while (0)
#define PG8_LDB(dst, b, h) do { _Pragma("unroll") for (int n = 0; n < 2; ++n) _Pragma("unroll") for (int k = 0; k < 2; ++k) dst[n][k] = *(const PG8_LAS bf16x8*)(lds + PG8_SB(b, h) + boff + n * 2048 + k * 1024); } while (0)
#define PG8_MMA(ai, bj, At, Bt) do { __builtin_amdgcn_s_setprio(1); _Pragma("unroll") for (int m = 0; m < 4; ++m) _Pragma("unroll") for (int n = 0; n < 2; ++n) _Pragma("unroll") for (int k = 0; k < 2; ++k) \
        acc[ai][bj][m][n] = __builtin_amdgcn_mfma_f32_16x16x32_bf16(Bt[n][k], At[m][k], acc[ai][bj][m][n], 0, 0, 0); __builtin_amdgcn_s_setprio(0); } while (0)
#define PG8_WAIT_V(n) asm volatile("s_waitcnt vmcnt(" #n ")" ::: "memory")
#define PG8_WAIT_L(n) asm volatile("s_waitcnt lgkmcnt(" #n ")" ::: "memory")
#define PG8_BAR __builtin_amdgcn_s_barrier()
#define PG8_SCHED __builtin_amdgcn_sched_barrier(0)
    Unit cur, nxt; int ui = 0;
    if (!S.next(0, cur)) return;
    f32x4 acc[2][2][4][2];
#pragma unroll
    for (int a = 0; a < 2; ++a)
#pragma unroll
        for (int b = 0; b < 2; ++b)
#pragma unroll
            for (int m = 0; m < 4; ++m)
#pragma unroll
                for (int n = 0; n < 2; ++n) acc[a][b][m][n] = (f32x4){0.f, 0.f, 0.f, 0.f};
    bf16x8 At[4][2], B0[2][2], B1[2][2];
    const char* cA = (const char*)g.A + (size_t)cur.pm * tstep; const char* cB = (const char*)g.Bt + (size_t)cur.pn * tstep;
    S.a_ready(cur);
    PG8_STAGE(PG8_SB(0, 0), cB, voffB); PG8_STAGE(PG8_SA(0, 0), cA, voffA); PG8_STAGE(PG8_SB(0, 1), cB + hstep, voffB); PG8_STAGE(PG8_SA(0, 1), cA + hstep, voffA);
    if (wr == 1) PG8_BAR;
    PG8_WAIT_V(4); PG8_BAR;
    PG8_STAGE(PG8_SB(1, 0), cB + kstep, voffB); PG8_STAGE(PG8_SA(1, 0), cA + kstep, voffA); PG8_STAGE(PG8_SB(1, 1), cB + hstep + kstep, voffB);
    PG8_WAIT_V(6); PG8_BAR;
    PG8_STAMP();
    for (;;) {
        const bool has_next = S.next(ui + 1, nxt);
        const char* nA = has_next ? (const char*)g.A + (size_t)nxt.pm * tstep : cA; const char* nB = has_next ? (const char*)g.Bt + (size_t)nxt.pn * tstep : cB;
        for (int t = 0; t < nt; t += 2) {
            const bool last = (t == nt - 2);
            const char* a1 = cA + (size_t)(t + 1) * kstep;
            const char* a2 = last ? nA : cA + (size_t)(t + 2) * kstep; const char* b2 = last ? nB : cB + (size_t)(t + 2) * kstep;
            const char* a3 = a2 + kstep; const char* b3 = b2 + kstep;
            if (last && has_next) S.a_ready(nxt);
            PG8_LDB(B0, 0, 0); PG8_SCHED; PG8_LDA(At, 0, 0); PG8_STAGE(PG8_SA(1, 1), a1 + hstep, voffA);
            PG8_WAIT_L(8); PG8_BAR; PG8_WAIT_L(0); PG8_MMA(0, 0, At, B0); PG8_BAR; PG8_SCHED;
            PG8_LDB(B1, 0, 1); PG8_STAGE(PG8_SB(0, 0), b2, voffB);
            PG8_BAR; PG8_WAIT_L(0); PG8_MMA(0, 1, At, B1); PG8_BAR;
            PG8_LDA(At, 0, 1); PG8_STAGE(PG8_SA(0, 0), a2, voffA);
            PG8_BAR; PG8_WAIT_L(0); PG8_MMA(1, 0, At, B0); PG8_BAR; PG8_SCHED;
            PG8_STAGE(PG8_SB(0, 1), b2 + hstep, voffB);
            PG8_WAIT_V(6); PG8_BAR; PG8_MMA(1, 1, At, B1); PG8_BAR;
            PG8_LDB(B0, 1, 0); PG8_SCHED; PG8_LDA(At, 1, 0); PG8_STAGE(PG8_SA(0, 1), a2 + hstep, voffA);
            PG8_WAIT_L(8); PG8_BAR; PG8_WAIT_L(0); PG8_MMA(0, 0, At, B0); PG8_BAR; PG8_SCHED;
            PG8_LDB(B1, 1, 1); PG8_STAGE(PG8_SB(1, 0), b3, voffB);
            PG8_BAR; PG8_WAIT_L(0); PG8_MMA(0, 1, At, B1); PG8_BAR;
            PG8_LDA(At, 1, 1); PG8_STAGE(PG8_SA(1, 0), a3, voffA);
            PG8_BAR; PG8_WAIT_L(0); PG8_MMA(1, 0, At, B0); PG8_BAR; PG8_SCHED;
            PG8_STAGE(PG8_SB(1, 1), b3 + hstep, voffB);
            PG8_WAIT_V(6); PG8_BAR; PG8_MMA(1, 1, At, B1); PG8_BAR;
        }
        PG8_STAMP();
        if constexpr (!Epi::AFTER_DRAIN) { E(acc, cur, wr, wc, fr, fq); S.done(cur); }
        PG8_STAMP();
        if (!has_next) break;
#pragma unroll
        for (int a = 0; a < 2; ++a)
#pragma unroll
            for (int b = 0; b < 2; ++b)
#pragma unroll
                for (int m = 0; m < 4; ++m)
#pragma unroll
                    for (int n = 0; n < 2; ++n) acc[a][b][m][n] = (f32x4){0.f, 0.f, 0.f, 0.f};
        cur = nxt; cA = nA; cB = nB; ++ui;
    }
    PG8_WAIT_V(0);
    if (wr == 0) PG8_BAR;
    PG8_BAR;
    if constexpr (Epi::AFTER_DRAIN) { E.fused(acc, cur, wr, wc, fr, fq, lds, wid, lane); S.done(cur); }
    PG8_STAMP();
    if (STAMP && wid == 0) { stamps[lane] = lane < nts ? (((unsigned long long)(unsigned)ts_hi << 32) | (unsigned)ts_lo) : 0ull;
        if (lane == 62) stamps[62] = rt_entry; if (lane == 63) stamps[63] = (unsigned long long)wall_clock64(); }
#undef PG8_STAMP
#undef PG8_SA
#undef PG8_SB
#undef PG8_STAGE
#undef PG8_LDA
#undef PG8_LDB
#undef PG8_MMA
#undef PG8_WAIT_V
#undef PG8_WAIT_L
#undef PG8_BAR
#undef PG8_SCHED
}
}

typedef unsigned short bf16_t;
typedef float f32x4 __attribute__((ext_vector_type(4)));
typedef float f32x16 __attribute__((ext_vector_type(16)));
typedef short bf16x8 __attribute__((ext_vector_type(8)));
typedef unsigned u32x4 __attribute__((ext_vector_type(4)));
typedef unsigned u32x2 __attribute__((ext_vector_type(2)));
#define LAS __attribute__((address_space(3)))

constexpr int D = 1024, BP = 2, T = 16384, NTP = BP * T  , NS = 128, NT = NTP + NS  , MP = 33024  ;
constexpr int NPROJ = 7680;
constexpr int NTHREADS = 512;
constexpr int LDS_BYTES = 155648;
constexpr float LN_EPS = 1e-5f;
constexpr float DN_ALPHA = 1.189207115002721f;

constexpr size_t OFF_YP = 0;
constexpr size_t OFF_YS = OFF_YP + (size_t)NTP * D;
constexpr size_t OFF_KVP0 = OFF_YS + (size_t)NS * D;
constexpr size_t OFF_KVP1 = OFF_KVP0 + (size_t)BP * 128 * 512;
constexpr size_t OFF_KVP2 = OFF_KVP1 + (size_t)BP * 512 * 512;
constexpr size_t OFF_GLAP = OFF_KVP2 + (size_t)BP * 2048 * 512;
constexpr size_t OFF_KVS0 = OFF_GLAP + (size_t)BP * 4 * 128 * 256;
constexpr size_t OFF_KVS1 = OFF_KVS0 + (size_t)NS * 128 * 512;
constexpr size_t OFF_KVS2 = OFF_KVS1 + (size_t)NS * 512 * 512;
constexpr size_t OFF_GLAS = OFF_KVS2 + (size_t)NS * 2048 * 512;
constexpr size_t OUT_TOTAL = OFF_GLAS + (size_t)NS * 4 * 128 * 256;

struct Params {
    const float *x_prompt, *x_sample, *c_prompt, *c_sample, *cache128, *cache512, *cache2048, *state_gla;
    const float *w_ada, *b_ada, *w_in, *w_gla_up, *b_gla, *gla_norm_w, *w_br_a, *w_br_b, *w_out, *ln1_w, *ln1_b;
    const float *w_pq, *peer_k1, *peer_k2, *peer_u, *peer_v, *ln2_w, *ln2_b;
    float* out;
    unsigned* bar;
    float* MOD; bf16_t* SC; bf16_t* WADA_T; bf16_t* WIN_T; bf16_t* WBRA_T; bf16_t* WBRB_T; bf16_t* WOUT_T; bf16_t* WPQ_T;
    bf16_t* KF; unsigned char* U8; unsigned char* V8; float* SU; float* SV;
    bf16_t* H; bf16_t* QKVA; bf16_t* QKB; bf16_t* VBB; bf16_t* RB; bf16_t* GA; bf16_t* GB; float* GLR;
    bf16_t* OG; float* LSE; float* LSEG; float* DSEG; float* SSEG; bf16_t* OGLA;
    bf16_t* OA; bf16_t* OB; bf16_t* TMP1; bf16_t* MERGED; float* Z1; float* LNST; bf16_t* QV; int* EIDX; float* EGW; float* ESU; float* EW; unsigned char* H8; float* HS;
};

__device__ __forceinline__ float bf2f(bf16_t v) { return __uint_as_float(((unsigned)v) << 16); }
__device__ __forceinline__ float bflo(unsigned w) { return __uint_as_float(w << 16); }
__device__ __forceinline__ float bfhi(unsigned w) { return __uint_as_float(w & 0xffff0000u); }
typedef __bf16 v2bf_t __attribute__((ext_vector_type(2)));
typedef float v2f_t __attribute__((ext_vector_type(2)));
__device__ __forceinline__ unsigned pack2(float lo, float hi) { const v2f_t f = {lo, hi}; const v2bf_t b = __builtin_convertvector(f, v2bf_t); return __builtin_bit_cast(unsigned, b); }
__device__ __forceinline__ bf16_t f2bf(float f) { return (bf16_t)(pack2(f, 0.f) & 0xffffu); }
__device__ __forceinline__ void unpack8(const u32x4 w, float (&o)[8]) { o[0] = bflo(w.x); o[1] = bfhi(w.x); o[2] = bflo(w.y); o[3] = bfhi(w.y); o[4] = bflo(w.z); o[5] = bfhi(w.z); o[6] = bflo(w.w); o[7] = bfhi(w.w); }
__device__ __forceinline__ float wave_sum(float v) {
#pragma unroll
    for (int o = 32; o >= 1; o >>= 1) v += __shfl_xor(v, o);
    return v;
}
__device__ __forceinline__ float wave_max(float v) {
#pragma unroll
    for (int o = 32; o >= 1; o >>= 1) v = fmaxf(v, __shfl_xor(v, o));
    return v;
}
#define DPP_ROR_F(v, n) __builtin_bit_cast(float, __builtin_amdgcn_update_dpp(0, __builtin_bit_cast(int, (v)), 0x120 + (n), 0xf, 0xf, true))
__device__ __forceinline__ float dpp_row_sum(float v) {
    v += DPP_ROR_F(v, 8); v += DPP_ROR_F(v, 4); v += DPP_ROR_F(v, 2); v += DPP_ROR_F(v, 1); return v;
}
__device__ __forceinline__ float sigmoidf_(float x) { return __builtin_amdgcn_rcpf(1.0f + __expf(-x)); }
__device__ __forceinline__ float siluf_(float x) { return x * __builtin_amdgcn_rcpf(1.0f + __expf(-x)); }
#define XB_TMO      128
#define XB_XCNT(j)  (256  + 64 * (j))
#define XB_XSUB(j)  (1280 + 64 * (j))
#define XB_XGEN(j)  (2304 + 64 * (j))
#define XB_TOP      3328
#define XB_TOPGEN   3392
#define XCD_BAR_WORDS 3456
#define XB_SPIN_CAP (1u << 22)

__device__ __forceinline__ unsigned xb_ld(unsigned* p)              { return __hip_atomic_load(p, __ATOMIC_RELAXED, __HIP_MEMORY_SCOPE_AGENT); }
__device__ __forceinline__ unsigned xb_add(unsigned* p, unsigned v) { return __hip_atomic_fetch_add(p, v, __ATOMIC_RELAXED, __HIP_MEMORY_SCOPE_AGENT); }
__device__ __forceinline__ unsigned xb_xcc_id() { return (unsigned)__builtin_amdgcn_s_getreg((3 << 11) | 20) & 0xFu; }
#define XB_SPIN(cond, bar) do { unsigned _sp = 0; while (cond) { __builtin_amdgcn_s_sleep(1); \
    if ((++_sp & 255u) == 0u) { if (xb_ld(&(bar)[XB_TMO])) break; if (_sp > XB_SPIN_CAP) { atomicAdd(&(bar)[XB_TMO], 1u); break; } } } } while (0)

struct XcdBarrier {
    unsigned* bar; unsigned x;
    volatile LAS unsigned* st;
};

__device__ __forceinline__ XcdBarrier xcd_barrier_post(unsigned* bar, volatile LAS unsigned* st) {
    XcdBarrier b; b.bar = bar; b.x = xb_xcc_id(); b.st = st;
    if (threadIdx.x == 0) (void)xb_add(&bar[XB_XCNT(b.x)], 1u);
    return b;
}
__device__ __forceinline__ void xcd_barrier_complete(unsigned* bar, unsigned x, unsigned& nloc, unsigned& nx) {
    const unsigned G = gridDim.x * gridDim.y * gridDim.z;
    unsigned sum, cnt, mine, sp = 0u;
    for (;;) {
        sum = 0u; cnt = 0u; mine = 0u;
#pragma unroll
        for (unsigned j = 0; j < 16; ++j) { const unsigned c = xb_ld(&bar[XB_XCNT(j)]); sum += c; cnt += (c > 0u) ? 1u : 0u; mine = (j == x) ? c : mine; }
        if (sum == G) break;
        __builtin_amdgcn_s_sleep(1);
        if ((++sp & 255u) == 0u) { if (xb_ld(&bar[XB_TMO])) break; if (sp > XB_SPIN_CAP) { atomicAdd(&bar[XB_TMO], 1u); break; } }
    }
    nloc = mine > 0u ? mine : 1u; nx = cnt > 0u ? cnt : 1u;
}

__device__ __forceinline__ void xcd_barrier(const XcdBarrier& b) {
    asm volatile("s_waitcnt vmcnt(0)" ::: "memory");
    __syncthreads();
    if (threadIdx.x == 0) {
        unsigned* bar = b.bar;
        __builtin_amdgcn_s_waitcnt(0);
        unsigned nloc = b.st[0], nx = b.st[1];
        if (nloc == 0u) { xcd_barrier_complete(bar, b.x, nloc, nx); b.st[0] = nloc; b.st[1] = nx; }
        const unsigned old = xb_add(&bar[XB_XSUB(b.x)], 1u);
        const unsigned gen = old / nloc;
        if (old + 1u == (gen + 1u) * nloc) {
            __builtin_amdgcn_fence(__ATOMIC_RELEASE, "agent");
            asm volatile("s_waitcnt vmcnt(0)" ::: "memory");
            const unsigned og = xb_add(&bar[XB_TOP], 1u);
            const unsigned tg = og / nx;
            if (og + 1u == (tg + 1u) * nx) xb_add(&bar[XB_TOPGEN], 1u);
            else XB_SPIN(xb_ld(&bar[XB_TOPGEN]) == tg, bar);
            __builtin_amdgcn_fence(__ATOMIC_ACQUIRE, "agent");
            xb_add(&bar[XB_XGEN(b.x)], 1u);
            asm volatile("s_waitcnt vmcnt(0)" ::: "memory");
        } else {
            XB_SPIN(xb_ld(&bar[XB_XGEN(b.x)]) == gen, bar);
            __builtin_amdgcn_fence(__ATOMIC_ACQUIRE, "agent");
            asm volatile("s_waitcnt vmcnt(0)" ::: "memory");
        }
    }
    __syncthreads();
}

__device__ __forceinline__ int win_cmap(int n) {
    if (n < 5376) return n;
    if (n < 6400) return n + 16;
    if (n < 7424) return n + 16;
    if (n < 7440) return n - 7424 + 5376;
    return -1;
}
__device__ __forceinline__ void tconv_tile(const float* __restrict__ src, int ldsrc, int K, bf16_t* __restrict__ dst, int tk, int tn, bool win, LAS float* tile) {
    int tid_ = threadIdx.x; asm volatile("" : "+v"(tid_));
    const int nl = tid_ & 63, kl0 = tid_ >> 6;
    const int n = tn * 64 + nl;
    const int sc = win ? win_cmap(n) : n;
#pragma unroll
    for (int i = 0; i < 8; ++i) { const int k = kl0 + 8 * i; tile[k * 65 + nl] = sc >= 0 ? src[(size_t)(tk * 64 + k) * ldsrc + sc] : 0.f; }
    __syncthreads();
    const int n2 = tid_ >> 3, kc = (tid_ & 7) * 8;
    u32x4 w;
    w.x = pack2(tile[(kc + 0) * 65 + n2], tile[(kc + 1) * 65 + n2]);
    w.y = pack2(tile[(kc + 2) * 65 + n2], tile[(kc + 3) * 65 + n2]);
    w.z = pack2(tile[(kc + 4) * 65 + n2], tile[(kc + 5) * 65 + n2]);
    w.w = pack2(tile[(kc + 6) * 65 + n2], tile[(kc + 7) * 65 + n2]);
    *(u32x4*)(dst + (size_t)(tn * 64 + n2) * K + tk * 64 + kc) = w;
    __syncthreads();
}
__device__ __forceinline__ void conv_chunk(const float* __restrict__ src, bf16_t* __restrict__ dst, size_t chunk) {
    int tid_ = threadIdx.x; asm volatile("" : "+v"(tid_));
    const size_t e = chunk * 4096 + (size_t)tid_ * 8;
    const f32x4 a = *(const f32x4*)(src + e), b = *(const f32x4*)(src + e + 4);
    u32x4 w; w.x = pack2(a[0], a[1]); w.y = pack2(a[2], a[3]); w.z = pack2(b[0], b[1]); w.w = pack2(b[2], b[3]);
    *(u32x4*)(dst + e) = w;
}

__device__ __forceinline__ void quant_rows8(const float* __restrict__ src, unsigned char* __restrict__ dst  , float* __restrict__ scl, int job) {
    int tid_ = threadIdx.x; asm volatile("" : "+v"(tid_));
    const int wave = tid_ >> 6, lane = tid_ & 63;
    const size_t row = (size_t)job * 8 + wave;
    const float* r = src + row * 1024 + 16 * lane;
    f32x4 x[4];
#pragma unroll
    for (int i = 0; i < 4; ++i) x[i] = *(const f32x4*)(r + 4 * i);
    float m = 0.f;
#pragma unroll
    for (int i = 0; i < 4; ++i) m = fmaxf(m, fmaxf(fmaxf(fabsf(x[i][0]), fabsf(x[i][1])), fmaxf(fabsf(x[i][2]), fabsf(x[i][3]))));
    m = wave_max(m);
    const float inv = m > 0.f ? 448.0f / m : 1.0f, sc = m > 0.f ? m * (1.0f / 448.0f) : 1.0f;
    u32x4 w;
#pragma unroll
    for (int i = 0; i < 4; ++i) {
        int d = 0;
        d = __builtin_amdgcn_cvt_pk_fp8_f32(x[i][0] * inv, x[i][1] * inv, d, false);
        d = __builtin_amdgcn_cvt_pk_fp8_f32(x[i][2] * inv, x[i][3] * inv, d, true);
        w[i] = (unsigned)d;
    }
    *(u32x4*)(dst + row * 2048 + 16 * lane) = w;
    if (lane == 0) scl[row] = sc;
}

__device__ __forceinline__ void kfrag_chunk(const float* __restrict__ k1, const float* __restrict__ k2, bf16_t* __restrict__ dst, int job) {
    int tid_ = threadIdx.x; asm volatile("" : "+v"(tid_));
    const int c = job * 512 + tid_, lane = c & 63, ks = (c >> 6) & 7, ni = (c >> 9) & 3, half = (c >> 11) & 1, h = c >> 12;
    const float* s = (half ? k2 : k1) + ((size_t)h * 128 + 32 * ni + (lane & 31)) * 128 + 16 * ks + 8 * (lane >> 5);
    const f32x4 a = *(const f32x4*)s, b = *(const f32x4*)(s + 4);
    u32x4 w; w.x = pack2(a[0], a[1]); w.y = pack2(a[2], a[3]); w.z = pack2(b[0], b[1]); w.w = pack2(b[2], b[3]);
    *(u32x4*)(dst + (size_t)c * 8) = w;
}
template <int STAGE> __device__ __forceinline__ void phase_prologue(const Params& p, int bid, int nb, LAS unsigned char* lds, int skip0) {
    int tid_ = threadIdx.x; asm volatile("" : "+v"(tid_));
    LAS float* tile = (LAS float*)lds;
    constexpr int J0 = 16 * 120, J1 = J0 + 16 * 96, J2 = J1 + 16 * 32, J3 = J2 + 256, J4 = J3 + 256, J5 = J4 + 64, J6 = J5 + 2048, J7 = J6 + 2048, J8 = J7 + 32, J9 = J8 + 32, J10 = J9 + 64;
    (void)J8;
    const int njobs = STAGE == 0 ? J1 + (J10 - J9) : J9 - J1;
    const int first = STAGE == 0 ? bid : bid - skip0, stride = STAGE == 0 ? nb : nb - skip0;
    if (first < 0 || stride <= 0) return;
    for (int jj = first; jj < njobs; jj += stride) {
        const int j = STAGE == 0 ? (jj < J1 ? jj : J9 + (jj - J1)) : J1 + jj;
        if (j < J0) { tconv_tile(p.w_in, 7440, 1024, p.WIN_T, j % 16, j / 16, true, tile); }
        else if (j < J1) { const int q = j - J0; tconv_tile(p.w_ada, 6144, 1024, p.WADA_T, q % 16, q / 16, false, tile); }
        else if (j < J2) { const int q = j - J1; tconv_tile(p.w_pq, 2048, 1024, p.WPQ_T, q % 16, q / 16, false, tile); }
        else if (j < J3) { const int q = j - J2; tconv_tile(p.w_br_b, 1024, 1024, p.WBRB_T, q % 16, q / 16, false, tile); }
        else if (j < J4) { const int q = j - J3; tconv_tile(p.w_out, 1024, 1024, p.WOUT_T, q % 16, q / 16, false, tile); }
        else if (j < J5) { const int q = j - J4; tconv_tile(p.w_br_a, 1024, 256, p.WBRA_T, q % 4, q / 4, false, tile); }
        else if (j < J6) { quant_rows8(p.peer_u, p.U8, p.SU, j - J5); }
        else if (j < J7) { quant_rows8(p.peer_v, p.U8 + 1024, p.SV, j - J6); }
        else if (j < J9) { kfrag_chunk(p.peer_k1, p.peer_k2, p.KF, j - J7); }
        else {
            const size_t e = (size_t)(j - J9) * 4096 + (size_t)tid_ * 8;
            const int row = (int)(e >> 10), col = (int)(e & 1023);
            float v[8];
#pragma unroll
            for (int i = 0; i < 8; ++i) v[i] = 0.f;
            if (row < 130) {
                const float* c = row < 2 ? p.c_prompt + (size_t)row * 1024 + col : p.c_sample + (size_t)(row - 2) * 1024 + col;
#pragma unroll
                for (int i = 0; i < 8; ++i) v[i] = siluf_(c[i]);
            }
            u32x4 w; w.x = pack2(v[0], v[1]); w.y = pack2(v[2], v[3]); w.z = pack2(v[4], v[5]); w.w = pack2(v[6], v[7]);
            *(u32x4*)(p.SC + e) = w;
        }
    }
}

__device__ __forceinline__ void row_stats(const float (&v)[16], float& mean, float& rstd) {
    float s = 0.f;
#pragma unroll
    for (int i = 0; i < 16; ++i) s += v[i];
    s = wave_sum(s);
    mean = s * (1.0f / 1024.0f);
    float q = 0.f;
#pragma unroll
    for (int i = 0; i < 16; ++i) { const float d = v[i] - mean; q += d * d; }
    q = wave_sum(q);
    rstd = rsqrtf(q * (1.0f / 1024.0f) + LN_EPS);
}
__device__ __forceinline__ void load_row16(const float* __restrict__ r, int lane, float (&v)[16]) {
    const f32x4 a = *(const f32x4*)(r + 8 * lane), b = *(const f32x4*)(r + 8 * lane + 4), c = *(const f32x4*)(r + 512 + 8 * lane), d = *(const f32x4*)(r + 512 + 8 * lane + 4);
#pragma unroll
    for (int i = 0; i < 4; ++i) { v[i] = a[i]; v[4 + i] = b[i]; v[8 + i] = c[i]; v[12 + i] = d[i]; }
}
__device__ __forceinline__ void store_row16_bf16(bf16_t* __restrict__ r, int lane, const float (&v)[16]) {
    u32x4 w0, w1;
    w0.x = pack2(v[0], v[1]); w0.y = pack2(v[2], v[3]); w0.z = pack2(v[4], v[5]); w0.w = pack2(v[6], v[7]);
    w1.x = pack2(v[8], v[9]); w1.y = pack2(v[10], v[11]); w1.z = pack2(v[12], v[13]); w1.w = pack2(v[14], v[15]);
    *(u32x4*)(r + 8 * lane) = w0; *(u32x4*)(r + 512 + 8 * lane) = w1;
}
__device__ __forceinline__ void store_row16_f32(float* __restrict__ r, int lane, const float (&v)[16]) {
    *(f32x4*)(r + 8 * lane) = (f32x4){v[0], v[1], v[2], v[3]}; *(f32x4*)(r + 8 * lane + 4) = (f32x4){v[4], v[5], v[6], v[7]};
    *(f32x4*)(r + 512 + 8 * lane) = (f32x4){v[8], v[9], v[10], v[11]}; *(f32x4*)(r + 512 + 8 * lane + 4) = (f32x4){v[12], v[13], v[14], v[15]};
}
__device__ __forceinline__ const float* x_row(const Params& p, int row) { return row < NTP ? p.x_prompt + (size_t)row * D : p.x_sample + (size_t)(row - NTP) * D; }
__device__ __forceinline__ int seq_of(int row) { return row < NTP ? (row >> 14) : 2 + (row - NTP); }

__device__ __forceinline__ void phase_lnmod1(const Params& p, int bid, int nb) {
    int tid_ = threadIdx.x; asm volatile("" : "+v"(tid_));
    const int wave = tid_ >> 6, lane = tid_ & 63;
    int row = bid * 8 + wave;
    float nx[16];
    if (row < NT) load_row16(x_row(p, row), lane, nx);
    for (; row < NT; row += nb * 8) {
        float v[16];
#pragma unroll
        for (int i = 0; i < 16; ++i) v[i] = nx[i];
        const int nrow = row + nb * 8;
        if (nrow < NT) load_row16(x_row(p, nrow), lane, nx);
        const float* mod = p.MOD + (size_t)seq_of(row) * 6144;
        float sh[16], sc[16];
        load_row16(mod, lane, sh); load_row16(mod + 1024, lane, sc);
        float mean, rstd; row_stats(v, mean, rstd);
#pragma unroll
        for (int i = 0; i < 16; ++i) v[i] = (v[i] - mean) * rstd * (1.0f + sc[i]) + sh[i];
        store_row16_bf16(p.H + (size_t)row * D, lane, v);
    }
}

struct EpiProj {
    static constexpr bool PERM = true, AFTER_DRAIN = false;
    bf16_t *QKVA, *QKB, *VBB, *RB, *GA, *GB; float* GLR; float* out;
    __device__ __forceinline__ void operator()(const pg8::f32x4 (&acc)[2][2][4][2], const pg8::Unit& u, int wr, int wc, int fr, int fq) const {
        const int pn = u.pn;
        bf16_t* dst; int ld = 1024, c0; float scale = 1.0f;
        if (pn < 9) { dst = QKVA; ld = 2304; c0 = pn * 256; }
        else if (pn < 13) { dst = QKB; c0 = (pn - 9) * 256; if (pn < 11) scale = 0.08838834764831845f; }
        else if (pn < 17) { dst = VBB; c0 = (pn - 13) * 256; }
        else if (pn < 21) { dst = RB; c0 = (pn - 17) * 256; }
        else if (pn < 25) { dst = GA; c0 = (pn - 21) * 256; }
        else if (pn < 29) { dst = GB; c0 = (pn - 25) * 256; }
        else { dst = nullptr; c0 = 0; }
        const bool kvt = pn >= 3 && pn < 9;
        const int g = kvt ? (pn - 3) % 3 : 0, kv = kvt ? (pn - 3) / 3 : 0;
        const int W = 128 << (2 * g);
        const size_t offp = g == 0 ? OFF_KVP0 : (g == 1 ? OFF_KVP1 : OFF_KVP2);
        const size_t offs = g == 0 ? OFF_KVS0 : (g == 1 ? OFF_KVS1 : OFF_KVS2);
        const int row0 = u.pm * 256 + wr * 64 + fr, colw = wc * 32 + 8 * fq;
#pragma unroll
        for (int ai = 0; ai < 2; ++ai)
#pragma unroll
            for (int m = 0; m < 4; ++m) {
                const int row = row0 + ai * 128 + m * 16;
#pragma unroll
                for (int bj = 0; bj < 2; ++bj) {
                    const int cc = bj * 128 + colw;
                    const pg8::f32x4 v0 = acc[ai][bj][m][0], v1 = acc[ai][bj][m][1];
                    if (dst) {
                        u32x4 w; w.x = pack2(v0[0] * scale, v0[1] * scale); w.y = pack2(v0[2] * scale, v0[3] * scale); w.z = pack2(v1[0] * scale, v1[1] * scale); w.w = pack2(v1[2] * scale, v1[3] * scale);
                        *(u32x4*)(dst + (size_t)row * ld + c0 + cc) = w;
                    } else if (cc < 16) {
                        *(pg8::f32x4*)(GLR + (size_t)row * 16 + cc) = v0; *(pg8::f32x4*)(GLR + (size_t)row * 16 + cc + 4) = v1;
                    }
                    if (kvt) {
                        if (row < NTP) {
                            const int b = row >> 14, t = row & (T - 1);
                            if (t >= T - W) { float* o = out + offp + ((size_t)(b * W + (t - (T - W))) * 2 + kv) * 256 + cc; *(pg8::f32x4*)o = v0; *(pg8::f32x4*)(o + 4) = v1; }
                        } else if (row < NT) {
                            const int s = row - NTP;
                            float* o = out + offs + ((size_t)(s * W + (W - 1)) * 2 + kv) * 256 + cc; *(pg8::f32x4*)o = v0; *(pg8::f32x4*)(o + 4) = v1;
                        }
                    }
                }
            }
    }
    __device__ __forceinline__ void emit16(int row, int col, const float (&v)[16]) const {
        const int pn = col >> 8, cc = col & 255;
        bf16_t* dst; int ld = 1024, c0; float scale = 1.0f;
        if (pn < 9) { dst = QKVA; ld = 2304; c0 = pn * 256; }
        else if (pn < 13) { dst = QKB; c0 = (pn - 9) * 256; if (pn < 11) scale = 0.08838834764831845f; }
        else if (pn < 17) { dst = VBB; c0 = (pn - 13) * 256; }
        else if (pn < 21) { dst = RB; c0 = (pn - 17) * 256; }
        else if (pn < 25) { dst = GA; c0 = (pn - 21) * 256; }
        else if (pn < 29) { dst = GB; c0 = (pn - 25) * 256; }
        else { dst = nullptr; c0 = 0; }
        if (dst) {
            u32x4 w0, w1;
            w0.x = pack2(v[0] * scale, v[1] * scale); w0.y = pack2(v[2] * scale, v[3] * scale); w0.z = pack2(v[4] * scale, v[5] * scale); w0.w = pack2(v[6] * scale, v[7] * scale);
            w1.x = pack2(v[8] * scale, v[9] * scale); w1.y = pack2(v[10] * scale, v[11] * scale); w1.z = pack2(v[12] * scale, v[13] * scale); w1.w = pack2(v[14] * scale, v[15] * scale);
            *(u32x4*)(dst + (size_t)row * ld + c0 + cc) = w0; *(u32x4*)(dst + (size_t)row * ld + c0 + cc + 8) = w1;
        } else if (cc == 0) {
#pragma unroll
            for (int i = 0; i < 4; ++i) *(f32x4*)(GLR + (size_t)row * 16 + 4 * i) = (f32x4){v[4 * i], v[4 * i + 1], v[4 * i + 2], v[4 * i + 3]};
        }
        if (pn >= 3 && pn < 9 && row >= NTP && row < NT) {
            const int g = (pn - 3) % 3, kv = (pn - 3) / 3, W = 128 << (2 * g), s = row - NTP;
            float* o = out + (g == 0 ? OFF_KVS0 : (g == 1 ? OFF_KVS1 : OFF_KVS2)) + ((size_t)(s * W + (W - 1)) * 2 + kv) * 256 + cc;
#pragma unroll
            for (int i = 0; i < 4; ++i) *(f32x4*)(o + 4 * i) = (f32x4){v[4 * i], v[4 * i + 1], v[4 * i + 2], v[4 * i + 3]};
        }
    }
};

__device__ __forceinline__ void phase_cache_copy(const Params& p, int bid, int nb) {
    int tid_ = threadIdx.x; asm volatile("" : "+v"(tid_));
    const size_t tid = (size_t)bid * NTHREADS + tid_, nth = (size_t)nb * NTHREADS;
#pragma unroll
    for (int g = 0; g < 3; ++g) {
        const int W = 128 << (2 * g);
        const float* src = g == 0 ? p.cache128 : (g == 1 ? p.cache512 : p.cache2048);
        float* dst = p.out + (g == 0 ? OFF_KVS0 : (g == 1 ? OFF_KVS1 : OFF_KVS2));
        const size_t per = (size_t)(W - 1) * 128, total = per * NS;
        for (size_t i = tid; i < total; i += nth) {
            const size_t s = i / per, rem = i - s * per;
            const f32x4 v = __builtin_nontemporal_load((const f32x4*)(src + (s * W + 1) * 512) + rem);
            __builtin_nontemporal_store(v, (f32x4*)(dst + s * W * 512) + rem);
        }
    }
}

__device__ __forceinline__ f32x16 mfma32(bf16x8 a, bf16x8 b, f32x16 c) { return __builtin_amdgcn_mfma_f32_32x32x16_bf16(a, b, c, 0, 0, 0); }
__device__ __forceinline__ f32x16 zero16() { f32x16 z; for (int i = 0; i < 16; ++i) z[i] = 0.f; return z; }
__device__ __forceinline__ bf16x8 ld_frag_g(const bf16_t* p) { return *(const bf16x8*)p; }
__device__ __forceinline__ bf16x8 ld_frag_l(const LAS bf16_t* p) { return *(const LAS bf16x8*)p; }
__device__ __forceinline__ int crow(int reg, int hh) { return (reg & 3) + 8 * (reg >> 2) + 4 * hh; }
__device__ __forceinline__ float log_sigmoidf_(float z) { return fminf(z, 0.f) - log1pf(__expf(-fabsf(z))); }

__device__ __forceinline__ void phase_gla_sample(const Params& p, int bid, int nb, LAS unsigned char* lds) {
    int tid_ = threadIdx.x; asm volatile("" : "+v"(tid_));
    LAS float* s_eg = (LAS float*)lds;
    LAS float* s_q = s_eg + 128;
    LAS float* s_k = s_q + 128;
    LAS float* s_o = s_k + 128;
    const int dv4 = tid_ & 63, kg = tid_ >> 6;
    for (int u = bid; u < NS * 4; u += nb) {
        const int s = u >> 2, h = u & 3;
        const size_t row = (size_t)(NTP + s);
        const float* S0 = p.state_gla + ((size_t)s * 4 + h) * 32768 + (size_t)(16 * kg) * 256 + 4 * dv4;
        float* Sn = p.out + OFF_GLAS + ((size_t)s * 4 + h) * 32768 + (size_t)(16 * kg) * 256 + 4 * dv4;
        f32x4 st[16];
#pragma unroll
        for (int i = 0; i < 16; ++i) st[i] = __builtin_nontemporal_load((const f32x4*)(S0 + i * 256));
        if (tid_ < 128) {
            const int kd = tid_; float z = p.b_gla[h * 128 + kd];
#pragma unroll
            for (int j = 0; j < 16; ++j) z += p.GLR[row * 16 + j] * p.w_gla_up[j * 512 + h * 128 + kd];
            s_eg[kd] = __expf(log_sigmoidf_(z) * (1.0f / 16.0f));
            s_q[kd] = bf2f(p.QKB[row * 1024 + h * 128 + kd]);
            s_k[kd] = bf2f(p.QKB[row * 1024 + 512 + h * 128 + kd]);
        }
        const u32x2 vw = *(const u32x2*)(p.VBB + row * 1024 + h * 256 + 4 * dv4);
        const f32x4 v4 = {bflo(vw.x), bfhi(vw.x), bflo(vw.y), bfhi(vw.y)};
        __syncthreads();
        f32x4 o = {0.f, 0.f, 0.f, 0.f};
#pragma unroll
        for (int i = 0; i < 16; ++i) {
            const int kd = 16 * kg + i;
            const f32x4 sv = st[i] * s_eg[kd] + v4 * s_k[kd];
            __builtin_nontemporal_store(sv, (f32x4*)(Sn + i * 256));
            o += sv * s_q[kd];
        }
        *(LAS f32x4*)(s_o + kg * 256 + 4 * dv4) = o;
        __syncthreads();
        float t = 0.f;
        if (tid_ < 256) {
#pragma unroll
            for (int w = 0; w < 8; ++w) t += s_o[w * 256 + tid_];
        }
        const float sq = wave_sum(t * t);
        __syncthreads();
        if ((tid_ & 63) == 0) s_o[tid_ >> 6] = sq;
        __syncthreads();
        if (tid_ < 256) {
            const float rn = rsqrtf((s_o[0] + s_o[1] + s_o[2] + s_o[3]) * (1.0f / 256.0f) + LN_EPS);
            p.OB[row * 1024 + h * 256 + tid_] = f2bf(t * rn * p.gla_norm_w[h * 256 + tid_] * siluf_(bf2f(p.RB[row * 1024 + h * 256 + tid_])));
        }
        __syncthreads();
    }
}

constexpr int G2_QP = 136;
constexpr int G2_TP = 72;
constexpr int G2_VP = 264;
typedef short v4s2_t __attribute__((ext_vector_type(4)));
constexpr int G2_BP = 132;
struct Gla2Lds {
    LAS float* glr; LAS float* tot; LAS float* dl; LAS float* bl; LAS float* bt; LAS bf16_t* qe; LAS bf16_t* ke; LAS bf16_t* kdt; LAS bf16_t* vt; LAS bf16_t* pp; LAS float* ss;
    __device__ __forceinline__ void carve(LAS unsigned char* lds) {
        glr = (LAS float*)lds; tot = glr + 1024; dl = tot + 512; bl = dl + 128; bt = bl + 128;
        qe = (LAS bf16_t*)(bt + 64 * G2_BP); ke = qe + 64 * G2_QP; kdt = ke + 64 * G2_QP; vt = kdt + 64 * G2_QP; pp = vt + 64 * G2_VP; ss = (LAS float*)(pp + 64 * G2_TP);
    }
};
struct Gla2Regs { f32x4 glr; u32x4 v[4], k[2], q[2]; };
__device__ __forceinline__ void gla2_load_chunk(const Params& p, Gla2Regs& R, int tid_, int b, int h, int c, bool need_qk) {
    const size_t row0 = (size_t)b * T + (size_t)c * 64;
    R.glr = *(const f32x4*)(p.GLR + row0 * 16 + (tid_ & 255) * 4);
#pragma unroll
    for (int i = 0; i < 4; ++i) { const int q = tid_ + 512 * i, t = q >> 5, dc = q & 31; R.v[i] = *(const u32x4*)(p.VBB + (row0 + t) * 1024 + h * 256 + dc * 8); }
#pragma unroll
    for (int i = 0; i < 2; ++i) { const int it = tid_ + 512 * i, t = it >> 4, kg = it & 15;
        R.k[i] = *(const u32x4*)(p.QKB + (row0 + t) * 1024 + 512 + h * 128 + kg * 8);
        if (need_qk) R.q[i] = *(const u32x4*)(p.QKB + (row0 + t) * 1024 + h * 128 + kg * 8); }
}
__device__ __forceinline__ float gla2_stage_chunk(const Gla2Lds& L, const Gla2Regs& R, int tid_, const float (&wup)[16], float bg, bool need_qk) {
    const int kd = tid_ >> 2, q4 = tid_ & 3;
    if (tid_ < 256) *(LAS f32x4*)(L.glr + tid_ * 4) = R.glr;
#pragma unroll
    for (int i = 0; i < 4; ++i) { const int q = tid_ + 512 * i, t = q >> 5, dc = q & 31; *(LAS u32x4*)(L.vt + t * G2_VP + dc * 8) = R.v[i]; }
    __syncthreads();
    float pre[16]; float run = 0.f;
#pragma unroll
    for (int i = 0; i < 16; ++i) {
        const int t = q4 * 16 + i; float z = bg;
#pragma unroll
        for (int j4 = 0; j4 < 4; ++j4) { const f32x4 gq = *(const LAS f32x4*)(L.glr + t * 16 + 4 * j4); z += gq[0] * wup[4 * j4] + gq[1] * wup[4 * j4 + 1] + gq[2] * wup[4 * j4 + 2] + gq[3] * wup[4 * j4 + 3]; }
        const float ls = fminf(z, 0.f) - __logf(1.0f + __expf(-fabsf(z)));
        run += ls * (1.0f / 16.0f); pre[i] = run;
    }
    const float t0 = __builtin_bit_cast(float, __builtin_amdgcn_update_dpp(0, __builtin_bit_cast(int, run), 0x00, 0xf, 0xf, true));
    const float t1 = __builtin_bit_cast(float, __builtin_amdgcn_update_dpp(0, __builtin_bit_cast(int, run), 0x55, 0xf, 0xf, true));
    const float t2 = __builtin_bit_cast(float, __builtin_amdgcn_update_dpp(0, __builtin_bit_cast(int, run), 0xaa, 0xf, 0xf, true));
    const float t3 = __builtin_bit_cast(float, __builtin_amdgcn_update_dpp(0, __builtin_bit_cast(int, run), 0xff, 0xf, 0xf, true));
    const float offs = (q4 > 0 ? t0 : 0.f) + (q4 > 1 ? t1 : 0.f) + (q4 > 2 ? t2 : 0.f), blast = (t0 + t1) + (t2 + t3);
#pragma unroll
    for (int i = 0; i < 16; ++i) L.bt[(q4 * 16 + i) * G2_BP + kd] = offs + pre[i];
    const float edl = __expf(blast);
    if (q4 == 0) { L.dl[kd] = edl; L.bl[kd] = blast; }
    __syncthreads();
#pragma unroll
    for (int i = 0; i < 2; ++i) {
        const int it = tid_ + 512 * i, t = it >> 4, kg = it & 15;
        const f32x4 b0 = *(const LAS f32x4*)(L.bt + t * G2_BP + 8 * kg), b1 = *(const LAS f32x4*)(L.bt + t * G2_BP + 8 * kg + 4);
        const f32x4 l0 = *(const LAS f32x4*)(L.bl + 8 * kg), l1 = *(const LAS f32x4*)(L.bl + 8 * kg + 4);
        const float bv[8] = {b0[0], b0[1], b0[2], b0[3], b1[0], b1[1], b1[2], b1[3]}, lv[8] = {l0[0], l0[1], l0[2], l0[3], l1[0], l1[1], l1[2], l1[3]};
        float k8[8]; unpack8(R.k[i], k8);
        { float kd8[8];
#pragma unroll
          for (int e = 0; e < 8; ++e) kd8[e] = k8[e] * __expf(lv[e] - bv[e]);
          u32x4 wd; wd.x = pack2(kd8[0], kd8[1]); wd.y = pack2(kd8[2], kd8[3]); wd.z = pack2(kd8[4], kd8[5]); wd.w = pack2(kd8[6], kd8[7]);
          *(LAS u32x4*)(L.kdt + t * G2_QP + 8 * kg) = wd; }
        if (need_qk) {
            float q8[8], qo[8], ko[8]; unpack8(R.q[i], q8);
#pragma unroll
            for (int e = 0; e < 8; ++e) { const float eb = __expf(bv[e]); qo[e] = q8[e] * eb; ko[e] = k8[e] * __builtin_amdgcn_rcpf(eb); }
            u32x4 wq, wk;
            wq.x = pack2(qo[0], qo[1]); wq.y = pack2(qo[2], qo[3]); wq.z = pack2(qo[4], qo[5]); wq.w = pack2(qo[6], qo[7]);
            wk.x = pack2(ko[0], ko[1]); wk.y = pack2(ko[2], ko[3]); wk.z = pack2(ko[4], ko[5]); wk.w = pack2(ko[6], ko[7]);
            *(LAS u32x4*)(L.qe + t * G2_QP + 8 * kg) = wq; *(LAS u32x4*)(L.ke + t * G2_QP + 8 * kg) = wk;
        }
    }
    __syncthreads();
    return edl;
}
__device__ __forceinline__ bf16x8 ld_frag_tr(const LAS bf16_t* img, int pitch, int row0, int col0, int lane) {
    const int i16 = lane & 15, hh = lane >> 5;
    const LAS bf16_t* ap = img + (row0 + 8 * hh + (i16 >> 2)) * pitch + col0 + 16 * ((lane >> 4) & 1) + 4 * (i16 & 3);
    union { bf16x8 v; v4s2_t h2[2]; } f;
    f.h2[0] = __builtin_amdgcn_ds_read_tr16_b64_v4i16((LAS v4s2_t*)ap);
    f.h2[1] = __builtin_amdgcn_ds_read_tr16_b64_v4i16((LAS v4s2_t*)(ap + 4 * pitch));
    return f.v;
}
__device__ __forceinline__ void gla2_update_state(const Gla2Lds& L, f32x16 (&S)[4], int wave, int lane) {
    const int hh = lane >> 5;
    bf16x8 vf[4];
#pragma unroll
    for (int ks = 0; ks < 4; ++ks) vf[ks] = ld_frag_tr(L.vt, G2_VP, 16 * ks, 32 * wave, lane);
#pragma unroll
    for (int mi = 0; mi < 4; ++mi) {
#pragma unroll
        for (int g4 = 0; g4 < 4; ++g4) {
            const f32x4 d = *(const LAS f32x4*)(L.dl + 32 * mi + 8 * g4 + 4 * hh);
#pragma unroll
            for (int j = 0; j < 4; ++j) S[mi][4 * g4 + j] *= d[j];
        }
#pragma unroll
        for (int ks = 0; ks < 4; ++ks) S[mi] = mfma32(ld_frag_tr(L.kdt, G2_QP, 16 * ks, 32 * mi, lane), vf[ks], S[mi]);
    }
}
__device__ __forceinline__ void phase_gla2_passA(const Params& p, int bid, int nb, LAS unsigned char* lds) {
    int tid_ = threadIdx.x; asm volatile("" : "+v"(tid_));
    Gla2Lds L; L.carve(lds);
    const int wave = tid_ >> 6, lane = tid_ & 63;
    for (int u = bid; u < 256; u += nb) {
        const int bh = u >> 5, seg = u & 31, b = bh >> 2, h = bh & 3;
        float wup[16];
#pragma unroll
        for (int j = 0; j < 16; ++j) wup[j] = p.w_gla_up[j * 512 + h * 128 + (tid_ >> 2)];
        const float bg = p.b_gla[h * 128 + (tid_ >> 2)];
        f32x16 S[4];
#pragma unroll
        for (int mi = 0; mi < 4; ++mi) S[mi] = zero16();
        float dprod = 1.0f;
        Gla2Regs R; gla2_load_chunk(p, R, tid_, b, h, seg * 8, false);
        for (int cc = 0; cc < 8; ++cc) {
            int tq = tid_; asm volatile("" : "+v"(tq));
            dprod *= gla2_stage_chunk(L, R, tq, wup, bg, false);
            if (cc < 7) gla2_load_chunk(p, R, tq, b, h, seg * 8 + cc + 1, false);
            gla2_update_state(L, S, wave, tq & 63);
            __syncthreads();
        }
        float* dst = p.LSEG + (size_t)u * 32768 + (size_t)wave * 4096 + lane;
#pragma unroll
        for (int mi = 0; mi < 4; ++mi)
#pragma unroll
            for (int reg = 0; reg < 16; ++reg) dst[(mi * 16 + reg) * 64] = S[mi][reg];
        if ((tid_ & 3) == 0) p.DSEG[(size_t)u * 128 + (tid_ >> 2)] = dprod;
    }
}
__device__ __forceinline__ void phase_gla2_scan(const Params& p, int bid, int nb) {
    int tid_ = threadIdx.x; asm volatile("" : "+v"(tid_));
    for (int e = bid * NTHREADS + tid_; e < 8 * 32768; e += nb * NTHREADS) {
        const int bh = e >> 15, idx = e & 32767, w = idx >> 12, rem = idx & 4095, mr = rem >> 6, ln = rem & 63, mi = mr >> 4, reg = mr & 15;
        const int kd = 32 * mi + crow(reg, ln >> 5), dv = 32 * w + (ln & 31);
        float S = 0.f;
        for (int s0 = 0; s0 < 32; s0 += 8) {
            float l[8], d[8];
#pragma unroll
            for (int i = 0; i < 8; ++i) { const size_t u = (size_t)bh * 32 + s0 + i; l[i] = p.LSEG[u * 32768 + idx]; d[i] = p.DSEG[u * 128 + kd]; }
#pragma unroll
            for (int i = 0; i < 8; ++i) { const size_t u = (size_t)bh * 32 + s0 + i; p.SSEG[u * 32768 + idx] = S; S = d[i] * S + l[i]; }
        }
        p.out[OFF_GLAP + ((size_t)bh * 128 + kd) * 256 + dv] = S;
    }
}
__device__ __forceinline__ void phase_gla2_passC(const Params& p, int bid, int nb, LAS unsigned char* lds) {
    int tid_ = threadIdx.x; asm volatile("" : "+v"(tid_));
    Gla2Lds L; L.carve(lds);
    const int wave = tid_ >> 6, lane = tid_ & 63;
    for (int u = bid; u < 256; u += nb) {
        const int bh = u >> 5, seg = u & 31, b = bh >> 2, h = bh & 3;
        float wup[16];
#pragma unroll
        for (int j = 0; j < 16; ++j) wup[j] = p.w_gla_up[j * 512 + h * 128 + (tid_ >> 2)];
        const float bg = p.b_gla[h * 128 + (tid_ >> 2)];
        Gla2Regs R; gla2_load_chunk(p, R, tid_, b, h, seg * 8, true);
        f32x16 S[4];
        {
            const float* src = p.SSEG + (size_t)u * 32768 + (size_t)wave * 4096 + lane;
#pragma unroll
            for (int mi = 0; mi < 4; ++mi)
#pragma unroll
                for (int reg = 0; reg < 16; ++reg) S[mi][reg] = src[(mi * 16 + reg) * 64];
        }
        for (int cc = 0; cc < 8; ++cc) {
            const int c = seg * 8 + cc, row0 = b * T + c * 64;
            int tq = tid_; asm volatile("" : "+v"(tq));
            const int r = tq & 31, hh = (tq >> 5) & 1;
            gla2_stage_chunk(L, R, tq, wup, bg, true);
            if (cc < 7) gla2_load_chunk(p, R, tq, b, h, c + 1, true);
            if (wave < 4) {
                const int mi = wave >> 1, ni = wave & 1;
                f32x16 acc = zero16();
#pragma unroll
                for (int ks = 0; ks < 8; ++ks) acc = mfma32(ld_frag_l(L.ke + (32 * ni + r) * G2_QP + 16 * ks + 8 * hh), ld_frag_l(L.qe + (32 * mi + r) * G2_QP + 16 * ks + 8 * hh), acc);
                const int t = 32 * mi + r;
#pragma unroll
                for (int rg = 0; rg < 4; ++rg) {
                    const int s0 = 32 * ni + 8 * rg + 4 * hh;
                    u32x2 w;
                    w.x = pack2(s0 + 0 <= t ? acc[4 * rg + 0] : 0.f, s0 + 1 <= t ? acc[4 * rg + 1] : 0.f);
                    w.y = pack2(s0 + 2 <= t ? acc[4 * rg + 2] : 0.f, s0 + 3 <= t ? acc[4 * rg + 3] : 0.f);
                    *(LAS u32x2*)(L.pp + t * G2_TP + s0) = w;
                }
            }
            union { bf16x8 v; unsigned w[4]; } sb[4][2];
#pragma unroll
            for (int mi = 0; mi < 4; ++mi)
#pragma unroll
                for (int s2 = 0; s2 < 2; ++s2)
#pragma unroll
                    for (int e = 0; e < 4; ++e) sb[mi][s2].w[e] = pack2(S[mi][8 * s2 + 2 * e], S[mi][8 * s2 + 2 * e + 1]);
            __syncthreads();
            f32x16 oacc[2];
#pragma unroll
            for (int tt = 0; tt < 2; ++tt) {
                f32x16 acc = zero16();
#pragma unroll
                for (int ks = 0; ks < 4; ++ks) acc = mfma32(ld_frag_tr(L.vt, G2_VP, 16 * ks, 32 * wave, tq & 63), ld_frag_l(L.pp + (32 * tt + r) * G2_TP + 16 * ks + 8 * hh), acc);
#pragma unroll
                for (int mi = 0; mi < 4; ++mi)
#pragma unroll
                    for (int s2 = 0; s2 < 2; ++s2) {
                        union { bf16x8 v; u32x2 h2[2]; } qa;
                        const LAS bf16_t* qp = L.qe + (32 * tt + r) * G2_QP + 32 * mi + 16 * s2 + 4 * hh;
                        qa.h2[0] = *(const LAS u32x2*)qp; qa.h2[1] = *(const LAS u32x2*)(qp + 8);
                        acc = mfma32(sb[mi][s2].v, qa.v, acc);
                    }
                float sq = 0.f;
#pragma unroll
                for (int i = 0; i < 16; ++i) sq += acc[i] * acc[i];
                sq += __shfl_xor(sq, 32);
                if (hh == 0) L.ss[wave * 64 + 32 * tt + r] = sq;
                oacc[tt] = acc;
            }
            gla2_update_state(L, S, wave, tq & 63);
            __syncthreads();
#pragma unroll
            for (int tt = 0; tt < 2; ++tt) {
                float tot = 0.f;
#pragma unroll
                for (int w = 0; w < 8; ++w) tot += L.ss[w * 64 + 32 * tt + r];
                const float rn = rsqrtf(tot * (1.0f / 256.0f) + LN_EPS);
                const size_t ro = (size_t)(row0 + 32 * tt + r) * 1024 + h * 256 + 32 * wave + 4 * hh;
                const float* gw = p.gla_norm_w + h * 256 + 32 * wave + 4 * hh;
#pragma unroll
                for (int rg = 0; rg < 4; ++rg) {
                    const u32x2 rw = *(const u32x2*)(p.RB + ro + 8 * rg);
                    const f32x4 g4 = *(const f32x4*)(gw + 8 * rg);
                    const float o0 = oacc[tt][4 * rg + 0] * rn * g4[0] * siluf_(bflo(rw.x)), o1 = oacc[tt][4 * rg + 1] * rn * g4[1] * siluf_(bfhi(rw.x));
                    const float o2 = oacc[tt][4 * rg + 2] * rn * g4[2] * siluf_(bflo(rw.y)), o3 = oacc[tt][4 * rg + 3] * rn * g4[3] * siluf_(bfhi(rw.y));
                    u32x2 w; w.x = pack2(o0, o1); w.y = pack2(o2, o3);
                    *(u32x2*)(p.OB + ro + 8 * rg) = w;
                }
            }
            __syncthreads();
        }
    }
}

constexpr int AKV_PITCH = 72;
typedef short v4s_t __attribute__((ext_vector_type(4)));
__device__ __forceinline__ float alibi_slope(int g, int j) { return exp2f(-8.0f * (float)(g * 4 + j + 1) / 12.0f); }

__device__ __forceinline__ void phase_attn_prompt(const Params& p, int bid, int nb_, LAS unsigned char* lds) {
    int tid_ = threadIdx.x; asm volatile("" : "+v"(tid_));
    LAS bf16_t* s_k = (LAS bf16_t*)lds;
    LAS bf16_t* s_v = s_k + 2 * 256 * AKV_PITCH;
    const int wave = tid_ >> 6, lane = tid_ & 63, r = lane & 31, hh = lane >> 5;
    const int jj = wave >> 2, qs = wave & 3;
    for (int u = bid; u < 1536; u += nb_) {
        const int hp = u & 1, nbq = (u >> 1) & 127, bg = u >> 8, g = bg % 3, b = bg / 3;
        const int d = 1 << (2 * g), nbk = 128 >> (2 * g);
        const int ph = nbq / nbk, nb = nbq % nbk;
#pragma unroll
        for (int half = 0; half < 2; ++half) {
            u32x4 w[8];
#pragma unroll
            for (int i = 0; i < 8; ++i) {
                const int q = tid_ + 512 * i, hj = q >> 11, key = (q >> 3) & 255, dc = q & 7;
                int lp = 128 * (nb - 1) + key; lp = lp < 0 ? 0 : lp;
                const size_t row = (size_t)b * T + (size_t)lp * d + ph;
                w[i] = *(const u32x4*)(p.QKVA + row * 2304 + (half ? 1536 : 768) + g * 256 + (2 * hp + hj) * 64 + dc * 8);
            }
#pragma unroll
            for (int i = 0; i < 8; ++i) {
                const int q = tid_ + 512 * i, hj = q >> 11, key = (q >> 3) & 255, dc = q & 7;
                *(LAS u32x4*)((half ? s_v : s_k) + (hj * 256 + key) * AKV_PITCH + dc * 8) = w[i];
            }
        }
        const int j = 2 * hp + jj;
        const float slope_d = alibi_slope(g, j) * (float)d;
        const int qi = 32 * qs + r;
        const size_t rowq = (size_t)b * T + (size_t)(128 * nb + qi) * d + ph;
        bf16x8 qf[4];
#pragma unroll
        for (int ks = 0; ks < 4; ++ks) qf[ks] = ld_frag_g(p.QKVA + rowq * 2304 + g * 256 + j * 64 + 16 * ks + 8 * hh);
        __syncthreads();
        float sc[5][16];
        const LAS bf16_t* kb = s_k + (jj * 256 + 32 * qs + r) * AKV_PITCH + 8 * hh;
#pragma unroll
        for (int kt = 0; kt < 5; ++kt) {
            f32x16 acc = zero16();
#pragma unroll
            for (int ks = 0; ks < 4; ++ks) acc = mfma32(ld_frag_l(kb + (32 * kt) * AKV_PITCH + 16 * ks), qf[ks], acc);
#pragma unroll
            for (int reg = 0; reg < 16; ++reg) sc[kt][reg] = acc[reg];
        }
        float m = -3.0e38f;
        float fb = (float)(r - 4 * hh + 128);
        asm volatile("" : "+v"(fb));
        const float fsmax = nb > 0 ? 128.0f : (float)qi;
#pragma unroll
        for (int kt = 0; kt < 5; ++kt)
#pragma unroll
            for (int reg = 0; reg < 16; ++reg) {
                const float fs = fb - (float)(32 * kt + (reg & 3) + 8 * (reg >> 2));
                const bool valid = fs >= 0.f && fs <= fsmax;
                const float v = valid ? sc[kt][reg] * 0.125f - slope_d * fs : -3.0e38f;
                sc[kt][reg] = v; m = fmaxf(m, v);
            }
        m = fmaxf(m, __shfl_xor(m, 32));
        float z = 0.f;
#pragma unroll
        for (int kt = 0; kt < 5; ++kt)
#pragma unroll
            for (int reg = 0; reg < 16; ++reg) { const float v = sc[kt][reg]; const float e = v > -1.0e38f ? __expf(v - m) : 0.f; sc[kt][reg] = e; z += e; if (reg == 15) __builtin_amdgcn_sched_barrier(0); }
        z += __shfl_xor(z, 32);
        const float rz = 1.0f / z;
        f32x16 o0 = zero16(), o1 = zero16();
        const int i16 = lane & 15;
        const LAS bf16_t* vb = s_v + (jj * 256 + 32 * qs + 4 * hh + (i16 >> 2)) * AKV_PITCH + 16 * ((lane >> 4) & 1) + 4 * (i16 & 3);
#pragma unroll
        for (int kt = 0; kt < 5; ++kt)
#pragma unroll
            for (int s2 = 0; s2 < 2; ++s2) {
                union { bf16x8 v; unsigned w[4]; } pb;
#pragma unroll
                for (int e = 0; e < 4; ++e) pb.w[e] = pack2(sc[kt][8 * s2 + 2 * e] * rz, sc[kt][8 * s2 + 2 * e + 1] * rz);
#pragma unroll
                for (int dt = 0; dt < 2; ++dt) {
                    union { bf16x8 v; v4s_t h2[2]; } va;
                    const LAS bf16_t* ap = vb + (32 * kt + 16 * s2) * AKV_PITCH + 32 * dt;
                    va.h2[0] = __builtin_amdgcn_ds_read_tr16_b64_v4i16((LAS v4s_t*)ap);
                    va.h2[1] = __builtin_amdgcn_ds_read_tr16_b64_v4i16((LAS v4s_t*)(ap + 8 * AKV_PITCH));
                    if (dt == 0) o0 = mfma32(va.v, pb.v, o0); else o1 = mfma32(va.v, pb.v, o1);
                }
                __builtin_amdgcn_sched_barrier(0);
            }
        bf16_t* og = p.OG + rowq * 768 + g * 256 + j * 64;
#pragma unroll
        for (int rg = 0; rg < 4; ++rg) {
            u32x2 w0, w1;
            w0.x = pack2(o0[4 * rg + 0], o0[4 * rg + 1]); w0.y = pack2(o0[4 * rg + 2], o0[4 * rg + 3]);
            w1.x = pack2(o1[4 * rg + 0], o1[4 * rg + 1]); w1.y = pack2(o1[4 * rg + 2], o1[4 * rg + 3]);
            *(u32x2*)(og + 8 * rg + 4 * hh) = w0; *(u32x2*)(og + 32 + 8 * rg + 4 * hh) = w1;
        }
        if (hh == 0) p.LSE[rowq * 12 + g * 4 + j] = m + __logf(z);
        __syncthreads();
    }
}

__device__ __forceinline__ void phase_attn_sample(const Params& p, int bid, int nb_, LAS unsigned char* lds) {
    int tid_ = threadIdx.x; asm volatile("" : "+v"(tid_));
    LAS float* s_sc = (LAS float*)lds;
    LAS float* s_o = s_sc + 4 * 132;
    const int wave = tid_ >> 6, lane = tid_ & 63, hd = lane >> 4;
    for (int u = bid; u < NS * 3; u += nb_) {
        const int s = u / 3, g = u % 3, d = 1 << (2 * g), W = 128 << (2 * g);
        const size_t row = (size_t)(NTP + s);
        const float* cache = (g == 0 ? p.cache128 : (g == 1 ? p.cache512 : p.cache2048)) + (size_t)s * W * 512;
        const int nk = wave == 0 ? 17 : 16;
        f32x4 kr[17];
#pragma unroll
        for (int i = 0; i < 17; ++i) {
            const int k = wave + 8 * i;
            if (i < nk) {
                if (k == 0) { const u32x2 w = *(const u32x2*)(p.QKVA + row * 2304 + 768 + g * 256 + 4 * lane); kr[i] = (f32x4){bflo(w.x), bfhi(w.x), bflo(w.y), bfhi(w.y)}; }
                else kr[i] = *(const f32x4*)(cache + ((size_t)(W - k * d) * 2 + 0) * 256 + 4 * lane);
            } else kr[i] = (f32x4){0.f, 0.f, 0.f, 0.f};
        }
        const u32x2 qw = *(const u32x2*)(p.QKVA + row * 2304 + g * 256 + 4 * lane);
        const f32x4 q4 = {bflo(qw.x), bfhi(qw.x), bflo(qw.y), bfhi(qw.y)};
        const float slope = alibi_slope(g, hd);
#pragma unroll
        for (int i = 0; i < 17; ++i) {
            const int k = wave + 8 * i;
            float dot = kr[i][0] * q4[0] + kr[i][1] * q4[1] + kr[i][2] * q4[2] + kr[i][3] * q4[3];
            dot = dpp_row_sum(dot);
            if (i < nk && (lane & 15) == 0) s_sc[hd * 132 + k] = dot * 0.125f - slope * (float)(k * d);
        }
        f32x4 vr[17];
#pragma unroll
        for (int i = 0; i < 17; ++i) {
            const int k = wave + 8 * i;
            if (i < nk) {
                if (k == 0) { const u32x2 w = *(const u32x2*)(p.QKVA + row * 2304 + 1536 + g * 256 + 4 * lane); vr[i] = (f32x4){bflo(w.x), bfhi(w.x), bflo(w.y), bfhi(w.y)}; }
                else vr[i] = *(const f32x4*)(cache + ((size_t)(W - k * d) * 2 + 1) * 256 + 4 * lane);
            } else vr[i] = (f32x4){0.f, 0.f, 0.f, 0.f};
        }
        __syncthreads();
        if (wave < 4) {
            const int h2 = wave;
            const float a0 = s_sc[h2 * 132 + lane], a1 = s_sc[h2 * 132 + 64 + lane], a2 = lane == 0 ? s_sc[h2 * 132 + 128] : -3.0e38f;
            const float m = wave_max(fmaxf(fmaxf(a0, a1), a2));
            const float e0 = __expf(a0 - m), e1 = __expf(a1 - m), e2 = lane == 0 ? __expf(a2 - m) : 0.f;
            const float z = wave_sum(e0 + e1 + e2), rz = 1.0f / z;
            s_sc[h2 * 132 + lane] = e0 * rz; s_sc[h2 * 132 + 64 + lane] = e1 * rz; if (lane == 0) { s_sc[h2 * 132 + 128] = e2 * rz; p.LSE[row * 12 + g * 4 + h2] = m + __logf(z); }
        }
        __syncthreads();
        f32x4 o = {0.f, 0.f, 0.f, 0.f};
#pragma unroll
        for (int i = 0; i < 17; ++i) { const int k = wave + 8 * i; if (i < nk) o += vr[i] * s_sc[hd * 132 + k]; }
        *(LAS f32x4*)(s_o + wave * 256 + 4 * lane) = o;
        __syncthreads();
        if (tid_ < 256) {
            float t2 = 0.f;
#pragma unroll
            for (int w = 0; w < 8; ++w) t2 += s_o[w * 256 + tid_];
            p.OG[row * 768 + g * 256 + tid_] = f2bf(t2);
        }
        __syncthreads();
    }
}

__device__ __forceinline__ void phase_merge_prep(const Params& p, int bid, int nb) {
    int tid_ = threadIdx.x; asm volatile("" : "+v"(tid_));
    const int wave = tid_ >> 6, lane = tid_ & 63;
    for (int row = bid * 8 + wave; row < NT; row += nb * 8) {
        const size_t R = (size_t)row;
        {
            const int j = lane >> 4;
            const float l0 = p.LSE[R * 12 + j], l1 = p.LSE[R * 12 + 4 + j], l2 = p.LSE[R * 12 + 8 + j];
            const float m = fmaxf(l0, fmaxf(l1, l2));
            float w0 = __expf(l0 - m), w1 = __expf(l1 - m), w2 = __expf(l2 - m);
            const float rs = 1.0f / (w0 + w1 + w2); w0 *= rs; w1 *= rs; w2 *= rs;
            const u32x2 a = *(const u32x2*)(p.OG + R * 768 + 4 * lane), b = *(const u32x2*)(p.OG + R * 768 + 256 + 4 * lane), c = *(const u32x2*)(p.OG + R * 768 + 512 + 4 * lane);
            u32x2 o;
            o.x = pack2(w0 * bflo(a.x) + w1 * bflo(b.x) + w2 * bflo(c.x), w0 * bfhi(a.x) + w1 * bfhi(b.x) + w2 * bfhi(c.x));
            o.y = pack2(w0 * bflo(a.y) + w1 * bflo(b.y) + w2 * bflo(c.y), w0 * bfhi(a.y) + w1 * bfhi(b.y) + w2 * bfhi(c.y));
            *(u32x2*)(p.OA + R * 256 + 4 * lane) = o;
        }
    }
}

template <int MODE> struct EpiGate {
    static constexpr bool PERM = true, AFTER_DRAIN = false;
    bf16_t* O; const bf16_t* G; const bf16_t* ADD; int ld;
    __device__ __forceinline__ void operator()(const pg8::f32x4 (&acc)[2][2][4][2], const pg8::Unit& u, int wr, int wc, int fr, int fq) const {
        const int row0 = u.pm * 256 + wr * 64 + fr, col0 = u.pn * 256 + wc * 32 + 8 * fq;
#pragma unroll
        for (int ai = 0; ai < 2; ++ai) {
            u32x4 gq[8], aq[8];
#pragma unroll
            for (int m = 0; m < 4; ++m)
#pragma unroll
                for (int bj = 0; bj < 2; ++bj) {
                    const size_t o = (size_t)(row0 + ai * 128 + m * 16) * ld + col0 + bj * 128;
                    if (MODE != 2) gq[m * 2 + bj] = *(const u32x4*)(G + o);
                    if (MODE == 1) aq[m * 2 + bj] = *(const u32x4*)(ADD + o);
                }
#pragma unroll
            for (int m = 0; m < 4; ++m)
#pragma unroll
                for (int bj = 0; bj < 2; ++bj) {
                    const size_t o = (size_t)(row0 + ai * 128 + m * 16) * ld + col0 + bj * 128;
                    const pg8::f32x4 v0 = acc[ai][bj][m][0], v1 = acc[ai][bj][m][1];
                    float v[8] = {v0[0], v0[1], v0[2], v0[3], v1[0], v1[1], v1[2], v1[3]};
                    if (MODE != 2) { float gg[8]; unpack8(gq[m * 2 + bj], gg);
#pragma unroll
                        for (int i = 0; i < 8; ++i) v[i] *= sigmoidf_(gg[i]); }
                    if (MODE == 1) { float aa[8]; unpack8(aq[m * 2 + bj], aa);
#pragma unroll
                        for (int i = 0; i < 8; ++i) v[i] += aa[i]; }
                    u32x4 w; w.x = pack2(v[0], v[1]); w.y = pack2(v[2], v[3]); w.z = pack2(v[4], v[5]); w.w = pack2(v[6], v[7]);
                    *(u32x4*)(O + o) = w;
                }
        }
    }
    __device__ __forceinline__ void emit16(int row, int col, const float (&vin)[16]) const {
#pragma unroll
        for (int hf = 0; hf < 2; ++hf) {
            const size_t o = (size_t)row * ld + col + 8 * hf;
            float v[8];
#pragma unroll
            for (int i = 0; i < 8; ++i) v[i] = vin[8 * hf + i];
            if (MODE != 2) { float gg[8]; unpack8(*(const u32x4*)(G + o), gg);
#pragma unroll
                for (int i = 0; i < 8; ++i) v[i] *= sigmoidf_(gg[i]); }
            if (MODE == 1) { float aa[8]; unpack8(*(const u32x4*)(ADD + o), aa);
#pragma unroll
                for (int i = 0; i < 8; ++i) v[i] += aa[i]; }
            u32x4 w; w.x = pack2(v[0], v[1]); w.y = pack2(v[2], v[3]); w.z = pack2(v[4], v[5]); w.w = pack2(v[6], v[7]);
            *(u32x4*)(O + o) = w;
        }
    }
};
struct EpiOut {
    static constexpr bool PERM = false, AFTER_DRAIN = false;
    float* Z1; const float* x_prompt; const float* x_sample; const float* MOD;
    __device__ __forceinline__ void operator()(const pg8::f32x4 (&acc)[2][2][4][2], const pg8::Unit& u, int wr, int wc, int fr, int fq) const {
        const int row0 = u.pm * 256 + wr * 64 + fr, col0 = u.pn * 256 + wc * 32 + 4 * fq;
        const float* g1 = MOD + (size_t)(row0 >> 14) * 6144 + 2048 + col0;
        pg8::f32x4 gv[2][2];
#pragma unroll
        for (int bj = 0; bj < 2; ++bj)
#pragma unroll
            for (int n = 0; n < 2; ++n) gv[bj][n] = *(const pg8::f32x4*)(g1 + bj * 128 + n * 16);
#pragma unroll
        for (int ai = 0; ai < 2; ++ai) {
            pg8::f32x4 xv[4][2][2];
#pragma unroll
            for (int m = 0; m < 4; ++m)
#pragma unroll
                for (int bj = 0; bj < 2; ++bj)
#pragma unroll
                    for (int n = 0; n < 2; ++n) xv[m][bj][n] = *(const pg8::f32x4*)(x_prompt + (size_t)(row0 + ai * 128 + m * 16) * D + col0 + bj * 128 + n * 16);
#pragma unroll
            for (int m = 0; m < 4; ++m)
#pragma unroll
                for (int bj = 0; bj < 2; ++bj)
#pragma unroll
                    for (int n = 0; n < 2; ++n)
                        *(pg8::f32x4*)(Z1 + (size_t)(row0 + ai * 128 + m * 16) * D + col0 + bj * 128 + n * 16) = xv[m][bj][n] * DN_ALPHA + gv[bj][n] * acc[ai][bj][m][n];
        }
    }
    __device__ __forceinline__ void emit16(int row, int col, const float (&v)[16]) const {
        if (row >= NT) return;
        const float* xr = row < NTP ? x_prompt + (size_t)row * D : x_sample + (size_t)(row - NTP) * D;
        const float* g1 = MOD + (size_t)seq_of(row) * 6144 + 2048;
#pragma unroll
        for (int i = 0; i < 4; ++i) {
            const f32x4 xv = *(const f32x4*)(xr + col + 4 * i), gv = *(const f32x4*)(g1 + col + 4 * i);
            *(f32x4*)(Z1 + (size_t)row * D + col + 4 * i) = xv * DN_ALPHA + gv * (f32x4){v[4 * i], v[4 * i + 1], v[4 * i + 2], v[4 * i + 3]};
        }
    }
};

__device__ __forceinline__ size_t qvf_index(int row, int c0) {
    return ((((((size_t)(row >> 5) * 8 + (c0 >> 8)) * 2 + ((c0 >> 7) & 1)) * 8 + ((c0 & 127) >> 4)) * 64) + (((c0 >> 3) & 1) * 32 + (row & 31))) * 8;
}
struct EpiQvf {
    static constexpr bool PERM = true, AFTER_DRAIN = false;
    bf16_t* O;
    __device__ __forceinline__ void operator()(const pg8::f32x4 (&acc)[2][2][4][2], const pg8::Unit& u, int wr, int wc, int fr, int fq) const {
        const int row0 = u.pm * 256 + wr * 64 + fr, col0 = u.pn * 256 + wc * 32 + 8 * fq;
#pragma unroll
        for (int ai = 0; ai < 2; ++ai)
#pragma unroll
            for (int m = 0; m < 4; ++m)
#pragma unroll
                for (int bj = 0; bj < 2; ++bj) {
                    const pg8::f32x4 v0 = acc[ai][bj][m][0], v1 = acc[ai][bj][m][1];
                    u32x4 w; w.x = pack2(v0[0], v0[1]); w.y = pack2(v0[2], v0[3]); w.z = pack2(v1[0], v1[1]); w.w = pack2(v1[2], v1[3]);
                    *(u32x4*)(O + qvf_index(row0 + ai * 128 + m * 16, col0 + bj * 128)) = w;
                }
    }
    __device__ __forceinline__ void emit16(int row, int col, const float (&v)[16]) const {
        u32x4 w0, w1;
        w0.x = pack2(v[0], v[1]); w0.y = pack2(v[2], v[3]); w0.z = pack2(v[4], v[5]); w0.w = pack2(v[6], v[7]);
        w1.x = pack2(v[8], v[9]); w1.y = pack2(v[10], v[11]); w1.z = pack2(v[12], v[13]); w1.w = pack2(v[14], v[15]);
        *(u32x4*)(O + qvf_index(row, col)) = w0; *(u32x4*)(O + qvf_index(row, col + 8)) = w1;
    }
};

__device__ __forceinline__ void phase_ln1(const Params& p, int bid, int nb) {
    int tid_ = threadIdx.x; asm volatile("" : "+v"(tid_));
    const int wave = tid_ >> 6, lane = tid_ & 63;
    float lw[16], lb[16];
    load_row16(p.ln1_w, lane, lw); load_row16(p.ln1_b, lane, lb);
    int row = bid * 8 + wave;
    float nx[16];
    if (row < NT) load_row16(p.Z1 + (size_t)row * D, lane, nx);
    for (; row < NT; row += nb * 8) {
        float v[16];
#pragma unroll
        for (int i = 0; i < 16; ++i) v[i] = nx[i];
        const int nrow = row + nb * 8;
        if (nrow < NT) load_row16(p.Z1 + (size_t)nrow * D, lane, nx);
        const float* mod = p.MOD + (size_t)seq_of(row) * 6144;
        float sh[16], sc[16];
        load_row16(mod + 3072, lane, sh); load_row16(mod + 4096, lane, sc);
        float mean, rstd; row_stats(v, mean, rstd);
        if (lane == 0) { p.LNST[(size_t)row * 2] = mean; p.LNST[(size_t)row * 2 + 1] = rstd; }
#pragma unroll
        for (int i = 0; i < 16; ++i) v[i] = (v[i] - mean) * rstd * lw[i] + lb[i];
        row_stats(v, mean, rstd);
#pragma unroll
        for (int i = 0; i < 16; ++i) v[i] = (v[i] - mean) * rstd * (1.0f + sc[i]) + sh[i];
        store_row16_bf16(p.H + (size_t)row * D, lane, v);
        float am = 0.f;
#pragma unroll
        for (int i = 0; i < 16; ++i) am = fmaxf(am, fabsf(v[i]));
        am = wave_max(am);
        const float inv = am > 0.f ? 448.0f / am : 1.0f;
        u32x4 w8;
#pragma unroll
        for (int i = 0; i < 4; ++i) {
            int d = 0;
            d = __builtin_amdgcn_cvt_pk_fp8_f32(v[4 * i] * inv, v[4 * i + 1] * inv, d, false);
            d = __builtin_amdgcn_cvt_pk_fp8_f32(v[4 * i + 2] * inv, v[4 * i + 3] * inv, d, true);
            w8[i] = (unsigned)d;
        }
        *(u32x2*)(p.H8 + (size_t)row * 1024 + 8 * lane) = (u32x2){w8[0], w8[1]};
        *(u32x2*)(p.H8 + (size_t)row * 1024 + 512 + 8 * lane) = (u32x2){w8[2], w8[3]};
        if (lane == 0) p.HS[row] = am > 0.f ? am * (1.0f / 448.0f) : 1.0f;
    }
}

__device__ __forceinline__ unsigned fkey(float f) { const unsigned u = __float_as_uint(f); return (u & 0x80000000u) ? ~u : (u | 0x80000000u); }
__device__ __forceinline__ float keyf(unsigned k) { return __uint_as_float((k & 0x80000000u) ? (k & 0x7fffffffu) : ~k); }

constexpr int CC_R0 = 128 * 127, CC_R1 = CC_R0 + 128 * 511, CC_ROWS = CC_R1 + 128 * 2047;
constexpr int CC_PER = 2, CC_STEPS = 84;
static_assert(CC_PER * CC_STEPS * 2048 >= CC_ROWS, "copy coverage");
template <int W> __device__ __forceinline__ void cc_addr_w(const float* s, float* d, int i, const float*& src, float*& dst) {
    const int seq = i / (W - 1), rr = i - seq * (W - 1);
    src = s + ((size_t)seq * W + rr + 1) * 512; dst = d + ((size_t)seq * W + rr) * 512;
}
__device__ __forceinline__ bool cc_addr(const Params& p, int row_, const float*& src, float*& dst) {
    const int rowu = __builtin_amdgcn_readfirstlane(row_);
    const bool ok = rowu < CC_ROWS;
    const int row = ok ? rowu : CC_ROWS - 1;
    if (row < CC_R0) cc_addr_w<128>(p.cache128, p.out + OFF_KVS0, row, src, dst);
    else if (row < CC_R1) cc_addr_w<512>(p.cache512, p.out + OFF_KVS1, row - CC_R0, src, dst);
    else cc_addr_w<2048>(p.cache2048, p.out + OFF_KVS2, row - CC_R1, src, dst);
    return ok;
}
struct CacheCopier {
    static constexpr int CAP = CC_PER * CC_STEPS;
    int row0, lane4, knext, kh0, kh1; f32x4 b0[2 * CC_PER], b1[2 * CC_PER];
    __device__ __forceinline__ void init(int bid, int tid) { row0 = __builtin_amdgcn_readfirstlane(bid * 8 + (tid >> 6)); lane4 = (tid & 63) * 4; knext = 0; kh0 = CAP; kh1 = CAP; }
    template <int W> __device__ __forceinline__ void store_part(const Params& p) {
        const int k0 = W ? kh1 : kh0;
#pragma unroll
        for (int j = 0; j < CC_PER; ++j) { const float* s; float* d; if (cc_addr(p, row0 + (k0 + j) * 2048, s, d)) {
            __builtin_nontemporal_store((W ? b1 : b0)[2 * j], (f32x4*)(d + lane4)); __builtin_nontemporal_store((W ? b1 : b0)[2 * j + 1], (f32x4*)(d + 256 + lane4)); } }
    }
    template <int W> __device__ __forceinline__ void load_part(const Params& p) {
        (W ? kh1 : kh0) = knext;
#pragma unroll
        for (int j = 0; j < CC_PER; ++j) { const float* s; float* d; (void)cc_addr(p, row0 + (knext + j) * 2048, s, d);
            (W ? b1 : b0)[2 * j] = __builtin_nontemporal_load((const f32x4*)(s + lane4)); (W ? b1 : b0)[2 * j + 1] = __builtin_nontemporal_load((const f32x4*)(s + 256 + lane4)); }
        knext = knext + CC_PER < CAP ? knext + CC_PER : CAP;
    }
    template <int W> __device__ __forceinline__ void step(const Params& p) { store_part<W>(p); load_part<W>(p); }
    __device__ __forceinline__ void flush(const Params& p) { while (kh0 < CAP || kh1 < CAP) { step<0>(p); step<1>(p); } }
};
constexpr int SK_PITCH = 132;
#define DPP_ROR(v, n) ((unsigned)__builtin_amdgcn_update_dpp(0, (int)(v), 0x120 + (n), 0xf, 0xf, true))
__device__ __forceinline__ unsigned row_max_u32(unsigned v) {
    v = max(v, DPP_ROR(v, 8)); v = max(v, DPP_ROR(v, 4)); v = max(v, DPP_ROR(v, 2)); v = max(v, DPP_ROR(v, 1)); return v;
}
#define CE_DESC(a, b) do { const unsigned hi_ = max(a, b), lo_ = min(a, b); a = hi_; b = lo_; } while (0)
__device__ __forceinline__ void phase_peer_select(const Params& p, int bid, int nb, LAS unsigned char* lds) {
    int tid_ = threadIdx.x; asm volatile("" : "+v"(tid_));
    LAS unsigned* s_key = (LAS unsigned*)lds;
    LAS unsigned* s_top = s_key + 256 * SK_PITCH;
    const int wave = tid_ >> 6, lane = tid_ & 63, r = lane & 31, hh = lane >> 5;
    const int li = tid_ & 15, rowid = tid_ >> 4;
    int cand_i[4], cand_j[4]; bool cand_ok[4];
#pragma unroll
    for (int s = 0; s < 4; ++s) {
        int i = 0, rem = 4 * li + s;
        while (i < 16 && rem >= 16 / (i + 1)) { rem -= 16 / (i + 1); ++i; }
        cand_ok[s] = i < 16; cand_i[s] = i < 16 ? i : 0; cand_j[s] = i < 16 ? rem : 0;
    }
    CacheCopier cc; cc.init(bid, tid_);
    for (int b = bid; b < 256; b += nb) {
        for (int tile = 0; tile < 5; ++tile) {
            const int nvalid = tile < 4 ? 32 : (b < NS ? 1 : 0);
            if (nvalid == 0) break;
            const int row0 = tile < 4 ? b * 128 + tile * 32 : NTP + b;
            for (int hq = 0; hq < 2; ++hq) {
#pragma unroll
                for (int jb = 0; jb < 4; ++jb) {
                    const int job = wave * 4 + jb, hl = job >> 3, half = (job >> 2) & 1, ni = job & 3;
                    const int h = 4 * hq + hl;
                    const int tix = tile < 4 ? b * 4 + tile : (NTP >> 5) + (b >> 5), rsel = tile < 4 ? r : (b & 31);
                    const bf16_t* A = p.QV + ((((size_t)tix * 8 + h) * 2 + half) * 8 * 64 + (hh * 32 + rsel)) * 8;
                    const bf16_t* B = p.KF + ((((size_t)h * 2 + half) * 4 + ni) * 8 * 64 + lane) * 8;
                    if (jb & 1) cc.store_part<1>(p); else cc.store_part<0>(p);
                    bf16x8 af[8], bfr[8];
#pragma unroll
                    for (int ks = 0; ks < 8; ++ks) { af[ks] = ld_frag_g(A + ks * 512); bfr[ks] = ld_frag_g(B + ks * 512); }
                    if (jb & 1) cc.load_part<1>(p); else cc.load_part<0>(p);
                    f32x16 acc = zero16();
#pragma unroll
                    for (int ks = 0; ks < 8; ++ks) acc = mfma32(af[ks], bfr[ks], acc);
                    LAS unsigned* dst = s_key + ((hl * 2 + half) * 32) * SK_PITCH + 32 * ni + r;
                    const unsigned tag = 127u - (unsigned)(32 * ni + r);
#pragma unroll
                    for (int reg = 0; reg < 16; ++reg) dst[crow(reg, hh) * SK_PITCH] = (fkey(acc[reg]) & ~127u) | tag;
                }
                __syncthreads();
                {
                    auto stage1 = [&](int it) {
                        unsigned k[2][8], res[2];
#pragma unroll
                        for (int z = 0; z < 2; ++z) {
                            const int q = (it + 4 * z) * 32 + rowid;
                            const u32x4 ka = *(const LAS u32x4*)(s_key + q * SK_PITCH + 8 * li), kb = *(const LAS u32x4*)(s_key + q * SK_PITCH + 8 * li + 4);
                            k[z][0] = ka.x; k[z][1] = ka.y; k[z][2] = ka.z; k[z][3] = ka.w; k[z][4] = kb.x; k[z][5] = kb.y; k[z][6] = kb.z; k[z][7] = kb.w; res[z] = 0u;
                        }
#pragma unroll
                        for (int z = 0; z < 2; ++z) {
                            CE_DESC(k[z][0], k[z][1]); CE_DESC(k[z][2], k[z][3]); CE_DESC(k[z][4], k[z][5]); CE_DESC(k[z][6], k[z][7]);
                            CE_DESC(k[z][0], k[z][2]); CE_DESC(k[z][1], k[z][3]); CE_DESC(k[z][4], k[z][6]); CE_DESC(k[z][5], k[z][7]);
                            CE_DESC(k[z][1], k[z][2]); CE_DESC(k[z][5], k[z][6]);
                            CE_DESC(k[z][0], k[z][4]); CE_DESC(k[z][1], k[z][5]); CE_DESC(k[z][2], k[z][6]); CE_DESC(k[z][3], k[z][7]);
                            CE_DESC(k[z][2], k[z][4]); CE_DESC(k[z][3], k[z][5]);
                            CE_DESC(k[z][1], k[z][2]); CE_DESC(k[z][3], k[z][4]); CE_DESC(k[z][5], k[z][6]);
                        }
#pragma unroll
                        for (int ps = 0; ps < 16; ++ps) {
#pragma unroll
                            for (int z = 0; z < 2; ++z) {
                                const unsigned mx = row_max_u32(k[z][0]);
                                res[z] = li == ps ? mx : res[z];
                                const bool pop = k[z][0] == mx;
#pragma unroll
                                for (int e = 0; e < 7; ++e) k[z][e] = pop ? k[z][e + 1] : k[z][e];
                                k[z][7] = pop ? 0u : k[z][7];
                            }
                        }
#pragma unroll
                        for (int z = 0; z < 2; ++z) s_top[((it + 4 * z) * 32 + rowid) * 16 + li] = res[z];
                    };
                    for (int it = 0; it < 4; it += 2) { cc.step<0>(p); if (rowid < nvalid) stage1(it); cc.step<1>(p); if (rowid < nvalid) stage1(it + 1); }
                }
                __syncthreads();
                {
                    auto stage2 = [&](int hl0) {
                        unsigned c[2][4], res[2];
#pragma unroll
                        for (int z = 0; z < 2; ++z) {
                            const int hl = hl0 + 2 * z;
                            const LAS unsigned* t1 = s_top + ((hl * 2 + 0) * 32 + rowid) * 16;
                            const LAS unsigned* t2 = s_top + ((hl * 2 + 1) * 32 + rowid) * 16;
#pragma unroll
                            for (int s = 0; s < 4; ++s) {
                                const float v = keyf(t1[cand_i[s]] & ~127u) + keyf(t2[cand_j[s]] & ~127u);
                                c[z][s] = cand_ok[s] ? ((fkey(v) & ~255u) | (255u - (unsigned)(cand_i[s] * 16 + cand_j[s]))) : 0u;
                            }
                            CE_DESC(c[z][0], c[z][1]); CE_DESC(c[z][2], c[z][3]); CE_DESC(c[z][0], c[z][2]); CE_DESC(c[z][1], c[z][3]); CE_DESC(c[z][1], c[z][2]);
                            res[z] = 0u;
                        }
#pragma unroll
                        for (int ps = 0; ps < 16; ++ps) {
#pragma unroll
                            for (int z = 0; z < 2; ++z) {
                                const unsigned mx = row_max_u32(c[z][0]);
                                res[z] = li == ps ? mx : res[z];
                                const bool pop = c[z][0] == mx;
                                c[z][0] = pop ? c[z][1] : c[z][0]; c[z][1] = pop ? c[z][2] : c[z][1]; c[z][2] = pop ? c[z][3] : c[z][2]; c[z][3] = pop ? 0u : c[z][3];
                            }
                        }
#pragma unroll
                        for (int z = 0; z < 2; ++z) {
                            const int hl = hl0 + 2 * z;
                            const LAS unsigned* t1 = s_top + ((hl * 2 + 0) * 32 + rowid) * 16;
                            const LAS unsigned* t2 = s_top + ((hl * 2 + 1) * 32 + rowid) * 16;
                            const int cidx = 255 - (int)(res[z] & 255u), i1 = cidx >> 4, i2 = cidx & 15;
                            const unsigned a1 = t1[i1], a2 = t2[i2];
                            const float sc = keyf(a1 & ~127u) + keyf(a2 & ~127u);
                            float mxs = sc;
                            mxs = fmaxf(mxs, DPP_ROR_F(mxs, 8)); mxs = fmaxf(mxs, DPP_ROR_F(mxs, 4)); mxs = fmaxf(mxs, DPP_ROR_F(mxs, 2)); mxs = fmaxf(mxs, DPP_ROR_F(mxs, 1));
                            const float ex = __expf(sc - mxs);
                            const float gw = ex / dpp_row_sum(ex);
                            const int ei = (127 - (int)(a1 & 127u)) * 128 + (127 - (int)(a2 & 127u));
                            const size_t o = (size_t)(row0 + rowid) * 128 + (4 * hq + hl) * 16 + li;
                            p.EIDX[o] = ei; p.EGW[o] = gw * p.SV[ei];
                        }
                    };
                    cc.step<0>(p); if (rowid < nvalid) stage2(0); cc.step<1>(p); if (rowid < nvalid) stage2(1);
                }
                __syncthreads();
            }
        }
    }
    cc.flush(p);
}

__device__ __forceinline__ float gelu_erf(float x) { return 0.5f * x * (1.0f + erff(x * 0.70710678118654752f)); }
__device__ __forceinline__ float wave_total_from_rows(float v) {
    return (__builtin_bit_cast(float, __builtin_amdgcn_readlane(__builtin_bit_cast(int, v), 0)) + __builtin_bit_cast(float, __builtin_amdgcn_readlane(__builtin_bit_cast(int, v), 16)))
         + (__builtin_bit_cast(float, __builtin_amdgcn_readlane(__builtin_bit_cast(int, v), 32)) + __builtin_bit_cast(float, __builtin_amdgcn_readlane(__builtin_bit_cast(int, v), 48)));
}
__device__ __forceinline__ void fp8x16_to_f32(const u32x4 w, float (&o)[16]) {
#pragma unroll
    for (int i = 0; i < 4; ++i) {
        const v2f_t lo = __builtin_amdgcn_cvt_pk_f32_fp8((int)w[i], false), hi = __builtin_amdgcn_cvt_pk_f32_fp8((int)w[i], true);
        o[4 * i] = lo.x; o[4 * i + 1] = lo.y; o[4 * i + 2] = hi.x; o[4 * i + 3] = hi.y;
    }
}
typedef long i64x2_t __attribute__((ext_vector_type(2)));
typedef int i32x2_t __attribute__((ext_vector_type(2)));
#define UP_PITCH 1040
__device__ __forceinline__ void up_tile_put(const u32x4 (&rows)[16], LAS unsigned char* tile, int lane16) {
#pragma unroll
    for (int q = 0; q < 16; ++q) *(LAS u32x4*)(tile + q * UP_PITCH + lane16) = rows[q];
}
__device__ __forceinline__ float up_tile_dots(LAS unsigned char* tile, const LAS unsigned char* hrow, int pr, int kg16) {
    f32x4 c0 = {0.f, 0.f, 0.f, 0.f}, c1 = c0;
    u32x4 hf[2][2], uf[2][2];
    auto rd = [&](int st, int s) {
#pragma unroll
        for (int i = 0; i < 2; ++i) { hf[s][i] = *(const LAS u32x4*)(hrow + 128 * st + 64 * i + kg16); uf[s][i] = *(const LAS u32x4*)(tile + pr * UP_PITCH + 128 * st + 64 * i + kg16); }
    };
    auto mm = [&](int s) {
#pragma unroll
        for (int i = 0; i < 2; ++i) {
            const i64x2_t a = __builtin_bit_cast(i64x2_t, hf[s][i]), b = __builtin_bit_cast(i64x2_t, uf[s][i]);
            c0 = __builtin_amdgcn_mfma_f32_16x16x32_fp8_fp8(a[0], b[0], c0, 0, 0, 0);
            c1 = __builtin_amdgcn_mfma_f32_16x16x32_fp8_fp8(a[1], b[1], c1, 0, 0, 0);
        }
    };
    rd(0, 0);
#pragma unroll
    for (int st = 0; st < 8; ++st) {
        if (st + 1 < 8) rd(st + 1, (st + 1) & 1);
        __builtin_amdgcn_sched_barrier(0);
        mm(st & 1);
        __builtin_amdgcn_sched_barrier(0);
    }
    return c0[0] + c1[0];
}

template <int V = 0>
__device__ __forceinline__ void phase_peer_upass(const Params& p, int bid, int nb, LAS unsigned char* lds, float* __restrict__ ewout) {
    int tid_ = threadIdx.x; asm volatile("" : "+v"(tid_));
    const int wave = tid_ >> 6, lane = tid_ & 63;
    constexpr int WSTR = 16 * UP_PITCH + 2048 + 64;
    LAS unsigned char* tile = lds + wave * WSTR;
    LAS int* lst = (LAS int*)tile;
    LAS unsigned char* hb = tile + 16 * UP_PITCH;
    LAS float* hsl = (LAS float*)(tile + 16 * UP_PITCH + 2048);
    static_assert(8 * WSTR <= LDS_BYTES - 16, "LDS carve of the expert-activation phase");
    const __amdgpu_buffer_rsrc_t ures = __builtin_amdgcn_make_buffer_rsrc((void*)p.U8, 0, 16384 * 2048, 0x00020000);
    const int pr = lane & 15, kg16 = (lane >> 4) * 16, lane16 = lane * 16;
    constexpr int TPB = NT / 32;
    static_assert(TPB * 32 == NT, "token ranges");
    struct TokIn { u32x4 h8; int ia, ib; float hs; };
    struct Tok { int t, n, e0, e1, k0, k1; float su0, su1; };
    for (int vb = bid; vb < 256; vb += nb) {
        const int x = vb & 7, t0 = (vb >> 3) * TPB, tend = t0 + TPB;
        {
        auto fetch_tok = [&](int t2, TokIn& ti) {
            t2 = t2 < tend ? t2 : tend - 1;
            const size_t R2 = (size_t)t2;
            ti.h8 = *(const u32x4*)(p.H8 + R2 * 1024 + 16 * lane); ti.hs = p.HS[R2];
            ti.ia = p.EIDX[R2 * 128 + lane]; ti.ib = p.EIDX[R2 * 128 + 64 + lane];
        };
        auto prep = [&](int t, TokIn& in, Tok& o, u32x4 (&buf)[16], int par) {
            const int ia = in.ia, ib = in.ib;
            o.t = t;
            *(LAS u32x4*)(hb + par * 1024 + 16 * lane) = in.h8; hsl[par] = in.hs;
            const bool inA = (ia >> 11) == x, inB = (ib >> 11) == x;
            const unsigned long long mA = __builtin_amdgcn_ballot_w64(inA), mB = __builtin_amdgcn_ballot_w64(inB);
            const int cntA = __builtin_popcountll(mA), n = cntA + __builtin_popcountll(mB);
            const int rankA = (int)__builtin_amdgcn_mbcnt_hi((unsigned)(mA >> 32), __builtin_amdgcn_mbcnt_lo((unsigned)mA, 0u));
            const int rankB = cntA + (int)__builtin_amdgcn_mbcnt_hi((unsigned)(mB >> 32), __builtin_amdgcn_mbcnt_lo((unsigned)mB, 0u));
            LAS int* L = lst;
            if (inA) { L[rankA] = ia; L[128 + rankA] = lane; }
            if (inB) { L[rankB] = ib; L[128 + rankB] = 64 + lane; }
            asm volatile("s_waitcnt lgkmcnt(0)" ::: "memory");
            o.n = n;
            o.e0 = lane < n ? L[lane] : (x << 11); o.e1 = 64 + lane < n ? L[64 + lane] : (x << 11);
            o.k0 = L[128 + lane]; o.k1 = L[192 + lane];
            o.su0 = p.SU[o.e0]; o.su1 = p.SU[o.e1];
#pragma unroll
            for (int q = 0; q < 16; ++q) { const int e = __builtin_amdgcn_readlane(o.e0, q); buf[q] = __builtin_amdgcn_raw_buffer_load_b128(ures, lane16, e << 11, 0); }
            fetch_tok(t + 16, in);
        };
        auto finish = [&](Tok& c, u32x4 (&buf)[16], int par) {
            const LAS unsigned char* hrow = hb + par * 1024; const float hs = hsl[par];
            __builtin_amdgcn_sched_barrier(0);
            __builtin_amdgcn_s_waitcnt(0x4F76);
            __builtin_amdgcn_sched_barrier(0);
            float dot0 = 0.f, dot1 = 0.f;
            for (int base = 0; base < 16 || base < c.n; base += 16) {
                up_tile_put(buf, tile, lane16);
                if (base + 16 < c.n) {
                    const int nb16 = base + 16, ev = nb16 < 64 ? c.e0 : c.e1;
#pragma unroll
                    for (int q = 0; q < 16; ++q) { const int e = __builtin_amdgcn_readlane(ev, (nb16 & 63) + q); buf[q] = __builtin_amdgcn_raw_buffer_load_b128(ures, lane16, e << 11, 0); }
                }
                __builtin_amdgcn_sched_barrier(0);
                const float d = up_tile_dots(tile, hrow, pr, kg16);
                if ((lane >> 4) == ((base >> 4) & 3)) { if (base < 64) dot0 = d; else dot1 = d; }
                if (base + 16 < c.n) {
                    __builtin_amdgcn_sched_barrier(0);
                    __builtin_amdgcn_s_waitcnt(0x0F70);
                    __builtin_amdgcn_sched_barrier(0);
                }
            }
            const size_t R = (size_t)c.t;
            if (lane < c.n) ewout[R * 128 + c.k0] = gelu_erf(c.su0 * hs * dot0);
            if (64 + lane < c.n) ewout[R * 128 + c.k1] = gelu_erf(c.su1 * hs * dot1);
        };
        TokIn iA, iB; Tok kA, kB; u32x4 bX[16], bY[16];
        fetch_tok(t0 + wave, iA); fetch_tok(t0 + wave + 8, iB);
        prep(t0 + wave, iA, kA, bX, 0);
        for (int t = t0 + wave; t < tend; t += 16) {
            prep(t + 8 < tend ? t + 8 : tend - 1, iB, kB, bY, 1);
            finish(kA, bX, 0);
            prep(t + 16 < tend ? t + 16 : tend - 1, iA, kA, bX, 0);
            finish(kB, bY, 1);
        }
        __builtin_amdgcn_s_waitcnt(0x0F70);
        }
    }
}

__device__ __forceinline__ void phase_peer_gather(const Params& p, int bid, int nb, LAS unsigned char* lds, int skip_ff = 0) {
    int tid_ = threadIdx.x; asm volatile("" : "+v"(tid_));
    const int wave = tid_ >> 6, lane = tid_ & 63;
    LAS float* s_ff = (LAS float*)lds;
    const __amdgpu_buffer_rsrc_t vres = __builtin_amdgcn_make_buffer_rsrc((void*)p.U8, 0, 16384 * 2048, 0x00020000);
    const int lane16v = lane * 16 + 1024;
    const int n_vb = (256 - bid + nb - 1) / nb;
    for (int it = 0; it < n_vb * 17; ++it) {
        const int vb = bid + (it / 17) * nb, sub = it % 17;
        const bool coop = sub == 16;
        if (coop && vb >= NS) continue;
        const int row = coop ? NTP + vb : vb * 128 + wave + 8 * sub;
        const int g0 = skip_ff ? 8 : (coop ? wave : 0), g1 = coop ? wave + 1 : 8;
        const size_t R = (size_t)row;
        v2f_t acc2[8];
#pragma unroll
        for (int i = 0; i < 8; ++i) acc2[i] = (v2f_t){0.f, 0.f};
        const int ia = p.EIDX[R * 128 + lane], ib = p.EIDX[R * 128 + 64 + lane];
        const float wa = p.EW[R * 128 + lane] * p.EGW[R * 128 + lane], wb = p.EW[R * 128 + 64 + lane] * p.EGW[R * 128 + 64 + lane];
        f32x4 zr[4];
#pragma unroll
        for (int i = 0; i < 4; ++i) zr[i] = *(const f32x4*)(p.Z1 + R * D + 16 * lane + 4 * i);
        const float mean1 = p.LNST[R * 2], rstd1 = p.LNST[R * 2 + 1];
        for (int grp = g0; grp < g1; ++grp) {
            const int iv = grp < 4 ? ia : ib; const float wv = grp < 4 ? wa : wb;
            const int l0 = (grp & 3) * 16;
            u32x4 vb16[16];
#pragma unroll
            for (int q = 0; q < 16; ++q) { const int e = __builtin_amdgcn_readlane(iv, l0 + q); vb16[q] = __builtin_amdgcn_raw_buffer_load_b128(vres, lane16v, e << 11, 0); }
#pragma unroll
            for (int q = 0; q < 16; ++q) {
                const float w = __builtin_bit_cast(float, __builtin_amdgcn_readlane(__builtin_bit_cast(int, wv), l0 + q));
                const v2f_t w2 = {w, w};
#pragma unroll
                for (int i = 0; i < 4; ++i) {
                    const v2f_t lo = __builtin_amdgcn_cvt_pk_f32_fp8((int)vb16[q][i], false), hi = __builtin_amdgcn_cvt_pk_f32_fp8((int)vb16[q][i], true);
                    acc2[2 * i] += w2 * lo; acc2[2 * i + 1] += w2 * hi;
                }
            }
        }
        float acc[16];
#pragma unroll
        for (int i = 0; i < 8; ++i) { acc[2 * i] = acc2[i].x; acc[2 * i + 1] = acc2[i].y; }
        if (coop) {
#pragma unroll
            for (int i = 0; i < 4; ++i) *(LAS f32x4*)(s_ff + wave * 1024 + 16 * lane + 4 * i) = (f32x4){acc[4 * i], acc[4 * i + 1], acc[4 * i + 2], acc[4 * i + 3]};
            __syncthreads();
            if (wave == 0) {
#pragma unroll
                for (int i = 0; i < 16; ++i) acc[i] = 0.f;
#pragma unroll
                for (int w = 0; w < 8; ++w)
#pragma unroll
                    for (int i = 0; i < 4; ++i) { const f32x4 t = *(const LAS f32x4*)(s_ff + w * 1024 + 16 * lane + 4 * i); acc[4 * i] += t[0]; acc[4 * i + 1] += t[1]; acc[4 * i + 2] += t[2]; acc[4 * i + 3] += t[3]; }
            }
        }
        if (!coop || wave == 0) {
            float x1[16], g2[16];
            const float* gr = p.MOD + (size_t)seq_of(row) * 6144 + 5120 + 16 * lane;
#pragma unroll
            for (int i = 0; i < 4; ++i) { const f32x4 a = zr[i], b = *(const f32x4*)(gr + 4 * i);
                const f32x4 lw = *(const f32x4*)(p.ln1_w + 16 * lane + 4 * i), lb = *(const f32x4*)(p.ln1_b + 16 * lane + 4 * i);
#pragma unroll
                for (int j = 0; j < 4; ++j) { x1[4 * i + j] = (a[j] - mean1) * rstd1 * lw[j] + lb[j]; g2[4 * i + j] = b[j]; } }
#pragma unroll
            for (int i = 0; i < 16; ++i) acc[i] = DN_ALPHA * x1[i] + g2[i] * acc[i];
            float mean, rstd; row_stats(acc, mean, rstd);
            float* yo = (row < NTP ? p.out + OFF_YP + R * D : p.out + OFF_YS + (size_t)(row - NTP) * D) + 16 * lane;
#pragma unroll
            for (int i = 0; i < 4; ++i) { const f32x4 w = *(const f32x4*)(p.ln2_w + 16 * lane + 4 * i), b = *(const f32x4*)(p.ln2_b + 16 * lane + 4 * i);
                f32x4 o;
#pragma unroll
                for (int j = 0; j < 4; ++j) o[j] = (acc[4 * i + j] - mean) * rstd * w[j] + b[j];
                *(f32x4*)(yo + 4 * i) = o; }
        }
        if (coop) __syncthreads();
    }
}

__device__ __forceinline__ void phase_z1_bypass(const Params& p, int bid, int nb) {
    int tid_ = threadIdx.x; asm volatile("" : "+v"(tid_));
    const int wave = tid_ >> 6, lane = tid_ & 63;
    for (int row = bid * 8 + wave; row < NT; row += nb * 8) {
        float v[16]; load_row16(x_row(p, row), lane, v);
#pragma unroll
        for (int i = 0; i < 16; ++i) v[i] *= DN_ALPHA;
        store_row16_f32(p.Z1 + (size_t)row * D, lane, v);
    }
}

#define DYN_LDS extern __shared__ __attribute__((aligned(16))) unsigned char shm_[]; LAS unsigned char* lds = (LAS unsigned char*)shm_;
template <class Epi> __device__ __forceinline__ void run_gemm(LAS unsigned char* lds, const bf16_t* A, const bf16_t* Bt, int M, int N, int K, const Epi& E) {
    int Ko = K; asm volatile("" : "+s"(Ko));
    pg8::StaticOrder S; S.init(M, N, (int)gridDim.x, (int)blockIdx.x);
    pg8::Gemm g{A, Bt, M, N, Ko};
    pg8::gemm_phase<Epi, pg8::StaticOrder, false>(lds, g, S, E, nullptr);
    __syncthreads();
}

template <class Epi> __device__ __forceinline__ void skinny_gemm(const bf16_t* __restrict__ A, const bf16_t* __restrict__ Bt, int N, int K, const Epi& E, int ushift) {
    int tid_ = threadIdx.x; asm volatile("" : "+v"(tid_));
    const int wave = tid_ >> 6, lane = tid_ & 63, r = lane & 31, hh = lane >> 5, rt = wave & 3, ct = wave >> 2;
    const int nb = (int)gridDim.x, vb = ((int)blockIdx.x + nb - (ushift % nb)) % nb;
    const int perm = 16 * ((r >> 2) & 1) + 4 * (r >> 3) + (r & 3);
    for (int u = vb; u < N / 64; u += nb) {
        int arow = NTP + 32 * rt + r; asm volatile("" : "+v"(arow));
        const bf16_t* ap = A + (size_t)arow * K + 8 * hh;
        const bf16_t* bp = Bt + (size_t)(u * 64 + 32 * ct + perm) * K + 8 * hh;
        f32x16 acc = zero16();
        for (int k0 = 0; k0 < K / 16; k0 += 8) {
            bf16x8 wa[8], xa[8];
#pragma unroll
            for (int i = 0; i < 8; ++i) { wa[i] = ld_frag_g(bp + 16 * (k0 + i)); xa[i] = ld_frag_g(ap + 16 * (k0 + i)); }
            __builtin_amdgcn_sched_barrier(0);
#pragma unroll
            for (int i = 0; i < 8; ++i) acc = mfma32(wa[i], xa[i], acc);
            __builtin_amdgcn_sched_barrier(0);
        }
        float v[16];
#pragma unroll
        for (int i = 0; i < 16; ++i) v[i] = acc[i];
        E.emit16(NTP + 32 * rt + r, u * 64 + 32 * ct + 16 * hh, v);
    }
}
__global__ void __launch_bounds__(NTHREADS, 2) k_mega(Params p) {
    DYN_LDS;
    volatile LAS unsigned* st = (volatile LAS unsigned*)(lds + LDS_BYTES - 16);
    if (threadIdx.x == 0) { st[0] = 0u; st[1] = 0u; st[2] = 0u; st[3] = 0u; }
    __syncthreads();
    const XcdBarrier bar = xcd_barrier_post(p.bar, st);
    const int bid = blockIdx.x, nb = gridDim.x;
    phase_prologue<0>(p, bid, nb, lds, 0);
    xcd_barrier(bar);
    run_gemm(lds, p.SC, p.WADA_T, 256, 6144, 1024, pg8::EpiF32{p.MOD, 6144, p.b_ada});
    phase_prologue<1>(p, bid, nb, lds, nb > 48 ? 24 : 0);
    xcd_barrier(bar);
    phase_lnmod1(p, bid, nb);
    xcd_barrier(bar);
    { const EpiProj E{p.QKVA, p.QKB, p.VBB, p.RB, p.GA, p.GB, p.GLR, p.out}; run_gemm(lds, p.H, p.WIN_T, NTP, NPROJ, 1024, E); skinny_gemm(p.H, p.WIN_T, NPROJ, 1024, E, 0); }
    xcd_barrier(bar);
    phase_gla2_passA(p, bid, nb, lds);
    phase_attn_prompt(p, bid, nb, lds);
    phase_attn_sample(p, bid, nb, lds);
    phase_gla_sample(p, bid, nb, lds);
    xcd_barrier(bar);
    phase_gla2_scan(p, bid, nb);
    xcd_barrier(bar);
    phase_gla2_passC(p, bid, nb, lds);
    phase_merge_prep(p, bid, nb);
    xcd_barrier(bar);
    { const EpiGate<0> E{p.TMP1, p.GA, nullptr, 1024}; run_gemm(lds, p.OA, p.WBRA_T, NTP, 1024, 256, E); skinny_gemm(p.OA, p.WBRA_T, 1024, 256, E, 0); }
    xcd_barrier(bar);
    { const EpiGate<1> E{p.MERGED, p.GB, p.TMP1, 1024}; run_gemm(lds, p.OB, p.WBRB_T, NTP, 1024, 1024, E); skinny_gemm(p.OB, p.WBRB_T, 1024, 1024, E, 64); }
    xcd_barrier(bar);
    { const EpiOut E{p.Z1, p.x_prompt, p.x_sample, p.MOD}; run_gemm(lds, p.MERGED, p.WOUT_T, NTP, 1024, 1024, E); skinny_gemm(p.MERGED, p.WOUT_T, 1024, 1024, E, 128); }
    xcd_barrier(bar);
    phase_ln1(p, bid, nb);
    xcd_barrier(bar);
    { const EpiQvf E{p.QV}; run_gemm(lds, p.H, p.WPQ_T, NTP, 2048, 1024, E); skinny_gemm(p.H, p.WPQ_T, 2048, 1024, E, 192); }
    xcd_barrier(bar);
    phase_peer_select(p, bid, nb, lds);
    xcd_barrier(bar);
    phase_peer_upass<0>(p, bid, nb, lds, p.EW);
#ifdef UP_PROBE
    xcd_barrier(bar);
    phase_peer_upass<UP_PROBE>(p, bid, nb, lds, (float*)p.TMP1);
#endif
    xcd_barrier(bar);
    phase_peer_gather(p, bid, nb, lds);
}

static inline size_t align_up(size_t v, size_t a) { return (v + a - 1) / a * a; }

extern "C" void kernel_launch(void* const* d_in, const int* in_sizes, int n_in, void* d_out, int out_size, void* d_ws, size_t ws_size, hipStream_t stream) {
    (void)in_sizes; (void)n_in; (void)out_size;
    Params p; memset(&p, 0, sizeof(p));
    const float* const* in = (const float* const*)d_in;
    p.x_prompt = in[0]; p.x_sample = in[1]; p.c_prompt = in[2]; p.c_sample = in[3]; p.cache128 = in[4]; p.cache512 = in[5]; p.cache2048 = in[6]; p.state_gla = in[7];
    p.w_ada = in[8]; p.b_ada = in[9]; p.w_in = in[10]; p.w_gla_up = in[11]; p.b_gla = in[12]; p.gla_norm_w = in[13]; p.w_br_a = in[14]; p.w_br_b = in[15]; p.w_out = in[16];
    p.ln1_w = in[17]; p.ln1_b = in[18]; p.w_pq = in[19]; p.peer_k1 = in[20]; p.peer_k2 = in[21]; p.peer_u = in[22]; p.peer_v = in[23]; p.ln2_w = in[24]; p.ln2_b = in[25];
    p.out = (float*)d_out;
    size_t off = 0; char* ws = (char*)d_ws;
#define CARVE(field, type, count) do { p.field = (type*)(ws + off); off = align_up(off + (size_t)(count) * sizeof(type), 256); } while (0)
    CARVE(bar, unsigned, 4096);
    CARVE(MOD, float, 256 * 6144); CARVE(SC, bf16_t, 256 * 1024); CARVE(WADA_T, bf16_t, 6144 * 1024); CARVE(WIN_T, bf16_t, (size_t)NPROJ * 1024);
    CARVE(WBRA_T, bf16_t, 1024 * 256); CARVE(WBRB_T, bf16_t, 1024 * 1024); CARVE(WOUT_T, bf16_t, 1024 * 1024); CARVE(WPQ_T, bf16_t, 2048 * 1024);
    CARVE(KF, bf16_t, 2 * 8 * 128 * 128); CARVE(U8, unsigned char, (size_t)16384 * 2048); p.V8 = p.U8 + 1024; CARVE(SU, float, 16384); CARVE(SV, float, 16384);
    CARVE(H, bf16_t, (size_t)MP * 1024); CARVE(QKVA, bf16_t, (size_t)MP * 2304); CARVE(QKB, bf16_t, (size_t)MP * 1024); CARVE(VBB, bf16_t, (size_t)MP * 1024);
    CARVE(RB, bf16_t, (size_t)MP * 1024); CARVE(GA, bf16_t, (size_t)MP * 1024); CARVE(GB, bf16_t, (size_t)MP * 1024); CARVE(GLR, float, (size_t)MP * 16);
    CARVE(OG, bf16_t, (size_t)MP * 768); CARVE(LSE, float, (size_t)MP * 12);
    CARVE(LSEG, float, (size_t)256 * 32768); CARVE(SSEG, float, (size_t)256 * 32768); CARVE(DSEG, float, (size_t)256 * 128); CARVE(OGLA, bf16_t, (size_t)MP * 1024);
    CARVE(OA, bf16_t, (size_t)MP * 256); CARVE(OB, bf16_t, (size_t)MP * 1024); CARVE(TMP1, bf16_t, (size_t)MP * 1024); CARVE(MERGED, bf16_t, (size_t)MP * 1024);
    CARVE(Z1, float, (size_t)MP * 1024); CARVE(LNST, float, (size_t)MP * 2); CARVE(QV, bf16_t, (size_t)MP * 2048); CARVE(EIDX, int, (size_t)MP * 128); CARVE(EGW, float, (size_t)MP * 128); CARVE(ESU, float, (size_t)MP * 128); CARVE(EW, float, (size_t)MP * 128); CARVE(H8, unsigned char, (size_t)MP * 1024); CARVE(HS, float, (size_t)MP);
    if (off > ws_size) { fprintf(stderr, "kernel_launch: workspace too small: need %zu, have %zu\n", off, ws_size); return; }

    static int grid = 0;
    if (!grid) {
        int dev = 0, cus = 0; (void)hipGetDevice(&dev); (void)hipDeviceGetAttribute(&cus, hipDeviceAttributeMultiprocessorCount, dev);
        grid = cus > 0 ? cus : 256;
        (void)hipFuncSetAttribute((const void*)k_mega, hipFuncAttributeMaxDynamicSharedMemorySize, LDS_BYTES);
        int per_cu = 0;
        if (hipOccupancyMaxActiveBlocksPerMultiprocessor(&per_cu, (const void*)k_mega, NTHREADS, LDS_BYTES) != hipSuccess || per_cu < 1)
            fprintf(stderr, "kernel_launch: occupancy query reports %d workgroups per CU for the persistent kernel\n", per_cu);
    }
    (void)hipMemsetAsync(p.bar, 0, 4096 * sizeof(unsigned), stream);
    hipLaunchKernelGGL(k_mega, dim3(grid), dim3(NTHREADS), LDS_BYTES, stream, p);
}
```

```cpp
#include <hip/hip_runtime.h>
#include <stdint.h>
#include <stdio.h>
#include <string.h>
#include <type_traits>
namespace pg8 {
#define PG8_LAS __attribute__((address_space(3)))
typedef unsigned short bf16_t;
typedef short bf16x8 __attribute__((ext_vector_type(8)));
typedef float f32x4 __attribute__((ext_vector_type(4)));
typedef unsigned u32x4 __attribute__((ext_vector_type(4)));
constexpr int BM = 256, BK = 64, HALF = 128, HTB = HALF * BK * 2  , STAGE_BYTES = 8 * HTB, NXCD = 8, WGM = 8;

__host__ __device__ __forceinline__ int lds_byte(int r, int c) { const int st = (r >> 4) * 2 + (c >> 5), rr = r & 15, cc = c & 31, ob = rr * 64 + cc * 2; return st * 1024 + (ob ^ (((ob >> 9) & 1) << 5)); }
__host__ __device__ __forceinline__ void stage_rc(int b, int& R, int& C) { const int st = b / 1024, sb = b % 1024, swz = sb ^ (((sb >> 9) & 1) << 5); R = (st >> 1) * 16 + swz / 64; C = (st & 1) * 32 + (swz % 64) / 2; }
__host__ __device__ __forceinline__ int perm32(int rho) { const int n = rho >> 4, i = rho & 15; return 8 * (i >> 2) + 4 * n + (i & 3); }

struct Unit { int pm, pn; };
struct Gemm { const bf16_t* A; const bf16_t* Bt; int M, N, K; };

struct StaticOrder {
    int nM, nN, nwg, G, c;
    __host__ __device__ void init(int M, int N, int G_, int c_) { nM = M / BM; nN = N / BM; nwg = nM * nN; G = G_; c = c_; }
    __host__ __device__ bool next(int i, Unit& u) const {
        const long L = (long)i * G + c; if (L >= nwg) return false;
        int wgid = (int)L; { const int q = nwg / NXCD, r = nwg % NXCD, xcd = wgid % NXCD, off = wgid / NXCD; wgid = (xcd < r ? xcd * (q + 1) : r * (q + 1) + (xcd - r) * q) + off; }
        const int nig = WGM * nN, gid = wgid / nig, fm = gid * WGM, gsz = (nM - fm) < WGM ? (nM - fm) : WGM;
        u.pm = fm + ((wgid % nig) % gsz); u.pn = (wgid % nig) / gsz; return true;
    }
    __device__ __forceinline__ void a_ready(const Unit&) const {}
    __device__ __forceinline__ void done(const Unit&) const {}
};
__device__ __forceinline__ unsigned cvt_pk_bf16(float lo, float hi) { unsigned r; asm volatile("v_cvt_pk_bf16_f32 %0, %1, %2" : "=v"(r) : "v"(lo), "v"(hi)); return r; }
typedef float f32x2 __attribute__((ext_vector_type(2)));
struct EpiF32 {
    static constexpr bool PERM = false, AFTER_DRAIN = false;
    float* C; int ldc; const float* bias;
    __device__ __forceinline__ void operator()(const f32x4 (&acc)[2][2][4][2], const Unit& u, int wr, int wc, int fr, int fq) const {
        const int row0 = u.pm * BM + wr * 64 + fr, col0 = u.pn * BM + wc * 32 + 4 * fq;
        f32x4 bv[2][2];
#pragma unroll
        for (int bj = 0; bj < 2; ++bj)
#pragma unroll
            for (int n = 0; n < 2; ++n) bv[bj][n] = bias ? *(const f32x4*)(bias + col0 + bj * HALF + n * 16) : (f32x4){0.f, 0.f, 0.f, 0.f};
#pragma unroll
        for (int ai = 0; ai < 2; ++ai)
#pragma unroll
            for (int m = 0; m < 4; ++m) { float* rowp = C + (size_t)(row0 + ai * HALF + m * 16) * ldc + col0;
#pragma unroll
                for (int bj = 0; bj < 2; ++bj)
#pragma unroll
                    for (int n = 0; n < 2; ++n) *(f32x4*)(rowp + bj * HALF + n * 16) = acc[ai][bj][m][n] + bv[bj][n]; }
    }
};
template <class Epi, class Sched, bool STAMP = false>
__device__ __forceinline__ void gemm_phase(PG8_LAS unsigned char* lds, const Gemm g, const Sched& S, const Epi& E, unsigned long long* stamps) {
    int tid_o = threadIdx.x; asm volatile("" : "+v"(tid_o));
    const int tid = tid_o, wid = __builtin_amdgcn_readfirstlane(tid >> 6), lane = tid & 63, wr = wid >> 2, wc = wid & 3, fr = lane & 15, fq = lane >> 4;
    const int K = g.K, nt = K / BK;
    int ts_lo = 0, ts_hi = 0, nts = 0; const unsigned long long rt_entry = STAMP ? (unsigned long long)wall_clock64() : 0ull;
#define PG8_STAMP() do { if (STAMP && wid == 0 && nts < 64) { const unsigned long long _c = (unsigned long long)clock64(); \
        ts_lo = (lane == nts) ? (int)(unsigned)_c : ts_lo; ts_hi = (lane == nts) ? (int)(unsigned)(_c >> 32) : ts_hi; ++nts; } } while (0)
    PG8_STAMP();
    unsigned voffA[2], voffB[2];
#pragma unroll
    for (int i = 0; i < 2; ++i) { int R, C; stage_rc(tid * 16 + i * 8192, R, C); const int Rb = Epi::PERM ? ((R & ~31) + perm32(R & 31)) : R;
        voffA[i] = (unsigned)(R * K + C) * 2u; voffB[i] = (unsigned)(Rb * K + C) * 2u; }
    const size_t kstep = (size_t)(BK * 2);
    const size_t hstep = (size_t)HALF * K * 2;
    const size_t tstep = 2 * hstep;
    const unsigned ldsw = (unsigned)wid * 1024u;
    const int aoff = lds_byte(wr * 64 + fr, fq * 8), boff = lds_byte(wc * 32 + fr, fq * 8);
#define PG8_SA(b, h) (((b) * 2 + (h)) * HTB)
#define PG8_SB(b, h) ((4 + (b) * 2 + (h)) * HTB)
#define PG8_STAGE(bufoff, gbase, voff) do { _Pragma("unroll") for (int _i = 0; _i < 2; ++_i) \
        __builtin_amdgcn_global_load_lds((const unsigned*)((const char*)(gbase) + (voff)[_i]), (PG8_LAS unsigned*)(lds + (bufoff) + ldsw + _i * 8192), 16, 0, 0); } while (0)
#define PG8_LDA(dst, b, h) do { _Pragma("unroll") for (int m = 0; m < 4; ++m) _Pragma("unroll") for (int k = 0; k < 2; ++k) dst[m][k] = *(const PG8_LAS bf16x8*)(lds + PG8_SA(b, h) + aoff + m * 2048 + k * 1024); } while (0)
#define PG8_LDB(dst, b, h) do { _Pragma("unroll") for (int n = 0; n < 2; ++n) _Pragma("unroll") for (int k = 0; k < 2; ++k) dst[n][k] = *(const PG8_LAS bf16x8*)(lds + PG8_SB(b, h) + boff + n * 2048 + k * 1024); } while (0)
#define PG8_MMA(ai, bj, At, Bt) do { __builtin_amdgcn_s_setprio(1); _Pragma("unroll") for (int m = 0; m < 4; ++m) _Pragma("unroll") for (int n = 0; n < 2; ++n) _Pragma("unroll") for (int k = 0; k < 2; ++k) \
        acc[ai][bj][m][n] = __builtin_amdgcn_mfma_f32_16x16x32_bf16(Bt[n][k], At[m][k], acc[ai][bj][m][n], 0, 0, 0); __builtin_amdgcn_s_setprio(0); } while (0)
#define PG8_WAIT_V(n) asm volatile("s_waitcnt vmcnt(" #n ")" ::: "memory")
#define PG8_WAIT_L(n) asm volatile("s_waitcnt lgkmcnt(" #n ")" ::: "memory")
#define PG8_BAR __builtin_amdgcn_s_barrier()
#define PG8_SCHED __builtin_amdgcn_sched_barrier(0)
    Unit cur, nxt; int ui = 0;
    if (!S.next(0, cur)) return;
    f32x4 acc[2][2][4][2];
#pragma unroll
    for (int a = 0; a < 2; ++a)
#pragma unroll
        for (int b = 0; b < 2; ++b)
#pragma unroll
            for (int m = 0; m < 4; ++m)
#pragma unroll
                for (int n = 0; n < 2; ++n) acc[a][b][m][n] = (f32x4){0.f, 0.f, 0.f, 0.f};
    bf16x8 At[4][2], B0[2][2], B1[2][2];
    const char* cA = (const char*)g.A + (size_t)cur.pm * tstep; const char* cB = (const char*)g.Bt + (size_t)cur.pn * tstep;
    S.a_ready(cur);
    PG8_STAGE(PG8_SB(0, 0), cB, voffB); PG8_STAGE(PG8_SA(0, 0), cA, voffA); PG8_STAGE(PG8_SB(0, 1), cB + hstep, voffB); PG8_STAGE(PG8_SA(0, 1), cA + hstep, voffA);
    if (wr == 1) PG8_BAR;
    PG8_WAIT_V(4); PG8_BAR;
    PG8_STAGE(PG8_SB(1, 0), cB + kstep, voffB); PG8_STAGE(PG8_SA(1, 0), cA + kstep, voffA); PG8_STAGE(PG8_SB(1, 1), cB + hstep + kstep, voffB);
    PG8_WAIT_V(6); PG8_BAR;
    PG8_STAMP();
    for (;;) {
        const bool has_next = S.next(ui + 1, nxt);
        const char* nA = has_next ? (const char*)g.A + (size_t)nxt.pm * tstep : cA; const char* nB = has_next ? (const char*)g.Bt + (size_t)nxt.pn * tstep : cB;
        for (int t = 0; t < nt; t += 2) {
            const bool last = (t == nt - 2);
            const char* a1 = cA + (size_t)(t + 1) * kstep;
            const char* a2 = last ? nA : cA + (size_t)(t + 2) * kstep; const char* b2 = last ? nB : cB + (size_t)(t + 2) * kstep;
            const char* a3 = a2 + kstep; const char* b3 = b2 + kstep;
            if (last && has_next) S.a_ready(nxt);
            PG8_LDB(B0, 0, 0); PG8_SCHED; PG8_LDA(At, 0, 0); PG8_STAGE(PG8_SA(1, 1), a1 + hstep, voffA);
            PG8_WAIT_L(8); PG8_BAR; PG8_WAIT_L(0); PG8_MMA(0, 0, At, B0); PG8_BAR; PG8_SCHED;
            PG8_LDB(B1, 0, 1); PG8_STAGE(PG8_SB(0, 0), b2, voffB);
            PG8_BAR; PG8_WAIT_L(0); PG8_MMA(0, 1, At, B1); PG8_BAR;
            PG8_LDA(At, 0, 1); PG8_STAGE(PG8_SA(0, 0), a2, voffA);
            PG8_BAR; PG8_WAIT_L(0); PG8_MMA(1, 0, At, B0); PG8_BAR; PG8_SCHED;
            PG8_STAGE(PG8_SB(0, 1), b2 + hstep, voffB);
            PG8_WAIT_V(6); PG8_BAR; PG8_MMA(1, 1, At, B1); PG8_BAR;
            PG8_LDB(B0, 1, 0); PG8_SCHED; PG8_LDA(At, 1, 0); PG8_STAGE(PG8_SA(0, 1), a2 + hstep, voffA);
            PG8_WAIT_L(8); PG8_BAR; PG8_WAIT_L(0); PG8_MMA(0, 0, At, B0); PG8_BAR; PG8_SCHED;
            PG8_LDB(B1, 1, 1); PG8_STAGE(PG8_SB(1, 0), b3, voffB);
            PG8_BAR; PG8_WAIT_L(0); PG8_MMA(0, 1, At, B1); PG8_BAR;
            PG8_LDA(At, 1, 1); PG8_STAGE(PG8_SA(1, 0), a3, voffA);
            PG8_BAR; PG8_WAIT_L(0); PG8_MMA(1, 0, At, B0); PG8_BAR; PG8_SCHED;
            PG8_STAGE(PG8_SB(1, 1), b3 + hstep, voffB);
            PG8_WAIT_V(6); PG8_BAR; PG8_MMA(1, 1, At, B1); PG8_BAR;
        }
        PG8_STAMP();
        if constexpr (!Epi::AFTER_DRAIN) { E(acc, cur, wr, wc, fr, fq); S.done(cur); }
        PG8_STAMP();
        if (!has_next) break;
#pragma unroll
        for (int a = 0; a < 2; ++a)
#pragma unroll
            for (int b = 0; b < 2; ++b)
#pragma unroll
                for (int m = 0; m < 4; ++m)
#pragma unroll
                    for (int n = 0; n < 2; ++n) acc[a][b][m][n] = (f32x4){0.f, 0.f, 0.f, 0.f};
        cur = nxt; cA = nA; cB = nB; ++ui;
    }
    PG8_WAIT_V(0);
    if (wr == 0) PG8_BAR;
    PG8_BAR;
    if constexpr (Epi::AFTER_DRAIN) { E.fused(acc, cur, wr, wc, fr, fq, lds, wid, lane); S.done(cur); }
    PG8_STAMP();
    if (STAMP && wid == 0) { stamps[lane] = lane < nts ? (((unsigned long long)(unsigned)ts_hi << 32) | (unsigned)ts_lo) : 0ull;
        if (lane == 62) stamps[62] = rt_entry; if (lane == 63) stamps[63] = (unsigned long long)wall_clock64(); }
#undef PG8_STAMP
#undef PG8_SA
#undef PG8_SB
#undef PG8_STAGE
#undef PG8_LDA
#undef PG8_LDB
#undef PG8_MMA
#undef PG8_WAIT_V
#undef PG8_WAIT_L
#undef PG8_BAR
#undef PG8_SCHED
}
}

typedef unsigned short bf16_t;
typedef float f32x4 __attribute__((ext_vector_type(4)));
typedef float f32x16 __attribute__((ext_vector_type(16)));
typedef short bf16x8 __attribute__((ext_vector_type(8)));
typedef unsigned u32x4 __attribute__((ext_vector_type(4)));
typedef unsigned u32x2 __attribute__((ext_vector_type(2)));
#define LAS __attribute__((address_space(3)))

constexpr int D = 1024, BP = 2, T = 16384, NTP = BP * T  , NS = 128, NT = NTP + NS  , MP = 33024  ;
constexpr int NPROJ = 7680;
constexpr int NTHREADS = 512;
constexpr int LDS_BYTES = 155648;
constexpr float LN_EPS = 1e-5f;
constexpr float DN_ALPHA = 1.189207115002721f;

constexpr size_t OFF_YP = 0;
constexpr size_t OFF_YS = OFF_YP + (size_t)NTP * D;
constexpr size_t OFF_KVP0 = OFF_YS + (size_t)NS * D;
constexpr size_t OFF_KVP1 = OFF_KVP0 + (size_t)BP * 128 * 512;
constexpr size_t OFF_KVP2 = OFF_KVP1 + (size_t)BP * 512 * 512;
constexpr size_t OFF_GLAP = OFF_KVP2 + (size_t)BP * 2048 * 512;
constexpr size_t OFF_KVS0 = OFF_GLAP + (size_t)BP * 4 * 128 * 256;
constexpr size_t OFF_KVS1 = OFF_KVS0 + (size_t)NS * 128 * 512;
constexpr size_t OFF_KVS2 = OFF_KVS1 + (size_t)NS * 512 * 512;
constexpr size_t OFF_GLAS = OFF_KVS2 + (size_t)NS * 2048 * 512;
constexpr size_t OUT_TOTAL = OFF_GLAS + (size_t)NS * 4 * 128 * 256;

struct Params {
    const float *x_prompt, *x_sample, *c_prompt, *c_sample, *cache128, *cache512, *cache2048, *state_gla;
    const float *w_ada, *b_ada, *w_in, *w_gla_up, *b_gla, *gla_norm_w, *w_br_a, *w_br_b, *w_out, *ln1_w, *ln1_b;
    const float *w_pq, *peer_k1, *peer_k2, *peer_u, *peer_v, *ln2_w, *ln2_b;
    float* out;
    unsigned* bar;
    float* MOD; bf16_t* SC; bf16_t* WADA_T; bf16_t* WIN_T; bf16_t* WBRA_T; bf16_t* WBRB_T; bf16_t* WOUT_T; bf16_t* WPQ_T;
    bf16_t* KF; unsigned char* U8; unsigned char* V8; float* SU; float* SV;
    bf16_t* H; bf16_t* QKVA; bf16_t* QKB; bf16_t* VBB; bf16_t* RB; bf16_t* GA; bf16_t* GB; float* GLR;
    bf16_t* OG; float* LSE; float* LSEG; float* DSEG; float* SSEG; bf16_t* OGLA;
    bf16_t* OA; bf16_t* OB; bf16_t* TMP1; bf16_t* MERGED; float* Z1; float* LNST; bf16_t* QV; int* EIDX; float* EGW; float* ESU; float* EW; unsigned char* H8; float* HS;
};

__device__ __forceinline__ float bf2f(bf16_t v) { return __uint_as_float(((unsigned)v) << 16); }
__device__ __forceinline__ float bflo(unsigned w) { return __uint_as_float(w << 16); }
__device__ __forceinline__ float bfhi(unsigned w) { return __uint_as_float(w & 0xffff0000u); }
typedef __bf16 v2bf_t __attribute__((ext_vector_type(2)));
typedef float v2f_t __attribute__((ext_vector_type(2)));
__device__ __forceinline__ unsigned pack2(float lo, float hi) { const v2f_t f = {lo, hi}; const v2bf_t b = __builtin_convertvector(f, v2bf_t); return __builtin_bit_cast(unsigned, b); }
__device__ __forceinline__ bf16_t f2bf(float f) { return (bf16_t)(pack2(f, 0.f) & 0xffffu); }
__device__ __forceinline__ void unpack8(const u32x4 w, float (&o)[8]) { o[0] = bflo(w.x); o[1] = bfhi(w.x); o[2] = bflo(w.y); o[3] = bfhi(w.y); o[4] = bflo(w.z); o[5] = bfhi(w.z); o[6] = bflo(w.w); o[7] = bfhi(w.w); }
__device__ __forceinline__ float wave_sum(float v) {
#pragma unroll
    for (int o = 32; o >= 1; o >>= 1) v += __shfl_xor(v, o);
    return v;
}
__device__ __forceinline__ float wave_max(float v) {
#pragma unroll
    for (int o = 32; o >= 1; o >>= 1) v = fmaxf(v, __shfl_xor(v, o));
    return v;
}
#define DPP_ROR_F(v, n) __builtin_bit_cast(float, __builtin_amdgcn_update_dpp(0, __builtin_bit_cast(int, (v)), 0x120 + (n), 0xf, 0xf, true))
__device__ __forceinline__ float dpp_row_sum(float v) {
    v += DPP_ROR_F(v, 8); v += DPP_ROR_F(v, 4); v += DPP_ROR_F(v, 2); v += DPP_ROR_F(v, 1); return v;
}
__device__ __forceinline__ float sigmoidf_(float x) { return __builtin_amdgcn_rcpf(1.0f + __expf(-x)); }
__device__ __forceinline__ float siluf_(float x) { return x * __builtin_amdgcn_rcpf(1.0f + __expf(-x)); }
#define XB_TMO      128
#define XB_XCNT(j)  (256  + 64 * (j))
#define XB_XSUB(j)  (1280 + 64 * (j))
#define XB_XGEN(j)  (2304 + 64 * (j))
#define XB_TOP      3328
#define XB_TOPGEN   3392
#define XCD_BAR_WORDS 3456
#define XB_SPIN_CAP (1u << 22)

__device__ __forceinline__ unsigned xb_ld(unsigned* p)              { return __hip_atomic_load(p, __ATOMIC_RELAXED, __HIP_MEMORY_SCOPE_AGENT); }
__device__ __forceinline__ unsigned xb_add(unsigned* p, unsigned v) { return __hip_atomic_fetch_add(p, v, __ATOMIC_RELAXED, __HIP_MEMORY_SCOPE_AGENT); }
__device__ __forceinline__ unsigned xb_xcc_id() { return (unsigned)__builtin_amdgcn_s_getreg((3 << 11) | 20) & 0xFu; }
#define XB_SPIN(cond, bar) do { unsigned _sp = 0; while (cond) { __builtin_amdgcn_s_sleep(1); \
    if ((++_sp & 255u) == 0u) { if (xb_ld(&(bar)[XB_TMO])) break; if (_sp > XB_SPIN_CAP) { atomicAdd(&(bar)[XB_TMO], 1u); break; } } } } while (0)

struct XcdBarrier {
    unsigned* bar; unsigned x;
    volatile LAS unsigned* st;
};

__device__ __forceinline__ XcdBarrier xcd_barrier_post(unsigned* bar, volatile LAS unsigned* st) {
    XcdBarrier b; b.bar = bar; b.x = xb_xcc_id(); b.st = st;
    if (threadIdx.x == 0) (void)xb_add(&bar[XB_XCNT(b.x)], 1u);
    return b;
}
__device__ __forceinline__ void xcd_barrier_complete(unsigned* bar, unsigned x, unsigned& nloc, unsigned& nx) {
    const unsigned G = gridDim.x * gridDim.y * gridDim.z;
    unsigned sum, cnt, mine, sp = 0u;
    for (;;) {
        sum = 0u; cnt = 0u; mine = 0u;
#pragma unroll
        for (unsigned j = 0; j < 16; ++j) { const unsigned c = xb_ld(&bar[XB_XCNT(j)]); sum += c; cnt += (c > 0u) ? 1u : 0u; mine = (j == x) ? c : mine; }
        if (sum == G) break;
        __builtin_amdgcn_s_sleep(1);
        if ((++sp & 255u) == 0u) { if (xb_ld(&bar[XB_TMO])) break; if (sp > XB_SPIN_CAP) { atomicAdd(&bar[XB_TMO], 1u); break; } }
    }
    nloc = mine > 0u ? mine : 1u; nx = cnt > 0u ? cnt : 1u;
}

__device__ __forceinline__ void xcd_barrier(const XcdBarrier& b) {
    asm volatile("s_waitcnt vmcnt(0)" ::: "memory");
    __syncthreads();
    if (threadIdx.x == 0) {
        unsigned* bar = b.bar;
        __builtin_amdgcn_s_waitcnt(0);
        unsigned nloc = b.st[0], nx = b.st[1];
        if (nloc == 0u) { xcd_barrier_complete(bar, b.x, nloc, nx); b.st[0] = nloc; b.st[1] = nx; }
        const unsigned old = xb_add(&bar[XB_XSUB(b.x)], 1u);
        const unsigned gen = old / nloc;
        if (old + 1u == (gen + 1u) * nloc) {
            __builtin_amdgcn_fence(__ATOMIC_RELEASE, "agent");
            asm volatile("s_waitcnt vmcnt(0)" ::: "memory");
            const unsigned og = xb_add(&bar[XB_TOP], 1u);
            const unsigned tg = og / nx;
            if (og + 1u == (tg + 1u) * nx) xb_add(&bar[XB_TOPGEN], 1u);
            else XB_SPIN(xb_ld(&bar[XB_TOPGEN]) == tg, bar);
            __builtin_amdgcn_fence(__ATOMIC_ACQUIRE, "agent");
            xb_add(&bar[XB_XGEN(b.x)], 1u);
            asm volatile("s_waitcnt vmcnt(0)" ::: "memory");
        } else {
            XB_SPIN(xb_ld(&bar[XB_XGEN(b.x)]) == gen, bar);
            __builtin_amdgcn_fence(__ATOMIC_ACQUIRE, "agent");
            asm volatile("s_waitcnt vmcnt(0)" ::: "memory");
        }
    }
    __syncthreads();
}

__device__ __forceinline__ int win_cmap(int n) {
    if (n < 5376) return n;
    if (n < 6400) return n + 16;
    if (n < 7424) return n + 16;
    if (n < 7440) return n - 7424 + 5376;
    return -1;
}
__device__ __forceinline__ void tconv_tile(const float* __restrict__ src, int ldsrc, int K, bf16_t* __restrict__ dst, int tk, int tn, bool win, LAS float* tile) {
    int tid_ = threadIdx.x; asm volatile("" : "+v"(tid_));
    const int nl = tid_ & 63, kl0 = tid_ >> 6;
    const int n = tn * 64 + nl;
    const int sc = win ? win_cmap(n) : n;
#pragma unroll
    for (int i = 0; i < 8; ++i) { const int k = kl0 + 8 * i; tile[k * 65 + nl] = sc >= 0 ? src[(size_t)(tk * 64 + k) * ldsrc + sc] : 0.f; }
    __syncthreads();
    const int n2 = tid_ >> 3, kc = (tid_ & 7) * 8;
    u32x4 w;
    w.x = pack2(tile[(kc + 0) * 65 + n2], tile[(kc + 1) * 65 + n2]);
    w.y = pack2(tile[(kc + 2) * 65 + n2], tile[(kc + 3) * 65 + n2]);
    w.z = pack2(tile[(kc + 4) * 65 + n2], tile[(kc + 5) * 65 + n2]);
    w.w = pack2(tile[(kc + 6) * 65 + n2], tile[(kc + 7) * 65 + n2]);
    *(u32x4*)(dst + (size_t)(tn * 64 + n2) * K + tk * 64 + kc) = w;
    __syncthreads();
}
__device__ __forceinline__ void conv_chunk(const float* __restrict__ src, bf16_t* __restrict__ dst, size_t chunk) {
    int tid_ = threadIdx.x; asm volatile("" : "+v"(tid_));
    const size_t e = chunk * 4096 + (size_t)tid_ * 8;
    const f32x4 a = *(const f32x4*)(src + e), b = *(const f32x4*)(src + e + 4);
    u32x4 w; w.x = pack2(a[0], a[1]); w.y = pack2(a[2], a[3]); w.z = pack2(b[0], b[1]); w.w = pack2(b[2], b[3]);
    *(u32x4*)(dst + e) = w;
}

__device__ __forceinline__ void quant_rows8(const float* __restrict__ src, unsigned char* __restrict__ dst  , float* __restrict__ scl, int job) {
    int tid_ = threadIdx.x; asm volatile("" : "+v"(tid_));
    const int wave = tid_ >> 6, lane = tid_ & 63;
    const size_t row = (size_t)job * 8 + wave;
    const float* r = src + row * 1024 + 16 * lane;
    f32x4 x[4];
#pragma unroll
    for (int i = 0; i < 4; ++i) x[i] = *(const f32x4*)(r + 4 * i);
    float m = 0.f;
#pragma unroll
    for (int i = 0; i < 4; ++i) m = fmaxf(m, fmaxf(fmaxf(fabsf(x[i][0]), fabsf(x[i][1])), fmaxf(fabsf(x[i][2]), fabsf(x[i][3]))));
    m = wave_max(m);
    const float inv = m > 0.f ? 448.0f / m : 1.0f, sc = m > 0.f ? m * (1.0f / 448.0f) : 1.0f;
    u32x4 w;
#pragma unroll
    for (int i = 0; i < 4; ++i) {
        int d = 0;
        d = __builtin_amdgcn_cvt_pk_fp8_f32(x[i][0] * inv, x[i][1] * inv, d, false);
        d = __builtin_amdgcn_cvt_pk_fp8_f32(x[i][2] * inv, x[i][3] * inv, d, true);
        w[i] = (unsigned)d;
    }
    *(u32x4*)(dst + row * 2048 + 16 * lane) = w;
    if (lane == 0) scl[row] = sc;
}

__device__ __forceinline__ void kfrag_chunk(const float* __restrict__ k1, const float* __restrict__ k2, bf16_t* __restrict__ dst, int job) {
    int tid_ = threadIdx.x; asm volatile("" : "+v"(tid_));
    const int c = job * 512 + tid_, lane = c & 63, ks = (c >> 6) & 7, ni = (c >> 9) & 3, half = (c >> 11) & 1, h = c >> 12;
    const float* s = (half ? k2 : k1) + ((size_t)h * 128 + 32 * ni + (lane & 31)) * 128 + 16 * ks + 8 * (lane >> 5);
    const f32x4 a = *(const f32x4*)s, b = *(const f32x4*)(s + 4);
    u32x4 w; w.x = pack2(a[0], a[1]); w.y = pack2(a[2], a[3]); w.z = pack2(b[0], b[1]); w.w = pack2(b[2], b[3]);
    *(u32x4*)(dst + (size_t)c * 8) = w;
}
template <int STAGE> __device__ __forceinline__ void phase_prologue(const Params& p, int bid, int nb, LAS unsigned char* lds, int skip0) {
    int tid_ = threadIdx.x; asm volatile("" : "+v"(tid_));
    LAS float* tile = (LAS float*)lds;
    constexpr int J0 = 16 * 120, J1 = J0 + 16 * 96, J2 = J1 + 16 * 32, J3 = J2 + 256, J4 = J3 + 256, J5 = J4 + 64, J6 = J5 + 2048, J7 = J6 + 2048, J8 = J7 + 32, J9 = J8 + 32, J10 = J9 + 64;
    (void)J8;
    const int njobs = STAGE == 0 ? J1 + (J10 - J9) : J9 - J1;
    const int first = STAGE == 0 ? bid : bid - skip0, stride = STAGE == 0 ? nb : nb - skip0;
    if (first < 0 || stride <= 0) return;
    for (int jj = first; jj < njobs; jj += stride) {
        const int j = STAGE == 0 ? (jj < J1 ? jj : J9 + (jj - J1)) : J1 + jj;
        if (j < J0) { tconv_tile(p.w_in, 7440, 1024, p.WIN_T, j % 16, j / 16, true, tile); }
        else if (j < J1) { const int q = j - J0; tconv_tile(p.w_ada, 6144, 1024, p.WADA_T, q % 16, q / 16, false, tile); }
        else if (j < J2) { const int q = j - J1; tconv_tile(p.w_pq, 2048, 1024, p.WPQ_T, q % 16, q / 16, false, tile); }
        else if (j < J3) { const int q = j - J2; tconv_tile(p.w_br_b, 1024, 1024, p.WBRB_T, q % 16, q / 16, false, tile); }
        else if (j < J4) { const int q = j - J3; tconv_tile(p.w_out, 1024, 1024, p.WOUT_T, q % 16, q / 16, false, tile); }
        else if (j < J5) { const int q = j - J4; tconv_tile(p.w_br_a, 1024, 256, p.WBRA_T, q % 4, q / 4, false, tile); }
        else if (j < J6) { quant_rows8(p.peer_u, p.U8, p.SU, j - J5); }
        else if (j < J7) { quant_rows8(p.peer_v, p.U8 + 1024, p.SV, j - J6); }
        else if (j < J9) { kfrag_chunk(p.peer_k1, p.peer_k2, p.KF, j - J7); }
        else {
            const size_t e = (size_t)(j - J9) * 4096 + (size_t)tid_ * 8;
            const int row = (int)(e >> 10), col = (int)(e & 1023);
            float v[8];
#pragma unroll
            for (int i = 0; i < 8; ++i) v[i] = 0.f;
            if (row < 130) {
                const float* c = row < 2 ? p.c_prompt + (size_t)row * 1024 + col : p.c_sample + (size_t)(row - 2) * 1024 + col;
#pragma unroll
                for (int i = 0; i < 8; ++i) v[i] = siluf_(c[i]);
            }
            u32x4 w; w.x = pack2(v[0], v[1]); w.y = pack2(v[2], v[3]); w.z = pack2(v[4], v[5]); w.w = pack2(v[6], v[7]);
            *(u32x4*)(p.SC + e) = w;
        }
    }
}

__device__ __forceinline__ void row_stats(const float (&v)[16], float& mean, float& rstd) {
    float s = 0.f;
#pragma unroll
    for (int i = 0; i < 16; ++i) s += v[i];
    s = wave_sum(s);
    mean = s * (1.0f / 1024.0f);
    float q = 0.f;
#pragma unroll
    for (int i = 0; i < 16; ++i) { const float d = v[i] - mean; q += d * d; }
    q = wave_sum(q);
    rstd = rsqrtf(q * (1.0f / 1024.0f) + LN_EPS);
}
__device__ __forceinline__ void load_row16(const float* __restrict__ r, int lane, float (&v)[16]) {
    const f32x4 a = *(const f32x4*)(r + 8 * lane), b = *(const f32x4*)(r + 8 * lane + 4), c = *(const f32x4*)(r + 512 + 8 * lane), d = *(const f32x4*)(r + 512 + 8 * lane + 4);
#pragma unroll
    for (int i = 0; i < 4; ++i) { v[i] = a[i]; v[4 + i] = b[i]; v[8 + i] = c[i]; v[12 + i] = d[i]; }
}
__device__ __forceinline__ void store_row16_bf16(bf16_t* __restrict__ r, int lane, const float (&v)[16]) {
    u32x4 w0, w1;
    w0.x = pack2(v[0], v[1]); w0.y = pack2(v[2], v[3]); w0.z = pack2(v[4], v[5]); w0.w = pack2(v[6], v[7]);
    w1.x = pack2(v[8], v[9]); w1.y = pack2(v[10], v[11]); w1.z = pack2(v[12], v[13]); w1.w = pack2(v[14], v[15]);
    *(u32x4*)(r + 8 * lane) = w0; *(u32x4*)(r + 512 + 8 * lane) = w1;
}
__device__ __forceinline__ void store_row16_f32(float* __restrict__ r, int lane, const float (&v)[16]) {
    *(f32x4*)(r + 8 * lane) = (f32x4){v[0], v[1], v[2], v[3]}; *(f32x4*)(r + 8 * lane + 4) = (f32x4){v[4], v[5], v[6], v[7]};
    *(f32x4*)(r + 512 + 8 * lane) = (f32x4){v[8], v[9], v[10], v[11]}; *(f32x4*)(r + 512 + 8 * lane + 4) = (f32x4){v[12], v[13], v[14], v[15]};
}
__device__ __forceinline__ const float* x_row(const Params& p, int row) { return row < NTP ? p.x_prompt + (size_t)row * D : p.x_sample + (size_t)(row - NTP) * D; }
__device__ __forceinline__ int seq_of(int row) { return row < NTP ? (row >> 14) : 2 + (row - NTP); }

__device__ __forceinline__ void phase_lnmod1(const Params& p, int bid, int nb) {
    int tid_ = threadIdx.x; asm volatile("" : "+v"(tid_));
    const int wave = tid_ >> 6, lane = tid_ & 63;
    int row = bid * 8 + wave;
    float nx[16];
    if (row < NT) load_row16(x_row(p, row), lane, nx);
    for (; row < NT; row += nb * 8) {
        float v[16];
#pragma unroll
        for (int i = 0; i < 16; ++i) v[i] = nx[i];
        const int nrow = row + nb * 8;
        if (nrow < NT) load_row16(x_row(p, nrow), lane, nx);
        const float* mod = p.MOD + (size_t)seq_of(row) * 6144;
        float sh[16], sc[16];
        load_row16(mod, lane, sh); load_row16(mod + 1024, lane, sc);
        float mean, rstd; row_stats(v, mean, rstd);
#pragma unroll
        for (int i = 0; i < 16; ++i) v[i] = (v[i] - mean) * rstd * (1.0f + sc[i]) + sh[i];
        store_row16_bf16(p.H + (size_t)row * D, lane, v);
    }
}

struct EpiProj {
    static constexpr bool PERM = true, AFTER_DRAIN = false;
    bf16_t *QKVA, *QKB, *VBB, *RB, *GA, *GB; float* GLR; float* out;
    __device__ __forceinline__ void operator()(const pg8::f32x4 (&acc)[2][2][4][2], const pg8::Unit& u, int wr, int wc, int fr, int fq) const {
        const int pn = u.pn;
        bf16_t* dst; int ld = 1024, c0; float scale = 1.0f;
        if (pn < 9) { dst = QKVA; ld = 2304; c0 = pn * 256; }
        else if (pn < 13) { dst = QKB; c0 = (pn - 9) * 256; if (pn < 11) scale = 0.08838834764831845f; }
        else if (pn < 17) { dst = VBB; c0 = (pn - 13) * 256; }
        else if (pn < 21) { dst = RB; c0 = (pn - 17) * 256; }
        else if (pn < 25) { dst = GA; c0 = (pn - 21) * 256; }
        else if (pn < 29) { dst = GB; c0 = (pn - 25) * 256; }
        else { dst = nullptr; c0 = 0; }
        const bool kvt = pn >= 3 && pn < 9;
        const int g = kvt ? (pn - 3) % 3 : 0, kv = kvt ? (pn - 3) / 3 : 0;
        const int W = 128 << (2 * g);
        const size_t offp = g == 0 ? OFF_KVP0 : (g == 1 ? OFF_KVP1 : OFF_KVP2);
        const size_t offs = g == 0 ? OFF_KVS0 : (g == 1 ? OFF_KVS1 : OFF_KVS2);
        const int row0 = u.pm * 256 + wr * 64 + fr, colw = wc * 32 + 8 * fq;
#pragma unroll
        for (int ai = 0; ai < 2; ++ai)
#pragma unroll
            for (int m = 0; m < 4; ++m) {
                const int row = row0 + ai * 128 + m * 16;
#pragma unroll
                for (int bj = 0; bj < 2; ++bj) {
                    const int cc = bj * 128 + colw;
                    const pg8::f32x4 v0 = acc[ai][bj][m][0], v1 = acc[ai][bj][m][1];
                    if (dst) {
                        u32x4 w; w.x = pack2(v0[0] * scale, v0[1] * scale); w.y = pack2(v0[2] * scale, v0[3] * scale); w.z = pack2(v1[0] * scale, v1[1] * scale); w.w = pack2(v1[2] * scale, v1[3] * scale);
                        *(u32x4*)(dst + (size_t)row * ld + c0 + cc) = w;
                    } else if (cc < 16) {
                        *(pg8::f32x4*)(GLR + (size_t)row * 16 + cc) = v0; *(pg8::f32x4*)(GLR + (size_t)row * 16 + cc + 4) = v1;
                    }
                    if (kvt) {
                        if (row < NTP) {
                            const int b = row >> 14, t = row & (T - 1);
                            if (t >= T - W) { float* o = out + offp + ((size_t)(b * W + (t - (T - W))) * 2 + kv) * 256 + cc; *(pg8::f32x4*)o = v0; *(pg8::f32x4*)(o + 4) = v1; }
                        } else if (row < NT) {
                            const int s = row - NTP;
                            float* o = out + offs + ((size_t)(s * W + (W - 1)) * 2 + kv) * 256 + cc; *(pg8::f32x4*)o = v0; *(pg8::f32x4*)(o + 4) = v1;
                        }
                    }
                }
            }
    }
    __device__ __forceinline__ void emit16(int row, int col, const float (&v)[16]) const {
        const int pn = col >> 8, cc = col & 255;
        bf16_t* dst; int ld = 1024, c0; float scale = 1.0f;
        if (pn < 9) { dst = QKVA; ld = 2304; c0 = pn * 256; }
        else if (pn < 13) { dst = QKB; c0 = (pn - 9) * 256; if (pn < 11) scale = 0.08838834764831845f; }
        else if (pn < 17) { dst = VBB; c0 = (pn - 13) * 256; }
        else if (pn < 21) { dst = RB; c0 = (pn - 17) * 256; }
        else if (pn < 25) { dst = GA; c0 = (pn - 21) * 256; }
        else if (pn < 29) { dst = GB; c0 = (pn - 25) * 256; }
        else { dst = nullptr; c0 = 0; }
        if (dst) {
            u32x4 w0, w1;
            w0.x = pack2(v[0] * scale, v[1] * scale); w0.y = pack2(v[2] * scale, v[3] * scale); w0.z = pack2(v[4] * scale, v[5] * scale); w0.w = pack2(v[6] * scale, v[7] * scale);
            w1.x = pack2(v[8] * scale, v[9] * scale); w1.y = pack2(v[10] * scale, v[11] * scale); w1.z = pack2(v[12] * scale, v[13] * scale); w1.w = pack2(v[14] * scale, v[15] * scale);
            *(u32x4*)(dst + (size_t)row * ld + c0 + cc) = w0; *(u32x4*)(dst + (size_t)row * ld + c0 + cc + 8) = w1;
        } else if (cc == 0) {
#pragma unroll
            for (int i = 0; i < 4; ++i) *(f32x4*)(GLR + (size_t)row * 16 + 4 * i) = (f32x4){v[4 * i], v[4 * i + 1], v[4 * i + 2], v[4 * i + 3]};
        }
        if (pn >= 3 && pn < 9 && row >= NTP && row < NT) {
            const int g = (pn - 3) % 3, kv = (pn - 3) / 3, W = 128 << (2 * g), s = row - NTP;
            float* o = out + (g == 0 ? OFF_KVS0 : (g == 1 ? OFF_KVS1 : OFF_KVS2)) + ((size_t)(s * W + (W - 1)) * 2 + kv) * 256 + cc;
#pragma unroll
            for (int i = 0; i < 4; ++i) *(f32x4*)(o + 4 * i) = (f32x4){v[4 * i], v[4 * i + 1], v[4 * i + 2], v[4 * i + 3]};
        }
    }
};

__device__ __forceinline__ void phase_cache_copy(const Params& p, int bid, int nb) {
    int tid_ = threadIdx.x; asm volatile("" : "+v"(tid_));
    const size_t tid = (size_t)bid * NTHREADS + tid_, nth = (size_t)nb * NTHREADS;
#pragma unroll
    for (int g = 0; g < 3; ++g) {
        const int W = 128 << (2 * g);
        const float* src = g == 0 ? p.cache128 : (g == 1 ? p.cache512 : p.cache2048);
        float* dst = p.out + (g == 0 ? OFF_KVS0 : (g == 1 ? OFF_KVS1 : OFF_KVS2));
        const size_t per = (size_t)(W - 1) * 128, total = per * NS;
        for (size_t i = tid; i < total; i += nth) {
            const size_t s = i / per, rem = i - s * per;
            const f32x4 v = __builtin_nontemporal_load((const f32x4*)(src + (s * W + 1) * 512) + rem);
            __builtin_nontemporal_store(v, (f32x4*)(dst + s * W * 512) + rem);
        }
    }
}

__device__ __forceinline__ f32x16 mfma32(bf16x8 a, bf16x8 b, f32x16 c) { return __builtin_amdgcn_mfma_f32_32x32x16_bf16(a, b, c, 0, 0, 0); }
__device__ __forceinline__ f32x16 zero16() { f32x16 z; for (int i = 0; i < 16; ++i) z[i] = 0.f; return z; }
__device__ __forceinline__ bf16x8 ld_frag_g(const bf16_t* p) { return *(const bf16x8*)p; }
__device__ __forceinline__ bf16x8 ld_frag_l(const LAS bf16_t* p) { return *(const LAS bf16x8*)p; }
__device__ __forceinline__ int crow(int reg, int hh) { return (reg & 3) + 8 * (reg >> 2) + 4 * hh; }
__device__ __forceinline__ float log_sigmoidf_(float z) { return fminf(z, 0.f) - log1pf(__expf(-fabsf(z))); }

__device__ __forceinline__ void phase_gla_sample(const Params& p, int bid, int nb, LAS unsigned char* lds) {
    int tid_ = threadIdx.x; asm volatile("" : "+v"(tid_));
    LAS float* s_eg = (LAS float*)lds;
    LAS float* s_q = s_eg + 128;
    LAS float* s_k = s_q + 128;
    LAS float* s_o = s_k + 128;
    const int dv4 = tid_ & 63, kg = tid_ >> 6;
    for (int u = bid; u < NS * 4; u += nb) {
        const int s = u >> 2, h = u & 3;
        const size_t row = (size_t)(NTP + s);
        const float* S0 = p.state_gla + ((size_t)s * 4 + h) * 32768 + (size_t)(16 * kg) * 256 + 4 * dv4;
        float* Sn = p.out + OFF_GLAS + ((size_t)s * 4 + h) * 32768 + (size_t)(16 * kg) * 256 + 4 * dv4;
        f32x4 st[16];
#pragma unroll
        for (int i = 0; i < 16; ++i) st[i] = __builtin_nontemporal_load((const f32x4*)(S0 + i * 256));
        if (tid_ < 128) {
            const int kd = tid_; float z = p.b_gla[h * 128 + kd];
#pragma unroll
            for (int j = 0; j < 16; ++j) z += p.GLR[row * 16 + j] * p.w_gla_up[j * 512 + h * 128 + kd];
            s_eg[kd] = __expf(log_sigmoidf_(z) * (1.0f / 16.0f));
            s_q[kd] = bf2f(p.QKB[row * 1024 + h * 128 + kd]);
            s_k[kd] = bf2f(p.QKB[row * 1024 + 512 + h * 128 + kd]);
        }
        const u32x2 vw = *(const u32x2*)(p.VBB + row * 1024 + h * 256 + 4 * dv4);
        const f32x4 v4 = {bflo(vw.x), bfhi(vw.x), bflo(vw.y), bfhi(vw.y)};
        __syncthreads();
        f32x4 o = {0.f, 0.f, 0.f, 0.f};
#pragma unroll
        for (int i = 0; i < 16; ++i) {
            const int kd = 16 * kg + i;
            const f32x4 sv = st[i] * s_eg[kd] + v4 * s_k[kd];
            __builtin_nontemporal_store(sv, (f32x4*)(Sn + i * 256));
            o += sv * s_q[kd];
        }
        *(LAS f32x4*)(s_o + kg * 256 + 4 * dv4) = o;
        __syncthreads();
        float t = 0.f;
        if (tid_ < 256) {
#pragma unroll
            for (int w = 0; w < 8; ++w) t += s_o[w * 256 + tid_];
        }
        const float sq = wave_sum(t * t);
        __syncthreads();
        if ((tid_ & 63) == 0) s_o[tid_ >> 6] = sq;
        __syncthreads();
        if (tid_ < 256) {
            const float rn = rsqrtf((s_o[0] + s_o[1] + s_o[2] + s_o[3]) * (1.0f / 256.0f) + LN_EPS);
            p.OB[row * 1024 + h * 256 + tid_] = f2bf(t * rn * p.gla_norm_w[h * 256 + tid_] * siluf_(bf2f(p.RB[row * 1024 + h * 256 + tid_])));
        }
        __syncthreads();
    }
}

constexpr int G2_QP = 136;
constexpr int G2_TP = 72;
constexpr int G2_VP = 264;
typedef short v4s2_t __attribute__((ext_vector_type(4)));
constexpr int G2_BP = 132;
struct Gla2Lds {
    LAS float* glr; LAS float* tot; LAS float* dl; LAS float* bl; LAS float* bt; LAS bf16_t* qe; LAS bf16_t* ke; LAS bf16_t* kdt; LAS bf16_t* vt; LAS bf16_t* pp; LAS float* ss;
    __device__ __forceinline__ void carve(LAS unsigned char* lds) {
        glr = (LAS float*)lds; tot = glr + 1024; dl = tot + 512; bl = dl + 128; bt = bl + 128;
        qe = (LAS bf16_t*)(bt + 64 * G2_BP); ke = qe + 64 * G2_QP; kdt = ke + 64 * G2_QP; vt = kdt + 64 * G2_QP; pp = vt + 64 * G2_VP; ss = (LAS float*)(pp + 64 * G2_TP);
    }
};
struct Gla2Regs { f32x4 glr; u32x4 v[4], k[2], q[2]; };
__device__ __forceinline__ void gla2_load_chunk(const Params& p, Gla2Regs& R, int tid_, int b, int h, int c, bool need_qk) {
    const size_t row0 = (size_t)b * T + (size_t)c * 64;
    R.glr = *(const f32x4*)(p.GLR + row0 * 16 + (tid_ & 255) * 4);
#pragma unroll
    for (int i = 0; i < 4; ++i) { const int q = tid_ + 512 * i, t = q >> 5, dc = q & 31; R.v[i] = *(const u32x4*)(p.VBB + (row0 + t) * 1024 + h * 256 + dc * 8); }
#pragma unroll
    for (int i = 0; i < 2; ++i) { const int it = tid_ + 512 * i, t = it >> 4, kg = it & 15;
        R.k[i] = *(const u32x4*)(p.QKB + (row0 + t) * 1024 + 512 + h * 128 + kg * 8);
        if (need_qk) R.q[i] = *(const u32x4*)(p.QKB + (row0 + t) * 1024 + h * 128 + kg * 8); }
}
__device__ __forceinline__ float gla2_stage_chunk(const Gla2Lds& L, const Gla2Regs& R, int tid_, const float (&wup)[16], float bg, bool need_qk) {
    const int kd = tid_ >> 2, q4 = tid_ & 3;
    if (tid_ < 256) *(LAS f32x4*)(L.glr + tid_ * 4) = R.glr;
#pragma unroll
    for (int i = 0; i < 4; ++i) { const int q = tid_ + 512 * i, t = q >> 5, dc = q & 31; *(LAS u32x4*)(L.vt + t * G2_VP + dc * 8) = R.v[i]; }
    __syncthreads();
    float pre[16]; float run = 0.f;
#pragma unroll
    for (int i = 0; i < 16; ++i) {
        const int t = q4 * 16 + i; float z = bg;
#pragma unroll
        for (int j4 = 0; j4 < 4; ++j4) { const f32x4 gq = *(const LAS f32x4*)(L.glr + t * 16 + 4 * j4); z += gq[0] * wup[4 * j4] + gq[1] * wup[4 * j4 + 1] + gq[2] * wup[4 * j4 + 2] + gq[3] * wup[4 * j4 + 3]; }
        const float ls = fminf(z, 0.f) - __logf(1.0f + __expf(-fabsf(z)));
        run += ls * (1.0f / 16.0f); pre[i] = run;
    }
    const float t0 = __builtin_bit_cast(float, __builtin_amdgcn_update_dpp(0, __builtin_bit_cast(int, run), 0x00, 0xf, 0xf, true));
    const float t1 = __builtin_bit_cast(float, __builtin_amdgcn_update_dpp(0, __builtin_bit_cast(int, run), 0x55, 0xf, 0xf, true));
    const float t2 = __builtin_bit_cast(float, __builtin_amdgcn_update_dpp(0, __builtin_bit_cast(int, run), 0xaa, 0xf, 0xf, true));
    const float t3 = __builtin_bit_cast(float, __builtin_amdgcn_update_dpp(0, __builtin_bit_cast(int, run), 0xff, 0xf, 0xf, true));
    const float offs = (q4 > 0 ? t0 : 0.f) + (q4 > 1 ? t1 : 0.f) + (q4 > 2 ? t2 : 0.f), blast = (t0 + t1) + (t2 + t3);
#pragma unroll
    for (int i = 0; i < 16; ++i) L.bt[(q4 * 16 + i) * G2_BP + kd] = offs + pre[i];
    const float edl = __expf(blast);
    if (q4 == 0) { L.dl[kd] = edl; L.bl[kd] = blast; }
    __syncthreads();
#pragma unroll
    for (int i = 0; i < 2; ++i) {
        const int it = tid_ + 512 * i, t = it >> 4, kg = it & 15;
        const f32x4 b0 = *(const LAS f32x4*)(L.bt + t * G2_BP + 8 * kg), b1 = *(const LAS f32x4*)(L.bt + t * G2_BP + 8 * kg + 4);
        const f32x4 l0 = *(const LAS f32x4*)(L.bl + 8 * kg), l1 = *(const LAS f32x4*)(L.bl + 8 * kg + 4);
        const float bv[8] = {b0[0], b0[1], b0[2], b0[3], b1[0], b1[1], b1[2], b1[3]}, lv[8] = {l0[0], l0[1], l0[2], l0[3], l1[0], l1[1], l1[2], l1[3]};
        float k8[8]; unpack8(R.k[i], k8);
        { float kd8[8];
#pragma unroll
          for (int e = 0; e < 8; ++e) kd8[e] = k8[e] * __expf(lv[e] - bv[e]);
          u32x4 wd; wd.x = pack2(kd8[0], kd8[1]); wd.y = pack2(kd8[2], kd8[3]); wd.z = pack2(kd8[4], kd8[5]); wd.w = pack2(kd8[6], kd8[7]);
          *(LAS u32x4*)(L.kdt + t * G2_QP + 8 * kg) = wd; }
        if (need_qk) {
            float q8[8], qo[8], ko[8]; unpack8(R.q[i], q8);
#pragma unroll
            for (int e = 0; e < 8; ++e) { const float eb = __expf(bv[e]); qo[e] = q8[e] * eb; ko[e] = k8[e] * __builtin_amdgcn_rcpf(eb); }
            u32x4 wq, wk;
            wq.x = pack2(qo[0], qo[1]); wq.y = pack2(qo[2], qo[3]); wq.z = pack2(qo[4], qo[5]); wq.w = pack2(qo[6], qo[7]);
            wk.x = pack2(ko[0], ko[1]); wk.y = pack2(ko[2], ko[3]); wk.z = pack2(ko[4], ko[5]); wk.w = pack2(ko[6], ko[7]);
            *(LAS u32x4*)(L.qe + t * G2_QP + 8 * kg) = wq; *(LAS u32x4*)(L.ke + t * G2_QP + 8 * kg) = wk;
        }
    }
    __syncthreads();
    return edl;
}
__device__ __forceinline__ bf16x8 ld_frag_tr(const LAS bf16_t* img, int pitch, int row0, int col0, int lane) {
    const int i16 = lane & 15, hh = lane >> 5;
    const LAS bf16_t* ap = img + (row0 + 8 * hh + (i16 >> 2)) * pitch + col0 + 16 * ((lane >> 4) & 1) + 4 * (i16 & 3);
    union { bf16x8 v; v4s2_t h2[2]; } f;
    f.h2[0] = __builtin_amdgcn_ds_read_tr16_b64_v4i16((LAS v4s2_t*)ap);
    f.h2[1] = __builtin_amdgcn_ds_read_tr16_b64_v4i16((LAS v4s2_t*)(ap + 4 * pitch));
    return f.v;
}
__device__ __forceinline__ void gla2_update_state(const Gla2Lds& L, f32x16 (&S)[4], int wave, int lane) {
    const int hh = lane >> 5;
    bf16x8 vf[4];
#pragma unroll
    for (int ks = 0; ks < 4; ++ks) vf[ks] = ld_frag_tr(L.vt, G2_VP, 16 * ks, 32 * wave, lane);
#pragma unroll
    for (int mi = 0; mi < 4; ++mi) {
#pragma unroll
        for (int g4 = 0; g4 < 4; ++g4) {
            const f32x4 d = *(const LAS f32x4*)(L.dl + 32 * mi + 8 * g4 + 4 * hh);
#pragma unroll
            for (int j = 0; j < 4; ++j) S[mi][4 * g4 + j] *= d[j];
        }
#pragma unroll
        for (int ks = 0; ks < 4; ++ks) S[mi] = mfma32(ld_frag_tr(L.kdt, G2_QP, 16 * ks, 32 * mi, lane), vf[ks], S[mi]);
    }
}
__device__ __forceinline__ void phase_gla2_passA(const Params& p, int bid, int nb, LAS unsigned char* lds) {
    int tid_ = threadIdx.x; asm volatile("" : "+v"(tid_));
    Gla2Lds L; L.carve(lds);
    const int wave = tid_ >> 6, lane = tid_ & 63;
    for (int u = bid; u < 256; u += nb) {
        const int bh = u >> 5, seg = u & 31, b = bh >> 2, h = bh & 3;
        float wup[16];
#pragma unroll
        for (int j = 0; j < 16; ++j) wup[j] = p.w_gla_up[j * 512 + h * 128 + (tid_ >> 2)];
        const float bg = p.b_gla[h * 128 + (tid_ >> 2)];
        f32x16 S[4];
#pragma unroll
        for (int mi = 0; mi < 4; ++mi) S[mi] = zero16();
        float dprod = 1.0f;
        Gla2Regs R; gla2_load_chunk(p, R, tid_, b, h, seg * 8, false);
        for (int cc = 0; cc < 8; ++cc) {
            int tq = tid_; asm volatile("" : "+v"(tq));
            dprod *= gla2_stage_chunk(L, R, tq, wup, bg, false);
            if (cc < 7) gla2_load_chunk(p, R, tq, b, h, seg * 8 + cc + 1, false);
            gla2_update_state(L, S, wave, tq & 63);
            __syncthreads();
        }
        float* dst = p.LSEG + (size_t)u * 32768 + (size_t)wave * 4096 + lane;
#pragma unroll
        for (int mi = 0; mi < 4; ++mi)
#pragma unroll
            for (int reg = 0; reg < 16; ++reg) dst[(mi * 16 + reg) * 64] = S[mi][reg];
        if ((tid_ & 3) == 0) p.DSEG[(size_t)u * 128 + (tid_ >> 2)] = dprod;
    }
}
__device__ __forceinline__ void phase_gla2_scan(const Params& p, int bid, int nb) {
    int tid_ = threadIdx.x; asm volatile("" : "+v"(tid_));
    for (int e = bid * NTHREADS + tid_; e < 8 * 32768; e += nb * NTHREADS) {
        const int bh = e >> 15, idx = e & 32767, w = idx >> 12, rem = idx & 4095, mr = rem >> 6, ln = rem & 63, mi = mr >> 4, reg = mr & 15;
        const int kd = 32 * mi + crow(reg, ln >> 5), dv = 32 * w + (ln & 31);
        float S = 0.f;
        for (int s0 = 0; s0 < 32; s0 += 8) {
            float l[8], d[8];
#pragma unroll
            for (int i = 0; i < 8; ++i) { const size_t u = (size_t)bh * 32 + s0 + i; l[i] = p.LSEG[u * 32768 + idx]; d[i] = p.DSEG[u * 128 + kd]; }
#pragma unroll
            for (int i = 0; i < 8; ++i) { const size_t u = (size_t)bh * 32 + s0 + i; p.SSEG[u * 32768 + idx] = S; S = d[i] * S + l[i]; }
        }
        p.out[OFF_GLAP + ((size_t)bh * 128 + kd) * 256 + dv] = S;
    }
}
__device__ __forceinline__ void phase_gla2_passC(const Params& p, int bid, int nb, LAS unsigned char* lds) {
    int tid_ = threadIdx.x; asm volatile("" : "+v"(tid_));
    Gla2Lds L; L.carve(lds);
    const int wave = tid_ >> 6, lane = tid_ & 63;
    for (int u = bid; u < 256; u += nb) {
        const int bh = u >> 5, seg = u & 31, b = bh >> 2, h = bh & 3;
        float wup[16];
#pragma unroll
        for (int j = 0; j < 16; ++j) wup[j] = p.w_gla_up[j * 512 + h * 128 + (tid_ >> 2)];
        const float bg = p.b_gla[h * 128 + (tid_ >> 2)];
        Gla2Regs R; gla2_load_chunk(p, R, tid_, b, h, seg * 8, true);
        f32x16 S[4];
        {
            const float* src = p.SSEG + (size_t)u * 32768 + (size_t)wave * 4096 + lane;
#pragma unroll
            for (int mi = 0; mi < 4; ++mi)
#pragma unroll
                for (int reg = 0; reg < 16; ++reg) S[mi][reg] = src[(mi * 16 + reg) * 64];
        }
        for (int cc = 0; cc < 8; ++cc) {
            const int c = seg * 8 + cc, row0 = b * T + c * 64;
            int tq = tid_; asm volatile("" : "+v"(tq));
            const int r = tq & 31, hh = (tq >> 5) & 1;
            gla2_stage_chunk(L, R, tq, wup, bg, true);
            if (cc < 7) gla2_load_chunk(p, R, tq, b, h, c + 1, true);
            if (wave < 4) {
                const int mi = wave >> 1, ni = wave & 1;
                f32x16 acc = zero16();
#pragma unroll
                for (int ks = 0; ks < 8; ++ks) acc = mfma32(ld_frag_l(L.ke + (32 * ni + r) * G2_QP + 16 * ks + 8 * hh), ld_frag_l(L.qe + (32 * mi + r) * G2_QP + 16 * ks + 8 * hh), acc);
                const int t = 32 * mi + r;
#pragma unroll
                for (int rg = 0; rg < 4; ++rg) {
                    const int s0 = 32 * ni + 8 * rg + 4 * hh;
                    u32x2 w;
                    w.x = pack2(s0 + 0 <= t ? acc[4 * rg + 0] : 0.f, s0 + 1 <= t ? acc[4 * rg + 1] : 0.f);
                    w.y = pack2(s0 + 2 <= t ? acc[4 * rg + 2] : 0.f, s0 + 3 <= t ? acc[4 * rg + 3] : 0.f);
                    *(LAS u32x2*)(L.pp + t * G2_TP + s0) = w;
                }
            }
            union { bf16x8 v; unsigned w[4]; } sb[4][2];
#pragma unroll
            for (int mi = 0; mi < 4; ++mi)
#pragma unroll
                for (int s2 = 0; s2 < 2; ++s2)
#pragma unroll
                    for (int e = 0; e < 4; ++e) sb[mi][s2].w[e] = pack2(S[mi][8 * s2 + 2 * e], S[mi][8 * s2 + 2 * e + 1]);
            __syncthreads();
            f32x16 oacc[2];
#pragma unroll
            for (int tt = 0; tt < 2; ++tt) {
                f32x16 acc = zero16();
#pragma unroll
                for (int ks = 0; ks < 4; ++ks) acc = mfma32(ld_frag_tr(L.vt, G2_VP, 16 * ks, 32 * wave, tq & 63), ld_frag_l(L.pp + (32 * tt + r) * G2_TP + 16 * ks + 8 * hh), acc);
#pragma unroll
                for (int mi = 0; mi < 4; ++mi)
#pragma unroll
                    for (int s2 = 0; s2 < 2; ++s2) {
                        union { bf16x8 v; u32x2 h2[2]; } qa;
                        const LAS bf16_t* qp = L.qe + (32 * tt + r) * G2_QP + 32 * mi + 16 * s2 + 4 * hh;
                        qa.h2[0] = *(const LAS u32x2*)qp; qa.h2[1] = *(const LAS u32x2*)(qp + 8);
                        acc = mfma32(sb[mi][s2].v, qa.v, acc);
                    }
                float sq = 0.f;
#pragma unroll
                for (int i = 0; i < 16; ++i) sq += acc[i] * acc[i];
                sq += __shfl_xor(sq, 32);
                if (hh == 0) L.ss[wave * 64 + 32 * tt + r] = sq;
                oacc[tt] = acc;
            }
            gla2_update_state(L, S, wave, tq & 63);
            __syncthreads();
#pragma unroll
            for (int tt = 0; tt < 2; ++tt) {
                float tot = 0.f;
#pragma unroll
                for (int w = 0; w < 8; ++w) tot += L.ss[w * 64 + 32 * tt + r];
                const float rn = rsqrtf(tot * (1.0f / 256.0f) + LN_EPS);
                const size_t ro = (size_t)(row0 + 32 * tt + r) * 1024 + h * 256 + 32 * wave + 4 * hh;
                const float* gw = p.gla_norm_w + h * 256 + 32 * wave + 4 * hh;
#pragma unroll
                for (int rg = 0; rg < 4; ++rg) {
                    const u32x2 rw = *(const u32x2*)(p.RB + ro + 8 * rg);
                    const f32x4 g4 = *(const f32x4*)(gw + 8 * rg);
                    const float o0 = oacc[tt][4 * rg + 0] * rn * g4[0] * siluf_(bflo(rw.x)), o1 = oacc[tt][4 * rg + 1] * rn * g4[1] * siluf_(bfhi(rw.x));
                    const float o2 = oacc[tt][4 * rg + 2] * rn * g4[2] * siluf_(bflo(rw.y)), o3 = oacc[tt][4 * rg + 3] * rn * g4[3] * siluf_(bfhi(rw.y));
                    u32x2 w; w.x = pack2(o0, o1); w.y = pack2(o2, o3);
                    *(u32x2*)(p.OB + ro + 8 * rg) = w;
                }
            }
            __syncthreads();
        }
    }
}

constexpr int AKV_PITCH = 72;
typedef short v4s_t __attribute__((ext_vector_type(4)));
__device__ __forceinline__ float alibi_slope(int g, int j) { return exp2f(-8.0f * (float)(g * 4 + j + 1) / 12.0f); }

__device__ __forceinline__ void phase_attn_prompt(const Params& p, int bid, int nb_, LAS unsigned char* lds) {
    int tid_ = threadIdx.x; asm volatile("" : "+v"(tid_));
    LAS bf16_t* s_k = (LAS bf16_t*)lds;
    LAS bf16_t* s_v = s_k + 2 * 256 * AKV_PITCH;
    const int wave = tid_ >> 6, lane = tid_ & 63, r = lane & 31, hh = lane >> 5;
    const int jj = wave >> 2, qs = wave & 3;
    for (int u = bid; u < 1536; u += nb_) {
        const int hp = u & 1, nbq = (u >> 1) & 127, bg = u >> 8, g = bg % 3, b = bg / 3;
        const int d = 1 << (2 * g), nbk = 128 >> (2 * g);
        const int ph = nbq / nbk, nb = nbq % nbk;
#pragma unroll
        for (int half = 0; half < 2; ++half) {
            u32x4 w[8];
#pragma unroll
            for (int i = 0; i < 8; ++i) {
                const int q = tid_ + 512 * i, hj = q >> 11, key = (q >> 3) & 255, dc = q & 7;
                int lp = 128 * (nb - 1) + key; lp = lp < 0 ? 0 : lp;
                const size_t row = (size_t)b * T + (size_t)lp * d + ph;
                w[i] = *(const u32x4*)(p.QKVA + row * 2304 + (half ? 1536 : 768) + g * 256 + (2 * hp + hj) * 64 + dc * 8);
            }
#pragma unroll
            for (int i = 0; i < 8; ++i) {
                const int q = tid_ + 512 * i, hj = q >> 11, key = (q >> 3) & 255, dc = q & 7;
                *(LAS u32x4*)((half ? s_v : s_k) + (hj * 256 + key) * AKV_PITCH + dc * 8) = w[i];
            }
        }
        const int j = 2 * hp + jj;
        const float slope_d = alibi_slope(g, j) * (float)d;
        const int qi = 32 * qs + r;
        const size_t rowq = (size_t)b * T + (size_t)(128 * nb + qi) * d + ph;
        bf16x8 qf[4];
#pragma unroll
        for (int ks = 0; ks < 4; ++ks) qf[ks] = ld_frag_g(p.QKVA + rowq * 2304 + g * 256 + j * 64 + 16 * ks + 8 * hh);
        __syncthreads();
        float sc[5][16];
        const LAS bf16_t* kb = s_k + (jj * 256 + 32 * qs + r) * AKV_PITCH + 8 * hh;
#pragma unroll
        for (int kt = 0; kt < 5; ++kt) {
            f32x16 acc = zero16();
#pragma unroll
            for (int ks = 0; ks < 4; ++ks) acc = mfma32(ld_frag_l(kb + (32 * kt) * AKV_PITCH + 16 * ks), qf[ks], acc);
#pragma unroll
            for (int reg = 0; reg < 16; ++reg) sc[kt][reg] = acc[reg];
        }
        float m = -3.0e38f;
        float fb = (float)(r - 4 * hh + 128);
        asm volatile("" : "+v"(fb));
        const float fsmax = nb > 0 ? 128.0f : (float)qi;
#pragma unroll
        for (int kt = 0; kt < 5; ++kt)
#pragma unroll
            for (int reg = 0; reg < 16; ++reg) {
                const float fs = fb - (float)(32 * kt + (reg & 3) + 8 * (reg >> 2));
                const bool valid = fs >= 0.f && fs <= fsmax;
                const float v = valid ? sc[kt][reg] * 0.125f - slope_d * fs : -3.0e38f;
                sc[kt][reg] = v; m = fmaxf(m, v);
            }
        m = fmaxf(m, __shfl_xor(m, 32));
        float z = 0.f;
#pragma unroll
        for (int kt = 0; kt < 5; ++kt)
#pragma unroll
            for (int reg = 0; reg < 16; ++reg) { const float v = sc[kt][reg]; const float e = v > -1.0e38f ? __expf(v - m) : 0.f; sc[kt][reg] = e; z += e; if (reg == 15) __builtin_amdgcn_sched_barrier(0); }
        z += __shfl_xor(z, 32);
        const float rz = 1.0f / z;
        f32x16 o0 = zero16(), o1 = zero16();
        const int i16 = lane & 15;
        const LAS bf16_t* vb = s_v + (jj * 256 + 32 * qs + 4 * hh + (i16 >> 2)) * AKV_PITCH + 16 * ((lane >> 4) & 1) + 4 * (i16 & 3);
#pragma unroll
        for (int kt = 0; kt < 5; ++kt)
#pragma unroll
            for (int s2 = 0; s2 < 2; ++s2) {
                union { bf16x8 v; unsigned w[4]; } pb;
#pragma unroll
                for (int e = 0; e < 4; ++e) pb.w[e] = pack2(sc[kt][8 * s2 + 2 * e] * rz, sc[kt][8 * s2 + 2 * e + 1] * rz);
#pragma unroll
                for (int dt = 0; dt < 2; ++dt) {
                    union { bf16x8 v; v4s_t h2[2]; } va;
                    const LAS bf16_t* ap = vb + (32 * kt + 16 * s2) * AKV_PITCH + 32 * dt;
                    va.h2[0] = __builtin_amdgcn_ds_read_tr16_b64_v4i16((LAS v4s_t*)ap);
                    va.h2[1] = __builtin_amdgcn_ds_read_tr16_b64_v4i16((LAS v4s_t*)(ap + 8 * AKV_PITCH));
                    if (dt == 0) o0 = mfma32(va.v, pb.v, o0); else o1 = mfma32(va.v, pb.v, o1);
                }
                __builtin_amdgcn_sched_barrier(0);
            }
        bf16_t* og = p.OG + rowq * 768 + g * 256 + j * 64;
#pragma unroll
        for (int rg = 0; rg < 4; ++rg) {
            u32x2 w0, w1;
            w0.x = pack2(o0[4 * rg + 0], o0[4 * rg + 1]); w0.y = pack2(o0[4 * rg + 2], o0[4 * rg + 3]);
            w1.x = pack2(o1[4 * rg + 0], o1[4 * rg + 1]); w1.y = pack2(o1[4 * rg + 2], o1[4 * rg + 3]);
            *(u32x2*)(og + 8 * rg + 4 * hh) = w0; *(u32x2*)(og + 32 + 8 * rg + 4 * hh) = w1;
        }
        if (hh == 0) p.LSE[rowq * 12 + g * 4 + j] = m + __logf(z);
        __syncthreads();
    }
}

__device__ __forceinline__ void phase_attn_sample(const Params& p, int bid, int nb_, LAS unsigned char* lds) {
    int tid_ = threadIdx.x; asm volatile("" : "+v"(tid_));
    LAS float* s_sc = (LAS float*)lds;
    LAS float* s_o = s_sc + 4 * 132;
    const int wave = tid_ >> 6, lane = tid_ & 63, hd = lane >> 4;
    for (int u = bid; u < NS * 3; u += nb_) {
        const int s = u / 3, g = u % 3, d = 1 << (2 * g), W = 128 << (2 * g);
        const size_t row = (size_t)(NTP + s);
        const float* cache = (g == 0 ? p.cache128 : (g == 1 ? p.cache512 : p.cache2048)) + (size_t)s * W * 512;
        const int nk = wave == 0 ? 17 : 16;
        f32x4 kr[17];
#pragma unroll
        for (int i = 0; i < 17; ++i) {
            const int k = wave + 8 * i;
            if (i < nk) {
                if (k == 0) { const u32x2 w = *(const u32x2*)(p.QKVA + row * 2304 + 768 + g * 256 + 4 * lane); kr[i] = (f32x4){bflo(w.x), bfhi(w.x), bflo(w.y), bfhi(w.y)}; }
                else kr[i] = *(const f32x4*)(cache + ((size_t)(W - k * d) * 2 + 0) * 256 + 4 * lane);
            } else kr[i] = (f32x4){0.f, 0.f, 0.f, 0.f};
        }
        const u32x2 qw = *(const u32x2*)(p.QKVA + row * 2304 + g * 256 + 4 * lane);
        const f32x4 q4 = {bflo(qw.x), bfhi(qw.x), bflo(qw.y), bfhi(qw.y)};
        const float slope = alibi_slope(g, hd);
#pragma unroll
        for (int i = 0; i < 17; ++i) {
            const int k = wave + 8 * i;
            float dot = kr[i][0] * q4[0] + kr[i][1] * q4[1] + kr[i][2] * q4[2] + kr[i][3] * q4[3];
            dot = dpp_row_sum(dot);
            if (i < nk && (lane & 15) == 0) s_sc[hd * 132 + k] = dot * 0.125f - slope * (float)(k * d);
        }
        f32x4 vr[17];
#pragma unroll
        for (int i = 0; i < 17; ++i) {
            const int k = wave + 8 * i;
            if (i < nk) {
                if (k == 0) { const u32x2 w = *(const u32x2*)(p.QKVA + row * 2304 + 1536 + g * 256 + 4 * lane); vr[i] = (f32x4){bflo(w.x), bfhi(w.x), bflo(w.y), bfhi(w.y)}; }
                else vr[i] = *(const f32x4*)(cache + ((size_t)(W - k * d) * 2 + 1) * 256 + 4 * lane);
            } else vr[i] = (f32x4){0.f, 0.f, 0.f, 0.f};
        }
        __syncthreads();
        if (wave < 4) {
            const int h2 = wave;
            const float a0 = s_sc[h2 * 132 + lane], a1 = s_sc[h2 * 132 + 64 + lane], a2 = lane == 0 ? s_sc[h2 * 132 + 128] : -3.0e38f;
            const float m = wave_max(fmaxf(fmaxf(a0, a1), a2));
            const float e0 = __expf(a0 - m), e1 = __expf(a1 - m), e2 = lane == 0 ? __expf(a2 - m) : 0.f;
            const float z = wave_sum(e0 + e1 + e2), rz = 1.0f / z;
            s_sc[h2 * 132 + lane] = e0 * rz; s_sc[h2 * 132 + 64 + lane] = e1 * rz; if (lane == 0) { s_sc[h2 * 132 + 128] = e2 * rz; p.LSE[row * 12 + g * 4 + h2] = m + __logf(z); }
        }
        __syncthreads();
        f32x4 o = {0.f, 0.f, 0.f, 0.f};
#pragma unroll
        for (int i = 0; i < 17; ++i) { const int k = wave + 8 * i; if (i < nk) o += vr[i] * s_sc[hd * 132 + k]; }
        *(LAS f32x4*)(s_o + wave * 256 + 4 * lane) = o;
        __syncthreads();
        if (tid_ < 256) {
            float t2 = 0.f;
#pragma unroll
            for (int w = 0; w < 8; ++w) t2 += s_o[w * 256 + tid_];
            p.OG[row * 768 + g * 256 + tid_] = f2bf(t2);
        }
        __syncthreads();
    }
}

__device__ __forceinline__ void phase_merge_prep(const Params& p, int bid, int nb) {
    int tid_ = threadIdx.x; asm volatile("" : "+v"(tid_));
    const int wave = tid_ >> 6, lane = tid_ & 63;
    for (int row = bid * 8 + wave; row < NT; row += nb * 8) {
        const size_t R = (size_t)row;
        {
            const int j = lane >> 4;
            const float l0 = p.LSE[R * 12 + j], l1 = p.LSE[R * 12 + 4 + j], l2 = p.LSE[R * 12 + 8 + j];
            const float m = fmaxf(l0, fmaxf(l1, l2));
            float w0 = __expf(l0 - m), w1 = __expf(l1 - m), w2 = __expf(l2 - m);
            const float rs = 1.0f / (w0 + w1 + w2); w0 *= rs; w1 *= rs; w2 *= rs;
            const u32x2 a = *(const u32x2*)(p.OG + R * 768 + 4 * lane), b = *(const u32x2*)(p.OG + R * 768 + 256 + 4 * lane), c = *(const u32x2*)(p.OG + R * 768 + 512 + 4 * lane);
            u32x2 o;
            o.x = pack2(w0 * bflo(a.x) + w1 * bflo(b.x) + w2 * bflo(c.x), w0 * bfhi(a.x) + w1 * bfhi(b.x) + w2 * bfhi(c.x));
            o.y = pack2(w0 * bflo(a.y) + w1 * bflo(b.y) + w2 * bflo(c.y), w0 * bfhi(a.y) + w1 * bfhi(b.y) + w2 * bfhi(c.y));
            *(u32x2*)(p.OA + R * 256 + 4 * lane) = o;
        }
    }
}

template <int MODE> struct EpiGate {
    static constexpr bool PERM = true, AFTER_DRAIN = false;
    bf16_t* O; const bf16_t* G; const bf16_t* ADD; int ld;
    __device__ __forceinline__ void operator()(const pg8::f32x4 (&acc)[2][2][4][2], const pg8::Unit& u, int wr, int wc, int fr, int fq) const {
        const int row0 = u.pm * 256 + wr * 64 + fr, col0 = u.pn * 256 + wc * 32 + 8 * fq;
#pragma unroll
        for (int ai = 0; ai < 2; ++ai) {
            u32x4 gq[8], aq[8];
#pragma unroll
            for (int m = 0; m < 4; ++m)
#pragma unroll
                for (int bj = 0; bj < 2; ++bj) {
                    const size_t o = (size_t)(row0 + ai * 128 + m * 16) * ld + col0 + bj * 128;
                    if (MODE != 2) gq[m * 2 + bj] = *(const u32x4*)(G + o);
                    if (MODE == 1) aq[m * 2 + bj] = *(const u32x4*)(ADD + o);
                }
#pragma unroll
            for (int m = 0; m < 4; ++m)
#pragma unroll
                for (int bj = 0; bj < 2; ++bj) {
                    const size_t o = (size_t)(row0 + ai * 128 + m * 16) * ld + col0 + bj * 128;
                    const pg8::f32x4 v0 = acc[ai][bj][m][0], v1 = acc[ai][bj][m][1];
                    float v[8] = {v0[0], v0[1], v0[2], v0[3], v1[0], v1[1], v1[2], v1[3]};
                    if (MODE != 2) { float gg[8]; unpack8(gq[m * 2 + bj], gg);
#pragma unroll
                        for (int i = 0; i < 8; ++i) v[i] *= sigmoidf_(gg[i]); }
                    if (MODE == 1) { float aa[8]; unpack8(aq[m * 2 + bj], aa);
#pragma unroll
                        for (int i = 0; i < 8; ++i) v[i] += aa[i]; }
                    u32x4 w; w.x = pack2(v[0], v[1]); w.y = pack2(v[2], v[3]); w.z = pack2(v[4], v[5]); w.w = pack2(v[6], v[7]);
                    *(u32x4*)(O + o) = w;
                }
        }
    }
    __device__ __forceinline__ void emit16(int row, int col, const float (&vin)[16]) const {
#pragma unroll
        for (int hf = 0; hf < 2; ++hf) {
            const size_t o = (size_t)row * ld + col + 8 * hf;
            float v[8];
#pragma unroll
            for (int i = 0; i < 8; ++i) v[i] = vin[8 * hf + i];
            if (MODE != 2) { float gg[8]; unpack8(*(const u32x4*)(G + o), gg);
#pragma unroll
                for (int i = 0; i < 8; ++i) v[i] *= sigmoidf_(gg[i]); }
            if (MODE == 1) { float aa[8]; unpack8(*(const u32x4*)(ADD + o), aa);
#pragma unroll
                for (int i = 0; i < 8; ++i) v[i] += aa[i]; }
            u32x4 w; w.x = pack2(v[0], v[1]); w.y = pack2(v[2], v[3]); w.z = pack2(v[4], v[5]); w.w = pack2(v[6], v[7]);
            *(u32x4*)(O + o) = w;
        }
    }
};
struct EpiOut {
    static constexpr bool PERM = false, AFTER_DRAIN = false;
    float* Z1; const float* x_prompt; const float* x_sample; const float* MOD;
    __device__ __forceinline__ void operator()(const pg8::f32x4 (&acc)[2][2][4][2], const pg8::Unit& u, int wr, int wc, int fr, int fq) const {
        const int row0 = u.pm * 256 + wr * 64 + fr, col0 = u.pn * 256 + wc * 32 + 4 * fq;
        const float* g1 = MOD + (size_t)(row0 >> 14) * 6144 + 2048 + col0;
        pg8::f32x4 gv[2][2];
#pragma unroll
        for (int bj = 0; bj < 2; ++bj)
#pragma unroll
            for (int n = 0; n < 2; ++n) gv[bj][n] = *(const pg8::f32x4*)(g1 + bj * 128 + n * 16);
#pragma unroll
        for (int ai = 0; ai < 2; ++ai) {
            pg8::f32x4 xv[4][2][2];
#pragma unroll
            for (int m = 0; m < 4; ++m)
#pragma unroll
                for (int bj = 0; bj < 2; ++bj)
#pragma unroll
                    for (int n = 0; n < 2; ++n) xv[m][bj][n] = *(const pg8::f32x4*)(x_prompt + (size_t)(row0 + ai * 128 + m * 16) * D + col0 + bj * 128 + n * 16);
#pragma unroll
            for (int m = 0; m < 4; ++m)
#pragma unroll
                for (int bj = 0; bj < 2; ++bj)
#pragma unroll
                    for (int n = 0; n < 2; ++n)
                        *(pg8::f32x4*)(Z1 + (size_t)(row0 + ai * 128 + m * 16) * D + col0 + bj * 128 + n * 16) = xv[m][bj][n] * DN_ALPHA + gv[bj][n] * acc[ai][bj][m][n];
        }
    }
    __device__ __forceinline__ void emit16(int row, int col, const float (&v)[16]) const {
        if (row >= NT) return;
        const float* xr = row < NTP ? x_prompt + (size_t)row * D : x_sample + (size_t)(row - NTP) * D;
        const float* g1 = MOD + (size_t)seq_of(row) * 6144 + 2048;
#pragma unroll
        for (int i = 0; i < 4; ++i) {
            const f32x4 xv = *(const f32x4*)(xr + col + 4 * i), gv = *(const f32x4*)(g1 + col + 4 * i);
            *(f32x4*)(Z1 + (size_t)row * D + col + 4 * i) = xv * DN_ALPHA + gv * (f32x4){v[4 * i], v[4 * i + 1], v[4 * i + 2], v[4 * i + 3]};
        }
    }
};

__device__ __forceinline__ size_t qvf_index(int row, int c0) {
    return ((((((size_t)(row >> 5) * 8 + (c0 >> 8)) * 2 + ((c0 >> 7) & 1)) * 8 + ((c0 & 127) >> 4)) * 64) + (((c0 >> 3) & 1) * 32 + (row & 31))) * 8;
}
struct EpiQvf {
    static constexpr bool PERM = true, AFTER_DRAIN = false;
    bf16_t* O;
    __device__ __forceinline__ void operator()(const pg8::f32x4 (&acc)[2][2][4][2], const pg8::Unit& u, int wr, int wc, int fr, int fq) const {
        const int row0 = u.pm * 256 + wr * 64 + fr, col0 = u.pn * 256 + wc * 32 + 8 * fq;
#pragma unroll
        for (int ai = 0; ai < 2; ++ai)
#pragma unroll
            for (int m = 0; m < 4; ++m)
#pragma unroll
                for (int bj = 0; bj < 2; ++bj) {
                    const pg8::f32x4 v0 = acc[ai][bj][m][0], v1 = acc[ai][bj][m][1];
                    u32x4 w; w.x = pack2(v0[0], v0[1]); w.y = pack2(v0[2], v0[3]); w.z = pack2(v1[0], v1[1]); w.w = pack2(v1[2], v1[3]);
                    *(u32x4*)(O + qvf_index(row0 + ai * 128 + m * 16, col0 + bj * 128)) = w;
                }
    }
    __device__ __forceinline__ void emit16(int row, int col, const float (&v)[16]) const {
        u32x4 w0, w1;
        w0.x = pack2(v[0], v[1]); w0.y = pack2(v[2], v[3]); w0.z = pack2(v[4], v[5]); w0.w = pack2(v[6], v[7]);
        w1.x = pack2(v[8], v[9]); w1.y = pack2(v[10], v[11]); w1.z = pack2(v[12], v[13]); w1.w = pack2(v[14], v[15]);
        *(u32x4*)(O + qvf_index(row, col)) = w0; *(u32x4*)(O + qvf_index(row, col + 8)) = w1;
    }
};

__device__ __forceinline__ void phase_ln1(const Params& p, int bid, int nb) {
    int tid_ = threadIdx.x; asm volatile("" : "+v"(tid_));
    const int wave = tid_ >> 6, lane = tid_ & 63;
    float lw[16], lb[16];
    load_row16(p.ln1_w, lane, lw); load_row16(p.ln1_b, lane, lb);
    int row = bid * 8 + wave;
    float nx[16];
    if (row < NT) load_row16(p.Z1 + (size_t)row * D, lane, nx);
    for (; row < NT; row += nb * 8) {
        float v[16];
#pragma unroll
        for (int i = 0; i < 16; ++i) v[i] = nx[i];
        const int nrow = row + nb * 8;
        if (nrow < NT) load_row16(p.Z1 + (size_t)nrow * D, lane, nx);
        const float* mod = p.MOD + (size_t)seq_of(row) * 6144;
        float sh[16], sc[16];
        load_row16(mod + 3072, lane, sh); load_row16(mod + 4096, lane, sc);
        float mean, rstd; row_stats(v, mean, rstd);
        if (lane == 0) { p.LNST[(size_t)row * 2] = mean; p.LNST[(size_t)row * 2 + 1] = rstd; }
#pragma unroll
        for (int i = 0; i < 16; ++i) v[i] = (v[i] - mean) * rstd * lw[i] + lb[i];
        row_stats(v, mean, rstd);
#pragma unroll
        for (int i = 0; i < 16; ++i) v[i] = (v[i] - mean) * rstd * (1.0f + sc[i]) + sh[i];
        store_row16_bf16(p.H + (size_t)row * D, lane, v);
        float am = 0.f;
#pragma unroll
        for (int i = 0; i < 16; ++i) am = fmaxf(am, fabsf(v[i]));
        am = wave_max(am);
        const float inv = am > 0.f ? 448.0f / am : 1.0f;
        u32x4 w8;
#pragma unroll
        for (int i = 0; i < 4; ++i) {
            int d = 0;
            d = __builtin_amdgcn_cvt_pk_fp8_f32(v[4 * i] * inv, v[4 * i + 1] * inv, d, false);
            d = __builtin_amdgcn_cvt_pk_fp8_f32(v[4 * i + 2] * inv, v[4 * i + 3] * inv, d, true);
            w8[i] = (unsigned)d;
        }
        *(u32x2*)(p.H8 + (size_t)row * 1024 + 8 * lane) = (u32x2){w8[0], w8[1]};
        *(u32x2*)(p.H8 + (size_t)row * 1024 + 512 + 8 * lane) = (u32x2){w8[2], w8[3]};
        if (lane == 0) p.HS[row] = am > 0.f ? am * (1.0f / 448.0f) : 1.0f;
    }
}

__device__ __forceinline__ unsigned fkey(float f) { const unsigned u = __float_as_uint(f); return (u & 0x80000000u) ? ~u : (u | 0x80000000u); }
__device__ __forceinline__ float keyf(unsigned k) { return __uint_as_float((k & 0x80000000u) ? (k & 0x7fffffffu) : ~k); }

constexpr int CC_R0 = 128 * 127, CC_R1 = CC_R0 + 128 * 511, CC_ROWS = CC_R1 + 128 * 2047;
constexpr int CC_PER = 2, CC_STEPS = 84;
static_assert(CC_PER * CC_STEPS * 2048 >= CC_ROWS, "copy coverage");
template <int W> __device__ __forceinline__ void cc_addr_w(const float* s, float* d, int i, const float*& src, float*& dst) {
    const int seq = i / (W - 1), rr = i - seq * (W - 1);
    src = s + ((size_t)seq * W + rr + 1) * 512; dst = d + ((size_t)seq * W + rr) * 512;
}
__device__ __forceinline__ bool cc_addr(const Params& p, int row_, const float*& src, float*& dst) {
    const int rowu = __builtin_amdgcn_readfirstlane(row_);
    const bool ok = rowu < CC_ROWS;
    const int row = ok ? rowu : CC_ROWS - 1;
    if (row < CC_R0) cc_addr_w<128>(p.cache128, p.out + OFF_KVS0, row, src, dst);
    else if (row < CC_R1) cc_addr_w<512>(p.cache512, p.out + OFF_KVS1, row - CC_R0, src, dst);
    else cc_addr_w<2048>(p.cache2048, p.out + OFF_KVS2, row - CC_R1, src, dst);
    return ok;
}
struct CacheCopier {
    static constexpr int CAP = CC_PER * CC_STEPS;
    int row0, lane4, knext, kh0, kh1; f32x4 b0[2 * CC_PER], b1[2 * CC_PER];
    __device__ __forceinline__ void init(int bid, int tid) { row0 = __builtin_amdgcn_readfirstlane(bid * 8 + (tid >> 6)); lane4 = (tid & 63) * 4; knext = 0; kh0 = CAP; kh1 = CAP; }
    template <int W> __device__ __forceinline__ void store_part(const Params& p) {
        const int k0 = W ? kh1 : kh0;
#pragma unroll
        for (int j = 0; j < CC_PER; ++j) { const float* s; float* d; if (cc_addr(p, row0 + (k0 + j) * 2048, s, d)) {
            __builtin_nontemporal_store((W ? b1 : b0)[2 * j], (f32x4*)(d + lane4)); __builtin_nontemporal_store((W ? b1 : b0)[2 * j + 1], (f32x4*)(d + 256 + lane4)); } }
    }
    template <int W> __device__ __forceinline__ void load_part(const Params& p) {
        (W ? kh1 : kh0) = knext;
#pragma unroll
        for (int j = 0; j < CC_PER; ++j) { const float* s; float* d; (void)cc_addr(p, row0 + (knext + j) * 2048, s, d);
            (W ? b1 : b0)[2 * j] = __builtin_nontemporal_load((const f32x4*)(s + lane4)); (W ? b1 : b0)[2 * j + 1] = __builtin_nontemporal_load((const f32x4*)(s + 256 + lane4)); }
        knext = knext + CC_PER < CAP ? knext + CC_PER : CAP;
    }
    template <int W> __device__ __forceinline__ void step(const Params& p) { store_part<W>(p); load_part<W>(p); }
    __device__ __forceinline__ void flush(const Params& p) { while (kh0 < CAP || kh1 < CAP) { step<0>(p); step<1>(p); } }
};
constexpr int SK_PITCH = 132;
#define DPP_ROR(v, n) ((unsigned)__builtin_amdgcn_update_dpp(0, (int)(v), 0x120 + (n), 0xf, 0xf, true))
__device__ __forceinline__ unsigned row_max_u32(unsigned v) {
    v = max(v, DPP_ROR(v, 8)); v = max(v, DPP_ROR(v, 4)); v = max(v, DPP_ROR(v, 2)); v = max(v, DPP_ROR(v, 1)); return v;
}
#define CE_DESC(a, b) do { const unsigned hi_ = max(a, b), lo_ = min(a, b); a = hi_; b = lo_; } while (0)
__device__ __forceinline__ void phase_peer_select(const Params& p, int bid, int nb, LAS unsigned char* lds) {
    int tid_ = threadIdx.x; asm volatile("" : "+v"(tid_));
    LAS unsigned* s_key = (LAS unsigned*)lds;
    LAS unsigned* s_top = s_key + 256 * SK_PITCH;
    const int wave = tid_ >> 6, lane = tid_ & 63, r = lane & 31, hh = lane >> 5;
    const int li = tid_ & 15, rowid = tid_ >> 4;
    int cand_i[4], cand_j[4]; bool cand_ok[4];
#pragma unroll
    for (int s = 0; s < 4; ++s) {
        int i = 0, rem = 4 * li + s;
        while (i < 16 && rem >= 16 / (i + 1)) { rem -= 16 / (i + 1); ++i; }
        cand_ok[s] = i < 16; cand_i[s] = i < 16 ? i : 0; cand_j[s] = i < 16 ? rem : 0;
    }
    CacheCopier cc; cc.init(bid, tid_);
    for (int b = bid; b < 256; b += nb) {
        for (int tile = 0; tile < 5; ++tile) {
            const int nvalid = tile < 4 ? 32 : (b < NS ? 1 : 0);
            if (nvalid == 0) break;
            const int row0 = tile < 4 ? b * 128 + tile * 32 : NTP + b;
            for (int hq = 0; hq < 2; ++hq) {
#pragma unroll
                for (int jb = 0; jb < 4; ++jb) {
                    const int job = wave * 4 + jb, hl = job >> 3, half = (job >> 2) & 1, ni = job & 3;
                    const int h = 4 * hq + hl;
                    const int tix = tile < 4 ? b * 4 + tile : (NTP >> 5) + (b >> 5), rsel = tile < 4 ? r : (b & 31);
                    const bf16_t* A = p.QV + ((((size_t)tix * 8 + h) * 2 + half) * 8 * 64 + (hh * 32 + rsel)) * 8;
                    const bf16_t* B = p.KF + ((((size_t)h * 2 + half) * 4 + ni) * 8 * 64 + lane) * 8;
                    if (jb & 1) cc.store_part<1>(p); else cc.store_part<0>(p);
                    bf16x8 af[8], bfr[8];
#pragma unroll
                    for (int ks = 0; ks < 8; ++ks) { af[ks] = ld_frag_g(A + ks * 512); bfr[ks] = ld_frag_g(B + ks * 512); }
                    if (jb & 1) cc.load_part<1>(p); else cc.load_part<0>(p);
                    f32x16 acc = zero16();
#pragma unroll
                    for (int ks = 0; ks < 8; ++ks) acc = mfma32(af[ks], bfr[ks], acc);
                    LAS unsigned* dst = s_key + ((hl * 2 + half) * 32) * SK_PITCH + 32 * ni + r;
                    const unsigned tag = 127u - (unsigned)(32 * ni + r);
#pragma unroll
                    for (int reg = 0; reg < 16; ++reg) dst[crow(reg, hh) * SK_PITCH] = (fkey(acc[reg]) & ~127u) | tag;
                }
                __syncthreads();
                {
                    auto stage1 = [&](int it) {
                        unsigned k[2][8], res[2];
#pragma unroll
                        for (int z = 0; z < 2; ++z) {
                            const int q = (it + 4 * z) * 32 + rowid;
                            const u32x4 ka = *(const LAS u32x4*)(s_key + q * SK_PITCH + 8 * li), kb = *(const LAS u32x4*)(s_key + q * SK_PITCH + 8 * li + 4);
                            k[z][0] = ka.x; k[z][1] = ka.y; k[z][2] = ka.z; k[z][3] = ka.w; k[z][4] = kb.x; k[z][5] = kb.y; k[z][6] = kb.z; k[z][7] = kb.w; res[z] = 0u;
                        }
#pragma unroll
                        for (int z = 0; z < 2; ++z) {
                            CE_DESC(k[z][0], k[z][1]); CE_DESC(k[z][2], k[z][3]); CE_DESC(k[z][4], k[z][5]); CE_DESC(k[z][6], k[z][7]);
                            CE_DESC(k[z][0], k[z][2]); CE_DESC(k[z][1], k[z][3]); CE_DESC(k[z][4], k[z][6]); CE_DESC(k[z][5], k[z][7]);
                            CE_DESC(k[z][1], k[z][2]); CE_DESC(k[z][5], k[z][6]);
                            CE_DESC(k[z][0], k[z][4]); CE_DESC(k[z][1], k[z][5]); CE_DESC(k[z][2], k[z][6]); CE_DESC(k[z][3], k[z][7]);
                            CE_DESC(k[z][2], k[z][4]); CE_DESC(k[z][3], k[z][5]);
                            CE_DESC(k[z][1], k[z][2]); CE_DESC(k[z][3], k[z][4]); CE_DESC(k[z][5], k[z][6]);
                        }
#pragma unroll
                        for (int ps = 0; ps < 16; ++ps) {
#pragma unroll
                            for (int z = 0; z < 2; ++z) {
                                const unsigned mx = row_max_u32(k[z][0]);
                                res[z] = li == ps ? mx : res[z];
                                const bool pop = k[z][0] == mx;
#pragma unroll
                                for (int e = 0; e < 7; ++e) k[z][e] = pop ? k[z][e + 1] : k[z][e];
                                k[z][7] = pop ? 0u : k[z][7];
                            }
                        }
#pragma unroll
                        for (int z = 0; z < 2; ++z) s_top[((it + 4 * z) * 32 + rowid) * 16 + li] = res[z];
                    };
                    for (int it = 0; it < 4; it += 2) { cc.step<0>(p); if (rowid < nvalid) stage1(it); cc.step<1>(p); if (rowid < nvalid) stage1(it + 1); }
                }
                __syncthreads();
                {
                    auto stage2 = [&](int hl0) {
                        unsigned c[2][4], res[2];
#pragma unroll
                        for (int z = 0; z < 2; ++z) {
                            const int hl = hl0 + 2 * z;
                            const LAS unsigned* t1 = s_top + ((hl * 2 + 0) * 32 + rowid) * 16;
                            const LAS unsigned* t2 = s_top + ((hl * 2 + 1) * 32 + rowid) * 16;
#pragma unroll
                            for (int s = 0; s < 4; ++s) {
                                const float v = keyf(t1[cand_i[s]] & ~127u) + keyf(t2[cand_j[s]] & ~127u);
                                c[z][s] = cand_ok[s] ? ((fkey(v) & ~255u) | (255u - (unsigned)(cand_i[s] * 16 + cand_j[s]))) : 0u;
                            }
                            CE_DESC(c[z][0], c[z][1]); CE_DESC(c[z][2], c[z][3]); CE_DESC(c[z][0], c[z][2]); CE_DESC(c[z][1], c[z][3]); CE_DESC(c[z][1], c[z][2]);
                            res[z] = 0u;
                        }
#pragma unroll
                        for (int ps = 0; ps < 16; ++ps) {
#pragma unroll
                            for (int z = 0; z < 2; ++z) {
                                const unsigned mx = row_max_u32(c[z][0]);
                                res[z] = li == ps ? mx : res[z];
                                const bool pop = c[z][0] == mx;
                                c[z][0] = pop ? c[z][1] : c[z][0]; c[z][1] = pop ? c[z][2] : c[z][1]; c[z][2] = pop ? c[z][3] : c[z][2]; c[z][3] = pop ? 0u : c[z][3];
                            }
                        }
#pragma unroll
                        for (int z = 0; z < 2; ++z) {
                            const int hl = hl0 + 2 * z;
                            const LAS unsigned* t1 = s_top + ((hl * 2 + 0) * 32 + rowid) * 16;
                            const LAS unsigned* t2 = s_top + ((hl * 2 + 1) * 32 + rowid) * 16;
                            const int cidx = 255 - (int)(res[z] & 255u), i1 = cidx >> 4, i2 = cidx & 15;
                            const unsigned a1 = t1[i1], a2 = t2[i2];
                            const float sc = keyf(a1 & ~127u) + keyf(a2 & ~127u);
                            float mxs = sc;
                            mxs = fmaxf(mxs, DPP_ROR_F(mxs, 8)); mxs = fmaxf(mxs, DPP_ROR_F(mxs, 4)); mxs = fmaxf(mxs, DPP_ROR_F(mxs, 2)); mxs = fmaxf(mxs, DPP_ROR_F(mxs, 1));
                            const float ex = __expf(sc - mxs);
                            const float gw = ex / dpp_row_sum(ex);
                            const int ei = (127 - (int)(a1 & 127u)) * 128 + (127 - (int)(a2 & 127u));
                            const size_t o = (size_t)(row0 + rowid) * 128 + (4 * hq + hl) * 16 + li;
                            p.EIDX[o] = ei; p.EGW[o] = gw * p.SV[ei];
                        }
                    };
                    cc.step<0>(p); if (rowid < nvalid) stage2(0); cc.step<1>(p); if (rowid < nvalid) stage2(1);
                }
                __syncthreads();
            }
        }
    }
    cc.flush(p);
}

__device__ __forceinline__ float gelu_erf(float x) { return 0.5f * x * (1.0f + erff(x * 0.70710678118654752f)); }
__device__ __forceinline__ float wave_total_from_rows(float v) {
    return (__builtin_bit_cast(float, __builtin_amdgcn_readlane(__builtin_bit_cast(int, v), 0)) + __builtin_bit_cast(float, __builtin_amdgcn_readlane(__builtin_bit_cast(int, v), 16)))
         + (__builtin_bit_cast(float, __builtin_amdgcn_readlane(__builtin_bit_cast(int, v), 32)) + __builtin_bit_cast(float, __builtin_amdgcn_readlane(__builtin_bit_cast(int, v), 48)));
}
__device__ __forceinline__ void fp8x16_to_f32(const u32x4 w, float (&o)[16]) {
#pragma unroll
    for (int i = 0; i < 4; ++i) {
        const v2f_t lo = __builtin_amdgcn_cvt_pk_f32_fp8((int)w[i], false), hi = __builtin_amdgcn_cvt_pk_f32_fp8((int)w[i], true);
        o[4 * i] = lo.x; o[4 * i + 1] = lo.y; o[4 * i + 2] = hi.x; o[4 * i + 3] = hi.y;
    }
}
typedef long i64x2_t __attribute__((ext_vector_type(2)));
typedef int i32x2_t __attribute__((ext_vector_type(2)));
#define UP_PITCH 1040
__device__ __forceinline__ void up_tile_put(const u32x4 (&rows)[16], LAS unsigned char* tile, int lane16) {
#pragma unroll
    for (int q = 0; q < 16; ++q) *(LAS u32x4*)(tile + q * UP_PITCH + lane16) = rows[q];
}
__device__ __forceinline__ float up_tile_dots(LAS unsigned char* tile, const LAS unsigned char* hrow, int pr, int kg16) {
    f32x4 c0 = {0.f, 0.f, 0.f, 0.f}, c1 = c0;
    u32x4 hf[2][2], uf[2][2];
    auto rd = [&](int st, int s) {
#pragma unroll
        for (int i = 0; i < 2; ++i) { hf[s][i] = *(const LAS u32x4*)(hrow + 128 * st + 64 * i + kg16); uf[s][i] = *(const LAS u32x4*)(tile + pr * UP_PITCH + 128 * st + 64 * i + kg16); }
    };
    auto mm = [&](int s) {
#pragma unroll
        for (int i = 0; i < 2; ++i) {
            const i64x2_t a = __builtin_bit_cast(i64x2_t, hf[s][i]), b = __builtin_bit_cast(i64x2_t, uf[s][i]);
            c0 = __builtin_amdgcn_mfma_f32_16x16x32_fp8_fp8(a[0], b[0], c0, 0, 0, 0);
            c1 = __builtin_amdgcn_mfma_f32_16x16x32_fp8_fp8(a[1], b[1], c1, 0, 0, 0);
        }
    };
    rd(0, 0);
#pragma unroll
    for (int st = 0; st < 8; ++st) {
        if (st + 1 < 8) rd(st + 1, (st + 1) & 1);
        __builtin_amdgcn_sched_barrier(0);
        mm(st & 1);
        __builtin_amdgcn_sched_barrier(0);
    }
    return c0[0] + c1[0];
}

__device__ __forceinline__ float up_reduce8(const float (&t8)[8], int lane) {
    float t4[4], t2[2], t1;
    { const bool b = lane & 2;
#pragma unroll
      for (int j = 0; j < 4; ++j) { const float keep = b ? t8[2 * j + 1] : t8[2 * j], send = b ? t8[2 * j] : t8[2 * j + 1]; t4[j] = keep + DPP_ROR_F(send, 2); } }
    { const bool b = lane & 4;
#pragma unroll
      for (int j = 0; j < 2; ++j) { const float keep = b ? t4[2 * j + 1] : t4[2 * j], send = b ? t4[2 * j] : t4[2 * j + 1]; t2[j] = keep + DPP_ROR_F(send, 4); } }
    { const bool b = lane & 8; const float keep = b ? t2[1] : t2[0], send = b ? t2[0] : t2[1]; t1 = keep + DPP_ROR_F(send, 8); }
    t1 += __shfl_xor(t1, 16); t1 += __shfl_xor(t1, 32);
    return t1;
}
template <int V = 0>
__device__ __forceinline__ void phase_peer_upass(const Params& p, int bid, int nb, LAS unsigned char* lds, float* __restrict__ ewout) {
    int tid_ = threadIdx.x; asm volatile("" : "+v"(tid_));
    const int wave = tid_ >> 6, lane = tid_ & 63;
    constexpr int WSTR = 1024 + 2048 + 64;
    LAS int* lst = (LAS int*)(lds + wave * WSTR);
    LAS unsigned char* hb = lds + wave * WSTR + 1024;
    LAS float* hsl = (LAS float*)(lds + wave * WSTR + 3072);
    static_assert(8 * WSTR <= LDS_BYTES - 16, "LDS carve of the expert-activation phase");
    const __amdgpu_buffer_rsrc_t ures = __builtin_amdgcn_make_buffer_rsrc((void*)p.U8, 0, 16384 * 2048, 0x00020000);
    const int lane16 = lane * 16;
    const int rsel = (((lane & 15) >> 2) == (lane >> 4)) ? (lane & 3) : 4;
    unsigned dmask[4];
#pragma unroll
    for (int r = 0; r < 4; ++r) { dmask[r] = rsel == r ? 0xffffffffu : 0u; asm volatile("" : "+v"(dmask[r])); }
    constexpr int TPB = NT / 32;
    static_assert(TPB * 32 == NT, "token ranges");
    struct TokIn { u32x4 h8; int ia, ib; float hs; };
    struct Tok { int t, n, e0, e1, k0, k1; float su0, su1; };
    for (int vb = bid; vb < 256; vb += nb) {
        const int x = vb & 7, t0 = (vb >> 3) * TPB, tend = t0 + TPB;
        {
        auto fetch_tok = [&](int t2, TokIn& ti) {
            t2 = t2 < tend ? t2 : tend - 1;
            const size_t R2 = (size_t)t2;
            ti.h8 = *(const u32x4*)(p.H8 + R2 * 1024 + 16 * lane); ti.hs = p.HS[R2];
            ti.ia = p.EIDX[R2 * 128 + lane]; ti.ib = p.EIDX[R2 * 128 + 64 + lane];
        };
        auto prep = [&](int t, TokIn& in, Tok& o, u32x4 (&buf)[16], int par) {
            const int ia = in.ia, ib = in.ib;
            o.t = t;
            *(LAS u32x4*)(hb + par * 1024 + 16 * lane) = in.h8; hsl[par] = in.hs;
            const bool inA = (ia >> 11) == x, inB = (ib >> 11) == x;
            const unsigned long long mA = __builtin_amdgcn_ballot_w64(inA), mB = __builtin_amdgcn_ballot_w64(inB);
            const int cntA = __builtin_popcountll(mA), n = cntA + __builtin_popcountll(mB);
            const int rankA = (int)__builtin_amdgcn_mbcnt_hi((unsigned)(mA >> 32), __builtin_amdgcn_mbcnt_lo((unsigned)mA, 0u));
            const int rankB = cntA + (int)__builtin_amdgcn_mbcnt_hi((unsigned)(mB >> 32), __builtin_amdgcn_mbcnt_lo((unsigned)mB, 0u));
            LAS int* L = lst;
            if (inA) { L[rankA] = ia; L[128 + rankA] = lane; }
            if (inB) { L[rankB] = ib; L[128 + rankB] = 64 + lane; }
            asm volatile("s_waitcnt lgkmcnt(0)" ::: "memory");
            o.n = n;
            o.e0 = lane < n ? L[lane] : (x << 11); o.e1 = 64 + lane < n ? L[64 + lane] : (x << 11);
            o.k0 = L[128 + lane]; o.k1 = L[192 + lane];
            o.su0 = p.SU[o.e0]; o.su1 = p.SU[o.e1];
#pragma unroll
            for (int q = 0; q < 16; ++q) { const int e = __builtin_amdgcn_readlane(o.e0, q); buf[q] = __builtin_amdgcn_raw_buffer_load_b128(ures, lane16, e << 11, 0); }
            fetch_tok(t + 16, in);
        };
        auto finish = [&](Tok& c, u32x4 (&buf)[16], int par) {
            const u32x4 h8 = *(const LAS u32x4*)(hb + par * 1024 + lane16); const float hs = hsl[par];
            const i64x2_t ha = __builtin_bit_cast(i64x2_t, h8);
            __builtin_amdgcn_sched_barrier(0);
            __builtin_amdgcn_s_waitcnt(0x4F76);
            __builtin_amdgcn_sched_barrier(0);
            float dot0 = 0.f, dot1 = 0.f;
            for (int base = 0; base < 16 || base < c.n; base += 16) {
                const bool more = base + 16 < c.n;
                const int nb16 = base + 16, ev = nb16 < 64 ? c.e0 : c.e1;
                float t8[8];
                f32x4 acc[4][4];
#pragma unroll
                for (int bq = 0; bq < 5; ++bq) {
                    const int q0 = 4 * bq;
                    if (bq < 4) {
#pragma unroll
                        for (int j = 0; j < 4; ++j) { const i64x2_t b = __builtin_bit_cast(i64x2_t, buf[q0 + j]); acc[bq][j] = __builtin_amdgcn_mfma_f32_16x16x32_fp8_fp8(ha[0], b[0], (f32x4){0.f, 0.f, 0.f, 0.f}, 0, 0, 0); }
#pragma unroll
                        for (int j = 0; j < 4; ++j) { const i64x2_t b = __builtin_bit_cast(i64x2_t, buf[q0 + j]); acc[bq][j] = __builtin_amdgcn_mfma_f32_16x16x32_fp8_fp8(ha[1], b[1], acc[bq][j], 0, 0, 0); }
                        if (more) {
#pragma unroll
                            for (int j = 0; j < 4; ++j) { const int e = __builtin_amdgcn_readlane(ev, (nb16 & 63) + q0 + j); buf[q0 + j] = __builtin_amdgcn_raw_buffer_load_b128(ures, lane16, e << 11, 0); }
                        }
                    }
                    if (bq > 0) {
                        float sv[4];
#pragma unroll
                        for (int j = 0; j < 4; ++j) sv[j] = __uint_as_float((__float_as_uint(acc[bq - 1][j][0]) & dmask[0]) | (__float_as_uint(acc[bq - 1][j][1]) & dmask[1]) | (__float_as_uint(acc[bq - 1][j][2]) & dmask[2]) | (__float_as_uint(acc[bq - 1][j][3]) & dmask[3]));
                        const bool b1 = lane & 1;
#pragma unroll
                        for (int j = 0; j < 2; ++j) { const float keep = b1 ? sv[2 * j + 1] : sv[2 * j], send = b1 ? sv[2 * j] : sv[2 * j + 1]; t8[2 * (bq - 1) + j] = keep + DPP_ROR_F(send, 1); }
                    }
                    __builtin_amdgcn_sched_barrier(0);
                }
                const float d = up_reduce8(t8, lane);
                if ((lane >> 4) == ((base >> 4) & 3)) { if (base < 64) dot0 = d; else dot1 = d; }
                if (more) {
                    __builtin_amdgcn_sched_barrier(0);
                    __builtin_amdgcn_s_waitcnt(0x0F70);
                    __builtin_amdgcn_sched_barrier(0);
                }
            }
            const size_t R = (size_t)c.t;
            if (lane < c.n) ewout[R * 128 + c.k0] = gelu_erf(c.su0 * hs * dot0);
            if (64 + lane < c.n) ewout[R * 128 + c.k1] = gelu_erf(c.su1 * hs * dot1);
        };
        TokIn iA, iB; Tok kA, kB; u32x4 bX[16], bY[16];
        fetch_tok(t0 + wave, iA); fetch_tok(t0 + wave + 8, iB);
        prep(t0 + wave, iA, kA, bX, 0);
        for (int t = t0 + wave; t < tend; t += 16) {
            prep(t + 8 < tend ? t + 8 : tend - 1, iB, kB, bY, 1);
            finish(kA, bX, 0);
            prep(t + 16 < tend ? t + 16 : tend - 1, iA, kA, bX, 0);
            finish(kB, bY, 1);
        }
        __builtin_amdgcn_s_waitcnt(0x0F70);
        }
    }
}

__device__ __forceinline__ void phase_peer_gather(const Params& p, int bid, int nb, LAS unsigned char* lds, int skip_ff = 0) {
    int tid_ = threadIdx.x; asm volatile("" : "+v"(tid_));
    const int wave = tid_ >> 6, lane = tid_ & 63;
    LAS float* s_ff = (LAS float*)lds;
    const __amdgpu_buffer_rsrc_t vres = __builtin_amdgcn_make_buffer_rsrc((void*)p.U8, 0, 16384 * 2048, 0x00020000);
    const int lane16v = lane * 16 + 1024;
    const int n_vb = (256 - bid + nb - 1) / nb;
    for (int it = 0; it < n_vb * 17; ++it) {
        const int vb = bid + (it / 17) * nb, sub = it % 17;
        const bool coop = sub == 16;
        if (coop && vb >= NS) continue;
        const int row = coop ? NTP + vb : vb * 128 + wave + 8 * sub;
        const int g0 = skip_ff ? 8 : (coop ? wave : 0), g1 = coop ? wave + 1 : 8;
        const size_t R = (size_t)row;
        v2f_t acc2[8];
#pragma unroll
        for (int i = 0; i < 8; ++i) acc2[i] = (v2f_t){0.f, 0.f};
        const int ia = p.EIDX[R * 128 + lane], ib = p.EIDX[R * 128 + 64 + lane];
        const float wa = p.EW[R * 128 + lane] * p.EGW[R * 128 + lane], wb = p.EW[R * 128 + 64 + lane] * p.EGW[R * 128 + 64 + lane];
        f32x4 zr[4];
#pragma unroll
        for (int i = 0; i < 4; ++i) zr[i] = *(const f32x4*)(p.Z1 + R * D + 16 * lane + 4 * i);
        const float mean1 = p.LNST[R * 2], rstd1 = p.LNST[R * 2 + 1];
        for (int grp = g0; grp < g1; ++grp) {
            const int iv = grp < 4 ? ia : ib; const float wv = grp < 4 ? wa : wb;
            const int l0 = (grp & 3) * 16;
            u32x4 vb16[16];
#pragma unroll
            for (int q = 0; q < 16; ++q) { const int e = __builtin_amdgcn_readlane(iv, l0 + q); vb16[q] = __builtin_amdgcn_raw_buffer_load_b128(vres, lane16v, e << 11, 0); }
#pragma unroll
            for (int q = 0; q < 16; ++q) {
                const float w = __builtin_bit_cast(float, __builtin_amdgcn_readlane(__builtin_bit_cast(int, wv), l0 + q));
                const v2f_t w2 = {w, w};
#pragma unroll
                for (int i = 0; i < 4; ++i) {
                    const v2f_t lo = __builtin_amdgcn_cvt_pk_f32_fp8((int)vb16[q][i], false), hi = __builtin_amdgcn_cvt_pk_f32_fp8((int)vb16[q][i], true);
                    acc2[2 * i] += w2 * lo; acc2[2 * i + 1] += w2 * hi;
                }
            }
        }
        float acc[16];
#pragma unroll
        for (int i = 0; i < 8; ++i) { acc[2 * i] = acc2[i].x; acc[2 * i + 1] = acc2[i].y; }
        if (coop) {
#pragma unroll
            for (int i = 0; i < 4; ++i) *(LAS f32x4*)(s_ff + wave * 1024 + 16 * lane + 4 * i) = (f32x4){acc[4 * i], acc[4 * i + 1], acc[4 * i + 2], acc[4 * i + 3]};
            __syncthreads();
            if (wave == 0) {
#pragma unroll
                for (int i = 0; i < 16; ++i) acc[i] = 0.f;
#pragma unroll
                for (int w = 0; w < 8; ++w)
#pragma unroll
                    for (int i = 0; i < 4; ++i) { const f32x4 t = *(const LAS f32x4*)(s_ff + w * 1024 + 16 * lane + 4 * i); acc[4 * i] += t[0]; acc[4 * i + 1] += t[1]; acc[4 * i + 2] += t[2]; acc[4 * i + 3] += t[3]; }
            }
        }
        if (!coop || wave == 0) {
            float x1[16], g2[16];
            const float* gr = p.MOD + (size_t)seq_of(row) * 6144 + 5120 + 16 * lane;
#pragma unroll
            for (int i = 0; i < 4; ++i) { const f32x4 a = zr[i], b = *(const f32x4*)(gr + 4 * i);
                const f32x4 lw = *(const f32x4*)(p.ln1_w + 16 * lane + 4 * i), lb = *(const f32x4*)(p.ln1_b + 16 * lane + 4 * i);
#pragma unroll
                for (int j = 0; j < 4; ++j) { x1[4 * i + j] = (a[j] - mean1) * rstd1 * lw[j] + lb[j]; g2[4 * i + j] = b[j]; } }
#pragma unroll
            for (int i = 0; i < 16; ++i) acc[i] = DN_ALPHA * x1[i] + g2[i] * acc[i];
            float mean, rstd; row_stats(acc, mean, rstd);
            float* yo = (row < NTP ? p.out + OFF_YP + R * D : p.out + OFF_YS + (size_t)(row - NTP) * D) + 16 * lane;
#pragma unroll
            for (int i = 0; i < 4; ++i) { const f32x4 w = *(const f32x4*)(p.ln2_w + 16 * lane + 4 * i), b = *(const f32x4*)(p.ln2_b + 16 * lane + 4 * i);
                f32x4 o;
#pragma unroll
                for (int j = 0; j < 4; ++j) o[j] = (acc[4 * i + j] - mean) * rstd * w[j] + b[j];
                *(f32x4*)(yo + 4 * i) = o; }
        }
        if (coop) __syncthreads();
    }
}

__device__ __forceinline__ void phase_z1_bypass(const Params& p, int bid, int nb) {
    int tid_ = threadIdx.x; asm volatile("" : "+v"(tid_));
    const int wave = tid_ >> 6, lane = tid_ & 63;
    for (int row = bid * 8 + wave; row < NT; row += nb * 8) {
        float v[16]; load_row16(x_row(p, row), lane, v);
#pragma unroll
        for (int i = 0; i < 16; ++i) v[i] *= DN_ALPHA;
        store_row16_f32(p.Z1 + (size_t)row * D, lane, v);
    }
}

#define DYN_LDS extern __shared__ __attribute__((aligned(16))) unsigned char shm_[]; LAS unsigned char* lds = (LAS unsigned char*)shm_;
template <class Epi> __device__ __forceinline__ void run_gemm(LAS unsigned char* lds, const bf16_t* A, const bf16_t* Bt, int M, int N, int K, const Epi& E) {
    int Ko = K; asm volatile("" : "+s"(Ko));
    pg8::StaticOrder S; S.init(M, N, (int)gridDim.x, (int)blockIdx.x);
    pg8::Gemm g{A, Bt, M, N, Ko};
    pg8::gemm_phase<Epi, pg8::StaticOrder, false>(lds, g, S, E, nullptr);
    __syncthreads();
}

template <class Epi> __device__ __forceinline__ void skinny_gemm(const bf16_t* __restrict__ A, const bf16_t* __restrict__ Bt, int N, int K, const Epi& E, int ushift) {
    int tid_ = threadIdx.x; asm volatile("" : "+v"(tid_));
    const int wave = tid_ >> 6, lane = tid_ & 63, r = lane & 31, hh = lane >> 5, rt = wave & 3, ct = wave >> 2;
    const int nb = (int)gridDim.x, vb = ((int)blockIdx.x + nb - (ushift % nb)) % nb;
    const int perm = 16 * ((r >> 2) & 1) + 4 * (r >> 3) + (r & 3);
    for (int u = vb; u < N / 64; u += nb) {
        int arow = NTP + 32 * rt + r; asm volatile("" : "+v"(arow));
        const bf16_t* ap = A + (size_t)arow * K + 8 * hh;
        const bf16_t* bp = Bt + (size_t)(u * 64 + 32 * ct + perm) * K + 8 * hh;
        f32x16 acc = zero16();
        for (int k0 = 0; k0 < K / 16; k0 += 8) {
            bf16x8 wa[8], xa[8];
#pragma unroll
            for (int i = 0; i < 8; ++i) { wa[i] = ld_frag_g(bp + 16 * (k0 + i)); xa[i] = ld_frag_g(ap + 16 * (k0 + i)); }
            __builtin_amdgcn_sched_barrier(0);
#pragma unroll
            for (int i = 0; i < 8; ++i) acc = mfma32(wa[i], xa[i], acc);
            __builtin_amdgcn_sched_barrier(0);
        }
        float v[16];
#pragma unroll
        for (int i = 0; i < 16; ++i) v[i] = acc[i];
        E.emit16(NTP + 32 * rt + r, u * 64 + 32 * ct + 16 * hh, v);
    }
}
__global__ void __launch_bounds__(NTHREADS, 2) k_mega(Params p) {
    DYN_LDS;
    volatile LAS unsigned* st = (volatile LAS unsigned*)(lds + LDS_BYTES - 16);
    if (threadIdx.x == 0) { st[0] = 0u; st[1] = 0u; st[2] = 0u; st[3] = 0u; }
    __syncthreads();
    const XcdBarrier bar = xcd_barrier_post(p.bar, st);
    const int bid = blockIdx.x, nb = gridDim.x;
    phase_prologue<0>(p, bid, nb, lds, 0);
    xcd_barrier(bar);
    run_gemm(lds, p.SC, p.WADA_T, 256, 6144, 1024, pg8::EpiF32{p.MOD, 6144, p.b_ada});
    phase_prologue<1>(p, bid, nb, lds, nb > 48 ? 24 : 0);
    xcd_barrier(bar);
    phase_lnmod1(p, bid, nb);
    xcd_barrier(bar);
    { const EpiProj E{p.QKVA, p.QKB, p.VBB, p.RB, p.GA, p.GB, p.GLR, p.out}; run_gemm(lds, p.H, p.WIN_T, NTP, NPROJ, 1024, E); skinny_gemm(p.H, p.WIN_T, NPROJ, 1024, E, 0); }
    xcd_barrier(bar);
    phase_gla2_passA(p, bid, nb, lds);
    phase_attn_prompt(p, bid, nb, lds);
    phase_attn_sample(p, bid, nb, lds);
    phase_gla_sample(p, bid, nb, lds);
    xcd_barrier(bar);
    phase_gla2_scan(p, bid, nb);
    xcd_barrier(bar);
    phase_gla2_passC(p, bid, nb, lds);
    phase_merge_prep(p, bid, nb);
    xcd_barrier(bar);
    { const EpiGate<0> E{p.TMP1, p.GA, nullptr, 1024}; run_gemm(lds, p.OA, p.WBRA_T, NTP, 1024, 256, E); skinny_gemm(p.OA, p.WBRA_T, 1024, 256, E, 0); }
    xcd_barrier(bar);
    { const EpiGate<1> E{p.MERGED, p.GB, p.TMP1, 1024}; run_gemm(lds, p.OB, p.WBRB_T, NTP, 1024, 1024, E); skinny_gemm(p.OB, p.WBRB_T, 1024, 1024, E, 64); }
    xcd_barrier(bar);
    { const EpiOut E{p.Z1, p.x_prompt, p.x_sample, p.MOD}; run_gemm(lds, p.MERGED, p.WOUT_T, NTP, 1024, 1024, E); skinny_gemm(p.MERGED, p.WOUT_T, 1024, 1024, E, 128); }
    xcd_barrier(bar);
    phase_ln1(p, bid, nb);
    xcd_barrier(bar);
    { const EpiQvf E{p.QV}; run_gemm(lds, p.H, p.WPQ_T, NTP, 2048, 1024, E); skinny_gemm(p.H, p.WPQ_T, 2048, 1024, E, 192); }
    xcd_barrier(bar);
    phase_peer_select(p, bid, nb, lds);
    xcd_barrier(bar);
    phase_peer_upass<0>(p, bid, nb, lds, p.EW);
#ifdef UP_PROBE
    xcd_barrier(bar);
    phase_peer_upass<UP_PROBE>(p, bid, nb, lds, (float*)p.TMP1);
#endif
    xcd_barrier(bar);
    phase_peer_gather(p, bid, nb, lds);
}

static inline size_t align_up(size_t v, size_t a) { return (v + a - 1) / a * a; }

extern "C" void kernel_launch(void* const* d_in, const int* in_sizes, int n_in, void* d_out, int out_size, void* d_ws, size_t ws_size, hipStream_t stream) {
    (void)in_sizes; (void)n_in; (void)out_size;
    Params p; memset(&p, 0, sizeof(p));
    const float* const* in = (const float* const*)d_in;
    p.x_prompt = in[0]; p.x_sample = in[1]; p.c_prompt = in[2]; p.c_sample = in[3]; p.cache128 = in[4]; p.cache512 = in[5]; p.cache2048 = in[6]; p.state_gla = in[7];
    p.w_ada = in[8]; p.b_ada = in[9]; p.w_in = in[10]; p.w_gla_up = in[11]; p.b_gla = in[12]; p.gla_norm_w = in[13]; p.w_br_a = in[14]; p.w_br_b = in[15]; p.w_out = in[16];
    p.ln1_w = in[17]; p.ln1_b = in[18]; p.w_pq = in[19]; p.peer_k1 = in[20]; p.peer_k2 = in[21]; p.peer_u = in[22]; p.peer_v = in[23]; p.ln2_w = in[24]; p.ln2_b = in[25];
    p.out = (float*)d_out;
    size_t off = 0; char* ws = (char*)d_ws;
#define CARVE(field, type, count) do { p.field = (type*)(ws + off); off = align_up(off + (size_t)(count) * sizeof(type), 256); } while (0)
    CARVE(bar, unsigned, 4096);
    CARVE(MOD, float, 256 * 6144); CARVE(SC, bf16_t, 256 * 1024); CARVE(WADA_T, bf16_t, 6144 * 1024); CARVE(WIN_T, bf16_t, (size_t)NPROJ * 1024);
    CARVE(WBRA_T, bf16_t, 1024 * 256); CARVE(WBRB_T, bf16_t, 1024 * 1024); CARVE(WOUT_T, bf16_t, 1024 * 1024); CARVE(WPQ_T, bf16_t, 2048 * 1024);
    CARVE(KF, bf16_t, 2 * 8 * 128 * 128); CARVE(U8, unsigned char, (size_t)16384 * 2048); p.V8 = p.U8 + 1024; CARVE(SU, float, 16384); CARVE(SV, float, 16384);
    CARVE(H, bf16_t, (size_t)MP * 1024); CARVE(QKVA, bf16_t, (size_t)MP * 2304); CARVE(QKB, bf16_t, (size_t)MP * 1024); CARVE(VBB, bf16_t, (size_t)MP * 1024);
    CARVE(RB, bf16_t, (size_t)MP * 1024); CARVE(GA, bf16_t, (size_t)MP * 1024); CARVE(GB, bf16_t, (size_t)MP * 1024); CARVE(GLR, float, (size_t)MP * 16);
    CARVE(OG, bf16_t, (size_t)MP * 768); CARVE(LSE, float, (size_t)MP * 12);
    CARVE(LSEG, float, (size_t)256 * 32768); CARVE(SSEG, float, (size_t)256 * 32768); CARVE(DSEG, float, (size_t)256 * 128); CARVE(OGLA, bf16_t, (size_t)MP * 1024);
    CARVE(OA, bf16_t, (size_t)MP * 256); CARVE(OB, bf16_t, (size_t)MP * 1024); CARVE(TMP1, bf16_t, (size_t)MP * 1024); CARVE(MERGED, bf16_t, (size_t)MP * 1024);
    CARVE(Z1, float, (size_t)MP * 1024); CARVE(LNST, float, (size_t)MP * 2); CARVE(QV, bf16_t, (size_t)MP * 2048); CARVE(EIDX, int, (size_t)MP * 128); CARVE(EGW, float, (size_t)MP * 128); CARVE(ESU, float, (size_t)MP * 128); CARVE(EW, float, (size_t)MP * 128); CARVE(H8, unsigned char, (size_t)MP * 1024); CARVE(HS, float, (size_t)MP);
    if (off > ws_size) { fprintf(stderr, "kernel_launch: workspace too small: need %zu, have %zu\n", off, ws_size); return; }

    static int grid = 0;
    if (!grid) {
        int dev = 0, cus = 0; (void)hipGetDevice(&dev); (void)hipDeviceGetAttribute(&cus, hipDeviceAttributeMultiprocessorCount, dev);
        grid = cus > 0 ? cus : 256;
        (void)hipFuncSetAttribute((const void*)k_mega, hipFuncAttributeMaxDynamicSharedMemorySize, LDS_BYTES);
        int per_cu = 0;
        if (hipOccupancyMaxActiveBlocksPerMultiprocessor(&per_cu, (const void*)k_mega, NTHREADS, LDS_BYTES) != hipSuccess || per_cu < 1)
            fprintf(stderr, "kernel_launch: occupancy query reports %d workgroups per CU for the persistent kernel\n", per_cu);
    }
    (void)hipMemsetAsync(p.bar, 0, 4096 * sizeof(unsigned), stream);
    hipLaunchKernelGGL(k_mega, dim3(grid), dim3(NTHREADS), LDS_BYTES, stream, p);
}
```

```cpp
#include <hip/hip_runtime.h>
#include <stdint.h>
#include <stdio.h>
#include <string.h>
#include <type_traits>
namespace pg8 {
#define PG8_LAS __attribute__((address_space(3)))
typedef unsigned short bf16_t;
typedef short bf16x8 __attribute__((ext_vector_type(8)));
typedef float f32x4 __attribute__((ext_vector_type(4)));
typedef unsigned u32x4 __attribute__((ext_vector_type(4)));
constexpr int BM = 256, BK = 64, HALF = 128, HTB = HALF * BK * 2  , STAGE_BYTES = 8 * HTB, NXCD = 8, WGM = 8;

__host__ __device__ __forceinline__ int lds_byte(int r, int c) { const int st = (r >> 4) * 2 + (c >> 5), rr = r & 15, cc = c & 31, ob = rr * 64 + cc * 2; return st * 1024 + (ob ^ (((ob >> 9) & 1) << 5)); }
__host__ __device__ __forceinline__ void stage_rc(int b, int& R, int& C) { const int st = b / 1024, sb = b % 1024, swz = sb ^ (((sb >> 9) & 1) << 5); R = (st >> 1) * 16 + swz / 64; C = (st & 1) * 32 + (swz % 64) / 2; }
__host__ __device__ __forceinline__ int perm32(int rho) { const int n = rho >> 4, i = rho & 15; return 8 * (i >> 2) + 4 * n + (i & 3); }

struct Unit { int pm, pn; };
struct Gemm { const bf16_t* A; const bf16_t* Bt; int M, N, K; };

struct StaticOrder {
    int nM, nN, nwg, G, c;
    __host__ __device__ void init(int M, int N, int G_, int c_) { nM = M / BM; nN = N / BM; nwg = nM * nN; G = G_; c = c_; }
    __host__ __device__ bool next(int i, Unit& u) const {
        const long L = (long)i * G + c; if (L >= nwg) return false;
        int wgid = (int)L; { const int q = nwg / NXCD, r = nwg % NXCD, xcd = wgid % NXCD, off = wgid / NXCD; wgid = (xcd < r ? xcd * (q + 1) : r * (q + 1) + (xcd - r) * q) + off; }
        const int nig = WGM * nN, gid = wgid / nig, fm = gid * WGM, gsz = (nM - fm) < WGM ? (nM - fm) : WGM;
        u.pm = fm + ((wgid % nig) % gsz); u.pn = (wgid % nig) / gsz; return true;
    }
    __device__ __forceinline__ void a_ready(const Unit&) const {}
    __device__ __forceinline__ void done(const Unit&) const {}
};
__device__ __forceinline__ unsigned cvt_pk_bf16(float lo, float hi) { unsigned r; asm volatile("v_cvt_pk_bf16_f32 %0, %1, %2" : "=v"(r) : "v"(lo), "v"(hi)); return r; }
typedef float f32x2 __attribute__((ext_vector_type(2)));
struct EpiF32 {
    static constexpr bool PERM = false, AFTER_DRAIN = false;
    float* C; int ldc; const float* bias;
    __device__ __forceinline__ void operator()(const f32x4 (&acc)[2][2][4][2], const Unit& u, int wr, int wc, int fr, int fq) const {
        const int row0 = u.pm * BM + wr * 64 + fr, col0 = u.pn * BM + wc * 32 + 4 * fq;
        f32x4 bv[2][2];
#pragma unroll
        for (int bj = 0; bj < 2; ++bj)
#pragma unroll
            for (int n = 0; n < 2; ++n) bv[bj][n] = bias ? *(const f32x4*)(bias + col0 + bj * HALF + n * 16) : (f32x4){0.f, 0.f, 0.f, 0.f};
#pragma unroll
        for (int ai = 0; ai < 2; ++ai)
#pragma unroll
            for (int m = 0; m < 4; ++m) { float* rowp = C + (size_t)(row0 + ai * HALF + m * 16) * ldc + col0;
#pragma unroll
                for (int bj = 0; bj < 2; ++bj)
#pragma unroll
                    for (int n = 0; n < 2; ++n) *(f32x4*)(rowp + bj * HALF + n * 16) = acc[ai][bj][m][n] + bv[bj][n]; }
    }
};
template <class Epi, class Sched, bool STAMP = false>
__device__ __forceinline__ void gemm_phase(PG8_LAS unsigned char* lds, const Gemm g, const Sched& S, const Epi& E, unsigned long long* stamps) {
    int tid_o = threadIdx.x; asm volatile("" : "+v"(tid_o));
    const int tid = tid_o, wid = __builtin_amdgcn_readfirstlane(tid >> 6), lane = tid & 63, wr = wid >> 2, wc = wid & 3, fr = lane & 15, fq = lane >> 4;
    const int K = g.K, nt = K / BK;
    int ts_lo = 0, ts_hi = 0, nts = 0; const unsigned long long rt_entry = STAMP ? (unsigned long long)wall_clock64() : 0ull;
#define PG8_STAMP() do { if (STAMP && wid == 0 && nts < 64) { const unsigned long long _c = (unsigned long long)clock64(); \
        ts_lo = (lane == nts) ? (int)(unsigned)_c : ts_lo; ts_hi = (lane == nts) ? (int)(unsigned)(_c >> 32) : ts_hi; ++nts; } } while (0)
    PG8_STAMP();
    unsigned voffA[2], voffB[2];
#pragma unroll
    for (int i = 0; i < 2; ++i) { int R, C; stage_rc(tid * 16 + i * 8192, R, C); const int Rb = Epi::PERM ? ((R & ~31) + perm32(R & 31)) : R;
        voffA[i] = (unsigned)(R * K + C) * 2u; voffB[i] = (unsigned)(Rb * K + C) * 2u; }
    const size_t kstep = (size_t)(BK * 2);
    const size_t hstep = (size_t)HALF * K * 2;
    const size_t tstep = 2 * hstep;
    const unsigned ldsw = (unsigned)wid * 1024u;
    const int aoff = lds_byte(wr * 64 + fr, fq * 8), boff = lds_byte(wc * 32 + fr, fq * 8);
#define PG8_SA(b, h) (((b) * 2 + (h)) * HTB)
#define PG8_SB(b, h) ((4 + (b) * 2 + (h)) * HTB)
#define PG8_STAGE(bufoff, gbase, voff) do { _Pragma("unroll") for (int _i = 0; _i < 2; ++_i) \
        __builtin_amdgcn_global_load_lds((const unsigned*)((const char*)(gbase) + (voff)[_i]), (PG8_LAS unsigned*)(lds + (bufoff) + ldsw + _i * 8192), 16, 0, 0); } while (0)
#define PG8_LDA(dst, b, h) do { _Pragma("unroll") for (int m = 0; m < 4; ++m) _Pragma("unroll") for (int k = 0; k < 2; ++k) dst[m][k] = *(const PG8_LAS bf16x8*)(lds + PG8_SA(b, h) + aoff + m * 2048 + k * 1024); } while (0)
#define PG8_LDB(dst, b, h) do { _Pragma("unroll") for (int n = 0; n < 2; ++n) _Pragma("unroll") for (int k = 0; k < 2; ++k) dst[n][k] = *(const PG8_LAS bf16x8*)(lds + PG8_SB(b, h) + boff + n * 2048 + k * 1024); } while (0)
#define PG8_MMA(ai, bj, At, Bt) do { __builtin_amdgcn_s_setprio(1); _Pragma("unroll") for (int m = 0; m < 4; ++m) _Pragma("unroll") for (int n = 0; n < 2; ++n) _Pragma("unroll") for (int k = 0; k < 2; ++k) \
        acc[ai][bj][m][n] = __builtin_amdgcn_mfma_f32_16x16x32_bf16(Bt[n][k], At[m][k], acc[ai][bj][m][n], 0, 0, 0); __builtin_amdgcn_s_setprio(0); } while (0)
#define PG8_WAIT_V(n) asm volatile("s_waitcnt vmcnt(" #n ")" ::: "memory")
#define PG8_WAIT_L(n) asm volatile("s_waitcnt lgkmcnt(" #n ")" ::: "memory")
#define PG8_BAR __builtin_amdgcn_s_barrier()
#define PG8_SCHED __builtin_amdgcn_sched_barrier(0)
    Unit cur, nxt; int ui = 0;
    if (!S.next(0, cur)) return;
    f32x4 acc[2][2][4][2];
#pragma unroll
    for (int a = 0; a < 2; ++a)
#pragma unroll
        for (int b = 0; b < 2; ++b)
#pragma unroll
            for (int m = 0; m < 4; ++m)
#pragma unroll
                for (int n = 0; n < 2; ++n) acc[a][b][m][n] = (f32x4){0.f, 0.f, 0.f, 0.f};
    bf16x8 At[4][2], B0[2][2], B1[2][2];
    const char* cA = (const char*)g.A + (size_t)cur.pm * tstep; const char* cB = (const char*)g.Bt + (size_t)cur.pn * tstep;
    S.a_ready(cur);
    PG8_STAGE(PG8_SB(0, 0), cB, voffB); PG8_STAGE(PG8_SA(0, 0), cA, voffA); PG8_STAGE(PG8_SB(0, 1), cB + hstep, voffB); PG8_STAGE(PG8_SA(0, 1), cA + hstep, voffA);
    if (wr == 1) PG8_BAR;
    PG8_WAIT_V(4); PG8_BAR;
    PG8_STAGE(PG8_SB(1, 0), cB + kstep, voffB); PG8_STAGE(PG8_SA(1, 0), cA + kstep, voffA); PG8_STAGE(PG8_SB(1, 1), cB + hstep + kstep, voffB);
    PG8_WAIT_V(6); PG8_BAR;
    PG8_STAMP();
    for (;;) {
        const bool has_next = S.next(ui + 1, nxt);
        const char* nA = has_next ? (const char*)g.A + (size_t)nxt.pm * tstep : cA; const char* nB = has_next ? (const char*)g.Bt + (size_t)nxt.pn * tstep : cB;
        for (int t = 0; t < nt; t += 2) {
            const bool last = (t == nt - 2);
            const char* a1 = cA + (size_t)(t + 1) * kstep;
            const char* a2 = last ? nA : cA + (size_t)(t + 2) * kstep; const char* b2 = last ? nB : cB + (size_t)(t + 2) * kstep;
            const char* a3 = a2 + kstep; const char* b3 = b2 + kstep;
            if (last && has_next) S.a_ready(nxt);
            PG8_LDB(B0, 0, 0); PG8_SCHED; PG8_LDA(At, 0, 0); PG8_STAGE(PG8_SA(1, 1), a1 + hstep, voffA);
            PG8_WAIT_L(8); PG8_BAR; PG8_WAIT_L(0); PG8_MMA(0, 0, At, B0); PG8_BAR; PG8_SCHED;
            PG8_LDB(B1, 0, 1); PG8_STAGE(PG8_SB(0, 0), b2, voffB);
            PG8_BAR; PG8_WAIT_L(0); PG8_MMA(0, 1, At, B1); PG8_BAR;
            PG8_LDA(At, 0, 1); PG8_STAGE(PG8_SA(0, 0), a2, voffA);
            PG8_BAR; PG8_WAIT_L(0); PG8_MMA(1, 0, At, B0); PG8_BAR; PG8_SCHED;
            PG8_STAGE(PG8_SB(0, 1), b2 + hstep, voffB);
            PG8_WAIT_V(6); PG8_BAR; PG8_MMA(1, 1, At, B1); PG8_BAR;
            PG8_LDB(B0, 1, 0); PG8_SCHED; PG8_LDA(At, 1, 0); PG8_STAGE(PG8_SA(0, 1), a2 + hstep, voffA);
            PG8_WAIT_L(8); PG8_BAR; PG8_WAIT_L(0); PG8_MMA(0, 0, At, B0); PG8_BAR; PG8_SCHED;
            PG8_LDB(B1, 1, 1); PG8_STAGE(PG8_SB(1, 0), b3, voffB);
            PG8_BAR; PG8_WAIT_L(0); PG8_MMA(0, 1, At, B1); PG8_BAR;
            PG8_LDA(At, 1, 1); PG8_STAGE(PG8_SA(1, 0), a3, voffA);
            PG8_BAR; PG8_WAIT_L(0); PG8_MMA(1, 0, At, B0); PG8_BAR; PG8_SCHED;
            PG8_STAGE(PG8_SB(1, 1), b3 + hstep, voffB);
            PG8_WAIT_V(6); PG8_BAR; PG8_MMA(1, 1, At, B1); PG8_BAR;
        }
        PG8_STAMP();
        if constexpr (!Epi::AFTER_DRAIN) { E(acc, cur, wr, wc, fr, fq); S.done(cur); }
        PG8_STAMP();
        if (!has_next) break;
#pragma unroll
        for (int a = 0; a < 2; ++a)
#pragma unroll
            for (int b = 0; b < 2; ++b)
#pragma unroll
                for (int m = 0; m < 4; ++m)
#pragma unroll
                    for (int n = 0; n < 2; ++n) acc[a][b][m][n] = (f32x4){0.f, 0.f, 0.f, 0.f};
        cur = nxt; cA = nA; cB = nB; ++ui;
    }
    PG8_WAIT_V(0);
    if (wr == 0) PG8_BAR;
    PG8_BAR;
    if constexpr (Epi::AFTER_DRAIN) { E.fused(acc, cur, wr, wc, fr, fq, lds, wid, lane); S.done(cur); }
    PG8_STAMP();
    if (STAMP && wid == 0) { stamps[lane] = lane < nts ? (((unsigned long long)(unsigned)ts_hi << 32) | (unsigned)ts_lo) : 0ull;
        if (lane == 62) stamps[62] = rt_entry; if (lane == 63) stamps[63] = (unsigned long long)wall_clock64(); }
#undef PG8_STAMP
#undef PG8_SA
#undef PG8_SB
#undef PG8_STAGE
#undef PG8_LDA
#undef PG8_LDB
#undef PG8_MMA
#undef PG8_WAIT_V
#undef PG8_WAIT_L
#undef PG8_BAR
#undef PG8_SCHED
}
}

typedef unsigned short bf16_t;
typedef float f32x4 __attribute__((ext_vector_type(4)));
typedef float f32x16 __attribute__((ext_vector_type(16)));
typedef short bf16x8 __attribute__((ext_vector_type(8)));
typedef unsigned u32x4 __attribute__((ext_vector_type(4)));
typedef unsigned u32x2 __attribute__((ext_vector_type(2)));
#define LAS __attribute__((address_space(3)))

constexpr int D = 1024, BP = 2, T = 16384, NTP = BP * T  , NS = 128, NT = NTP + NS  , MP = 33024  ;
constexpr int NPROJ = 7680;
constexpr int NTHREADS = 512;
constexpr int LDS_BYTES = 155648;
constexpr float LN_EPS = 1e-5f;
constexpr float DN_ALPHA = 1.189207115002721f;

constexpr size_t OFF_YP = 0;
constexpr size_t OFF_YS = OFF_YP + (size_t)NTP * D;
constexpr size_t OFF_KVP0 = OFF_YS + (size_t)NS * D;
constexpr size_t OFF_KVP1 = OFF_KVP0 + (size_t)BP * 128 * 512;
constexpr size_t OFF_KVP2 = OFF_KVP1 + (size_t)BP * 512 * 512;
constexpr size_t OFF_GLAP = OFF_KVP2 + (size_t)BP * 2048 * 512;
constexpr size_t OFF_KVS0 = OFF_GLAP + (size_t)BP * 4 * 128 * 256;
constexpr size_t OFF_KVS1 = OFF_KVS0 + (size_t)NS * 128 * 512;
constexpr size_t OFF_KVS2 = OFF_KVS1 + (size_t)NS * 512 * 512;
constexpr size_t OFF_GLAS = OFF_KVS2 + (size_t)NS * 2048 * 512;
constexpr size_t OUT_TOTAL = OFF_GLAS + (size_t)NS * 4 * 128 * 256;

struct Params {
    const float *x_prompt, *x_sample, *c_prompt, *c_sample, *cache128, *cache512, *cache2048, *state_gla;
    const float *w_ada, *b_ada, *w_in, *w_gla_up, *b_gla, *gla_norm_w, *w_br_a, *w_br_b, *w_out, *ln1_w, *ln1_b;
    const float *w_pq, *peer_k1, *peer_k2, *peer_u, *peer_v, *ln2_w, *ln2_b;
    float* out;
    unsigned* bar;
    float* MOD; bf16_t* SC; bf16_t* WADA_T; bf16_t* WIN_T; bf16_t* WBRA_T; bf16_t* WBRB_T; bf16_t* WOUT_T; bf16_t* WPQ_T;
    bf16_t* KF; unsigned char* U8; unsigned char* V8; float* SU; float* SV;
    bf16_t* H; bf16_t* QKVA; bf16_t* QKB; bf16_t* VBB; bf16_t* RB; bf16_t* GA; bf16_t* GB; float* GLR;
    bf16_t* OG; float* LSE; float* LSEG; float* DSEG; float* SSEG; bf16_t* OGLA;
    bf16_t* OA; bf16_t* OB; bf16_t* TMP1; bf16_t* MERGED; float* Z1; float* LNST; bf16_t* QV; int* EIDX; float* EGW; float* ESU; float* EW; unsigned char* H8; float* HS;
};

__device__ __forceinline__ float bf2f(bf16_t v) { return __uint_as_float(((unsigned)v) << 16); }
__device__ __forceinline__ float bflo(unsigned w) { return __uint_as_float(w << 16); }
__device__ __forceinline__ float bfhi(unsigned w) { return __uint_as_float(w & 0xffff0000u); }
typedef __bf16 v2bf_t __attribute__((ext_vector_type(2)));
typedef float v2f_t __attribute__((ext_vector_type(2)));
__device__ __forceinline__ unsigned pack2(float lo, float hi) { const v2f_t f = {lo, hi}; const v2bf_t b = __builtin_convertvector(f, v2bf_t); return __builtin_bit_cast(unsigned, b); }
__device__ __forceinline__ bf16_t f2bf(float f) { return (bf16_t)(pack2(f, 0.f) & 0xffffu); }
__device__ __forceinline__ void unpack8(const u32x4 w, float (&o)[8]) { o[0] = bflo(w.x); o[1] = bfhi(w.x); o[2] = bflo(w.y); o[3] = bfhi(w.y); o[4] = bflo(w.z); o[5] = bfhi(w.z); o[6] = bflo(w.w); o[7] = bfhi(w.w); }
__device__ __forceinline__ float wave_sum(float v) {
#pragma unroll
    for (int o = 32; o >= 1; o >>= 1) v += __shfl_xor(v, o);
    return v;
}
__device__ __forceinline__ float wave_max(float v) {
#pragma unroll
    for (int o = 32; o >= 1; o >>= 1) v = fmaxf(v, __shfl_xor(v, o));
    return v;
}
#define DPP_ROR_F(v, n) __builtin_bit_cast(float, __builtin_amdgcn_update_dpp(0, __builtin_bit_cast(int, (v)), 0x120 + (n), 0xf, 0xf, true))
__device__ __forceinline__ float dpp_row_sum(float v) {
    v += DPP_ROR_F(v, 8); v += DPP_ROR_F(v, 4); v += DPP_ROR_F(v, 2); v += DPP_ROR_F(v, 1); return v;
}
__device__ __forceinline__ float sigmoidf_(float x) { return __builtin_amdgcn_rcpf(1.0f + __expf(-x)); }
__device__ __forceinline__ float siluf_(float x) { return x * __builtin_amdgcn_rcpf(1.0f + __expf(-x)); }
#define XB_TMO      128
#define XB_XCNT(j)  (256  + 64 * (j))
#define XB_XSUB(j)  (1280 + 64 * (j))
#define XB_XGEN(j)  (2304 + 64 * (j))
#define XB_TOP      3328
#define XB_TOPGEN   3392
#define XCD_BAR_WORDS 3456
#define XB_SPIN_CAP (1u << 22)

__device__ __forceinline__ unsigned xb_ld(unsigned* p)              { return __hip_atomic_load(p, __ATOMIC_RELAXED, __HIP_MEMORY_SCOPE_AGENT); }
__device__ __forceinline__ unsigned xb_add(unsigned* p, unsigned v) { return __hip_atomic_fetch_add(p, v, __ATOMIC_RELAXED, __HIP_MEMORY_SCOPE_AGENT); }
__device__ __forceinline__ unsigned xb_xcc_id() { return (unsigned)__builtin_amdgcn_s_getreg((3 << 11) | 20) & 0xFu; }
#define XB_SPIN(cond, bar) do { unsigned _sp = 0; while (cond) { __builtin_amdgcn_s_sleep(1); \
    if ((++_sp & 255u) == 0u) { if (xb_ld(&(bar)[XB_TMO])) break; if (_sp > XB_SPIN_CAP) { atomicAdd(&(bar)[XB_TMO], 1u); break; } } } } while (0)

struct XcdBarrier {
    unsigned* bar; unsigned x;
    volatile LAS unsigned* st;
};

__device__ __forceinline__ XcdBarrier xcd_barrier_post(unsigned* bar, volatile LAS unsigned* st) {
    XcdBarrier b; b.bar = bar; b.x = xb_xcc_id(); b.st = st;
    if (threadIdx.x == 0) (void)xb_add(&bar[XB_XCNT(b.x)], 1u);
    return b;
}
__device__ __forceinline__ void xcd_barrier_complete(unsigned* bar, unsigned x, unsigned& nloc, unsigned& nx) {
    const unsigned G = gridDim.x * gridDim.y * gridDim.z;
    unsigned sum, cnt, mine, sp = 0u;
    for (;;) {
        sum = 0u; cnt = 0u; mine = 0u;
#pragma unroll
        for (unsigned j = 0; j < 16; ++j) { const unsigned c = xb_ld(&bar[XB_XCNT(j)]); sum += c; cnt += (c > 0u) ? 1u : 0u; mine = (j == x) ? c : mine; }
        if (sum == G) break;
        __builtin_amdgcn_s_sleep(1);
        if ((++sp & 255u) == 0u) { if (xb_ld(&bar[XB_TMO])) break; if (sp > XB_SPIN_CAP) { atomicAdd(&bar[XB_TMO], 1u); break; } }
    }
    nloc = mine > 0u ? mine : 1u; nx = cnt > 0u ? cnt : 1u;
}

__device__ __forceinline__ void xcd_barrier(const XcdBarrier& b) {
    asm volatile("s_waitcnt vmcnt(0)" ::: "memory");
    __syncthreads();
    if (threadIdx.x == 0) {
        unsigned* bar = b.bar;
        __builtin_amdgcn_s_waitcnt(0);
        unsigned nloc = b.st[0], nx = b.st[1];
        if (nloc == 0u) { xcd_barrier_complete(bar, b.x, nloc, nx); b.st[0] = nloc; b.st[1] = nx; }
        const unsigned old = xb_add(&bar[XB_XSUB(b.x)], 1u);
        const unsigned gen = old / nloc;
        if (old + 1u == (gen + 1u) * nloc) {
            __builtin_amdgcn_fence(__ATOMIC_RELEASE, "agent");
            asm volatile("s_waitcnt vmcnt(0)" ::: "memory");
            const unsigned og = xb_add(&bar[XB_TOP], 1u);
            const unsigned tg = og / nx;
            if (og + 1u == (tg + 1u) * nx) xb_add(&bar[XB_TOPGEN], 1u);
            else XB_SPIN(xb_ld(&bar[XB_TOPGEN]) == tg, bar);
            __builtin_amdgcn_fence(__ATOMIC_ACQUIRE, "agent");
            xb_add(&bar[XB_XGEN(b.x)], 1u);
            asm volatile("s_waitcnt vmcnt(0)" ::: "memory");
        } else {
            XB_SPIN(xb_ld(&bar[XB_XGEN(b.x)]) == gen, bar);
            __builtin_amdgcn_fence(__ATOMIC_ACQUIRE, "agent");
            asm volatile("s_waitcnt vmcnt(0)" ::: "memory");
        }
    }
    __syncthreads();
}

__device__ __forceinline__ int win_cmap(int n) {
    if (n < 5376) return n;
    if (n < 6400) return n + 16;
    if (n < 7424) return n + 16;
    if (n < 7440) return n - 7424 + 5376;
    return -1;
}
__device__ __forceinline__ void tconv_tile(const float* __restrict__ src, int ldsrc, int K, bf16_t* __restrict__ dst, int tk, int tn, bool win, LAS float* tile) {
    int tid_ = threadIdx.x; asm volatile("" : "+v"(tid_));
    const int nl = tid_ & 63, kl0 = tid_ >> 6;
    const int n = tn * 64 + nl;
    const int sc = win ? win_cmap(n) : n;
#pragma unroll
    for (int i = 0; i < 8; ++i) { const int k = kl0 + 8 * i; tile[k * 65 + nl] = sc >= 0 ? src[(size_t)(tk * 64 + k) * ldsrc + sc] : 0.f; }
    __syncthreads();
    const int n2 = tid_ >> 3, kc = (tid_ & 7) * 8;
    u32x4 w;
    w.x = pack2(tile[(kc + 0) * 65 + n2], tile[(kc + 1) * 65 + n2]);
    w.y = pack2(tile[(kc + 2) * 65 + n2], tile[(kc + 3) * 65 + n2]);
    w.z = pack2(tile[(kc + 4) * 65 + n2], tile[(kc + 5) * 65 + n2]);
    w.w = pack2(tile[(kc + 6) * 65 + n2], tile[(kc + 7) * 65 + n2]);
    *(u32x4*)(dst + (size_t)(tn * 64 + n2) * K + tk * 64 + kc) = w;
    __syncthreads();
}
__device__ __forceinline__ void conv_chunk(const float* __restrict__ src, bf16_t* __restrict__ dst, size_t chunk) {
    int tid_ = threadIdx.x; asm volatile("" : "+v"(tid_));
    const size_t e = chunk * 4096 + (size_t)tid_ * 8;
    const f32x4 a = *(const f32x4*)(src + e), b = *(const f32x4*)(src + e + 4);
    u32x4 w; w.x = pack2(a[0], a[1]); w.y = pack2(a[2], a[3]); w.z = pack2(b[0], b[1]); w.w = pack2(b[2], b[3]);
    *(u32x4*)(dst + e) = w;
}

__device__ __forceinline__ void quant_rows8(const float* __restrict__ src, unsigned char* __restrict__ dst  , float* __restrict__ scl, int job) {
    int tid_ = threadIdx.x; asm volatile("" : "+v"(tid_));
    const int wave = tid_ >> 6, lane = tid_ & 63;
    const size_t row = (size_t)job * 8 + wave;
    const float* r = src + row * 1024 + 16 * lane;
    f32x4 x[4];
#pragma unroll
    for (int i = 0; i < 4; ++i) x[i] = *(const f32x4*)(r + 4 * i);
    float m = 0.f;
#pragma unroll
    for (int i = 0; i < 4; ++i) m = fmaxf(m, fmaxf(fmaxf(fabsf(x[i][0]), fabsf(x[i][1])), fmaxf(fabsf(x[i][2]), fabsf(x[i][3]))));
    m = wave_max(m);
    const float inv = m > 0.f ? 448.0f / m : 1.0f, sc = m > 0.f ? m * (1.0f / 448.0f) : 1.0f;
    u32x4 w;
#pragma unroll
    for (int i = 0; i < 4; ++i) {
        int d = 0;
        d = __builtin_amdgcn_cvt_pk_fp8_f32(x[i][0] * inv, x[i][1] * inv, d, false);
        d = __builtin_amdgcn_cvt_pk_fp8_f32(x[i][2] * inv, x[i][3] * inv, d, true);
        w[i] = (unsigned)d;
    }
    *(u32x4*)(dst + row * 2048 + 16 * lane) = w;
    if (lane == 0) scl[row] = sc;
}

__device__ __forceinline__ void kfrag_chunk(const float* __restrict__ k1, const float* __restrict__ k2, bf16_t* __restrict__ dst, int job) {
    int tid_ = threadIdx.x; asm volatile("" : "+v"(tid_));
    const int c = job * 512 + tid_, lane = c & 63, ks = (c >> 6) & 7, ni = (c >> 9) & 3, half = (c >> 11) & 1, h = c >> 12;
    const float* s = (half ? k2 : k1) + ((size_t)h * 128 + 32 * ni + (lane & 31)) * 128 + 16 * ks + 8 * (lane >> 5);
    const f32x4 a = *(const f32x4*)s, b = *(const f32x4*)(s + 4);
    u32x4 w; w.x = pack2(a[0], a[1]); w.y = pack2(a[2], a[3]); w.z = pack2(b[0], b[1]); w.w = pack2(b[2], b[3]);
    *(u32x4*)(dst + (size_t)c * 8) = w;
}
template <int STAGE> __device__ __forceinline__ void phase_prologue(const Params& p, int bid, int nb, LAS unsigned char* lds, int skip0) {
    int tid_ = threadIdx.x; asm volatile("" : "+v"(tid_));
    LAS float* tile = (LAS float*)lds;
    constexpr int J0 = 16 * 120, J1 = J0 + 16 * 96, J2 = J1 + 16 * 32, J3 = J2 + 256, J4 = J3 + 256, J5 = J4 + 64, J6 = J5 + 2048, J7 = J6 + 2048, J8 = J7 + 32, J9 = J8 + 32, J10 = J9 + 64;
    (void)J8;
    const int njobs = STAGE == 0 ? J1 + (J10 - J9) : J9 - J1;
    const int first = STAGE == 0 ? bid : bid - skip0, stride = STAGE == 0 ? nb : nb - skip0;
    if (first < 0 || stride <= 0) return;
    for (int jj = first; jj < njobs; jj += stride) {
        const int j = STAGE == 0 ? (jj < J1 ? jj : J9 + (jj - J1)) : J1 + jj;
        if (j < J0) { tconv_tile(p.w_in, 7440, 1024, p.WIN_T, j % 16, j / 16, true, tile); }
        else if (j < J1) { const int q = j - J0; tconv_tile(p.w_ada, 6144, 1024, p.WADA_T, q % 16, q / 16, false, tile); }
        else if (j < J2) { const int q = j - J1; tconv_tile(p.w_pq, 2048, 1024, p.WPQ_T, q % 16, q / 16, false, tile); }
        else if (j < J3) { const int q = j - J2; tconv_tile(p.w_br_b, 1024, 1024, p.WBRB_T, q % 16, q / 16, false, tile); }
        else if (j < J4) { const int q = j - J3; tconv_tile(p.w_out, 1024, 1024, p.WOUT_T, q % 16, q / 16, false, tile); }
        else if (j < J5) { const int q = j - J4; tconv_tile(p.w_br_a, 1024, 256, p.WBRA_T, q % 4, q / 4, false, tile); }
        else if (j < J6) { quant_rows8(p.peer_u, p.U8, p.SU, j - J5); }
        else if (j < J7) { quant_rows8(p.peer_v, p.U8 + 1024, p.SV, j - J6); }
        else if (j < J9) { kfrag_chunk(p.peer_k1, p.peer_k2, p.KF, j - J7); }
        else {
            const size_t e = (size_t)(j - J9) * 4096 + (size_t)tid_ * 8;
            const int row = (int)(e >> 10), col = (int)(e & 1023);
            float v[8];
#pragma unroll
            for (int i = 0; i < 8; ++i) v[i] = 0.f;
            if (row < 130) {
                const float* c = row < 2 ? p.c_prompt + (size_t)row * 1024 + col : p.c_sample + (size_t)(row - 2) * 1024 + col;
#pragma unroll
                for (int i = 0; i < 8; ++i) v[i] = siluf_(c[i]);
            }
            u32x4 w; w.x = pack2(v[0], v[1]); w.y = pack2(v[2], v[3]); w.z = pack2(v[4], v[5]); w.w = pack2(v[6], v[7]);
            *(u32x4*)(p.SC + e) = w;
        }
    }
}

__device__ __forceinline__ void row_stats(const float (&v)[16], float& mean, float& rstd) {
    float s = 0.f;
#pragma unroll
    for (int i = 0; i < 16; ++i) s += v[i];
    s = wave_sum(s);
    mean = s * (1.0f / 1024.0f);
    float q = 0.f;
#pragma unroll
    for (int i = 0; i < 16; ++i) { const float d = v[i] - mean; q += d * d; }
    q = wave_sum(q);
    rstd = rsqrtf(q * (1.0f / 1024.0f) + LN_EPS);
}
__device__ __forceinline__ void load_row16(const float* __restrict__ r, int lane, float (&v)[16]) {
    const f32x4 a = *(const f32x4*)(r + 8 * lane), b = *(const f32x4*)(r + 8 * lane + 4), c = *(const f32x4*)(r + 512 + 8 * lane), d = *(const f32x4*)(r + 512 + 8 * lane + 4);
#pragma unroll
    for (int i = 0; i < 4; ++i) { v[i] = a[i]; v[4 + i] = b[i]; v[8 + i] = c[i]; v[12 + i] = d[i]; }
}
__device__ __forceinline__ void store_row16_bf16(bf16_t* __restrict__ r, int lane, const float (&v)[16]) {
    u32x4 w0, w1;
    w0.x = pack2(v[0], v[1]); w0.y = pack2(v[2], v[3]); w0.z = pack2(v[4], v[5]); w0.w = pack2(v[6], v[7]);
    w1.x = pack2(v[8], v[9]); w1.y = pack2(v[10], v[11]); w1.z = pack2(v[12], v[13]); w1.w = pack2(v[14], v[15]);
    *(u32x4*)(r + 8 * lane) = w0; *(u32x4*)(r + 512 + 8 * lane) = w1;
}
__device__ __forceinline__ void store_row16_f32(float* __restrict__ r, int lane, const float (&v)[16]) {
    *(f32x4*)(r + 8 * lane) = (f32x4){v[0], v[1], v[2], v[3]}; *(f32x4*)(r + 8 * lane + 4) = (f32x4){v[4], v[5], v[6], v[7]};
    *(f32x4*)(r + 512 + 8 * lane) = (f32x4){v[8], v[9], v[10], v[11]}; *(f32x4*)(r + 512 + 8 * lane + 4) = (f32x4){v[12], v[13], v[14], v[15]};
}
__device__ __forceinline__ const float* x_row(const Params& p, int row) { return row < NTP ? p.x_prompt + (size_t)row * D : p.x_sample + (size_t)(row - NTP) * D; }
__device__ __forceinline__ int seq_of(int row) { return row < NTP ? (row >> 14) : 2 + (row - NTP); }

__device__ __forceinline__ void phase_lnmod1(const Params& p, int bid, int nb) {
    int tid_ = threadIdx.x; asm volatile("" : "+v"(tid_));
    const int wave = tid_ >> 6, lane = tid_ & 63;
    int row = bid * 8 + wave;
    float nx[16];
    if (row < NT) load_row16(x_row(p, row), lane, nx);
    for (; row < NT; row += nb * 8) {
        float v[16];
#pragma unroll
        for (int i = 0; i < 16; ++i) v[i] = nx[i];
        const int nrow = row + nb * 8;
        if (nrow < NT) load_row16(x_row(p, nrow), lane, nx);
        const float* mod = p.MOD + (size_t)seq_of(row) * 6144;
        float sh[16], sc[16];
        load_row16(mod, lane, sh); load_row16(mod + 1024, lane, sc);
        float mean, rstd; row_stats(v, mean, rstd);
#pragma unroll
        for (int i = 0; i < 16; ++i) v[i] = (v[i] - mean) * rstd * (1.0f + sc[i]) + sh[i];
        store_row16_bf16(p.H + (size_t)row * D, lane, v);
    }
}

struct EpiProj {
    static constexpr bool PERM = true, AFTER_DRAIN = false;
    bf16_t *QKVA, *QKB, *VBB, *RB, *GA, *GB; float* GLR; float* out;
    __device__ __forceinline__ void operator()(const pg8::f32x4 (&acc)[2][2][4][2], const pg8::Unit& u, int wr, int wc, int fr, int fq) const {
        const int pn = u.pn;
        bf16_t* dst; int ld = 1024, c0; float scale = 1.0f;
        if (pn < 9) { dst = QKVA; ld = 2304; c0 = pn * 256; }
        else if (pn < 13) { dst = QKB; c0 = (pn - 9) * 256; if (pn < 11) scale = 0.08838834764831845f; }
        else if (pn < 17) { dst = VBB; c0 = (pn - 13) * 256; }
        else if (pn < 21) { dst = RB; c0 = (pn - 17) * 256; }
        else if (pn < 25) { dst = GA; c0 = (pn - 21) * 256; }
        else if (pn < 29) { dst = GB; c0 = (pn - 25) * 256; }
        else { dst = nullptr; c0 = 0; }
        const bool kvt = pn >= 3 && pn < 9;
        const int g = kvt ? (pn - 3) % 3 : 0, kv = kvt ? (pn - 3) / 3 : 0;
        const int W = 128 << (2 * g);
        const size_t offp = g == 0 ? OFF_KVP0 : (g == 1 ? OFF_KVP1 : OFF_KVP2);
        const size_t offs = g == 0 ? OFF_KVS0 : (g == 1 ? OFF_KVS1 : OFF_KVS2);
        const int row0 = u.pm * 256 + wr * 64 + fr, colw = wc * 32 + 8 * fq;
#pragma unroll
        for (int ai = 0; ai < 2; ++ai)
#pragma unroll
            for (int m = 0; m < 4; ++m) {
                const int row = row0 + ai * 128 + m * 16;
#pragma unroll
                for (int bj = 0; bj < 2; ++bj) {
                    const int cc = bj * 128 + colw;
                    const pg8::f32x4 v0 = acc[ai][bj][m][0], v1 = acc[ai][bj][m][1];
                    if (dst) {
                        u32x4 w; w.x = pack2(v0[0] * scale, v0[1] * scale); w.y = pack2(v0[2] * scale, v0[3] * scale); w.z = pack2(v1[0] * scale, v1[1] * scale); w.w = pack2(v1[2] * scale, v1[3] * scale);
                        *(u32x4*)(dst + (size_t)row * ld + c0 + cc) = w;
                    } else if (cc < 16) {
                        *(pg8::f32x4*)(GLR + (size_t)row * 16 + cc) = v0; *(pg8::f32x4*)(GLR + (size_t)row * 16 + cc + 4) = v1;
                    }
                    if (kvt) {
                        if (row < NTP) {
                            const int b = row >> 14, t = row & (T - 1);
                            if (t >= T - W) { float* o = out + offp + ((size_t)(b * W + (t - (T - W))) * 2 + kv) * 256 + cc; *(pg8::f32x4*)o = v0; *(pg8::f32x4*)(o + 4) = v1; }
                        } else if (row < NT) {
                            const int s = row - NTP;
                            float* o = out + offs + ((size_t)(s * W + (W - 1)) * 2 + kv) * 256 + cc; *(pg8::f32x4*)o = v0; *(pg8::f32x4*)(o + 4) = v1;
                        }
                    }
                }
            }
    }
    __device__ __forceinline__ void emit16(int row, int col, const float (&v)[16]) const {
        const int pn = col >> 8, cc = col & 255;
        bf16_t* dst; int ld = 1024, c0; float scale = 1.0f;
        if (pn < 9) { dst = QKVA; ld = 2304; c0 = pn * 256; }
        else if (pn < 13) { dst = QKB; c0 = (pn - 9) * 256; if (pn < 11) scale = 0.08838834764831845f; }
        else if (pn < 17) { dst = VBB; c0 = (pn - 13) * 256; }
        else if (pn < 21) { dst = RB; c0 = (pn - 17) * 256; }
        else if (pn < 25) { dst = GA; c0 = (pn - 21) * 256; }
        else if (pn < 29) { dst = GB; c0 = (pn - 25) * 256; }
        else { dst = nullptr; c0 = 0; }
        if (dst) {
            u32x4 w0, w1;
            w0.x = pack2(v[0] * scale, v[1] * scale); w0.y = pack2(v[2] * scale, v[3] * scale); w0.z = pack2(v[4] * scale, v[5] * scale); w0.w = pack2(v[6] * scale, v[7] * scale);
            w1.x = pack2(v[8] * scale, v[9] * scale); w1.y = pack2(v[10] * scale, v[11] * scale); w1.z = pack2(v[12] * scale, v[13] * scale); w1.w = pack2(v[14] * scale, v[15] * scale);
            *(u32x4*)(dst + (size_t)row * ld + c0 + cc) = w0; *(u32x4*)(dst + (size_t)row * ld + c0 + cc + 8) = w1;
        } else if (cc == 0) {
#pragma unroll
            for (int i = 0; i < 4; ++i) *(f32x4*)(GLR + (size_t)row * 16 + 4 * i) = (f32x4){v[4 * i], v[4 * i + 1], v[4 * i + 2], v[4 * i + 3]};
        }
        if (pn >= 3 && pn < 9 && row >= NTP && row < NT) {
            const int g = (pn - 3) % 3, kv = (pn - 3) / 3, W = 128 << (2 * g), s = row - NTP;
            float* o = out + (g == 0 ? OFF_KVS0 : (g == 1 ? OFF_KVS1 : OFF_KVS2)) + ((size_t)(s * W + (W - 1)) * 2 + kv) * 256 + cc;
#pragma unroll
            for (int i = 0; i < 4; ++i) *(f32x4*)(o + 4 * i) = (f32x4){v[4 * i], v[4 * i + 1], v[4 * i + 2], v[4 * i + 3]};
        }
    }
};

__device__ __forceinline__ void phase_cache_copy(const Params& p, int bid, int nb) {
    int tid_ = threadIdx.x; asm volatile("" : "+v"(tid_));
    const size_t tid = (size_t)bid * NTHREADS + tid_, nth = (size_t)nb * NTHREADS;
#pragma unroll
    for (int g = 0; g < 3; ++g) {
        const int W = 128 << (2 * g);
        const float* src = g == 0 ? p.cache128 : (g == 1 ? p.cache512 : p.cache2048);
        float* dst = p.out + (g == 0 ? OFF_KVS0 : (g == 1 ? OFF_KVS1 : OFF_KVS2));
        const size_t per = (size_t)(W - 1) * 128, total = per * NS;
        for (size_t i = tid; i < total; i += nth) {
            const size_t s = i / per, rem = i - s * per;
            const f32x4 v = __builtin_nontemporal_load((const f32x4*)(src + (s * W + 1) * 512) + rem);
            __builtin_nontemporal_store(v, (f32x4*)(dst + s * W * 512) + rem);
        }
    }
}

__device__ __forceinline__ f32x16 mfma32(bf16x8 a, bf16x8 b, f32x16 c) { return __builtin_amdgcn_mfma_f32_32x32x16_bf16(a, b, c, 0, 0, 0); }
__device__ __forceinline__ f32x16 zero16() { f32x16 z; for (int i = 0; i < 16; ++i) z[i] = 0.f; return z; }
__device__ __forceinline__ bf16x8 ld_frag_g(const bf16_t* p) { return *(const bf16x8*)p; }
__device__ __forceinline__ bf16x8 ld_frag_l(const LAS bf16_t* p) { return *(const LAS bf16x8*)p; }
__device__ __forceinline__ int crow(int reg, int hh) { return (reg & 3) + 8 * (reg >> 2) + 4 * hh; }
__device__ __forceinline__ float log_sigmoidf_(float z) { return fminf(z, 0.f) - log1pf(__expf(-fabsf(z))); }

__device__ __forceinline__ void phase_gla_sample(const Params& p, int bid, int nb, LAS unsigned char* lds) {
    int tid_ = threadIdx.x; asm volatile("" : "+v"(tid_));
    LAS float* s_eg = (LAS float*)lds;
    LAS float* s_q = s_eg + 128;
    LAS float* s_k = s_q + 128;
    LAS float* s_o = s_k + 128;
    const int dv4 = tid_ & 63, kg = tid_ >> 6;
    for (int u = bid; u < NS * 4; u += nb) {
        const int s = u >> 2, h = u & 3;
        const size_t row = (size_t)(NTP + s);
        const float* S0 = p.state_gla + ((size_t)s * 4 + h) * 32768 + (size_t)(16 * kg) * 256 + 4 * dv4;
        float* Sn = p.out + OFF_GLAS + ((size_t)s * 4 + h) * 32768 + (size_t)(16 * kg) * 256 + 4 * dv4;
        f32x4 st[16];
#pragma unroll
        for (int i = 0; i < 16; ++i) st[i] = __builtin_nontemporal_load((const f32x4*)(S0 + i * 256));
        if (tid_ < 128) {
            const int kd = tid_; float z = p.b_gla[h * 128 + kd];
#pragma unroll
            for (int j = 0; j < 16; ++j) z += p.GLR[row * 16 + j] * p.w_gla_up[j * 512 + h * 128 + kd];
            s_eg[kd] = __expf(log_sigmoidf_(z) * (1.0f / 16.0f));
            s_q[kd] = bf2f(p.QKB[row * 1024 + h * 128 + kd]);
            s_k[kd] = bf2f(p.QKB[row * 1024 + 512 + h * 128 + kd]);
        }
        const u32x2 vw = *(const u32x2*)(p.VBB + row * 1024 + h * 256 + 4 * dv4);
        const f32x4 v4 = {bflo(vw.x), bfhi(vw.x), bflo(vw.y), bfhi(vw.y)};
        __syncthreads();
        f32x4 o = {0.f, 0.f, 0.f, 0.f};
#pragma unroll
        for (int i = 0; i < 16; ++i) {
            const int kd = 16 * kg + i;
            const f32x4 sv = st[i] * s_eg[kd] + v4 * s_k[kd];
            __builtin_nontemporal_store(sv, (f32x4*)(Sn + i * 256));
            o += sv * s_q[kd];
        }
        *(LAS f32x4*)(s_o + kg * 256 + 4 * dv4) = o;
        __syncthreads();
        float t = 0.f;
        if (tid_ < 256) {
#pragma unroll
            for (int w = 0; w < 8; ++w) t += s_o[w * 256 + tid_];
        }
        const float sq = wave_sum(t * t);
        __syncthreads();
        if ((tid_ & 63) == 0) s_o[tid_ >> 6] = sq;
        __syncthreads();
        if (tid_ < 256) {
            const float rn = rsqrtf((s_o[0] + s_o[1] + s_o[2] + s_o[3]) * (1.0f / 256.0f) + LN_EPS);
            p.OB[row * 1024 + h * 256 + tid_] = f2bf(t * rn * p.gla_norm_w[h * 256 + tid_] * siluf_(bf2f(p.RB[row * 1024 + h * 256 + tid_])));
        }
        __syncthreads();
    }
}

constexpr int G2_QP = 136;
constexpr int G2_TP = 72;
constexpr int G2_VP = 264;
typedef short v4s2_t __attribute__((ext_vector_type(4)));
constexpr int G2_BP = 132;
struct Gla2Lds {
    LAS float* glr; LAS float* tot; LAS float* dl; LAS float* bl; LAS float* bt; LAS bf16_t* qe; LAS bf16_t* ke; LAS bf16_t* kdt; LAS bf16_t* vt; LAS bf16_t* pp; LAS float* ss;
    __device__ __forceinline__ void carve(LAS unsigned char* lds) {
        glr = (LAS float*)lds; tot = glr + 1024; dl = tot + 512; bl = dl + 128; bt = bl + 128;
        qe = (LAS bf16_t*)(bt + 64 * G2_BP); ke = qe + 64 * G2_QP; kdt = ke + 64 * G2_QP; vt = kdt + 64 * G2_QP; pp = vt + 64 * G2_VP; ss = (LAS float*)(pp + 64 * G2_TP);
    }
};
struct Gla2Regs { f32x4 glr; u32x4 v[4], k[2], q[2]; };
__device__ __forceinline__ void gla2_load_chunk(const Params& p, Gla2Regs& R, int tid_, int b, int h, int c, bool need_qk) {
    const size_t row0 = (size_t)b * T + (size_t)c * 64;
    R.glr = *(const f32x4*)(p.GLR + row0 * 16 + (tid_ & 255) * 4);
#pragma unroll
    for (int i = 0; i < 4; ++i) { const int q = tid_ + 512 * i, t = q >> 5, dc = q & 31; R.v[i] = *(const u32x4*)(p.VBB + (row0 + t) * 1024 + h * 256 + dc * 8); }
#pragma unroll
    for (int i = 0; i < 2; ++i) { const int it = tid_ + 512 * i, t = it >> 4, kg = it & 15;
        R.k[i] = *(const u32x4*)(p.QKB + (row0 + t) * 1024 + 512 + h * 128 + kg * 8);
        if (need_qk) R.q[i] = *(const u32x4*)(p.QKB + (row0 + t) * 1024 + h * 128 + kg * 8); }
}
__device__ __forceinline__ float gla2_stage_chunk(const Gla2Lds& L, const Gla2Regs& R, int tid_, const float (&wup)[16], float bg, bool need_qk) {
    const int kd = tid_ >> 2, q4 = tid_ & 3;
    if (tid_ < 256) *(LAS f32x4*)(L.glr + tid_ * 4) = R.glr;
#pragma unroll
    for (int i = 0; i < 4; ++i) { const int q = tid_ + 512 * i, t = q >> 5, dc = q & 31; *(LAS u32x4*)(L.vt + t * G2_VP + dc * 8) = R.v[i]; }
    __syncthreads();
    float pre[16]; float run = 0.f;
#pragma unroll
    for (int i = 0; i < 16; ++i) {
        const int t = q4 * 16 + i; float z = bg;
#pragma unroll
        for (int j4 = 0; j4 < 4; ++j4) { const f32x4 gq = *(const LAS f32x4*)(L.glr + t * 16 + 4 * j4); z += gq[0] * wup[4 * j4] + gq[1] * wup[4 * j4 + 1] + gq[2] * wup[4 * j4 + 2] + gq[3] * wup[4 * j4 + 3]; }
        const float ls = fminf(z, 0.f) - __logf(1.0f + __expf(-fabsf(z)));
        run += ls * (1.0f / 16.0f); pre[i] = run;
    }
    const float t0 = __builtin_bit_cast(float, __builtin_amdgcn_update_dpp(0, __builtin_bit_cast(int, run), 0x00, 0xf, 0xf, true));
    const float t1 = __builtin_bit_cast(float, __builtin_amdgcn_update_dpp(0, __builtin_bit_cast(int, run), 0x55, 0xf, 0xf, true));
    const float t2 = __builtin_bit_cast(float, __builtin_amdgcn_update_dpp(0, __builtin_bit_cast(int, run), 0xaa, 0xf, 0xf, true));
    const float t3 = __builtin_bit_cast(float, __builtin_amdgcn_update_dpp(0, __builtin_bit_cast(int, run), 0xff, 0xf, 0xf, true));
    const float offs = (q4 > 0 ? t0 : 0.f) + (q4 > 1 ? t1 : 0.f) + (q4 > 2 ? t2 : 0.f), blast = (t0 + t1) + (t2 + t3);
#pragma unroll
    for (int i = 0; i < 16; ++i) L.bt[(q4 * 16 + i) * G2_BP + kd] = offs + pre[i];
    const float edl = __expf(blast);
    if (q4 == 0) { L.dl[kd] = edl; L.bl[kd] = blast; }
    __syncthreads();
#pragma unroll
    for (int i = 0; i < 2; ++i) {
        const int it = tid_ + 512 * i, t = it >> 4, kg = it & 15;
        const f32x4 b0 = *(const LAS f32x4*)(L.bt + t * G2_BP + 8 * kg), b1 = *(const LAS f32x4*)(L.bt + t * G2_BP + 8 * kg + 4);
        const f32x4 l0 = *(const LAS f32x4*)(L.bl + 8 * kg), l1 = *(const LAS f32x4*)(L.bl + 8 * kg + 4);
        const float bv[8] = {b0[0], b0[1], b0[2], b0[3], b1[0], b1[1], b1[2], b1[3]}, lv[8] = {l0[0], l0[1], l0[2], l0[3], l1[0], l1[1], l1[2], l1[3]};
        float k8[8]; unpack8(R.k[i], k8);
        { float kd8[8];
#pragma unroll
          for (int e = 0; e < 8; ++e) kd8[e] = k8[e] * __expf(lv[e] - bv[e]);
          u32x4 wd; wd.x = pack2(kd8[0], kd8[1]); wd.y = pack2(kd8[2], kd8[3]); wd.z = pack2(kd8[4], kd8[5]); wd.w = pack2(kd8[6], kd8[7]);
          *(LAS u32x4*)(L.kdt + t * G2_QP + 8 * kg) = wd; }
        if (need_qk) {
            float q8[8], qo[8], ko[8]; unpack8(R.q[i], q8);
#pragma unroll
            for (int e = 0; e < 8; ++e) { const float eb = __expf(bv[e]); qo[e] = q8[e] * eb; ko[e] = k8[e] * __builtin_amdgcn_rcpf(eb); }
            u32x4 wq, wk;
            wq.x = pack2(qo[0], qo[1]); wq.y = pack2(qo[2], qo[3]); wq.z = pack2(qo[4], qo[5]); wq.w = pack2(qo[6], qo[7]);
            wk.x = pack2(ko[0], ko[1]); wk.y = pack2(ko[2], ko[3]); wk.z = pack2(ko[4], ko[5]); wk.w = pack2(ko[6], ko[7]);
            *(LAS u32x4*)(L.qe + t * G2_QP + 8 * kg) = wq; *(LAS u32x4*)(L.ke + t * G2_QP + 8 * kg) = wk;
        }
    }
    __syncthreads();
    return edl;
}
__device__ __forceinline__ bf16x8 ld_frag_tr(const LAS bf16_t* img, int pitch, int row0, int col0, int lane) {
    const int i16 = lane & 15, hh = lane >> 5;
    const LAS bf16_t* ap = img + (row0 + 8 * hh + (i16 >> 2)) * pitch + col0 + 16 * ((lane >> 4) & 1) + 4 * (i16 & 3);
    union { bf16x8 v; v4s2_t h2[2]; } f;
    f.h2[0] = __builtin_amdgcn_ds_read_tr16_b64_v4i16((LAS v4s2_t*)ap);
    f.h2[1] = __builtin_amdgcn_ds_read_tr16_b64_v4i16((LAS v4s2_t*)(ap + 4 * pitch));
    return f.v;
}
__device__ __forceinline__ void gla2_update_state(const Gla2Lds& L, f32x16 (&S)[4], int wave, int lane) {
    const int hh = lane >> 5;
    bf16x8 vf[4];
#pragma unroll
    for (int ks = 0; ks < 4; ++ks) vf[ks] = ld_frag_tr(L.vt, G2_VP, 16 * ks, 32 * wave, lane);
#pragma unroll
    for (int mi = 0; mi < 4; ++mi) {
#pragma unroll
        for (int g4 = 0; g4 < 4; ++g4) {
            const f32x4 d = *(const LAS f32x4*)(L.dl + 32 * mi + 8 * g4 + 4 * hh);
#pragma unroll
            for (int j = 0; j < 4; ++j) S[mi][4 * g4 + j] *= d[j];
        }
#pragma unroll
        for (int ks = 0; ks < 4; ++ks) S[mi] = mfma32(ld_frag_tr(L.kdt, G2_QP, 16 * ks, 32 * mi, lane), vf[ks], S[mi]);
    }
}
__device__ __forceinline__ void phase_gla2_passA(const Params& p, int bid, int nb, LAS unsigned char* lds) {
    int tid_ = threadIdx.x; asm volatile("" : "+v"(tid_));
    Gla2Lds L; L.carve(lds);
    const int wave = tid_ >> 6, lane = tid_ & 63;
    for (int u = bid; u < 256; u += nb) {
        const int bh = u >> 5, seg = u & 31, b = bh >> 2, h = bh & 3;
        float wup[16];
#pragma unroll
        for (int j = 0; j < 16; ++j) wup[j] = p.w_gla_up[j * 512 + h * 128 + (tid_ >> 2)];
        const float bg = p.b_gla[h * 128 + (tid_ >> 2)];
        f32x16 S[4];
#pragma unroll
        for (int mi = 0; mi < 4; ++mi) S[mi] = zero16();
        float dprod = 1.0f;
        Gla2Regs R; gla2_load_chunk(p, R, tid_, b, h, seg * 8, false);
        for (int cc = 0; cc < 8; ++cc) {
            int tq = tid_; asm volatile("" : "+v"(tq));
            dprod *= gla2_stage_chunk(L, R, tq, wup, bg, false);
            if (cc < 7) gla2_load_chunk(p, R, tq, b, h, seg * 8 + cc + 1, false);
            gla2_update_state(L, S, wave, tq & 63);
            __syncthreads();
        }
        float* dst = p.LSEG + (size_t)u * 32768 + (size_t)wave * 4096 + lane;
#pragma unroll
        for (int mi = 0; mi < 4; ++mi)
#pragma unroll
            for (int reg = 0; reg < 16; ++reg) dst[(mi * 16 + reg) * 64] = S[mi][reg];
        if ((tid_ & 3) == 0) p.DSEG[(size_t)u * 128 + (tid_ >> 2)] = dprod;
    }
}
__device__ __forceinline__ void phase_gla2_scan(const Params& p, int bid, int nb) {
    int tid_ = threadIdx.x; asm volatile("" : "+v"(tid_));
    for (int e = bid * NTHREADS + tid_; e < 8 * 32768; e += nb * NTHREADS) {
        const int bh = e >> 15, idx = e & 32767, w = idx >> 12, rem = idx & 4095, mr = rem >> 6, ln = rem & 63, mi = mr >> 4, reg = mr & 15;
        const int kd = 32 * mi + crow(reg, ln >> 5), dv = 32 * w + (ln & 31);
        float S = 0.f;
        for (int s0 = 0; s0 < 32; s0 += 8) {
            float l[8], d[8];
#pragma unroll
            for (int i = 0; i < 8; ++i) { const size_t u = (size_t)bh * 32 + s0 + i; l[i] = p.LSEG[u * 32768 + idx]; d[i] = p.DSEG[u * 128 + kd]; }
#pragma unroll
            for (int i = 0; i < 8; ++i) { const size_t u = (size_t)bh * 32 + s0 + i; p.SSEG[u * 32768 + idx] = S; S = d[i] * S + l[i]; }
        }
        p.out[OFF_GLAP + ((size_t)bh * 128 + kd) * 256 + dv] = S;
    }
}
__device__ __forceinline__ void phase_gla2_passC(const Params& p, int bid, int nb, LAS unsigned char* lds) {
    int tid_ = threadIdx.x; asm volatile("" : "+v"(tid_));
    Gla2Lds L; L.carve(lds);
    const int wave = tid_ >> 6, lane = tid_ & 63;
    for (int u = bid; u < 256; u += nb) {
        const int bh = u >> 5, seg = u & 31, b = bh >> 2, h = bh & 3;
        float wup[16];
#pragma unroll
        for (int j = 0; j < 16; ++j) wup[j] = p.w_gla_up[j * 512 + h * 128 + (tid_ >> 2)];
        const float bg = p.b_gla[h * 128 + (tid_ >> 2)];
        Gla2Regs R; gla2_load_chunk(p, R, tid_, b, h, seg * 8, true);
        f32x16 S[4];
        {
            const float* src = p.SSEG + (size_t)u * 32768 + (size_t)wave * 4096 + lane;
#pragma unroll
            for (int mi = 0; mi < 4; ++mi)
#pragma unroll
                for (int reg = 0; reg < 16; ++reg) S[mi][reg] = src[(mi * 16 + reg) * 64];
        }
        for (int cc = 0; cc < 8; ++cc) {
            const int c = seg * 8 + cc, row0 = b * T + c * 64;
            int tq = tid_; asm volatile("" : "+v"(tq));
            const int r = tq & 31, hh = (tq >> 5) & 1;
            gla2_stage_chunk(L, R, tq, wup, bg, true);
            if (cc < 7) gla2_load_chunk(p, R, tq, b, h, c + 1, true);
            if (wave < 4) {
                const int mi = wave >> 1, ni = wave & 1;
                f32x16 acc = zero16();
#pragma unroll
                for (int ks = 0; ks < 8; ++ks) acc = mfma32(ld_frag_l(L.ke + (32 * ni + r) * G2_QP + 16 * ks + 8 * hh), ld_frag_l(L.qe + (32 * mi + r) * G2_QP + 16 * ks + 8 * hh), acc);
                const int t = 32 * mi + r;
#pragma unroll
                for (int rg = 0; rg < 4; ++rg) {
                    const int s0 = 32 * ni + 8 * rg + 4 * hh;
                    u32x2 w;
                    w.x = pack2(s0 + 0 <= t ? acc[4 * rg + 0] : 0.f, s0 + 1 <= t ? acc[4 * rg + 1] : 0.f);
                    w.y = pack2(s0 + 2 <= t ? acc[4 * rg + 2] : 0.f, s0 + 3 <= t ? acc[4 * rg + 3] : 0.f);
                    *(LAS u32x2*)(L.pp + t * G2_TP + s0) = w;
                }
            }
            union { bf16x8 v; unsigned w[4]; } sb[4][2];
#pragma unroll
            for (int mi = 0; mi < 4; ++mi)
#pragma unroll
                for (int s2 = 0; s2 < 2; ++s2)
#pragma unroll
                    for (int e = 0; e < 4; ++e) sb[mi][s2].w[e] = pack2(S[mi][8 * s2 + 2 * e], S[mi][8 * s2 + 2 * e + 1]);
            __syncthreads();
            f32x16 oacc[2];
#pragma unroll
            for (int tt = 0; tt < 2; ++tt) {
                f32x16 acc = zero16();
#pragma unroll
                for (int ks = 0; ks < 4; ++ks) acc = mfma32(ld_frag_tr(L.vt, G2_VP, 16 * ks, 32 * wave, tq & 63), ld_frag_l(L.pp + (32 * tt + r) * G2_TP + 16 * ks + 8 * hh), acc);
#pragma unroll
                for (int mi = 0; mi < 4; ++mi)
#pragma unroll
                    for (int s2 = 0; s2 < 2; ++s2) {
                        union { bf16x8 v; u32x2 h2[2]; } qa;
                        const LAS bf16_t* qp = L.qe + (32 * tt + r) * G2_QP + 32 * mi + 16 * s2 + 4 * hh;
                        qa.h2[0] = *(const LAS u32x2*)qp; qa.h2[1] = *(const LAS u32x2*)(qp + 8);
                        acc = mfma32(sb[mi][s2].v, qa.v, acc);
                    }
                float sq = 0.f;
#pragma unroll
                for (int i = 0; i < 16; ++i) sq += acc[i] * acc[i];
                sq += __shfl_xor(sq, 32);
                if (hh == 0) L.ss[wave * 64 + 32 * tt + r] = sq;
                oacc[tt] = acc;
            }
            gla2_update_state(L, S, wave, tq & 63);
            __syncthreads();
#pragma unroll
            for (int tt = 0; tt < 2; ++tt) {
                float tot = 0.f;
#pragma unroll
                for (int w = 0; w < 8; ++w) tot += L.ss[w * 64 + 32 * tt + r];
                const float rn = rsqrtf(tot * (1.0f / 256.0f) + LN_EPS);
                const size_t ro = (size_t)(row0 + 32 * tt + r) * 1024 + h * 256 + 32 * wave + 4 * hh;
                const float* gw = p.gla_norm_w + h * 256 + 32 * wave + 4 * hh;
#pragma unroll
                for (int rg = 0; rg < 4; ++rg) {
                    const u32x2 rw = *(const u32x2*)(p.RB + ro + 8 * rg);
                    const f32x4 g4 = *(const f32x4*)(gw + 8 * rg);
                    const float o0 = oacc[tt][4 * rg + 0] * rn * g4[0] * siluf_(bflo(rw.x)), o1 = oacc[tt][4 * rg + 1] * rn * g4[1] * siluf_(bfhi(rw.x));
                    const float o2 = oacc[tt][4 * rg + 2] * rn * g4[2] * siluf_(bflo(rw.y)), o3 = oacc[tt][4 * rg + 3] * rn * g4[3] * siluf_(bfhi(rw.y));
                    u32x2 w; w.x = pack2(o0, o1); w.y = pack2(o2, o3);
                    *(u32x2*)(p.OB + ro + 8 * rg) = w;
                }
            }
            __syncthreads();
        }
    }
}

constexpr int AKV_PITCH = 72;
typedef short v4s_t __attribute__((ext_vector_type(4)));
__device__ __forceinline__ float alibi_slope(int g, int j) { return exp2f(-8.0f * (float)(g * 4 + j + 1) / 12.0f); }

__device__ __forceinline__ void phase_attn_prompt(const Params& p, int bid, int nb_, LAS unsigned char* lds) {
    int tid_ = threadIdx.x; asm volatile("" : "+v"(tid_));
    LAS bf16_t* s_k = (LAS bf16_t*)lds;
    LAS bf16_t* s_v = s_k + 2 * 256 * AKV_PITCH;
    const int wave = tid_ >> 6, lane = tid_ & 63, r = lane & 31, hh = lane >> 5;
    const int jj = wave >> 2, qs = wave & 3;
    for (int u = bid; u < 1536; u += nb_) {
        const int hp = u & 1, nbq = (u >> 1) & 127, bg = u >> 8, g = bg % 3, b = bg / 3;
        const int d = 1 << (2 * g), nbk = 128 >> (2 * g);
        const int ph = nbq / nbk, nb = nbq % nbk;
#pragma unroll
        for (int half = 0; half < 2; ++half) {
            u32x4 w[8];
#pragma unroll
            for (int i = 0; i < 8; ++i) {
                const int q = tid_ + 512 * i, hj = q >> 11, key = (q >> 3) & 255, dc = q & 7;
                int lp = 128 * (nb - 1) + key; lp = lp < 0 ? 0 : lp;
                const size_t row = (size_t)b * T + (size_t)lp * d + ph;
                w[i] = *(const u32x4*)(p.QKVA + row * 2304 + (half ? 1536 : 768) + g * 256 + (2 * hp + hj) * 64 + dc * 8);
            }
#pragma unroll
            for (int i = 0; i < 8; ++i) {
                const int q = tid_ + 512 * i, hj = q >> 11, key = (q >> 3) & 255, dc = q & 7;
                *(LAS u32x4*)((half ? s_v : s_k) + (hj * 256 + key) * AKV_PITCH + dc * 8) = w[i];
            }
        }
        const int j = 2 * hp + jj;
        const float slope_d = alibi_slope(g, j) * (float)d;
        const int qi = 32 * qs + r;
        const size_t rowq = (size_t)b * T + (size_t)(128 * nb + qi) * d + ph;
        bf16x8 qf[4];
#pragma unroll
        for (int ks = 0; ks < 4; ++ks) qf[ks] = ld_frag_g(p.QKVA + rowq * 2304 + g * 256 + j * 64 + 16 * ks + 8 * hh);
        __syncthreads();
        float sc[5][16];
        const LAS bf16_t* kb = s_k + (jj * 256 + 32 * qs + r) * AKV_PITCH + 8 * hh;
#pragma unroll
        for (int kt = 0; kt < 5; ++kt) {
            f32x16 acc = zero16();
#pragma unroll
            for (int ks = 0; ks < 4; ++ks) acc = mfma32(ld_frag_l(kb + (32 * kt) * AKV_PITCH + 16 * ks), qf[ks], acc);
#pragma unroll
            for (int reg = 0; reg < 16; ++reg) sc[kt][reg] = acc[reg];
        }
        float m = -3.0e38f;
        float fb = (float)(r - 4 * hh + 128);
        asm volatile("" : "+v"(fb));
        const float fsmax = nb > 0 ? 128.0f : (float)qi;
#pragma unroll
        for (int kt = 0; kt < 5; ++kt)
#pragma unroll
            for (int reg = 0; reg < 16; ++reg) {
                const float fs = fb - (float)(32 * kt + (reg & 3) + 8 * (reg >> 2));
                const bool valid = fs >= 0.f && fs <= fsmax;
                const float v = valid ? sc[kt][reg] * 0.125f - slope_d * fs : -3.0e38f;
                sc[kt][reg] = v; m = fmaxf(m, v);
            }
        m = fmaxf(m, __shfl_xor(m, 32));
        float z = 0.f;
#pragma unroll
        for (int kt = 0; kt < 5; ++kt)
#pragma unroll
            for (int reg = 0; reg < 16; ++reg) { const float v = sc[kt][reg]; const float e = v > -1.0e38f ? __expf(v - m) : 0.f; sc[kt][reg] = e; z += e; if (reg == 15) __builtin_amdgcn_sched_barrier(0); }
        z += __shfl_xor(z, 32);
        const float rz = 1.0f / z;
        f32x16 o0 = zero16(), o1 = zero16();
        const int i16 = lane & 15;
        const LAS bf16_t* vb = s_v + (jj * 256 + 32 * qs + 4 * hh + (i16 >> 2)) * AKV_PITCH + 16 * ((lane >> 4) & 1) + 4 * (i16 & 3);
#pragma unroll
        for (int kt = 0; kt < 5; ++kt)
#pragma unroll
            for (int s2 = 0; s2 < 2; ++s2) {
                union { bf16x8 v; unsigned w[4]; } pb;
#pragma unroll
                for (int e = 0; e < 4; ++e) pb.w[e] = pack2(sc[kt][8 * s2 + 2 * e] * rz, sc[kt][8 * s2 + 2 * e + 1] * rz);
#pragma unroll
                for (int dt = 0; dt < 2; ++dt) {
                    union { bf16x8 v; v4s_t h2[2]; } va;
                    const LAS bf16_t* ap = vb + (32 * kt + 16 * s2) * AKV_PITCH + 32 * dt;
                    va.h2[0] = __builtin_amdgcn_ds_read_tr16_b64_v4i16((LAS v4s_t*)ap);
                    va.h2[1] = __builtin_amdgcn_ds_read_tr16_b64_v4i16((LAS v4s_t*)(ap + 8 * AKV_PITCH));
                    if (dt == 0) o0 = mfma32(va.v, pb.v, o0); else o1 = mfma32(va.v, pb.v, o1);
                }
                __builtin_amdgcn_sched_barrier(0);
            }
        bf16_t* og = p.OG + rowq * 768 + g * 256 + j * 64;
#pragma unroll
        for (int rg = 0; rg < 4; ++rg) {
            u32x2 w0, w1;
            w0.x = pack2(o0[4 * rg + 0], o0[4 * rg + 1]); w0.y = pack2(o0[4 * rg + 2], o0[4 * rg + 3]);
            w1.x = pack2(o1[4 * rg + 0], o1[4 * rg + 1]); w1.y = pack2(o1[4 * rg + 2], o1[4 * rg + 3]);
            *(u32x2*)(og + 8 * rg + 4 * hh) = w0; *(u32x2*)(og + 32 + 8 * rg + 4 * hh) = w1;
        }
        if (hh == 0) p.LSE[rowq * 12 + g * 4 + j] = m + __logf(z);
        __syncthreads();
    }
}

__device__ __forceinline__ void phase_attn_sample(const Params& p, int bid, int nb_, LAS unsigned char* lds) {
    int tid_ = threadIdx.x; asm volatile("" : "+v"(tid_));
    LAS float* s_sc = (LAS float*)lds;
    LAS float* s_o = s_sc + 4 * 132;
    const int wave = tid_ >> 6, lane = tid_ & 63, hd = lane >> 4;
    for (int u = bid; u < NS * 3; u += nb_) {
        const int s = u / 3, g = u % 3, d = 1 << (2 * g), W = 128 << (2 * g);
        const size_t row = (size_t)(NTP + s);
        const float* cache = (g == 0 ? p.cache128 : (g == 1 ? p.cache512 : p.cache2048)) + (size_t)s * W * 512;
        const int nk = wave == 0 ? 17 : 16;
        f32x4 kr[17];
#pragma unroll
        for (int i = 0; i < 17; ++i) {
            const int k = wave + 8 * i;
            if (i < nk) {
                if (k == 0) { const u32x2 w = *(const u32x2*)(p.QKVA + row * 2304 + 768 + g * 256 + 4 * lane); kr[i] = (f32x4){bflo(w.x), bfhi(w.x), bflo(w.y), bfhi(w.y)}; }
                else kr[i] = *(const f32x4*)(cache + ((size_t)(W - k * d) * 2 + 0) * 256 + 4 * lane);
            } else kr[i] = (f32x4){0.f, 0.f, 0.f, 0.f};
        }
        const u32x2 qw = *(const u32x2*)(p.QKVA + row * 2304 + g * 256 + 4 * lane);
        const f32x4 q4 = {bflo(qw.x), bfhi(qw.x), bflo(qw.y), bfhi(qw.y)};
        const float slope = alibi_slope(g, hd);
#pragma unroll
        for (int i = 0; i < 17; ++i) {
            const int k = wave + 8 * i;
            float dot = kr[i][0] * q4[0] + kr[i][1] * q4[1] + kr[i][2] * q4[2] + kr[i][3] * q4[3];
            dot = dpp_row_sum(dot);
            if (i < nk && (lane & 15) == 0) s_sc[hd * 132 + k] = dot * 0.125f - slope * (float)(k * d);
        }
        f32x4 vr[17];
#pragma unroll
        for (int i = 0; i < 17; ++i) {
            const int k = wave + 8 * i;
            if (i < nk) {
                if (k == 0) { const u32x2 w = *(const u32x2*)(p.QKVA + row * 2304 + 1536 + g * 256 + 4 * lane); vr[i] = (f32x4){bflo(w.x), bfhi(w.x), bflo(w.y), bfhi(w.y)}; }
                else vr[i] = *(const f32x4*)(cache + ((size_t)(W - k * d) * 2 + 1) * 256 + 4 * lane);
            } else vr[i] = (f32x4){0.f, 0.f, 0.f, 0.f};
        }
        __syncthreads();
        if (wave < 4) {
            const int h2 = wave;
            const float a0 = s_sc[h2 * 132 + lane], a1 = s_sc[h2 * 132 + 64 + lane], a2 = lane == 0 ? s_sc[h2 * 132 + 128] : -3.0e38f;
            const float m = wave_max(fmaxf(fmaxf(a0, a1), a2));
            const float e0 = __expf(a0 - m), e1 = __expf(a1 - m), e2 = lane == 0 ? __expf(a2 - m) : 0.f;
            const float z = wave_sum(e0 + e1 + e2), rz = 1.0f / z;
            s_sc[h2 * 132 + lane] = e0 * rz; s_sc[h2 * 132 + 64 + lane] = e1 * rz; if (lane == 0) { s_sc[h2 * 132 + 128] = e2 * rz; p.LSE[row * 12 + g * 4 + h2] = m + __logf(z); }
        }
        __syncthreads();
        f32x4 o = {0.f, 0.f, 0.f, 0.f};
#pragma unroll
        for (int i = 0; i < 17; ++i) { const int k = wave + 8 * i; if (i < nk) o += vr[i] * s_sc[hd * 132 + k]; }
        *(LAS f32x4*)(s_o + wave * 256 + 4 * lane) = o;
        __syncthreads();
        if (tid_ < 256) {
            float t2 = 0.f;
#pragma unroll
            for (int w = 0; w < 8; ++w) t2 += s_o[w * 256 + tid_];
            p.OG[row * 768 + g * 256 + tid_] = f2bf(t2);
        }
        __syncthreads();
    }
}

__device__ __forceinline__ void phase_merge_prep(const Params& p, int bid, int nb) {
    int tid_ = threadIdx.x; asm volatile("" : "+v"(tid_));
    const int wave = tid_ >> 6, lane = tid_ & 63;
    for (int row = bid * 8 + wave; row < NT; row += nb * 8) {
        const size_t R = (size_t)row;
        {
            const int j = lane >> 4;
            const float l0 = p.LSE[R * 12 + j], l1 = p.LSE[R * 12 + 4 + j], l2 = p.LSE[R * 12 + 8 + j];
            const float m = fmaxf(l0, fmaxf(l1, l2));
            float w0 = __expf(l0 - m), w1 = __expf(l1 - m), w2 = __expf(l2 - m);
            const float rs = 1.0f / (w0 + w1 + w2); w0 *= rs; w1 *= rs; w2 *= rs;
            const u32x2 a = *(const u32x2*)(p.OG + R * 768 + 4 * lane), b = *(const u32x2*)(p.OG + R * 768 + 256 + 4 * lane), c = *(const u32x2*)(p.OG + R * 768 + 512 + 4 * lane);
            u32x2 o;
            o.x = pack2(w0 * bflo(a.x) + w1 * bflo(b.x) + w2 * bflo(c.x), w0 * bfhi(a.x) + w1 * bfhi(b.x) + w2 * bfhi(c.x));
            o.y = pack2(w0 * bflo(a.y) + w1 * bflo(b.y) + w2 * bflo(c.y), w0 * bfhi(a.y) + w1 * bfhi(b.y) + w2 * bfhi(c.y));
            *(u32x2*)(p.OA + R * 256 + 4 * lane) = o;
        }
    }
}

template <int MODE> struct EpiGate {
    static constexpr bool PERM = true, AFTER_DRAIN = false;
    bf16_t* O; const bf16_t* G; const bf16_t* ADD; int ld;
    __device__ __forceinline__ void operator()(const pg8::f32x4 (&acc)[2][2][4][2], const pg8::Unit& u, int wr, int wc, int fr, int fq) const {
        const int row0 = u.pm * 256 + wr * 64 + fr, col0 = u.pn * 256 + wc * 32 + 8 * fq;
#pragma unroll
        for (int ai = 0; ai < 2; ++ai) {
            u32x4 gq[8], aq[8];
#pragma unroll
            for (int m = 0; m < 4; ++m)
#pragma unroll
                for (int bj = 0; bj < 2; ++bj) {
                    const size_t o = (size_t)(row0 + ai * 128 + m * 16) * ld + col0 + bj * 128;
                    if (MODE != 2) gq[m * 2 + bj] = *(const u32x4*)(G + o);
                    if (MODE == 1) aq[m * 2 + bj] = *(const u32x4*)(ADD + o);
                }
#pragma unroll
            for (int m = 0; m < 4; ++m)
#pragma unroll
                for (int bj = 0; bj < 2; ++bj) {
                    const size_t o = (size_t)(row0 + ai * 128 + m * 16) * ld + col0 + bj * 128;
                    const pg8::f32x4 v0 = acc[ai][bj][m][0], v1 = acc[ai][bj][m][1];
                    float v[8] = {v0[0], v0[1], v0[2], v0[3], v1[0], v1[1], v1[2], v1[3]};
                    if (MODE != 2) { float gg[8]; unpack8(gq[m * 2 + bj], gg);
#pragma unroll
                        for (int i = 0; i < 8; ++i) v[i] *= sigmoidf_(gg[i]); }
                    if (MODE == 1) { float aa[8]; unpack8(aq[m * 2 + bj], aa);
#pragma unroll
                        for (int i = 0; i < 8; ++i) v[i] += aa[i]; }
                    u32x4 w; w.x = pack2(v[0], v[1]); w.y = pack2(v[2], v[3]); w.z = pack2(v[4], v[5]); w.w = pack2(v[6], v[7]);
                    *(u32x4*)(O + o) = w;
                }
        }
    }
    __device__ __forceinline__ void emit16(int row, int col, const float (&vin)[16]) const {
#pragma unroll
        for (int hf = 0; hf < 2; ++hf) {
            const size_t o = (size_t)row * ld + col + 8 * hf;
            float v[8];
#pragma unroll
            for (int i = 0; i < 8; ++i) v[i] = vin[8 * hf + i];
            if (MODE != 2) { float gg[8]; unpack8(*(const u32x4*)(G + o), gg);
#pragma unroll
                for (int i = 0; i < 8; ++i) v[i] *= sigmoidf_(gg[i]); }
            if (MODE == 1) { float aa[8]; unpack8(*(const u32x4*)(ADD + o), aa);
#pragma unroll
                for (int i = 0; i < 8; ++i) v[i] += aa[i]; }
            u32x4 w; w.x = pack2(v[0], v[1]); w.y = pack2(v[2], v[3]); w.z = pack2(v[4], v[5]); w.w = pack2(v[6], v[7]);
            *(u32x4*)(O + o) = w;
        }
    }
};
struct EpiOut {
    static constexpr bool PERM = false, AFTER_DRAIN = false;
    float* Z1; const float* x_prompt; const float* x_sample; const float* MOD;
    __device__ __forceinline__ void operator()(const pg8::f32x4 (&acc)[2][2][4][2], const pg8::Unit& u, int wr, int wc, int fr, int fq) const {
        const int row0 = u.pm * 256 + wr * 64 + fr, col0 = u.pn * 256 + wc * 32 + 4 * fq;
        const float* g1 = MOD + (size_t)(row0 >> 14) * 6144 + 2048 + col0;
        pg8::f32x4 gv[2][2];
#pragma unroll
        for (int bj = 0; bj < 2; ++bj)
#pragma unroll
            for (int n = 0; n < 2; ++n) gv[bj][n] = *(const pg8::f32x4*)(g1 + bj * 128 + n * 16);
#pragma unroll
        for (int ai = 0; ai < 2; ++ai) {
            pg8::f32x4 xv[4][2][2];
#pragma unroll
            for (int m = 0; m < 4; ++m)
#pragma unroll
                for (int bj = 0; bj < 2; ++bj)
#pragma unroll
                    for (int n = 0; n < 2; ++n) xv[m][bj][n] = *(const pg8::f32x4*)(x_prompt + (size_t)(row0 + ai * 128 + m * 16) * D + col0 + bj * 128 + n * 16);
#pragma unroll
            for (int m = 0; m < 4; ++m)
#pragma unroll
                for (int bj = 0; bj < 2; ++bj)
#pragma unroll
                    for (int n = 0; n < 2; ++n)
                        *(pg8::f32x4*)(Z1 + (size_t)(row0 + ai * 128 + m * 16) * D + col0 + bj * 128 + n * 16) = xv[m][bj][n] * DN_ALPHA + gv[bj][n] * acc[ai][bj][m][n];
        }
    }
    __device__ __forceinline__ void emit16(int row, int col, const float (&v)[16]) const {
        if (row >= NT) return;
        const float* xr = row < NTP ? x_prompt + (size_t)row * D : x_sample + (size_t)(row - NTP) * D;
        const float* g1 = MOD + (size_t)seq_of(row) * 6144 + 2048;
#pragma unroll
        for (int i = 0; i < 4; ++i) {
            const f32x4 xv = *(const f32x4*)(xr + col + 4 * i), gv = *(const f32x4*)(g1 + col + 4 * i);
            *(f32x4*)(Z1 + (size_t)row * D + col + 4 * i) = xv * DN_ALPHA + gv * (f32x4){v[4 * i], v[4 * i + 1], v[4 * i + 2], v[4 * i + 3]};
        }
    }
};

__device__ __forceinline__ size_t qvf_index(int row, int c0) {
    return ((((((size_t)(row >> 5) * 8 + (c0 >> 8)) * 2 + ((c0 >> 7) & 1)) * 8 + ((c0 & 127) >> 4)) * 64) + (((c0 >> 3) & 1) * 32 + (row & 31))) * 8;
}
struct EpiQvf {
    static constexpr bool PERM = true, AFTER_DRAIN = false;
    bf16_t* O;
    __device__ __forceinline__ void operator()(const pg8::f32x4 (&acc)[2][2][4][2], const pg8::Unit& u, int wr, int wc, int fr, int fq) const {
        const int row0 = u.pm * 256 + wr * 64 + fr, col0 = u.pn * 256 + wc * 32 + 8 * fq;
#pragma unroll
        for (int ai = 0; ai < 2; ++ai)
#pragma unroll
            for (int m = 0; m < 4; ++m)
#pragma unroll
                for (int bj = 0; bj < 2; ++bj) {
                    const pg8::f32x4 v0 = acc[ai][bj][m][0], v1 = acc[ai][bj][m][1];
                    u32x4 w; w.x = pack2(v0[0], v0[1]); w.y = pack2(v0[2], v0[3]); w.z = pack2(v1[0], v1[1]); w.w = pack2(v1[2], v1[3]);
                    *(u32x4*)(O + qvf_index(row0 + ai * 128 + m * 16, col0 + bj * 128)) = w;
                }
    }
    __device__ __forceinline__ void emit16(int row, int col, const float (&v)[16]) const {
        u32x4 w0, w1;
        w0.x = pack2(v[0], v[1]); w0.y = pack2(v[2], v[3]); w0.z = pack2(v[4], v[5]); w0.w = pack2(v[6], v[7]);
        w1.x = pack2(v[8], v[9]); w1.y = pack2(v[10], v[11]); w1.z = pack2(v[12], v[13]); w1.w = pack2(v[14], v[15]);
        *(u32x4*)(O + qvf_index(row, col)) = w0; *(u32x4*)(O + qvf_index(row, col + 8)) = w1;
    }
};

__device__ __forceinline__ void phase_ln1(const Params& p, int bid, int nb) {
    int tid_ = threadIdx.x; asm volatile("" : "+v"(tid_));
    const int wave = tid_ >> 6, lane = tid_ & 63;
    float lw[16], lb[16];
    load_row16(p.ln1_w, lane, lw); load_row16(p.ln1_b, lane, lb);
    int row = bid * 8 + wave;
    float nx[16];
    if (row < NT) load_row16(p.Z1 + (size_t)row * D, lane, nx);
    for (; row < NT; row += nb * 8) {
        float v[16];
#pragma unroll
        for (int i = 0; i < 16; ++i) v[i] = nx[i];
        const int nrow = row + nb * 8;
        if (nrow < NT) load_row16(p.Z1 + (size_t)nrow * D, lane, nx);
        const float* mod = p.MOD + (size_t)seq_of(row) * 6144;
        float sh[16], sc[16];
        load_row16(mod + 3072, lane, sh); load_row16(mod + 4096, lane, sc);
        float mean, rstd; row_stats(v, mean, rstd);
        if (lane == 0) { p.LNST[(size_t)row * 2] = mean; p.LNST[(size_t)row * 2 + 1] = rstd; }
#pragma unroll
        for (int i = 0; i < 16; ++i) v[i] = (v[i] - mean) * rstd * lw[i] + lb[i];
        row_stats(v, mean, rstd);
#pragma unroll
        for (int i = 0; i < 16; ++i) v[i] = (v[i] - mean) * rstd * (1.0f + sc[i]) + sh[i];
        store_row16_bf16(p.H + (size_t)row * D, lane, v);
        float am = 0.f;
#pragma unroll
        for (int i = 0; i < 16; ++i) am = fmaxf(am, fabsf(v[i]));
        am = wave_max(am);
        const float inv = am > 0.f ? 448.0f / am : 1.0f;
        u32x4 w8;
#pragma unroll
        for (int i = 0; i < 4; ++i) {
            int d = 0;
            d = __builtin_amdgcn_cvt_pk_fp8_f32(v[4 * i] * inv, v[4 * i + 1] * inv, d, false);
            d = __builtin_amdgcn_cvt_pk_fp8_f32(v[4 * i + 2] * inv, v[4 * i + 3] * inv, d, true);
            w8[i] = (unsigned)d;
        }
        *(u32x2*)(p.H8 + (size_t)row * 1024 + 8 * lane) = (u32x2){w8[0], w8[1]};
        *(u32x2*)(p.H8 + (size_t)row * 1024 + 512 + 8 * lane) = (u32x2){w8[2], w8[3]};
        if (lane == 0) p.HS[row] = am > 0.f ? am * (1.0f / 448.0f) : 1.0f;
    }
}

__device__ __forceinline__ unsigned fkey(float f) { const unsigned u = __float_as_uint(f); return (u & 0x80000000u) ? ~u : (u | 0x80000000u); }
__device__ __forceinline__ float keyf(unsigned k) { return __uint_as_float((k & 0x80000000u) ? (k & 0x7fffffffu) : ~k); }

constexpr int CC_R0 = 128 * 127, CC_R1 = CC_R0 + 128 * 511, CC_ROWS = CC_R1 + 128 * 2047;
constexpr int CC_PER = 2, CC_STEPS = 84;
static_assert(CC_PER * CC_STEPS * 2048 >= CC_ROWS, "copy coverage");
template <int W> __device__ __forceinline__ void cc_addr_w(const float* s, float* d, int i, const float*& src, float*& dst) {
    const int seq = i / (W - 1), rr = i - seq * (W - 1);
    src = s + ((size_t)seq * W + rr + 1) * 512; dst = d + ((size_t)seq * W + rr) * 512;
}
__device__ __forceinline__ bool cc_addr(const Params& p, int row_, const float*& src, float*& dst) {
    const int rowu = __builtin_amdgcn_readfirstlane(row_);
    const bool ok = rowu < CC_ROWS;
    const int row = ok ? rowu : CC_ROWS - 1;
    if (row < CC_R0) cc_addr_w<128>(p.cache128, p.out + OFF_KVS0, row, src, dst);
    else if (row < CC_R1) cc_addr_w<512>(p.cache512, p.out + OFF_KVS1, row - CC_R0, src, dst);
    else cc_addr_w<2048>(p.cache2048, p.out + OFF_KVS2, row - CC_R1, src, dst);
    return ok;
}
struct CacheCopier {
    static constexpr int CAP = CC_PER * CC_STEPS;
    int row0, lane4, knext, kh0, kh1; f32x4 b0[2 * CC_PER], b1[2 * CC_PER];
    __device__ __forceinline__ void init(int bid, int tid) { row0 = __builtin_amdgcn_readfirstlane(bid * 8 + (tid >> 6)); lane4 = (tid & 63) * 4; knext = 0; kh0 = CAP; kh1 = CAP; }
    template <int W> __device__ __forceinline__ void store_part(const Params& p) {
        const int k0 = W ? kh1 : kh0;
#pragma unroll
        for (int j = 0; j < CC_PER; ++j) { const float* s; float* d; if (cc_addr(p, row0 + (k0 + j) * 2048, s, d)) {
            __builtin_nontemporal_store((W ? b1 : b0)[2 * j], (f32x4*)(d + lane4)); __builtin_nontemporal_store((W ? b1 : b0)[2 * j + 1], (f32x4*)(d + 256 + lane4)); } }
    }
    template <int W> __device__ __forceinline__ void load_part(const Params& p) {
        (W ? kh1 : kh0) = knext;
#pragma unroll
        for (int j = 0; j < CC_PER; ++j) { const float* s; float* d; (void)cc_addr(p, row0 + (knext + j) * 2048, s, d);
            (W ? b1 : b0)[2 * j] = __builtin_nontemporal_load((const f32x4*)(s + lane4)); (W ? b1 : b0)[2 * j + 1] = __builtin_nontemporal_load((const f32x4*)(s + 256 + lane4)); }
        knext = knext + CC_PER < CAP ? knext + CC_PER : CAP;
    }
    template <int W> __device__ __forceinline__ void step(const Params& p) { store_part<W>(p); load_part<W>(p); }
    __device__ __forceinline__ void flush(const Params& p) { while (kh0 < CAP || kh1 < CAP) { step<0>(p); step<1>(p); } }
};
constexpr int SK_PITCH = 132;
#define DPP_ROR(v, n) ((unsigned)__builtin_amdgcn_update_dpp(0, (int)(v), 0x120 + (n), 0xf, 0xf, true))
__device__ __forceinline__ unsigned row_max_u32(unsigned v) {
    v = max(v, DPP_ROR(v, 8)); v = max(v, DPP_ROR(v, 4)); v = max(v, DPP_ROR(v, 2)); v = max(v, DPP_ROR(v, 1)); return v;
}
#define CE_DESC(a, b) do { const unsigned hi_ = max(a, b), lo_ = min(a, b); a = hi_; b = lo_; } while (0)
__device__ __forceinline__ void phase_peer_select(const Params& p, int bid, int nb, LAS unsigned char* lds) {
    int tid_ = threadIdx.x; asm volatile("" : "+v"(tid_));
    LAS unsigned* s_key = (LAS unsigned*)lds;
    LAS unsigned* s_top = s_key + 256 * SK_PITCH;
    const int wave = tid_ >> 6, lane = tid_ & 63, r = lane & 31, hh = lane >> 5;
    const int li = tid_ & 15, rowid = tid_ >> 4;
    int cand_i[4], cand_j[4]; bool cand_ok[4];
#pragma unroll
    for (int s = 0; s < 4; ++s) {
        int i = 0, rem = 4 * li + s;
        while (i < 16 && rem >= 16 / (i + 1)) { rem -= 16 / (i + 1); ++i; }
        cand_ok[s] = i < 16; cand_i[s] = i < 16 ? i : 0; cand_j[s] = i < 16 ? rem : 0;
    }
    CacheCopier cc; cc.init(bid, tid_);
    for (int b = bid; b < 256; b += nb) {
        for (int tile = 0; tile < 5; ++tile) {
            const int nvalid = tile < 4 ? 32 : (b < NS ? 1 : 0);
            if (nvalid == 0) break;
            const int row0 = tile < 4 ? b * 128 + tile * 32 : NTP + b;
            for (int hq = 0; hq < 2; ++hq) {
#pragma unroll
                for (int jb = 0; jb < 4; ++jb) {
                    const int job = wave * 4 + jb, hl = job >> 3, half = (job >> 2) & 1, ni = job & 3;
                    const int h = 4 * hq + hl;
                    const int tix = tile < 4 ? b * 4 + tile : (NTP >> 5) + (b >> 5), rsel = tile < 4 ? r : (b & 31);
                    const bf16_t* A = p.QV + ((((size_t)tix * 8 + h) * 2 + half) * 8 * 64 + (hh * 32 + rsel)) * 8;
                    const bf16_t* B = p.KF + ((((size_t)h * 2 + half) * 4 + ni) * 8 * 64 + lane) * 8;
                    if (jb & 1) cc.store_part<1>(p); else cc.store_part<0>(p);
                    bf16x8 af[8], bfr[8];
#pragma unroll
                    for (int ks = 0; ks < 8; ++ks) { af[ks] = ld_frag_g(A + ks * 512); bfr[ks] = ld_frag_g(B + ks * 512); }
                    if (jb & 1) cc.load_part<1>(p); else cc.load_part<0>(p);
                    f32x16 acc = zero16();
#pragma unroll
                    for (int ks = 0; ks < 8; ++ks) acc = mfma32(af[ks], bfr[ks], acc);
                    LAS unsigned* dst = s_key + ((hl * 2 + half) * 32) * SK_PITCH + 32 * ni + r;
                    const unsigned tag = 127u - (unsigned)(32 * ni + r);
#pragma unroll
                    for (int reg = 0; reg < 16; ++reg) dst[crow(reg, hh) * SK_PITCH] = (fkey(acc[reg]) & ~127u) | tag;
                }
                __syncthreads();
                {
                    auto stage1 = [&](int it) {
                        unsigned k[2][8], res[2];
#pragma unroll
                        for (int z = 0; z < 2; ++z) {
                            const int q = (it + 4 * z) * 32 + rowid;
                            const u32x4 ka = *(const LAS u32x4*)(s_key + q * SK_PITCH + 8 * li), kb = *(const LAS u32x4*)(s_key + q * SK_PITCH + 8 * li + 4);
                            k[z][0] = ka.x; k[z][1] = ka.y; k[z][2] = ka.z; k[z][3] = ka.w; k[z][4] = kb.x; k[z][5] = kb.y; k[z][6] = kb.z; k[z][7] = kb.w; res[z] = 0u;
                        }
#pragma unroll
                        for (int z = 0; z < 2; ++z) {
                            CE_DESC(k[z][0], k[z][1]); CE_DESC(k[z][2], k[z][3]); CE_DESC(k[z][4], k[z][5]); CE_DESC(k[z][6], k[z][7]);
                            CE_DESC(k[z][0], k[z][2]); CE_DESC(k[z][1], k[z][3]); CE_DESC(k[z][4], k[z][6]); CE_DESC(k[z][5], k[z][7]);
                            CE_DESC(k[z][1], k[z][2]); CE_DESC(k[z][5], k[z][6]);
                            CE_DESC(k[z][0], k[z][4]); CE_DESC(k[z][1], k[z][5]); CE_DESC(k[z][2], k[z][6]); CE_DESC(k[z][3], k[z][7]);
                            CE_DESC(k[z][2], k[z][4]); CE_DESC(k[z][3], k[z][5]);
                            CE_DESC(k[z][1], k[z][2]); CE_DESC(k[z][3], k[z][4]); CE_DESC(k[z][5], k[z][6]);
                        }
#pragma unroll
                        for (int ps = 0; ps < 16; ++ps) {
#pragma unroll
                            for (int z = 0; z < 2; ++z) {
                                const unsigned mx = row_max_u32(k[z][0]);
                                res[z] = li == ps ? mx : res[z];
                                const bool pop = k[z][0] == mx;
#pragma unroll
                                for (int e = 0; e < 7; ++e) k[z][e] = pop ? k[z][e + 1] : k[z][e];
                                k[z][7] = pop ? 0u : k[z][7];
                            }
                        }
#pragma unroll
                        for (int z = 0; z < 2; ++z) s_top[((it + 4 * z) * 32 + rowid) * 16 + li] = res[z];
                    };
                    for (int it = 0; it < 4; it += 2) { cc.step<0>(p); if (rowid < nvalid) stage1(it); cc.step<1>(p); if (rowid < nvalid) stage1(it + 1); }
                }
                __syncthreads();
                {
                    auto stage2 = [&](int hl0) {
                        unsigned c[2][4], res[2];
#pragma unroll
                        for (int z = 0; z < 2; ++z) {
                            const int hl = hl0 + 2 * z;
                            const LAS unsigned* t1 = s_top + ((hl * 2 + 0) * 32 + rowid) * 16;
                            const LAS unsigned* t2 = s_top + ((hl * 2 + 1) * 32 + rowid) * 16;
#pragma unroll
                            for (int s = 0; s < 4; ++s) {
                                const float v = keyf(t1[cand_i[s]] & ~127u) + keyf(t2[cand_j[s]] & ~127u);
                                c[z][s] = cand_ok[s] ? ((fkey(v) & ~255u) | (255u - (unsigned)(cand_i[s] * 16 + cand_j[s]))) : 0u;
                            }
                            CE_DESC(c[z][0], c[z][1]); CE_DESC(c[z][2], c[z][3]); CE_DESC(c[z][0], c[z][2]); CE_DESC(c[z][1], c[z][3]); CE_DESC(c[z][1], c[z][2]);
                            res[z] = 0u;
                        }
#pragma unroll
                        for (int ps = 0; ps < 16; ++ps) {
#pragma unroll
                            for (int z = 0; z < 2; ++z) {
                                const unsigned mx = row_max_u32(c[z][0]);
                                res[z] = li == ps ? mx : res[z];
                                const bool pop = c[z][0] == mx;
                                c[z][0] = pop ? c[z][1] : c[z][0]; c[z][1] = pop ? c[z][2] : c[z][1]; c[z][2] = pop ? c[z][3] : c[z][2]; c[z][3] = pop ? 0u : c[z][3];
                            }
                        }
#pragma unroll
                        for (int z = 0; z < 2; ++z) {
                            const int hl = hl0 + 2 * z;
                            const LAS unsigned* t1 = s_top + ((hl * 2 + 0) * 32 + rowid) * 16;
                            const LAS unsigned* t2 = s_top + ((hl * 2 + 1) * 32 + rowid) * 16;
                            const int cidx = 255 - (int)(res[z] & 255u), i1 = cidx >> 4, i2 = cidx & 15;
                            const unsigned a1 = t1[i1], a2 = t2[i2];
                            const float sc = keyf(a1 & ~127u) + keyf(a2 & ~127u);
                            float mxs = sc;
                            mxs = fmaxf(mxs, DPP_ROR_F(mxs, 8)); mxs = fmaxf(mxs, DPP_ROR_F(mxs, 4)); mxs = fmaxf(mxs, DPP_ROR_F(mxs, 2)); mxs = fmaxf(mxs, DPP_ROR_F(mxs, 1));
                            const float ex = __expf(sc - mxs);
                            const float gw = ex / dpp_row_sum(ex);
                            const int ei = (127 - (int)(a1 & 127u)) * 128 + (127 - (int)(a2 & 127u));
                            const size_t o = (size_t)(row0 + rowid) * 128 + (4 * hq + hl) * 16 + li;
                            p.EIDX[o] = ei; p.EGW[o] = gw * p.SV[ei];
                        }
                    };
                    cc.step<0>(p); if (rowid < nvalid) stage2(0); cc.step<1>(p); if (rowid < nvalid) stage2(1);
                }
                __syncthreads();
            }
        }
    }
    cc.flush(p);
}

__device__ __forceinline__ float gelu_erf(float x) { return 0.5f * x * (1.0f + erff(x * 0.70710678118654752f)); }
__device__ __forceinline__ float wave_total_from_rows(float v) {
    return (__builtin_bit_cast(float, __builtin_amdgcn_readlane(__builtin_bit_cast(int, v), 0)) + __builtin_bit_cast(float, __builtin_amdgcn_readlane(__builtin_bit_cast(int, v), 16)))
         + (__builtin_bit_cast(float, __builtin_amdgcn_readlane(__builtin_bit_cast(int, v), 32)) + __builtin_bit_cast(float, __builtin_amdgcn_readlane(__builtin_bit_cast(int, v), 48)));
}
__device__ __forceinline__ void fp8x16_to_f32(const u32x4 w, float (&o)[16]) {
#pragma unroll
    for (int i = 0; i < 4; ++i) {
        const v2f_t lo = __builtin_amdgcn_cvt_pk_f32_fp8((int)w[i], false), hi = __builtin_amdgcn_cvt_pk_f32_fp8((int)w[i], true);
        o[4 * i] = lo.x; o[4 * i + 1] = lo.y; o[4 * i + 2] = hi.x; o[4 * i + 3] = hi.y;
    }
}
typedef long i64x2_t __attribute__((ext_vector_type(2)));
typedef int i32x2_t __attribute__((ext_vector_type(2)));
#define UP_PITCH 1040
__device__ __forceinline__ void up_tile_put(const u32x4 (&rows)[16], LAS unsigned char* tile, int lane16) {
#pragma unroll
    for (int q = 0; q < 16; ++q) *(LAS u32x4*)(tile + q * UP_PITCH + lane16) = rows[q];
}
__device__ __forceinline__ float up_tile_dots(LAS unsigned char* tile, const LAS unsigned char* hrow, int pr, int kg16) {
    f32x4 c0 = {0.f, 0.f, 0.f, 0.f}, c1 = c0;
    u32x4 hf[2][2], uf[2][2];
    auto rd = [&](int st, int s) {
#pragma unroll
        for (int i = 0; i < 2; ++i) { hf[s][i] = *(const LAS u32x4*)(hrow + 128 * st + 64 * i + kg16); uf[s][i] = *(const LAS u32x4*)(tile + pr * UP_PITCH + 128 * st + 64 * i + kg16); }
    };
    auto mm = [&](int s) {
#pragma unroll
        for (int i = 0; i < 2; ++i) {
            const i64x2_t a = __builtin_bit_cast(i64x2_t, hf[s][i]), b = __builtin_bit_cast(i64x2_t, uf[s][i]);
            c0 = __builtin_amdgcn_mfma_f32_16x16x32_fp8_fp8(a[0], b[0], c0, 0, 0, 0);
            c1 = __builtin_amdgcn_mfma_f32_16x16x32_fp8_fp8(a[1], b[1], c1, 0, 0, 0);
        }
    };
    rd(0, 0);
#pragma unroll
    for (int st = 0; st < 8; ++st) {
        if (st + 1 < 8) rd(st + 1, (st + 1) & 1);
        __builtin_amdgcn_sched_barrier(0);
        mm(st & 1);
        __builtin_amdgcn_sched_barrier(0);
    }
    return c0[0] + c1[0];
}

__device__ __forceinline__ float up_reduce8(const float (&t8)[8], int lane) {
    float t4[4], t2[2], t1;
    { const bool b = lane & 2;
#pragma unroll
      for (int j = 0; j < 4; ++j) { const float keep = b ? t8[2 * j + 1] : t8[2 * j], send = b ? t8[2 * j] : t8[2 * j + 1]; t4[j] = keep + DPP_ROR_F(send, 2); } }
    { const bool b = lane & 4;
#pragma unroll
      for (int j = 0; j < 2; ++j) { const float keep = b ? t4[2 * j + 1] : t4[2 * j], send = b ? t4[2 * j] : t4[2 * j + 1]; t2[j] = keep + DPP_ROR_F(send, 4); } }
    { const bool b = lane & 8; const float keep = b ? t2[1] : t2[0], send = b ? t2[0] : t2[1]; t1 = keep + DPP_ROR_F(send, 8); }
    t1 += __shfl_xor(t1, 16); t1 += __shfl_xor(t1, 32);
    return t1;
}
template <int V = 0>
__device__ __forceinline__ void phase_peer_upass(const Params& p, int bid, int nb, LAS unsigned char* lds, float* __restrict__ ewout) {
    int tid_ = threadIdx.x; asm volatile("" : "+v"(tid_));
    const int wave = tid_ >> 6, lane = tid_ & 63;
    constexpr int WSTR = 1024 + 2048 + 64;
    LAS int* lst = (LAS int*)(lds + wave * WSTR);
    LAS unsigned char* hb = lds + wave * WSTR + 1024;
    LAS float* hsl = (LAS float*)(lds + wave * WSTR + 3072);
    static_assert(8 * WSTR <= LDS_BYTES - 16, "LDS carve of the expert-activation phase");
    const __amdgpu_buffer_rsrc_t ures = __builtin_amdgcn_make_buffer_rsrc((void*)p.U8, 0, 16384 * 2048, 0x00020000);
    const int lane16 = lane * 16;
    const int rsel = (((lane & 15) >> 2) == (lane >> 4)) ? (lane & 3) : 4;
    unsigned dmask[4];
#pragma unroll
    for (int r = 0; r < 4; ++r) { dmask[r] = rsel == r ? 0xffffffffu : 0u; asm volatile("" : "+v"(dmask[r])); }
    constexpr int TPB = NT / 32;
    static_assert(TPB * 32 == NT, "token ranges");
    struct TokIn { u32x4 h8; int ia, ib; float hs; };
    struct Tok { int t, n, e0, e1, k0, k1; float su0, su1; };
    for (int vb = bid; vb < 256; vb += nb) {
        const int x = vb & 7, t0 = (vb >> 3) * TPB, tend = t0 + TPB;
        {
        auto fetch_tok = [&](int t2, TokIn& ti) {
            t2 = t2 < tend ? t2 : tend - 1;
            const size_t R2 = (size_t)t2;
            ti.h8 = *(const u32x4*)(p.H8 + R2 * 1024 + 16 * lane); ti.hs = p.HS[R2];
            ti.ia = p.EIDX[R2 * 128 + lane]; ti.ib = p.EIDX[R2 * 128 + 64 + lane];
        };
        auto prep = [&](int t, TokIn& in, Tok& o, u32x4 (&buf)[16], int par) {
            const int ia = in.ia, ib = in.ib;
            o.t = t;
            *(LAS u32x4*)(hb + par * 1024 + 16 * lane) = in.h8; hsl[par] = in.hs;
            const bool inA = (ia >> 11) == x, inB = (ib >> 11) == x;
            const unsigned long long mA = __builtin_amdgcn_ballot_w64(inA), mB = __builtin_amdgcn_ballot_w64(inB);
            const int cntA = __builtin_popcountll(mA), n = cntA + __builtin_popcountll(mB);
            const int rankA = (int)__builtin_amdgcn_mbcnt_hi((unsigned)(mA >> 32), __builtin_amdgcn_mbcnt_lo((unsigned)mA, 0u));
            const int rankB = cntA + (int)__builtin_amdgcn_mbcnt_hi((unsigned)(mB >> 32), __builtin_amdgcn_mbcnt_lo((unsigned)mB, 0u));
            LAS int* L = lst;
            if (inA) { L[rankA] = ia; L[128 + rankA] = lane; }
            if (inB) { L[rankB] = ib; L[128 + rankB] = 64 + lane; }
            asm volatile("s_waitcnt lgkmcnt(0)" ::: "memory");
            o.n = n;
            o.e0 = lane < n ? L[lane] : (x << 11); o.e1 = 64 + lane < n ? L[64 + lane] : (x << 11);
            o.k0 = L[128 + lane]; o.k1 = L[192 + lane];
            o.su0 = p.SU[o.e0]; o.su1 = p.SU[o.e1];
#pragma unroll
            for (int q = 0; q < 16; ++q) { const int e = __builtin_amdgcn_readlane(o.e0, q); buf[q] = __builtin_amdgcn_raw_buffer_load_b128(ures, lane16, e << 11, 0); }
            fetch_tok(t + 16, in);
        };
        auto finish = [&](Tok& c, u32x4 (&buf)[16], int par) {
            const u32x4 h8 = *(const LAS u32x4*)(hb + par * 1024 + lane16); const float hs = hsl[par];
            const i64x2_t ha = __builtin_bit_cast(i64x2_t, h8);
            __builtin_amdgcn_sched_barrier(0);
            __builtin_amdgcn_s_waitcnt(0x4F76);
            __builtin_amdgcn_sched_barrier(0);
            float dot0 = 0.f, dot1 = 0.f;
            for (int base = 0; base < 16 || base < c.n; base += 16) {
                const bool more = base + 16 < c.n;
                const int nb16 = base + 16, ev = nb16 < 64 ? c.e0 : c.e1;
                float t8[8];
#pragma unroll
                for (int bq = 0; bq < 4; ++bq) {
                    const int q0 = 4 * bq;
                    if (base + q0 < c.n) {
                        f32x4 acc[4];
#pragma unroll
                        for (int j = 0; j < 4; ++j) { const i64x2_t b = __builtin_bit_cast(i64x2_t, buf[q0 + j]); acc[j] = __builtin_amdgcn_mfma_f32_16x16x32_fp8_fp8(ha[0], b[0], (f32x4){0.f, 0.f, 0.f, 0.f}, 0, 0, 0); }
#pragma unroll
                        for (int j = 0; j < 4; ++j) { const i64x2_t b = __builtin_bit_cast(i64x2_t, buf[q0 + j]); acc[j] = __builtin_amdgcn_mfma_f32_16x16x32_fp8_fp8(ha[1], b[1], acc[j], 0, 0, 0); }
                        float sv[4];
#pragma unroll
                        for (int j = 0; j < 4; ++j) sv[j] = __uint_as_float((__float_as_uint(acc[j][0]) & dmask[0]) | (__float_as_uint(acc[j][1]) & dmask[1]) | (__float_as_uint(acc[j][2]) & dmask[2]) | (__float_as_uint(acc[j][3]) & dmask[3]));
                        const bool b1 = lane & 1;
#pragma unroll
                        for (int j = 0; j < 2; ++j) { const float keep = b1 ? sv[2 * j + 1] : sv[2 * j], send = b1 ? sv[2 * j] : sv[2 * j + 1]; t8[2 * bq + j] = keep + DPP_ROR_F(send, 1); }
                    } else { t8[2 * bq] = 0.f; t8[2 * bq + 1] = 0.f; }
                    if (nb16 + q0 < c.n) {
#pragma unroll
                        for (int j = 0; j < 4; ++j) { const int e = __builtin_amdgcn_readlane(ev, (nb16 & 63) + q0 + j); buf[q0 + j] = __builtin_amdgcn_raw_buffer_load_b128(ures, lane16, e << 11, 0); }
                    }
                }
                const float d = up_reduce8(t8, lane);
                if ((lane >> 4) == ((base >> 4) & 3)) { if (base < 64) dot0 = d; else dot1 = d; }
                if (more) {
                    __builtin_amdgcn_sched_barrier(0);
                    __builtin_amdgcn_s_waitcnt(0x0F70);
                    __builtin_amdgcn_sched_barrier(0);
                }
            }
            const size_t R = (size_t)c.t;
            if (lane < c.n) ewout[R * 128 + c.k0] = gelu_erf(c.su0 * hs * dot0);
            if (64 + lane < c.n) ewout[R * 128 + c.k1] = gelu_erf(c.su1 * hs * dot1);
        };
        TokIn iA, iB; Tok kA, kB; u32x4 bX[16], bY[16];
        fetch_tok(t0 + wave, iA); fetch_tok(t0 + wave + 8, iB);
        prep(t0 + wave, iA, kA, bX, 0);
        for (int t = t0 + wave; t < tend; t += 16) {
            prep(t + 8 < tend ? t + 8 : tend - 1, iB, kB, bY, 1);
            finish(kA, bX, 0);
            prep(t + 16 < tend ? t + 16 : tend - 1, iA, kA, bX, 0);
            finish(kB, bY, 1);
        }
        __builtin_amdgcn_s_waitcnt(0x0F70);
        }
    }
}

__device__ __forceinline__ void phase_peer_gather(const Params& p, int bid, int nb, LAS unsigned char* lds, int skip_ff = 0) {
    int tid_ = threadIdx.x; asm volatile("" : "+v"(tid_));
    const int wave = tid_ >> 6, lane = tid_ & 63;
    LAS float* s_ff = (LAS float*)lds;
    const __amdgpu_buffer_rsrc_t vres = __builtin_amdgcn_make_buffer_rsrc((void*)p.U8, 0, 16384 * 2048, 0x00020000);
    const int lane16v = lane * 16 + 1024;
    const int n_vb = (256 - bid + nb - 1) / nb;
    for (int it = 0; it < n_vb * 17; ++it) {
        const int vb = bid + (it / 17) * nb, sub = it % 17;
        const bool coop = sub == 16;
        if (coop && vb >= NS) continue;
        const int row = coop ? NTP + vb : vb * 128 + wave + 8 * sub;
        const int g0 = skip_ff ? 8 : (coop ? wave : 0), g1 = coop ? wave + 1 : 8;
        const size_t R = (size_t)row;
        v2f_t acc2[8];
#pragma unroll
        for (int i = 0; i < 8; ++i) acc2[i] = (v2f_t){0.f, 0.f};
        const int ia = p.EIDX[R * 128 + lane], ib = p.EIDX[R * 128 + 64 + lane];
        const float wa = p.EW[R * 128 + lane] * p.EGW[R * 128 + lane], wb = p.EW[R * 128 + 64 + lane] * p.EGW[R * 128 + 64 + lane];
        f32x4 zr[4];
#pragma unroll
        for (int i = 0; i < 4; ++i) zr[i] = *(const f32x4*)(p.Z1 + R * D + 16 * lane + 4 * i);
        const float mean1 = p.LNST[R * 2], rstd1 = p.LNST[R * 2 + 1];
        for (int grp = g0; grp < g1; ++grp) {
            const int iv = grp < 4 ? ia : ib; const float wv = grp < 4 ? wa : wb;
            const int l0 = (grp & 3) * 16;
            u32x4 vb16[16];
#pragma unroll
            for (int q = 0; q < 16; ++q) { const int e = __builtin_amdgcn_readlane(iv, l0 + q); vb16[q] = __builtin_amdgcn_raw_buffer_load_b128(vres, lane16v, e << 11, 0); }
#pragma unroll
            for (int q = 0; q < 16; ++q) {
                const float w = __builtin_bit_cast(float, __builtin_amdgcn_readlane(__builtin_bit_cast(int, wv), l0 + q));
                const v2f_t w2 = {w, w};
#pragma unroll
                for (int i = 0; i < 4; ++i) {
                    const v2f_t lo = __builtin_amdgcn_cvt_pk_f32_fp8((int)vb16[q][i], false), hi = __builtin_amdgcn_cvt_pk_f32_fp8((int)vb16[q][i], true);
                    acc2[2 * i] += w2 * lo; acc2[2 * i + 1] += w2 * hi;
                }
            }
        }
        float acc[16];
#pragma unroll
        for (int i = 0; i < 8; ++i) { acc[2 * i] = acc2[i].x; acc[2 * i + 1] = acc2[i].y; }
        if (coop) {
#pragma unroll
            for (int i = 0; i < 4; ++i) *(LAS f32x4*)(s_ff + wave * 1024 + 16 * lane + 4 * i) = (f32x4){acc[4 * i], acc[4 * i + 1], acc[4 * i + 2], acc[4 * i + 3]};
            __syncthreads();
            if (wave == 0) {
#pragma unroll
                for (int i = 0; i < 16; ++i) acc[i] = 0.f;
#pragma unroll
                for (int w = 0; w < 8; ++w)
#pragma unroll
                    for (int i = 0; i < 4; ++i) { const f32x4 t = *(const LAS f32x4*)(s_ff + w * 1024 + 16 * lane + 4 * i); acc[4 * i] += t[0]; acc[4 * i + 1] += t[1]; acc[4 * i + 2] += t[2]; acc[4 * i + 3] += t[3]; }
            }
        }
        if (!coop || wave == 0) {
            float x1[16], g2[16];
            const float* gr = p.MOD + (size_t)seq_of(row) * 6144 + 5120 + 16 * lane;
#pragma unroll
            for (int i = 0; i < 4; ++i) { const f32x4 a = zr[i], b = *(const f32x4*)(gr + 4 * i);
                const f32x4 lw = *(const f32x4*)(p.ln1_w + 16 * lane + 4 * i), lb = *(const f32x4*)(p.ln1_b + 16 * lane + 4 * i);
#pragma unroll
                for (int j = 0; j < 4; ++j) { x1[4 * i + j] = (a[j] - mean1) * rstd1 * lw[j] + lb[j]; g2[4 * i + j] = b[j]; } }
#pragma unroll
            for (int i = 0; i < 16; ++i) acc[i] = DN_ALPHA * x1[i] + g2[i] * acc[i];
            float mean, rstd; row_stats(acc, mean, rstd);
            float* yo = (row < NTP ? p.out + OFF_YP + R * D : p.out + OFF_YS + (size_t)(row - NTP) * D) + 16 * lane;
#pragma unroll
            for (int i = 0; i < 4; ++i) { const f32x4 w = *(const f32x4*)(p.ln2_w + 16 * lane + 4 * i), b = *(const f32x4*)(p.ln2_b + 16 * lane + 4 * i);
                f32x4 o;
#pragma unroll
                for (int j = 0; j < 4; ++j) o[j] = (acc[4 * i + j] - mean) * rstd * w[j] + b[j];
                *(f32x4*)(yo + 4 * i) = o; }
        }
        if (coop) __syncthreads();
    }
}

__device__ __forceinline__ void phase_z1_bypass(const Params& p, int bid, int nb) {
    int tid_ = threadIdx.x; asm volatile("" : "+v"(tid_));
    const int wave = tid_ >> 6, lane = tid_ & 63;
    for (int row = bid * 8 + wave; row < NT; row += nb * 8) {
        float v[16]; load_row16(x_row(p, row), lane, v);
#pragma unroll
        for (int i = 0; i < 16; ++i) v[i] *= DN_ALPHA;
        store_row16_f32(p.Z1 + (size_t)row * D, lane, v);
    }
}

#define DYN_LDS extern __shared__ __attribute__((aligned(16))) unsigned char shm_[]; LAS unsigned char* lds = (LAS unsigned char*)shm_;
template <class Epi> __device__ __forceinline__ void run_gemm(LAS unsigned char* lds, const bf16_t* A, const bf16_t* Bt, int M, int N, int K, const Epi& E) {
    int Ko = K; asm volatile("" : "+s"(Ko));
    pg8::StaticOrder S; S.init(M, N, (int)gridDim.x, (int)blockIdx.x);
    pg8::Gemm g{A, Bt, M, N, Ko};
    pg8::gemm_phase<Epi, pg8::StaticOrder, false>(lds, g, S, E, nullptr);
    __syncthreads();
}

template <class Epi> __device__ __forceinline__ void skinny_gemm(const bf16_t* __restrict__ A, const bf16_t* __restrict__ Bt, int N, int K, const Epi& E, int ushift) {
    int tid_ = threadIdx.x; asm volatile("" : "+v"(tid_));
    const int wave = tid_ >> 6, lane = tid_ & 63, r = lane & 31, hh = lane >> 5, rt = wave & 3, ct = wave >> 2;
    const int nb = (int)gridDim.x, vb = ((int)blockIdx.x + nb - (ushift % nb)) % nb;
    const int perm = 16 * ((r >> 2) & 1) + 4 * (r >> 3) + (r & 3);
    for (int u = vb; u < N / 64; u += nb) {
        int arow = NTP + 32 * rt + r; asm volatile("" : "+v"(arow));
        const bf16_t* ap = A + (size_t)arow * K + 8 * hh;
        const bf16_t* bp = Bt + (size_t)(u * 64 + 32 * ct + perm) * K + 8 * hh;
        f32x16 acc = zero16();
        for (int k0 = 0; k0 < K / 16; k0 += 8) {
            bf16x8 wa[8], xa[8];
#pragma unroll
            for (int i = 0; i < 8; ++i) { wa[i] = ld_frag_g(bp + 16 * (k0 + i)); xa[i] = ld_frag_g(ap + 16 * (k0 + i)); }
            __builtin_amdgcn_sched_barrier(0);
#pragma unroll
            for (int i = 0; i < 8; ++i) acc = mfma32(wa[i], xa[i], acc);
            __builtin_amdgcn_sched_barrier(0);
        }
        float v[16];
#pragma unroll
        for (int i = 0; i < 16; ++i) v[i] = acc[i];
        E.emit16(NTP + 32 * rt + r, u * 64 + 32 * ct + 16 * hh, v);
    }
}
__global__ void __launch_bounds__(NTHREADS, 2) k_mega(Params p) {
    DYN_LDS;
    volatile LAS unsigned* st = (volatile LAS unsigned*)(lds + LDS_BYTES - 16);
    if (threadIdx.x == 0) { st[0] = 0u; st[1] = 0u; st[2] = 0u; st[3] = 0u; }
    __syncthreads();
    const XcdBarrier bar = xcd_barrier_post(p.bar, st);
    const int bid = blockIdx.x, nb = gridDim.x;
    phase_prologue<0>(p, bid, nb, lds, 0);
    xcd_barrier(bar);
    run_gemm(lds, p.SC, p.WADA_T, 256, 6144, 1024, pg8::EpiF32{p.MOD, 6144, p.b_ada});
    phase_prologue<1>(p, bid, nb, lds, nb > 48 ? 24 : 0);
    xcd_barrier(bar);
    phase_lnmod1(p, bid, nb);
    xcd_barrier(bar);
    { const EpiProj E{p.QKVA, p.QKB, p.VBB, p.RB, p.GA, p.GB, p.GLR, p.out}; run_gemm(lds, p.H, p.WIN_T, NTP, NPROJ, 1024, E); skinny_gemm(p.H, p.WIN_T, NPROJ, 1024, E, 0); }
    xcd_barrier(bar);
    phase_gla2_passA(p, bid, nb, lds);
    phase_attn_prompt(p, bid, nb, lds);
    phase_attn_sample(p, bid, nb, lds);
    phase_gla_sample(p, bid, nb, lds);
    xcd_barrier(bar);
    phase_gla2_scan(p, bid, nb);
    xcd_barrier(bar);
    phase_gla2_passC(p, bid, nb, lds);
    phase_merge_prep(p, bid, nb);
    xcd_barrier(bar);
    { const EpiGate<0> E{p.TMP1, p.GA, nullptr, 1024}; run_gemm(lds, p.OA, p.WBRA_T, NTP, 1024, 256, E); skinny_gemm(p.OA, p.WBRA_T, 1024, 256, E, 0); }
    xcd_barrier(bar);
    { const EpiGate<1> E{p.MERGED, p.GB, p.TMP1, 1024}; run_gemm(lds, p.OB, p.WBRB_T, NTP, 1024, 1024, E); skinny_gemm(p.OB, p.WBRB_T, 1024, 1024, E, 64); }
    xcd_barrier(bar);
    { const EpiOut E{p.Z1, p.x_prompt, p.x_sample, p.MOD}; run_gemm(lds, p.MERGED, p.WOUT_T, NTP, 1024, 1024, E); skinny_gemm(p.MERGED, p.WOUT_T, 1024, 1024, E, 128); }
    xcd_barrier(bar);
    phase_ln1(p, bid, nb);
    xcd_barrier(bar);
    { const EpiQvf E{p.QV}; run_gemm(lds, p.H, p.WPQ_T, NTP, 2048, 1024, E); skinny_gemm(p.H, p.WPQ_T, 2048, 1024, E, 192); }
    xcd_barrier(bar);
    phase_peer_select(p, bid, nb, lds);
    xcd_barrier(bar);
    phase_peer_upass<0>(p, bid, nb, lds, p.EW);
#ifdef UP_PROBE
    xcd_barrier(bar);
    phase_peer_upass<UP_PROBE>(p, bid, nb, lds, (float*)p.TMP1);
#endif
    xcd_barrier(bar);
    phase_peer_gather(p, bid, nb, lds);
}

static inline size_t align_up(size_t v, size_t a) { return (v + a - 1) / a * a; }

extern "C" void kernel_launch(void* const* d_in, const int* in_sizes, int n_in, void* d_out, int out_size, void* d_ws, size_t ws_size, hipStream_t stream) {
    (void)in_sizes; (void)n_in; (void)out_size;
    Params p; memset(&p, 0, sizeof(p));
    const float* const* in = (const float* const*)d_in;
    p.x_prompt = in[0]; p.x_sample = in[1]; p.c_prompt = in[2]; p.c_sample = in[3]; p.cache128 = in[4]; p.cache512 = in[5]; p.cache2048 = in[6]; p.state_gla = in[7];
    p.w_ada = in[8]; p.b_ada = in[9]; p.w_in = in[10]; p.w_gla_up = in[11]; p.b_gla = in[12]; p.gla_norm_w = in[13]; p.w_br_a = in[14]; p.w_br_b = in[15]; p.w_out = in[16];
    p.ln1_w = in[17]; p.ln1_b = in[18]; p.w_pq = in[19]; p.peer_k1 = in[20]; p.peer_k2 = in[21]; p.peer_u = in[22]; p.peer_v = in[23]; p.ln2_w = in[24]; p.ln2_b = in[25];
    p.out = (float*)d_out;
    size_t off = 0; char* ws = (char*)d_ws;
#define CARVE(field, type, count) do { p.field = (type*)(ws + off); off = align_up(off + (size_t)(count) * sizeof(type), 256); } while (0)
    CARVE(bar, unsigned, 4096);
    CARVE(MOD, float, 256 * 6144); CARVE(SC, bf16_t, 256 * 1024); CARVE(WADA_T, bf16_t, 6144 * 1024); CARVE(WIN_T, bf16_t, (size_t)NPROJ * 1024);
    CARVE(WBRA_T, bf16_t, 1024 * 256); CARVE(WBRB_T, bf16_t, 1024 * 1024); CARVE(WOUT_T, bf16_t, 1024 * 1024); CARVE(WPQ_T, bf16_t, 2048 * 1024);
    CARVE(KF, bf16_t, 2 * 8 * 128 * 128); CARVE(U8, unsigned char, (size_t)16384 * 2048); p.V8 = p.U8 + 1024; CARVE(SU, float, 16384); CARVE(SV, float, 16384);
    CARVE(H, bf16_t, (size_t)MP * 1024); CARVE(QKVA, bf16_t, (size_t)MP * 2304); CARVE(QKB, bf16_t, (size_t)MP * 1024); CARVE(VBB, bf16_t, (size_t)MP * 1024);
    CARVE(RB, bf16_t, (size_t)MP * 1024); CARVE(GA, bf16_t, (size_t)MP * 1024); CARVE(GB, bf16_t, (size_t)MP * 1024); CARVE(GLR, float, (size_t)MP * 16);
    CARVE(OG, bf16_t, (size_t)MP * 768); CARVE(LSE, float, (size_t)MP * 12);
    CARVE(LSEG, float, (size_t)256 * 32768); CARVE(SSEG, float, (size_t)256 * 32768); CARVE(DSEG, float, (size_t)256 * 128); CARVE(OGLA, bf16_t, (size_t)MP * 1024);
    CARVE(OA, bf16_t, (size_t)MP * 256); CARVE(OB, bf16_t, (size_t)MP * 1024); CARVE(TMP1, bf16_t, (size_t)MP * 1024); CARVE(MERGED, bf16_t, (size_t)MP * 1024);
    CARVE(Z1, float, (size_t)MP * 1024); CARVE(LNST, float, (size_t)MP * 2); CARVE(QV, bf16_t, (size_t)MP * 2048); CARVE(EIDX, int, (size_t)MP * 128); CARVE(EGW, float, (size_t)MP * 128); CARVE(ESU, float, (size_t)MP * 128); CARVE(EW, float, (size_t)MP * 128); CARVE(H8, unsigned char, (size_t)MP * 1024); CARVE(HS, float, (size_t)MP);
    if (off > ws_size) { fprintf(stderr, "kernel_launch: workspace too small: need %zu, have %zu\n", off, ws_size); return; }

    static int grid = 0;
    if (!grid) {
        int dev = 0, cus = 0; (void)hipGetDevice(&dev); (void)hipDeviceGetAttribute(&cus, hipDeviceAttributeMultiprocessorCount, dev);
        grid = cus > 0 ? cus : 256;
        (void)hipFuncSetAttribute((const void*)k_mega, hipFuncAttributeMaxDynamicSharedMemorySize, LDS_BYTES);
        int per_cu = 0;
        if (hipOccupancyMaxActiveBlocksPerMultiprocessor(&per_cu, (const void*)k_mega, NTHREADS, LDS_BYTES) != hipSuccess || per_cu < 1)
            fprintf(stderr, "kernel_launch: occupancy query reports %d workgroups per CU for the persistent kernel\n", per_cu);
    }
    (void)hipMemsetAsync(p.bar, 0, 4096 * sizeof(unsigned), stream);
    hipLaunchKernelGGL(k_mega, dim3(grid), dim3(NTHREADS), LDS_BYTES, stream, p);
}
```

```cpp
#include <hip/hip_runtime.h>
#include <stdint.h>
#include <stdio.h>
#include <string.h>
#include <type_traits>
namespace pg8 {
#define PG8_LAS __attribute__((address_space(3)))
typedef unsigned short bf16_t;
typedef short bf16x8 __attribute__((ext_vector_type(8)));
typedef float f32x4 __attribute__((ext_vector_type(4)));
typedef unsigned u32x4 __attribute__((ext_vector_type(4)));
constexpr int BM = 256, BK = 64, HALF = 128, HTB = HALF * BK * 2  , STAGE_BYTES = 8 * HTB, NXCD = 8, WGM = 8;

__host__ __device__ __forceinline__ int lds_byte(int r, int c) { const int st = (r >> 4) * 2 + (c >> 5), rr = r & 15, cc = c & 31, ob = rr * 64 + cc * 2; return st * 1024 + (ob ^ (((ob >> 9) & 1) << 5)); }
__host__ __device__ __forceinline__ void stage_rc(int b, int& R, int& C) { const int st = b / 1024, sb = b % 1024, swz = sb ^ (((sb >> 9) & 1) << 5); R = (st >> 1) * 16 + swz / 64; C = (st & 1) * 32 + (swz % 64) / 2; }
__host__ __device__ __forceinline__ int perm32(int rho) { const int n = rho >> 4, i = rho & 15; return 8 * (i >> 2) + 4 * n + (i & 3); }

struct Unit { int pm, pn; };
struct Gemm { const bf16_t* A; const bf16_t* Bt; int M, N, K; };

struct StaticOrder {
    int nM, nN, nwg, G, c;
    __host__ __device__ void init(int M, int N, int G_, int c_) { nM = M / BM; nN = N / BM; nwg = nM * nN; G = G_; c = c_; }
    __host__ __device__ bool next(int i, Unit& u) const {
        const long L = (long)i * G + c; if (L >= nwg) return false;
        int wgid = (int)L; { const int q = nwg / NXCD, r = nwg % NXCD, xcd = wgid % NXCD, off = wgid / NXCD; wgid = (xcd < r ? xcd * (q + 1) : r * (q + 1) + (xcd - r) * q) + off; }
        const int nig = WGM * nN, gid = wgid / nig, fm = gid * WGM, gsz = (nM - fm) < WGM ? (nM - fm) : WGM;
        u.pm = fm + ((wgid % nig) % gsz); u.pn = (wgid % nig) / gsz; return true;
    }
    __device__ __forceinline__ void a_ready(const Unit&) const {}
    __device__ __forceinline__ void done(const Unit&) const {}
};
__device__ __forceinline__ unsigned cvt_pk_bf16(float lo, float hi) { unsigned r; asm volatile("v_cvt_pk_bf16_f32 %0, %1, %2" : "=v"(r) : "v"(lo), "v"(hi)); return r; }
typedef float f32x2 __attribute__((ext_vector_type(2)));
struct EpiF32 {
    static constexpr bool PERM = false, AFTER_DRAIN = false;
    float* C; int ldc; const float* bias;
    __device__ __forceinline__ void operator()(const f32x4 (&acc)[2][2][4][2], const Unit& u, int wr, int wc, int fr, int fq) const {
        const int row0 = u.pm * BM + wr * 64 + fr, col0 = u.pn * BM + wc * 32 + 4 * fq;
        f32x4 bv[2][2];
#pragma unroll
        for (int bj = 0; bj < 2; ++bj)
#pragma unroll
            for (int n = 0; n < 2; ++n) bv[bj][n] = bias ? *(const f32x4*)(bias + col0 + bj * HALF + n * 16) : (f32x4){0.f, 0.f, 0.f, 0.f};
#pragma unroll
        for (int ai = 0; ai < 2; ++ai)
#pragma unroll
            for (int m = 0; m < 4; ++m) { float* rowp = C + (size_t)(row0 + ai * HALF + m * 16) * ldc + col0;
#pragma unroll
                for (int bj = 0; bj < 2; ++bj)
#pragma unroll
                    for (int n = 0; n < 2; ++n) *(f32x4*)(rowp + bj * HALF + n * 16) = acc[ai][bj][m][n] + bv[bj][n]; }
    }
};
template <class Epi, class Sched, bool STAMP = false>
__device__ __forceinline__ void gemm_phase(PG8_LAS unsigned char* lds, const Gemm g, const Sched& S, const Epi& E, unsigned long long* stamps) {
    int tid_o = threadIdx.x; asm volatile("" : "+v"(tid_o));
    const int tid = tid_o, wid = __builtin_amdgcn_readfirstlane(tid >> 6), lane = tid & 63, wr = wid >> 2, wc = wid & 3, fr = lane & 15, fq = lane >> 4;
    const int K = g.K, nt = K / BK;
    int ts_lo = 0, ts_hi = 0, nts = 0; const unsigned long long rt_entry = STAMP ? (unsigned long long)wall_clock64() : 0ull;
#define PG8_STAMP() do { if (STAMP && wid == 0 && nts < 64) { const unsigned long long _c = (unsigned long long)clock64(); \
        ts_lo = (lane == nts) ? (int)(unsigned)_c : ts_lo; ts_hi = (lane == nts) ? (int)(unsigned)(_c >> 32) : ts_hi; ++nts; } } while (0)
    PG8_STAMP();
    unsigned voffA[2], voffB[2];
#pragma unroll
    for (int i = 0; i < 2; ++i) { int R, C; stage_rc(tid * 16 + i * 8192, R, C); const int Rb = Epi::PERM ? ((R & ~31) + perm32(R & 31)) : R;
        voffA[i] = (unsigned)(R * K + C) * 2u; voffB[i] = (unsigned)(Rb * K + C) * 2u; }
    const size_t kstep = (size_t)(BK * 2);
    const size_t hstep = (size_t)HALF * K * 2;
    const size_t tstep = 2 * hstep;
    const unsigned ldsw = (unsigned)wid * 1024u;
    const int aoff = lds_byte(wr * 64 + fr, fq * 8), boff = lds_byte(wc * 32 + fr, fq * 8);
#define PG8_SA(b, h) (((b) * 2 + (h)) * HTB)
#define PG8_SB(b, h) ((4 + (b) * 2 + (h)) * HTB)
#define PG8_STAGE(bufoff, gbase, voff) do { _Pragma("unroll") for (int _i = 0; _i < 2; ++_i) \
        __builtin_amdgcn_global_load_lds((const unsigned*)((const char*)(gbase) + (voff)[_i]), (PG8_LAS unsigned*)(lds + (bufoff) + ldsw + _i * 8192), 16, 0, 0); } while (0)
#define PG8_LDA(dst, b, h) do { _Pragma("unroll") for (int m = 0; m < 4; ++m) _Pragma("unroll") for (int k = 0; k < 2; ++k) dst[m][k] = *(const PG8_LAS bf16x8*)(lds + PG8_SA(b, h) + aoff + m * 2048 + k * 1024); } while (0)
#define PG8_LDB(dst, b, h) do { _Pragma("unroll") for (int n = 0; n < 2; ++n) _Pragma("unroll") for (int k = 0; k < 2; ++k) dst[n][k] = *(const PG8_LAS bf16x8*)(lds + PG8_SB(b, h) + boff + n * 2048 + k * 1024); } while (0)
#define PG8_MMA(ai, bj, At, Bt) do { __builtin_amdgcn_s_setprio(1); _Pragma("unroll") for (int m = 0; m < 4; ++m) _Pragma("unroll") for (int n = 0; n < 2; ++n) _Pragma("unroll") for (int k = 0; k < 2; ++k) \
        acc[ai][bj][m][n] = __builtin_amdgcn_mfma_f32_16x16x32_bf16(Bt[n][k], At[m][k], acc[ai][bj][m][n], 0, 0, 0); __builtin_amdgcn_s_setprio(0); } while (0)
#define PG8_WAIT_V(n) asm volatile("s_waitcnt vmcnt(" #n ")" ::: "memory")
#define PG8_WAIT_L(n) asm volatile("s_waitcnt lgkmcnt(" #n ")" ::: "memory")
#define PG8_BAR __builtin_amdgcn_s_barrier()
#define PG8_SCHED __builtin_amdgcn_sched_barrier(0)
    Unit cur, nxt; int ui = 0;
    if (!S.next(0, cur)) return;
    f32x4 acc[2][2][4][2];
#pragma unroll
    for (int a = 0; a < 2; ++a)
#pragma unroll
        for (int b = 0; b < 2; ++b)
#pragma unroll
            for (int m = 0; m < 4; ++m)
#pragma unroll
                for (int n = 0; n < 2; ++n) acc[a][b][m][n] = (f32x4){0.f, 0.f, 0.f, 0.f};
    bf16x8 At[4][2], B0[2][2], B1[2][2];
    const char* cA = (const char*)g.A + (size_t)cur.pm * tstep; const char* cB = (const char*)g.Bt + (size_t)cur.pn * tstep;
    S.a_ready(cur);
    PG8_STAGE(PG8_SB(0, 0), cB, voffB); PG8_STAGE(PG8_SA(0, 0), cA, voffA); PG8_STAGE(PG8_SB(0, 1), cB + hstep, voffB); PG8_STAGE(PG8_SA(0, 1), cA + hstep, voffA);
    if (wr == 1) PG8_BAR;
    PG8_WAIT_V(4); PG8_BAR;
    PG8_STAGE(PG8_SB(1, 0), cB + kstep, voffB); PG8_STAGE(PG8_SA(1, 0), cA + kstep, voffA); PG8_STAGE(PG8_SB(1, 1), cB + hstep + kstep, voffB);
    PG8_WAIT_V(6); PG8_BAR;
    PG8_STAMP();
    for (;;) {
        const bool has_next = S.next(ui + 1, nxt);
        const char* nA = has_next ? (const char*)g.A + (size_t)nxt.pm * tstep : cA; const char* nB = has_next ? (const char*)g.Bt + (size_t)nxt.pn * tstep : cB;
        for (int t = 0; t < nt; t += 2) {
            const bool last = (t == nt - 2);
            const char* a1 = cA + (size_t)(t + 1) * kstep;
            const char* a2 = last ? nA : cA + (size_t)(t + 2) * kstep; const char* b2 = last ? nB : cB + (size_t)(t + 2) * kstep;
            const char* a3 = a2 + kstep; const char* b3 = b2 + kstep;
            if (last && has_next) S.a_ready(nxt);
            PG8_LDB(B0, 0, 0); PG8_SCHED; PG8_LDA(At, 0, 0); PG8_STAGE(PG8_SA(1, 1), a1 + hstep, voffA);
            PG8_WAIT_L(8); PG8_BAR; PG8_WAIT_L(0); PG8_MMA(0, 0, At, B0); PG8_BAR; PG8_SCHED;
            PG8_LDB(B1, 0, 1); PG8_STAGE(PG8_SB(0, 0), b2, voffB);
            PG8_BAR; PG8_WAIT_L(0); PG8_MMA(0, 1, At, B1); PG8_BAR;
            PG8_LDA(At, 0, 1); PG8_STAGE(PG8_SA(0, 0), a2, voffA);
            PG8_BAR; PG8_WAIT_L(0); PG8_MMA(1, 0, At, B0); PG8_BAR; PG8_SCHED;
            PG8_STAGE(PG8_SB(0, 1), b2 + hstep, voffB);
            PG8_WAIT_V(6); PG8_BAR; PG8_MMA(1, 1, At, B1); PG8_BAR;
            PG8_LDB(B0, 1, 0); PG8_SCHED; PG8_LDA(At, 1, 0); PG8_STAGE(PG8_SA(0, 1), a2 + hstep, voffA);
            PG8_WAIT_L(8); PG8_BAR; PG8_WAIT_L(0); PG8_MMA(0, 0, At, B0); PG8_BAR; PG8_SCHED;
            PG8_LDB(B1, 1, 1); PG8_STAGE(PG8_SB(1, 0), b3, voffB);
            PG8_BAR; PG8_WAIT_L(0); PG8_MMA(0, 1, At, B1); PG8_BAR;
            PG8_LDA(At, 1, 1); PG8_STAGE(PG8_SA(1, 0), a3, voffA);
            PG8_BAR; PG8_WAIT_L(0); PG8_MMA(1, 0, At, B0); PG8_BAR; PG8_SCHED;
            PG8_STAGE(PG8_SB(1, 1), b3 + hstep, voffB);
            PG8_WAIT_V(6); PG8_BAR; PG8_MMA(1, 1, At, B1); PG8_BAR;
        }
        PG8_STAMP();
        if constexpr (!Epi::AFTER_DRAIN) { E(acc, cur, wr, wc, fr, fq); S.done(cur); }
        PG8_STAMP();
        if (!has_next) break;
#pragma unroll
        for (int a = 0; a < 2; ++a)
#pragma unroll
            for (int b = 0; b < 2; ++b)
#pragma unroll
                for (int m = 0; m < 4; ++m)
#pragma unroll
                    for (int n = 0; n < 2; ++n) acc[a][b][m][n] = (f32x4){0.f, 0.f, 0.f, 0.f};
        cur = nxt; cA = nA; cB = nB; ++ui;
    }
    PG8_WAIT_V(0);
    if (wr == 0) PG8_BAR;
    PG8_BAR;
    if constexpr (Epi::AFTER_DRAIN) { E.fused(acc, cur, wr, wc, fr, fq, lds, wid, lane); S.done(cur); }
    PG8_STAMP();
    if (STAMP && wid == 0) { stamps[lane] = lane < nts ? (((unsigned long long)(unsigned)ts_hi << 32) | (unsigned)ts_lo) : 0ull;
        if (lane == 62) stamps[62] = rt_entry; if (lane == 63) stamps[63] = (unsigned long long)wall_clock64(); }
#undef PG8_STAMP
#undef PG8_SA
#undef PG8_SB
#undef PG8_STAGE
#undef PG8_LDA
#undef PG8_LDB
#undef PG8_MMA
#undef PG8_WAIT_V
#undef PG8_WAIT_L
#undef PG8_BAR
#undef PG8_SCHED
}
}

typedef unsigned short bf16_t;
typedef float f32x4 __attribute__((ext_vector_type(4)));
typedef float f32x16 __attribute__((ext_vector_type(16)));
typedef short bf16x8 __attribute__((ext_vector_type(8)));
typedef unsigned u32x4 __attribute__((ext_vector_type(4)));
typedef unsigned u32x2 __attribute__((ext_vector_type(2)));
#define LAS __attribute__((address_space(3)))

constexpr int D = 1024, BP = 2, T = 16384, NTP = BP * T  , NS = 128, NT = NTP + NS  , MP = 33024  ;
constexpr int NPROJ = 7680;
constexpr int NTHREADS = 512;
constexpr int LDS_BYTES = 155648;
constexpr float LN_EPS = 1e-5f;
constexpr float DN_ALPHA = 1.189207115002721f;

constexpr size_t OFF_YP = 0;
constexpr size_t OFF_YS = OFF_YP + (size_t)NTP * D;
constexpr size_t OFF_KVP0 = OFF_YS + (size_t)NS * D;
constexpr size_t OFF_KVP1 = OFF_KVP0 + (size_t)BP * 128 * 512;
constexpr size_t OFF_KVP2 = OFF_KVP1 + (size_t)BP * 512 * 512;
constexpr size_t OFF_GLAP = OFF_KVP2 + (size_t)BP * 2048 * 512;
constexpr size_t OFF_KVS0 = OFF_GLAP + (size_t)BP * 4 * 128 * 256;
constexpr size_t OFF_KVS1 = OFF_KVS0 + (size_t)NS * 128 * 512;
constexpr size_t OFF_KVS2 = OFF_KVS1 + (size_t)NS * 512 * 512;
constexpr size_t OFF_GLAS = OFF_KVS2 + (size_t)NS * 2048 * 512;
constexpr size_t OUT_TOTAL = OFF_GLAS + (size_t)NS * 4 * 128 * 256;

struct Params {
    const float *x_prompt, *x_sample, *c_prompt, *c_sample, *cache128, *cache512, *cache2048, *state_gla;
    const float *w_ada, *b_ada, *w_in, *w_gla_up, *b_gla, *gla_norm_w, *w_br_a, *w_br_b, *w_out, *ln1_w, *ln1_b;
    const float *w_pq, *peer_k1, *peer_k2, *peer_u, *peer_v, *ln2_w, *ln2_b;
    float* out;
    unsigned* bar;
    float* MOD; bf16_t* SC; bf16_t* WADA_T; bf16_t* WIN_T; bf16_t* WBRA_T; bf16_t* WBRB_T; bf16_t* WOUT_T; bf16_t* WPQ_T;
    bf16_t* KF; unsigned char* U8; unsigned char* V8; float* SU; float* SV;
    bf16_t* H; bf16_t* QKVA; bf16_t* QKB; bf16_t* VBB; bf16_t* RB; bf16_t* GA; bf16_t* GB; float* GLR;
    bf16_t* OG; float* LSE; float* LSEG; float* DSEG; float* SSEG; bf16_t* OGLA;
    bf16_t* OA; bf16_t* OB; bf16_t* TMP1; bf16_t* MERGED; float* Z1; float* LNST; bf16_t* QV; int* EIDX; float* EGW; float* ESU; float* EW; unsigned char* H8; float* HS;
};

__device__ __forceinline__ float bf2f(bf16_t v) { return __uint_as_float(((unsigned)v) << 16); }
__device__ __forceinline__ float bflo(unsigned w) { return __uint_as_float(w << 16); }
__device__ __forceinline__ float bfhi(unsigned w) { return __uint_as_float(w & 0xffff0000u); }
typedef __bf16 v2bf_t __attribute__((ext_vector_type(2)));
typedef float v2f_t __attribute__((ext_vector_type(2)));
__device__ __forceinline__ unsigned pack2(float lo, float hi) { const v2f_t f = {lo, hi}; const v2bf_t b = __builtin_convertvector(f, v2bf_t); return __builtin_bit_cast(unsigned, b); }
__device__ __forceinline__ bf16_t f2bf(float f) { return (bf16_t)(pack2(f, 0.f) & 0xffffu); }
__device__ __forceinline__ void unpack8(const u32x4 w, float (&o)[8]) { o[0] = bflo(w.x); o[1] = bfhi(w.x); o[2] = bflo(w.y); o[3] = bfhi(w.y); o[4] = bflo(w.z); o[5] = bfhi(w.z); o[6] = bflo(w.w); o[7] = bfhi(w.w); }
__device__ __forceinline__ float wave_sum(float v) {
#pragma unroll
    for (int o = 32; o >= 1; o >>= 1) v += __shfl_xor(v, o);
    return v;
}
__device__ __forceinline__ float wave_max(float v) {
#pragma unroll
    for (int o = 32; o >= 1; o >>= 1) v = fmaxf(v, __shfl_xor(v, o));
    return v;
}
#define DPP_ROR_F(v, n) __builtin_bit_cast(float, __builtin_amdgcn_update_dpp(0, __builtin_bit_cast(int, (v)), 0x120 + (n), 0xf, 0xf, true))
__device__ __forceinline__ float dpp_row_sum(float v) {
    v += DPP_ROR_F(v, 8); v += DPP_ROR_F(v, 4); v += DPP_ROR_F(v, 2); v += DPP_ROR_F(v, 1); return v;
}
__device__ __forceinline__ float sigmoidf_(float x) { return __builtin_amdgcn_rcpf(1.0f + __expf(-x)); }
__device__ __forceinline__ float siluf_(float x) { return x * __builtin_amdgcn_rcpf(1.0f + __expf(-x)); }
#define XB_TMO      128
#define XB_XCNT(j)  (256  + 64 * (j))
#define XB_XSUB(j)  (1280 + 64 * (j))
#define XB_XGEN(j)  (2304 + 64 * (j))
#define XB_TOP      3328
#define XB_TOPGEN   3392
#define XCD_BAR_WORDS 3456
#define XB_SPIN_CAP (1u << 22)

__device__ __forceinline__ unsigned xb_ld(unsigned* p)              { return __hip_atomic_load(p, __ATOMIC_RELAXED, __HIP_MEMORY_SCOPE_AGENT); }
__device__ __forceinline__ unsigned xb_add(unsigned* p, unsigned v) { return __hip_atomic_fetch_add(p, v, __ATOMIC_RELAXED, __HIP_MEMORY_SCOPE_AGENT); }
__device__ __forceinline__ unsigned xb_xcc_id() { return (unsigned)__builtin_amdgcn_s_getreg((3 << 11) | 20) & 0xFu; }
#define XB_SPIN(cond, bar) do { unsigned _sp = 0; while (cond) { __builtin_amdgcn_s_sleep(1); \
    if ((++_sp & 255u) == 0u) { if (xb_ld(&(bar)[XB_TMO])) break; if (_sp > XB_SPIN_CAP) { atomicAdd(&(bar)[XB_TMO], 1u); break; } } } } while (0)

struct XcdBarrier {
    unsigned* bar; unsigned x;
    volatile LAS unsigned* st;
};

__device__ __forceinline__ XcdBarrier xcd_barrier_post(unsigned* bar, volatile LAS unsigned* st) {
    XcdBarrier b; b.bar = bar; b.x = xb_xcc_id(); b.st = st;
    if (threadIdx.x == 0) (void)xb_add(&bar[XB_XCNT(b.x)], 1u);
    return b;
}
__device__ __forceinline__ void xcd_barrier_complete(unsigned* bar, unsigned x, unsigned& nloc, unsigned& nx) {
    const unsigned G = gridDim.x * gridDim.y * gridDim.z;
    unsigned sum, cnt, mine, sp = 0u;
    for (;;) {
        sum = 0u; cnt = 0u; mine = 0u;
#pragma unroll
        for (unsigned j = 0; j < 16; ++j) { const unsigned c = xb_ld(&bar[XB_XCNT(j)]); sum += c; cnt += (c > 0u) ? 1u : 0u; mine = (j == x) ? c : mine; }
        if (sum == G) break;
        __builtin_amdgcn_s_sleep(1);
        if ((++sp & 255u) == 0u) { if (xb_ld(&bar[XB_TMO])) break; if (sp > XB_SPIN_CAP) { atomicAdd(&bar[XB_TMO], 1u); break; } }
    }
    nloc = mine > 0u ? mine : 1u; nx = cnt > 0u ? cnt : 1u;
}

__device__ __forceinline__ void xcd_barrier(const XcdBarrier& b) {
    asm volatile("s_waitcnt vmcnt(0)" ::: "memory");
    __syncthreads();
    if (threadIdx.x == 0) {
        unsigned* bar = b.bar;
        __builtin_amdgcn_s_waitcnt(0);
        unsigned nloc = b.st[0], nx = b.st[1];
        if (nloc == 0u) { xcd_barrier_complete(bar, b.x, nloc, nx); b.st[0] = nloc; b.st[1] = nx; }
        const unsigned old = xb_add(&bar[XB_XSUB(b.x)], 1u);
        const unsigned gen = old / nloc;
        if (old + 1u == (gen + 1u) * nloc) {
            __builtin_amdgcn_fence(__ATOMIC_RELEASE, "agent");
            asm volatile("s_waitcnt vmcnt(0)" ::: "memory");
            const unsigned og = xb_add(&bar[XB_TOP], 1u);
            const unsigned tg = og / nx;
            if (og + 1u == (tg + 1u) * nx) xb_add(&bar[XB_TOPGEN], 1u);
            else XB_SPIN(xb_ld(&bar[XB_TOPGEN]) == tg, bar);
            __builtin_amdgcn_fence(__ATOMIC_ACQUIRE, "agent");
            xb_add(&bar[XB_XGEN(b.x)], 1u);
            asm volatile("s_waitcnt vmcnt(0)" ::: "memory");
        } else {
            XB_SPIN(xb_ld(&bar[XB_XGEN(b.x)]) == gen, bar);
            __builtin_amdgcn_fence(__ATOMIC_ACQUIRE, "agent");
            asm volatile("s_waitcnt vmcnt(0)" ::: "memory");
        }
    }
    __syncthreads();
}

__device__ __forceinline__ int win_cmap(int n) {
    if (n < 5376) return n;
    if (n < 6400) return n + 16;
    if (n < 7424) return n + 16;
    if (n < 7440) return n - 7424 + 5376;
    return -1;
}
__device__ __forceinline__ void tconv_tile(const float* __restrict__ src, int ldsrc, int K, bf16_t* __restrict__ dst, int tk, int tn, bool win, LAS float* tile) {
    int tid_ = threadIdx.x; asm volatile("" : "+v"(tid_));
    const int nl = tid_ & 63, kl0 = tid_ >> 6;
    const int n = tn * 64 + nl;
    const int sc = win ? win_cmap(n) : n;
#pragma unroll
    for (int i = 0; i < 8; ++i) { const int k = kl0 + 8 * i; tile[k * 65 + nl] = sc >= 0 ? src[(size_t)(tk * 64 + k) * ldsrc + sc] : 0.f; }
    __syncthreads();
    const int n2 = tid_ >> 3, kc = (tid_ & 7) * 8;
    u32x4 w;
    w.x = pack2(tile[(kc + 0) * 65 + n2], tile[(kc + 1) * 65 + n2]);
    w.y = pack2(tile[(kc + 2) * 65 + n2], tile[(kc + 3) * 65 + n2]);
    w.z = pack2(tile[(kc + 4) * 65 + n2], tile[(kc + 5) * 65 + n2]);
    w.w = pack2(tile[(kc + 6) * 65 + n2], tile[(kc + 7) * 65 + n2]);
    *(u32x4*)(dst + (size_t)(tn * 64 + n2) * K + tk * 64 + kc) = w;
    __syncthreads();
}
__device__ __forceinline__ void conv_chunk(const float* __restrict__ src, bf16_t* __restrict__ dst, size_t chunk) {
    int tid_ = threadIdx.x; asm volatile("" : "+v"(tid_));
    const size_t e = chunk * 4096 + (size_t)tid_ * 8;
    const f32x4 a = *(const f32x4*)(src + e), b = *(const f32x4*)(src + e + 4);
    u32x4 w; w.x = pack2(a[0], a[1]); w.y = pack2(a[2], a[3]); w.z = pack2(b[0], b[1]); w.w = pack2(b[2], b[3]);
    *(u32x4*)(dst + e) = w;
}

__device__ __forceinline__ void quant_rows8(const float* __restrict__ src, unsigned char* __restrict__ dst  , float* __restrict__ scl, int job) {
    int tid_ = threadIdx.x; asm volatile("" : "+v"(tid_));
    const int wave = tid_ >> 6, lane = tid_ & 63;
    const size_t row = (size_t)job * 8 + wave;
    const float* r = src + row * 1024 + 16 * lane;
    f32x4 x[4];
#pragma unroll
    for (int i = 0; i < 4; ++i) x[i] = *(const f32x4*)(r + 4 * i);
    float m = 0.f;
#pragma unroll
    for (int i = 0; i < 4; ++i) m = fmaxf(m, fmaxf(fmaxf(fabsf(x[i][0]), fabsf(x[i][1])), fmaxf(fabsf(x[i][2]), fabsf(x[i][3]))));
    m = wave_max(m);
    const float inv = m > 0.f ? 448.0f / m : 1.0f, sc = m > 0.f ? m * (1.0f / 448.0f) : 1.0f;
    u32x4 w;
#pragma unroll
    for (int i = 0; i < 4; ++i) {
        int d = 0;
        d = __builtin_amdgcn_cvt_pk_fp8_f32(x[i][0] * inv, x[i][1] * inv, d, false);
        d = __builtin_amdgcn_cvt_pk_fp8_f32(x[i][2] * inv, x[i][3] * inv, d, true);
        w[i] = (unsigned)d;
    }
    *(u32x4*)(dst + row * 2048 + 16 * lane) = w;
    if (lane == 0) scl[row] = sc;
}

__device__ __forceinline__ void kfrag_chunk(const float* __restrict__ k1, const float* __restrict__ k2, bf16_t* __restrict__ dst, int job) {
    int tid_ = threadIdx.x; asm volatile("" : "+v"(tid_));
    const int c = job * 512 + tid_, lane = c & 63, ks = (c >> 6) & 7, ni = (c >> 9) & 3, half = (c >> 11) & 1, h = c >> 12;
    const float* s = (half ? k2 : k1) + ((size_t)h * 128 + 32 * ni + (lane & 31)) * 128 + 16 * ks + 8 * (lane >> 5);
    const f32x4 a = *(const f32x4*)s, b = *(const f32x4*)(s + 4);
    u32x4 w; w.x = pack2(a[0], a[1]); w.y = pack2(a[2], a[3]); w.z = pack2(b[0], b[1]); w.w = pack2(b[2], b[3]);
    *(u32x4*)(dst + (size_t)c * 8) = w;
}
template <int STAGE> __device__ __forceinline__ void phase_prologue(const Params& p, int bid, int nb, LAS unsigned char* lds, int skip0) {
    int tid_ = threadIdx.x; asm volatile("" : "+v"(tid_));
    LAS float* tile = (LAS float*)lds;
    constexpr int J0 = 16 * 120, J1 = J0 + 16 * 96, J2 = J1 + 16 * 32, J3 = J2 + 256, J4 = J3 + 256, J5 = J4 + 64, J6 = J5 + 2048, J7 = J6 + 2048, J8 = J7 + 32, J9 = J8 + 32, J10 = J9 + 64;
    (void)J8;
    const int njobs = STAGE == 0 ? J1 + (J10 - J9) : J9 - J1;
    const int first = STAGE == 0 ? bid : bid - skip0, stride = STAGE == 0 ? nb : nb - skip0;
    if (first < 0 || stride <= 0) return;
    for (int jj = first; jj < njobs; jj += stride) {
        const int j = STAGE == 0 ? (jj < J1 ? jj : J9 + (jj - J1)) : J1 + jj;
        if (j < J0) { tconv_tile(p.w_in, 7440, 1024, p.WIN_T, j % 16, j / 16, true, tile); }
        else if (j < J1) { const int q = j - J0; tconv_tile(p.w_ada, 6144, 1024, p.WADA_T, q % 16, q / 16, false, tile); }
        else if (j < J2) { const int q = j - J1; tconv_tile(p.w_pq, 2048, 1024, p.WPQ_T, q % 16, q / 16, false, tile); }
        else if (j < J3) { const int q = j - J2; tconv_tile(p.w_br_b, 1024, 1024, p.WBRB_T, q % 16, q / 16, false, tile); }
        else if (j < J4) { const int q = j - J3; tconv_tile(p.w_out, 1024, 1024, p.WOUT_T, q % 16, q / 16, false, tile); }
        else if (j < J5) { const int q = j - J4; tconv_tile(p.w_br_a, 1024, 256, p.WBRA_T, q % 4, q / 4, false, tile); }
        else if (j < J6) { quant_rows8(p.peer_u, p.U8, p.SU, j - J5); }
        else if (j < J7) { quant_rows8(p.peer_v, p.U8 + 1024, p.SV, j - J6); }
        else if (j < J9) { kfrag_chunk(p.peer_k1, p.peer_k2, p.KF, j - J7); }
        else {
            const size_t e = (size_t)(j - J9) * 4096 + (size_t)tid_ * 8;
            const int row = (int)(e >> 10), col = (int)(e & 1023);
            float v[8];
#pragma unroll
            for (int i = 0; i < 8; ++i) v[i] = 0.f;
            if (row < 130) {
                const float* c = row < 2 ? p.c_prompt + (size_t)row * 1024 + col : p.c_sample + (size_t)(row - 2) * 1024 + col;
#pragma unroll
                for (int i = 0; i < 8; ++i) v[i] = siluf_(c[i]);
            }
            u32x4 w; w.x = pack2(v[0], v[1]); w.y = pack2(v[2], v[3]); w.z = pack2(v[4], v[5]); w.w = pack2(v[6], v[7]);
            *(u32x4*)(p.SC + e) = w;
        }
    }
}

__device__ __forceinline__ void row_stats(const float (&v)[16], float& mean, float& rstd) {
    float s = 0.f;
#pragma unroll
    for (int i = 0; i < 16; ++i) s += v[i];
    s = wave_sum(s);
    mean = s * (1.0f / 1024.0f);
    float q = 0.f;
#pragma unroll
    for (int i = 0; i < 16; ++i) { const float d = v[i] - mean; q += d * d; }
    q = wave_sum(q);
    rstd = rsqrtf(q * (1.0f / 1024.0f) + LN_EPS);
}
__device__ __forceinline__ void load_row16(const float* __restrict__ r, int lane, float (&v)[16]) {
    const f32x4 a = *(const f32x4*)(r + 8 * lane), b = *(const f32x4*)(r + 8 * lane + 4), c = *(const f32x4*)(r + 512 + 8 * lane), d = *(const f32x4*)(r + 512 + 8 * lane + 4);
#pragma unroll
    for (int i = 0; i < 4; ++i) { v[i] = a[i]; v[4 + i] = b[i]; v[8 + i] = c[i]; v[12 + i] = d[i]; }
}
__device__ __forceinline__ void store_row16_bf16(bf16_t* __restrict__ r, int lane, const float (&v)[16]) {
    u32x4 w0, w1;
    w0.x = pack2(v[0], v[1]); w0.y = pack2(v[2], v[3]); w0.z = pack2(v[4], v[5]); w0.w = pack2(v[6], v[7]);
    w1.x = pack2(v[8], v[9]); w1.y = pack2(v[10], v[11]); w1.z = pack2(v[12], v[13]); w1.w = pack2(v[14], v[15]);
    *(u32x4*)(r + 8 * lane) = w0; *(u32x4*)(r + 512 + 8 * lane) = w1;
}
__device__ __forceinline__ void store_row16_f32(float* __restrict__ r, int lane, const float (&v)[16]) {
    *(f32x4*)(r + 8 * lane) = (f32x4){v[0], v[1], v[2], v[3]}; *(f32x4*)(r + 8 * lane + 4) = (f32x4){v[4], v[5], v[6], v[7]};
    *(f32x4*)(r + 512 + 8 * lane) = (f32x4){v[8], v[9], v[10], v[11]}; *(f32x4*)(r + 512 + 8 * lane + 4) = (f32x4){v[12], v[13], v[14], v[15]};
}
__device__ __forceinline__ const float* x_row(const Params& p, int row) { return row < NTP ? p.x_prompt + (size_t)row * D : p.x_sample + (size_t)(row - NTP) * D; }
__device__ __forceinline__ int seq_of(int row) { return row < NTP ? (row >> 14) : 2 + (row - NTP); }

__device__ __forceinline__ void phase_lnmod1(const Params& p, int bid, int nb) {
    int tid_ = threadIdx.x; asm volatile("" : "+v"(tid_));
    const int wave = tid_ >> 6, lane = tid_ & 63;
    int row = bid * 8 + wave;
    float nx[16];
    if (row < NT) load_row16(x_row(p, row), lane, nx);
    for (; row < NT; row += nb * 8) {
        float v[16];
#pragma unroll
        for (int i = 0; i < 16; ++i) v[i] = nx[i];
        const int nrow = row + nb * 8;
        if (nrow < NT) load_row16(x_row(p, nrow), lane, nx);
        const float* mod = p.MOD + (size_t)seq_of(row) * 6144;
        float sh[16], sc[16];
        load_row16(mod, lane, sh); load_row16(mod + 1024, lane, sc);
        float mean, rstd; row_stats(v, mean, rstd);
#pragma unroll
        for (int i = 0; i < 16; ++i) v[i] = (v[i] - mean) * rstd * (1.0f + sc[i]) + sh[i];
        store_row16_bf16(p.H + (size_t)row * D, lane, v);
    }
}

struct EpiProj {
    static constexpr bool PERM = true, AFTER_DRAIN = false;
    bf16_t *QKVA, *QKB, *VBB, *RB, *GA, *GB; float* GLR; float* out;
    __device__ __forceinline__ void operator()(const pg8::f32x4 (&acc)[2][2][4][2], const pg8::Unit& u, int wr, int wc, int fr, int fq) const {
        const int pn = u.pn;
        bf16_t* dst; int ld = 1024, c0; float scale = 1.0f;
        if (pn < 9) { dst = QKVA; ld = 2304; c0 = pn * 256; }
        else if (pn < 13) { dst = QKB; c0 = (pn - 9) * 256; if (pn < 11) scale = 0.08838834764831845f; }
        else if (pn < 17) { dst = VBB; c0 = (pn - 13) * 256; }
        else if (pn < 21) { dst = RB; c0 = (pn - 17) * 256; }
        else if (pn < 25) { dst = GA; c0 = (pn - 21) * 256; }
        else if (pn < 29) { dst = GB; c0 = (pn - 25) * 256; }
        else { dst = nullptr; c0 = 0; }
        const bool kvt = pn >= 3 && pn < 9;
        const int g = kvt ? (pn - 3) % 3 : 0, kv = kvt ? (pn - 3) / 3 : 0;
        const int W = 128 << (2 * g);
        const size_t offp = g == 0 ? OFF_KVP0 : (g == 1 ? OFF_KVP1 : OFF_KVP2);
        const size_t offs = g == 0 ? OFF_KVS0 : (g == 1 ? OFF_KVS1 : OFF_KVS2);
        const int row0 = u.pm * 256 + wr * 64 + fr, colw = wc * 32 + 8 * fq;
#pragma unroll
        for (int ai = 0; ai < 2; ++ai)
#pragma unroll
            for (int m = 0; m < 4; ++m) {
                const int row = row0 + ai * 128 + m * 16;
#pragma unroll
                for (int bj = 0; bj < 2; ++bj) {
                    const int cc = bj * 128 + colw;
                    const pg8::f32x4 v0 = acc[ai][bj][m][0], v1 = acc[ai][bj][m][1];
                    if (dst) {
                        u32x4 w; w.x = pack2(v0[0] * scale, v0[1] * scale); w.y = pack2(v0[2] * scale, v0[3] * scale); w.z = pack2(v1[0] * scale, v1[1] * scale); w.w = pack2(v1[2] * scale, v1[3] * scale);
                        *(u32x4*)(dst + (size_t)row * ld + c0 + cc) = w;
                    } else if (cc < 16) {
                        *(pg8::f32x4*)(GLR + (size_t)row * 16 + cc) = v0; *(pg8::f32x4*)(GLR + (size_t)row * 16 + cc + 4) = v1;
                    }
                    if (kvt) {
                        if (row < NTP) {
                            const int b = row >> 14, t = row & (T - 1);
                            if (t >= T - W) { float* o = out + offp + ((size_t)(b * W + (t - (T - W))) * 2 + kv) * 256 + cc; *(pg8::f32x4*)o = v0; *(pg8::f32x4*)(o + 4) = v1; }
                        } else if (row < NT) {
                            const int s = row - NTP;
                            float* o = out + offs + ((size_t)(s * W + (W - 1)) * 2 + kv) * 256 + cc; *(pg8::f32x4*)o = v0; *(pg8::f32x4*)(o + 4) = v1;
                        }
                    }
                }
            }
    }
    __device__ __forceinline__ void emit16(int row, int col, const float (&v)[16]) const {
        const int pn = col >> 8, cc = col & 255;
        bf16_t* dst; int ld = 1024, c0; float scale = 1.0f;
        if (pn < 9) { dst = QKVA; ld = 2304; c0 = pn * 256; }
        else if (pn < 13) { dst = QKB; c0 = (pn - 9) * 256; if (pn < 11) scale = 0.08838834764831845f; }
        else if (pn < 17) { dst = VBB; c0 = (pn - 13) * 256; }
        else if (pn < 21) { dst = RB; c0 = (pn - 17) * 256; }
        else if (pn < 25) { dst = GA; c0 = (pn - 21) * 256; }
        else if (pn < 29) { dst = GB; c0 = (pn - 25) * 256; }
        else { dst = nullptr; c0 = 0; }
        if (dst) {
            u32x4 w0, w1;
            w0.x = pack2(v[0] * scale, v[1] * scale); w0.y = pack2(v[2] * scale, v[3] * scale); w0.z = pack2(v[4] * scale, v[5] * scale); w0.w = pack2(v[6] * scale, v[7] * scale);
            w1.x = pack2(v[8] * scale, v[9] * scale); w1.y = pack2(v[10] * scale, v[11] * scale); w1.z = pack2(v[12] * scale, v[13] * scale); w1.w = pack2(v[14] * scale, v[15] * scale);
            *(u32x4*)(dst + (size_t)row * ld + c0 + cc) = w0; *(u32x4*)(dst + (size_t)row * ld + c0 + cc + 8) = w1;
        } else if (cc == 0) {
#pragma unroll
            for (int i = 0; i < 4; ++i) *(f32x4*)(GLR + (size_t)row * 16 + 4 * i) = (f32x4){v[4 * i], v[4 * i + 1], v[4 * i + 2], v[4 * i + 3]};
        }
        if (pn >= 3 && pn < 9 && row >= NTP && row < NT) {
            const int g = (pn - 3) % 3, kv = (pn - 3) / 3, W = 128 << (2 * g), s = row - NTP;
            float* o = out + (g == 0 ? OFF_KVS0 : (g == 1 ? OFF_KVS1 : OFF_KVS2)) + ((size_t)(s * W + (W - 1)) * 2 + kv) * 256 + cc;
#pragma unroll
            for (int i = 0; i < 4; ++i) *(f32x4*)(o + 4 * i) = (f32x4){v[4 * i], v[4 * i + 1], v[4 * i + 2], v[4 * i + 3]};
        }
    }
};

__device__ __forceinline__ void phase_cache_copy(const Params& p, int bid, int nb) {
    int tid_ = threadIdx.x; asm volatile("" : "+v"(tid_));
    const size_t tid = (size_t)bid * NTHREADS + tid_, nth = (size_t)nb * NTHREADS;
#pragma unroll
    for (int g = 0; g < 3; ++g) {
        const int W = 128 << (2 * g);
        const float* src = g == 0 ? p.cache128 : (g == 1 ? p.cache512 : p.cache2048);
        float* dst = p.out + (g == 0 ? OFF_KVS0 : (g == 1 ? OFF_KVS1 : OFF_KVS2));
        const size_t per = (size_t)(W - 1) * 128, total = per * NS;
        for (size_t i = tid; i < total; i += nth) {
            const size_t s = i / per, rem = i - s * per;
            const f32x4 v = __builtin_nontemporal_load((const f32x4*)(src + (s * W + 1) * 512) + rem);
            __builtin_nontemporal_store(v, (f32x4*)(dst + s * W * 512) + rem);
        }
    }
}

__device__ __forceinline__ f32x16 mfma32(bf16x8 a, bf16x8 b, f32x16 c) { return __builtin_amdgcn_mfma_f32_32x32x16_bf16(a, b, c, 0, 0, 0); }
__device__ __forceinline__ f32x16 zero16() { f32x16 z; for (int i = 0; i < 16; ++i) z[i] = 0.f; return z; }
__device__ __forceinline__ bf16x8 ld_frag_g(const bf16_t* p) { return *(const bf16x8*)p; }
__device__ __forceinline__ bf16x8 ld_frag_l(const LAS bf16_t* p) { return *(const LAS bf16x8*)p; }
__device__ __forceinline__ int crow(int reg, int hh) { return (reg & 3) + 8 * (reg >> 2) + 4 * hh; }
__device__ __forceinline__ float log_sigmoidf_(float z) { return fminf(z, 0.f) - log1pf(__expf(-fabsf(z))); }

__device__ __forceinline__ void phase_gla_sample(const Params& p, int bid, int nb, LAS unsigned char* lds) {
    int tid_ = threadIdx.x; asm volatile("" : "+v"(tid_));
    LAS float* s_eg = (LAS float*)lds;
    LAS float* s_q = s_eg + 128;
    LAS float* s_k = s_q + 128;
    LAS float* s_o = s_k + 128;
    const int dv4 = tid_ & 63, kg = tid_ >> 6;
    for (int u = bid; u < NS * 4; u += nb) {
        const int s = u >> 2, h = u & 3;
        const size_t row = (size_t)(NTP + s);
        const float* S0 = p.state_gla + ((size_t)s * 4 + h) * 32768 + (size_t)(16 * kg) * 256 + 4 * dv4;
        float* Sn = p.out + OFF_GLAS + ((size_t)s * 4 + h) * 32768 + (size_t)(16 * kg) * 256 + 4 * dv4;
        f32x4 st[16];
#pragma unroll
        for (int i = 0; i < 16; ++i) st[i] = __builtin_nontemporal_load((const f32x4*)(S0 + i * 256));
        if (tid_ < 128) {
            const int kd = tid_; float z = p.b_gla[h * 128 + kd];
#pragma unroll
            for (int j = 0; j < 16; ++j) z += p.GLR[row * 16 + j] * p.w_gla_up[j * 512 + h * 128 + kd];
            s_eg[kd] = __expf(log_sigmoidf_(z) * (1.0f / 16.0f));
            s_q[kd] = bf2f(p.QKB[row * 1024 + h * 128 + kd]);
            s_k[kd] = bf2f(p.QKB[row * 1024 + 512 + h * 128 + kd]);
        }
        const u32x2 vw = *(const u32x2*)(p.VBB + row * 1024 + h * 256 + 4 * dv4);
        const f32x4 v4 = {bflo(vw.x), bfhi(vw.x), bflo(vw.y), bfhi(vw.y)};
        __syncthreads();
        f32x4 o = {0.f, 0.f, 0.f, 0.f};
#pragma unroll
        for (int i = 0; i < 16; ++i) {
            const int kd = 16 * kg + i;
            const f32x4 sv = st[i] * s_eg[kd] + v4 * s_k[kd];
            __builtin_nontemporal_store(sv, (f32x4*)(Sn + i * 256));
            o += sv * s_q[kd];
        }
        *(LAS f32x4*)(s_o + kg * 256 + 4 * dv4) = o;
        __syncthreads();
        float t = 0.f;
        if (tid_ < 256) {
#pragma unroll
            for (int w = 0; w < 8; ++w) t += s_o[w * 256 + tid_];
        }
        const float sq = wave_sum(t * t);
        __syncthreads();
        if ((tid_ & 63) == 0) s_o[tid_ >> 6] = sq;
        __syncthreads();
        if (tid_ < 256) {
            const float rn = rsqrtf((s_o[0] + s_o[1] + s_o[2] + s_o[3]) * (1.0f / 256.0f) + LN_EPS);
            p.OB[row * 1024 + h * 256 + tid_] = f2bf(t * rn * p.gla_norm_w[h * 256 + tid_] * siluf_(bf2f(p.RB[row * 1024 + h * 256 + tid_])));
        }
        __syncthreads();
    }
}

constexpr int G2_QP = 136;
constexpr int G2_TP = 72;
constexpr int G2_VP = 264;
typedef short v4s2_t __attribute__((ext_vector_type(4)));
constexpr int G2_BP = 132;
struct Gla2Lds {
    LAS float* glr; LAS float* tot; LAS float* dl; LAS float* bl; LAS float* bt; LAS bf16_t* qe; LAS bf16_t* ke; LAS bf16_t* kdt; LAS bf16_t* vt; LAS bf16_t* pp; LAS float* ss;
    __device__ __forceinline__ void carve(LAS unsigned char* lds) {
        glr = (LAS float*)lds; tot = glr + 1024; dl = tot + 512; bl = dl + 128; bt = bl + 128;
        qe = (LAS bf16_t*)(bt + 64 * G2_BP); ke = qe + 64 * G2_QP; kdt = ke + 64 * G2_QP; vt = kdt + 64 * G2_QP; pp = vt + 64 * G2_VP; ss = (LAS float*)(pp + 64 * G2_TP);
    }
};
struct Gla2Regs { f32x4 glr; u32x4 v[4], k[2], q[2]; };
__device__ __forceinline__ void gla2_load_chunk(const Params& p, Gla2Regs& R, int tid_, int b, int h, int c, bool need_qk) {
    const size_t row0 = (size_t)b * T + (size_t)c * 64;
    R.glr = *(const f32x4*)(p.GLR + row0 * 16 + (tid_ & 255) * 4);
#pragma unroll
    for (int i = 0; i < 4; ++i) { const int q = tid_ + 512 * i, t = q >> 5, dc = q & 31; R.v[i] = *(const u32x4*)(p.VBB + (row0 + t) * 1024 + h * 256 + dc * 8); }
#pragma unroll
    for (int i = 0; i < 2; ++i) { const int it = tid_ + 512 * i, t = it >> 4, kg = it & 15;
        R.k[i] = *(const u32x4*)(p.QKB + (row0 + t) * 1024 + 512 + h * 128 + kg * 8);
        if (need_qk) R.q[i] = *(const u32x4*)(p.QKB + (row0 + t) * 1024 + h * 128 + kg * 8); }
}
__device__ __forceinline__ float gla2_stage_chunk(const Gla2Lds& L, const Gla2Regs& R, int tid_, const float (&wup)[16], float bg, bool need_qk) {
    const int kd = tid_ >> 2, q4 = tid_ & 3;
    if (tid_ < 256) *(LAS f32x4*)(L.glr + tid_ * 4) = R.glr;
#pragma unroll
    for (int i = 0; i < 4; ++i) { const int q = tid_ + 512 * i, t = q >> 5, dc = q & 31; *(LAS u32x4*)(L.vt + t * G2_VP + dc * 8) = R.v[i]; }
    __syncthreads();
    float pre[16]; float run = 0.f;
#pragma unroll
    for (int i = 0; i < 16; ++i) {
        const int t = q4 * 16 + i; float z = bg;
#pragma unroll
        for (int j4 = 0; j4 < 4; ++j4) { const f32x4 gq = *(const LAS f32x4*)(L.glr + t * 16 + 4 * j4); z += gq[0] * wup[4 * j4] + gq[1] * wup[4 * j4 + 1] + gq[2] * wup[4 * j4 + 2] + gq[3] * wup[4 * j4 + 3]; }
        const float ls = fminf(z, 0.f) - __logf(1.0f + __expf(-fabsf(z)));
        run += ls * (1.0f / 16.0f); pre[i] = run;
    }
    const float t0 = __builtin_bit_cast(float, __builtin_amdgcn_update_dpp(0, __builtin_bit_cast(int, run), 0x00, 0xf, 0xf, true));
    const float t1 = __builtin_bit_cast(float, __builtin_amdgcn_update_dpp(0, __builtin_bit_cast(int, run), 0x55, 0xf, 0xf, true));
    const float t2 = __builtin_bit_cast(float, __builtin_amdgcn_update_dpp(0, __builtin_bit_cast(int, run), 0xaa, 0xf, 0xf, true));
    const float t3 = __builtin_bit_cast(float, __builtin_amdgcn_update_dpp(0, __builtin_bit_cast(int, run), 0xff, 0xf, 0xf, true));
    const float offs = (q4 > 0 ? t0 : 0.f) + (q4 > 1 ? t1 : 0.f) + (q4 > 2 ? t2 : 0.f), blast = (t0 + t1) + (t2 + t3);
#pragma unroll
    for (int i = 0; i < 16; ++i) L.bt[(q4 * 16 + i) * G2_BP + kd] = offs + pre[i];
    const float edl = __expf(blast);
    if (q4 == 0) { L.dl[kd] = edl; L.bl[kd] = blast; }
    __syncthreads();
#pragma unroll
    for (int i = 0; i < 2; ++i) {
        const int it = tid_ + 512 * i, t = it >> 4, kg = it & 15;
        const f32x4 b0 = *(const LAS f32x4*)(L.bt + t * G2_BP + 8 * kg), b1 = *(const LAS f32x4*)(L.bt + t * G2_BP + 8 * kg + 4);
        const f32x4 l0 = *(const LAS f32x4*)(L.bl + 8 * kg), l1 = *(const LAS f32x4*)(L.bl + 8 * kg + 4);
        const float bv[8] = {b0[0], b0[1], b0[2], b0[3], b1[0], b1[1], b1[2], b1[3]}, lv[8] = {l0[0], l0[1], l0[2], l0[3], l1[0], l1[1], l1[2], l1[3]};
        float k8[8]; unpack8(R.k[i], k8);
        { float kd8[8];
#pragma unroll
          for (int e = 0; e < 8; ++e) kd8[e] = k8[e] * __expf(lv[e] - bv[e]);
          u32x4 wd; wd.x = pack2(kd8[0], kd8[1]); wd.y = pack2(kd8[2], kd8[3]); wd.z = pack2(kd8[4], kd8[5]); wd.w = pack2(kd8[6], kd8[7]);
          *(LAS u32x4*)(L.kdt + t * G2_QP + 8 * kg) = wd; }
        if (need_qk) {
            float q8[8], qo[8], ko[8]; unpack8(R.q[i], q8);
#pragma unroll
            for (int e = 0; e < 8; ++e) { const float eb = __expf(bv[e]); qo[e] = q8[e] * eb; ko[e] = k8[e] * __builtin_amdgcn_rcpf(eb); }
            u32x4 wq, wk;
            wq.x = pack2(qo[0], qo[1]); wq.y = pack2(qo[2], qo[3]); wq.z = pack2(qo[4], qo[5]); wq.w = pack2(qo[6], qo[7]);
            wk.x = pack2(ko[0], ko[1]); wk.y = pack2(ko[2], ko[3]); wk.z = pack2(ko[4], ko[5]); wk.w = pack2(ko[6], ko[7]);
            *(LAS u32x4*)(L.qe + t * G2_QP + 8 * kg) = wq; *(LAS u32x4*)(L.ke + t * G2_QP + 8 * kg) = wk;
        }
    }
    __syncthreads();
    return edl;
}
__device__ __forceinline__ bf16x8 ld_frag_tr(const LAS bf16_t* img, int pitch, int row0, int col0, int lane) {
    const int i16 = lane & 15, hh = lane >> 5;
    const LAS bf16_t* ap = img + (row0 + 8 * hh + (i16 >> 2)) * pitch + col0 + 16 * ((lane >> 4) & 1) + 4 * (i16 & 3);
    union { bf16x8 v; v4s2_t h2[2]; } f;
    f.h2[0] = __builtin_amdgcn_ds_read_tr16_b64_v4i16((LAS v4s2_t*)ap);
    f.h2[1] = __builtin_amdgcn_ds_read_tr16_b64_v4i16((LAS v4s2_t*)(ap + 4 * pitch));
    return f.v;
}
__device__ __forceinline__ void gla2_update_state(const Gla2Lds& L, f32x16 (&S)[4], int wave, int lane) {
    const int hh = lane >> 5;
    bf16x8 vf[4];
#pragma unroll
    for (int ks = 0; ks < 4; ++ks) vf[ks] = ld_frag_tr(L.vt, G2_VP, 16 * ks, 32 * wave, lane);
#pragma unroll
    for (int mi = 0; mi < 4; ++mi) {
#pragma unroll
        for (int g4 = 0; g4 < 4; ++g4) {
            const f32x4 d = *(const LAS f32x4*)(L.dl + 32 * mi + 8 * g4 + 4 * hh);
#pragma unroll
            for (int j = 0; j < 4; ++j) S[mi][4 * g4 + j] *= d[j];
        }
#pragma unroll
        for (int ks = 0; ks < 4; ++ks) S[mi] = mfma32(ld_frag_tr(L.kdt, G2_QP, 16 * ks, 32 * mi, lane), vf[ks], S[mi]);
    }
}
__device__ __forceinline__ void phase_gla2_passA(const Params& p, int bid, int nb, LAS unsigned char* lds) {
    int tid_ = threadIdx.x; asm volatile("" : "+v"(tid_));
    Gla2Lds L; L.carve(lds);
    const int wave = tid_ >> 6, lane = tid_ & 63;
    for (int u = bid; u < 256; u += nb) {
        const int bh = u >> 5, seg = u & 31, b = bh >> 2, h = bh & 3;
        float wup[16];
#pragma unroll
        for (int j = 0; j < 16; ++j) wup[j] = p.w_gla_up[j * 512 + h * 128 + (tid_ >> 2)];
        const float bg = p.b_gla[h * 128 + (tid_ >> 2)];
        f32x16 S[4];
#pragma unroll
        for (int mi = 0; mi < 4; ++mi) S[mi] = zero16();
        float dprod = 1.0f;
        Gla2Regs R; gla2_load_chunk(p, R, tid_, b, h, seg * 8, false);
        for (int cc = 0; cc < 8; ++cc) {
            int tq = tid_; asm volatile("" : "+v"(tq));
            dprod *= gla2_stage_chunk(L, R, tq, wup, bg, false);
            if (cc < 7) gla2_load_chunk(p, R, tq, b, h, seg * 8 + cc + 1, false);
            gla2_update_state(L, S, wave, tq & 63);
            __syncthreads();
        }
        float* dst = p.LSEG + (size_t)u * 32768 + (size_t)wave * 4096 + lane;
#pragma unroll
        for (int mi = 0; mi < 4; ++mi)
#pragma unroll
            for (int reg = 0; reg < 16; ++reg) dst[(mi * 16 + reg) * 64] = S[mi][reg];
        if ((tid_ & 3) == 0) p.DSEG[(size_t)u * 128 + (tid_ >> 2)] = dprod;
    }
}
__device__ __forceinline__ void phase_gla2_scan(const Params& p, int bid, int nb) {
    int tid_ = threadIdx.x; asm volatile("" : "+v"(tid_));
    for (int e = bid * NTHREADS + tid_; e < 8 * 32768; e += nb * NTHREADS) {
        const int bh = e >> 15, idx = e & 32767, w = idx >> 12, rem = idx & 4095, mr = rem >> 6, ln = rem & 63, mi = mr >> 4, reg = mr & 15;
        const int kd = 32 * mi + crow(reg, ln >> 5), dv = 32 * w + (ln & 31);
        float S = 0.f;
        for (int s0 = 0; s0 < 32; s0 += 8) {
            float l[8], d[8];
#pragma unroll
            for (int i = 0; i < 8; ++i) { const size_t u = (size_t)bh * 32 + s0 + i; l[i] = p.LSEG[u * 32768 + idx]; d[i] = p.DSEG[u * 128 + kd]; }
#pragma unroll
            for (int i = 0; i < 8; ++i) { const size_t u = (size_t)bh * 32 + s0 + i; p.SSEG[u * 32768 + idx] = S; S = d[i] * S + l[i]; }
        }
        p.out[OFF_GLAP + ((size_t)bh * 128 + kd) * 256 + dv] = S;
    }
}
__device__ __forceinline__ void phase_gla2_passC(const Params& p, int bid, int nb, LAS unsigned char* lds) {
    int tid_ = threadIdx.x; asm volatile("" : "+v"(tid_));
    Gla2Lds L; L.carve(lds);
    const int wave = tid_ >> 6, lane = tid_ & 63;
    for (int u = bid; u < 256; u += nb) {
        const int bh = u >> 5, seg = u & 31, b = bh >> 2, h = bh & 3;
        float wup[16];
#pragma unroll
        for (int j = 0; j < 16; ++j) wup[j] = p.w_gla_up[j * 512 + h * 128 + (tid_ >> 2)];
        const float bg = p.b_gla[h * 128 + (tid_ >> 2)];
        Gla2Regs R; gla2_load_chunk(p, R, tid_, b, h, seg * 8, true);
        f32x16 S[4];
        {
            const float* src = p.SSEG + (size_t)u * 32768 + (size_t)wave * 4096 + lane;
#pragma unroll
            for (int mi = 0; mi < 4; ++mi)
#pragma unroll
                for (int reg = 0; reg < 16; ++reg) S[mi][reg] = src[(mi * 16 + reg) * 64];
        }
        for (int cc = 0; cc < 8; ++cc) {
            const int c = seg * 8 + cc, row0 = b * T + c * 64;
            int tq = tid_; asm volatile("" : "+v"(tq));
            const int r = tq & 31, hh = (tq >> 5) & 1;
            gla2_stage_chunk(L, R, tq, wup, bg, true);
            if (cc < 7) gla2_load_chunk(p, R, tq, b, h, c + 1, true);
            if (wave < 4) {
                const int mi = wave >> 1, ni = wave & 1;
                f32x16 acc = zero16();
#pragma unroll
                for (int ks = 0; ks < 8; ++ks) acc = mfma32(ld_frag_l(L.ke + (32 * ni + r) * G2_QP + 16 * ks + 8 * hh), ld_frag_l(L.qe + (32 * mi + r) * G2_QP + 16 * ks + 8 * hh), acc);
                const int t = 32 * mi + r;
#pragma unroll
                for (int rg = 0; rg < 4; ++rg) {
                    const int s0 = 32 * ni + 8 * rg + 4 * hh;
                    u32x2 w;
                    w.x = pack2(s0 + 0 <= t ? acc[4 * rg + 0] : 0.f, s0 + 1 <= t ? acc[4 * rg + 1] : 0.f);
                    w.y = pack2(s0 + 2 <= t ? acc[4 * rg + 2] : 0.f, s0 + 3 <= t ? acc[4 * rg + 3] : 0.f);
                    *(LAS u32x2*)(L.pp + t * G2_TP + s0) = w;
                }
            }
            union { bf16x8 v; unsigned w[4]; } sb[4][2];
#pragma unroll
            for (int mi = 0; mi < 4; ++mi)
#pragma unroll
                for (int s2 = 0; s2 < 2; ++s2)
#pragma unroll
                    for (int e = 0; e < 4; ++e) sb[mi][s2].w[e] = pack2(S[mi][8 * s2 + 2 * e], S[mi][8 * s2 + 2 * e + 1]);
            __syncthreads();
            f32x16 oacc[2];
#pragma unroll
            for (int tt = 0; tt < 2; ++tt) {
                f32x16 acc = zero16();
#pragma unroll
                for (int ks = 0; ks < 4; ++ks) acc = mfma32(ld_frag_tr(L.vt, G2_VP, 16 * ks, 32 * wave, tq & 63), ld_frag_l(L.pp + (32 * tt + r) * G2_TP + 16 * ks + 8 * hh), acc);
#pragma unroll
                for (int mi = 0; mi < 4; ++mi)
#pragma unroll
                    for (int s2 = 0; s2 < 2; ++s2) {
                        union { bf16x8 v; u32x2 h2[2]; } qa;
                        const LAS bf16_t* qp = L.qe + (32 * tt + r) * G2_QP + 32 * mi + 16 * s2 + 4 * hh;
                        qa.h2[0] = *(const LAS u32x2*)qp; qa.h2[1] = *(const LAS u32x2*)(qp + 8);
                        acc = mfma32(sb[mi][s2].v, qa.v, acc);
                    }
                float sq = 0.f;
#pragma unroll
                for (int i = 0; i < 16; ++i) sq += acc[i] * acc[i];
                sq += __shfl_xor(sq, 32);
                if (hh == 0) L.ss[wave * 64 + 32 * tt + r] = sq;
                oacc[tt] = acc;
            }
            gla2_update_state(L, S, wave, tq & 63);
            __syncthreads();
#pragma unroll
            for (int tt = 0; tt < 2; ++tt) {
                float tot = 0.f;
#pragma unroll
                for (int w = 0; w < 8; ++w) tot += L.ss[w * 64 + 32 * tt + r];
                const float rn = rsqrtf(tot * (1.0f / 256.0f) + LN_EPS);
                const size_t ro = (size_t)(row0 + 32 * tt + r) * 1024 + h * 256 + 32 * wave + 4 * hh;
                const float* gw = p.gla_norm_w + h * 256 + 32 * wave + 4 * hh;
#pragma unroll
                for (int rg = 0; rg < 4; ++rg) {
                    const u32x2 rw = *(const u32x2*)(p.RB + ro + 8 * rg);
                    const f32x4 g4 = *(const f32x4*)(gw + 8 * rg);
                    const float o0 = oacc[tt][4 * rg + 0] * rn * g4[0] * siluf_(bflo(rw.x)), o1 = oacc[tt][4 * rg + 1] * rn * g4[1] * siluf_(bfhi(rw.x));
                    const float o2 = oacc[tt][4 * rg + 2] * rn * g4[2] * siluf_(bflo(rw.y)), o3 = oacc[tt][4 * rg + 3] * rn * g4[3] * siluf_(bfhi(rw.y));
                    u32x2 w; w.x = pack2(o0, o1); w.y = pack2(o2, o3);
                    *(u32x2*)(p.OB + ro + 8 * rg) = w;
                }
            }
            __syncthreads();
        }
    }
}

constexpr int AKV_PITCH = 72;
typedef short v4s_t __attribute__((ext_vector_type(4)));
__device__ __forceinline__ float alibi_slope(int g, int j) { return exp2f(-8.0f * (float)(g * 4 + j + 1) / 12.0f); }

__device__ __forceinline__ void phase_attn_prompt(const Params& p, int bid, int nb_, LAS unsigned char* lds) {
    int tid_ = threadIdx.x; asm volatile("" : "+v"(tid_));
    LAS bf16_t* s_k = (LAS bf16_t*)lds;
    LAS bf16_t* s_v = s_k + 2 * 256 * AKV_PITCH;
    const int wave = tid_ >> 6, lane = tid_ & 63, r = lane & 31, hh = lane >> 5;
    const int jj = wave >> 2, qs = wave & 3;
    for (int u = bid; u < 1536; u += nb_) {
        const int hp = u & 1, nbq = (u >> 1) & 127, bg = u >> 8, g = bg % 3, b = bg / 3;
        const int d = 1 << (2 * g), nbk = 128 >> (2 * g);
        const int ph = nbq / nbk, nb = nbq % nbk;
#pragma unroll
        for (int half = 0; half < 2; ++half) {
            u32x4 w[8];
#pragma unroll
            for (int i = 0; i < 8; ++i) {
                const int q = tid_ + 512 * i, hj = q >> 11, key = (q >> 3) & 255, dc = q & 7;
                int lp = 128 * (nb - 1) + key; lp = lp < 0 ? 0 : lp;
                const size_t row = (size_t)b * T + (size_t)lp * d + ph;
                w[i] = *(const u32x4*)(p.QKVA + row * 2304 + (half ? 1536 : 768) + g * 256 + (2 * hp + hj) * 64 + dc * 8);
            }
#pragma unroll
            for (int i = 0; i < 8; ++i) {
                const int q = tid_ + 512 * i, hj = q >> 11, key = (q >> 3) & 255, dc = q & 7;
                *(LAS u32x4*)((half ? s_v : s_k) + (hj * 256 + key) * AKV_PITCH + dc * 8) = w[i];
            }
        }
        const int j = 2 * hp + jj;
        const float slope_d = alibi_slope(g, j) * (float)d;
        const int qi = 32 * qs + r;
        const size_t rowq = (size_t)b * T + (size_t)(128 * nb + qi) * d + ph;
        bf16x8 qf[4];
#pragma unroll
        for (int ks = 0; ks < 4; ++ks) qf[ks] = ld_frag_g(p.QKVA + rowq * 2304 + g * 256 + j * 64 + 16 * ks + 8 * hh);
        __syncthreads();
        float sc[5][16];
        const LAS bf16_t* kb = s_k + (jj * 256 + 32 * qs + r) * AKV_PITCH + 8 * hh;
#pragma unroll
        for (int kt = 0; kt < 5; ++kt) {
            f32x16 acc = zero16();
#pragma unroll
            for (int ks = 0; ks < 4; ++ks) acc = mfma32(ld_frag_l(kb + (32 * kt) * AKV_PITCH + 16 * ks), qf[ks], acc);
#pragma unroll
            for (int reg = 0; reg < 16; ++reg) sc[kt][reg] = acc[reg];
        }
        float m = -3.0e38f;
        float fb = (float)(r - 4 * hh + 128);
        asm volatile("" : "+v"(fb));
        const float fsmax = nb > 0 ? 128.0f : (float)qi;
#pragma unroll
        for (int kt = 0; kt < 5; ++kt)
#pragma unroll
            for (int reg = 0; reg < 16; ++reg) {
                const float fs = fb - (float)(32 * kt + (reg & 3) + 8 * (reg >> 2));
                const bool valid = fs >= 0.f && fs <= fsmax;
                const float v = valid ? sc[kt][reg] * 0.125f - slope_d * fs : -3.0e38f;
                sc[kt][reg] = v; m = fmaxf(m, v);
            }
        m = fmaxf(m, __shfl_xor(m, 32));
        float z = 0.f;
#pragma unroll
        for (int kt = 0; kt < 5; ++kt)
#pragma unroll
            for (int reg = 0; reg < 16; ++reg) { const float v = sc[kt][reg]; const float e = v > -1.0e38f ? __expf(v - m) : 0.f; sc[kt][reg] = e; z += e; if (reg == 15) __builtin_amdgcn_sched_barrier(0); }
        z += __shfl_xor(z, 32);
        const float rz = 1.0f / z;
        f32x16 o0 = zero16(), o1 = zero16();
        const int i16 = lane & 15;
        const LAS bf16_t* vb = s_v + (jj * 256 + 32 * qs + 4 * hh + (i16 >> 2)) * AKV_PITCH + 16 * ((lane >> 4) & 1) + 4 * (i16 & 3);
#pragma unroll
        for (int kt = 0; kt < 5; ++kt)
#pragma unroll
            for (int s2 = 0; s2 < 2; ++s2) {
                union { bf16x8 v; unsigned w[4]; } pb;
#pragma unroll
                for (int e = 0; e < 4; ++e) pb.w[e] = pack2(sc[kt][8 * s2 + 2 * e] * rz, sc[kt][8 * s2 + 2 * e + 1] * rz);
#pragma unroll
                for (int dt = 0; dt < 2; ++dt) {
                    union { bf16x8 v; v4s_t h2[2]; } va;
                    const LAS bf16_t* ap = vb + (32 * kt + 16 * s2) * AKV_PITCH + 32 * dt;
                    va.h2[0] = __builtin_amdgcn_ds_read_tr16_b64_v4i16((LAS v4s_t*)ap);
                    va.h2[1] = __builtin_amdgcn_ds_read_tr16_b64_v4i16((LAS v4s_t*)(ap + 8 * AKV_PITCH));
                    if (dt == 0) o0 = mfma32(va.v, pb.v, o0); else o1 = mfma32(va.v, pb.v, o1);
                }
                __builtin_amdgcn_sched_barrier(0);
            }
        bf16_t* og = p.OG + rowq * 768 + g * 256 + j * 64;
#pragma unroll
        for (int rg = 0; rg < 4; ++rg) {
            u32x2 w0, w1;
            w0.x = pack2(o0[4 * rg + 0], o0[4 * rg + 1]); w0.y = pack2(o0[4 * rg + 2], o0[4 * rg + 3]);
            w1.x = pack2(o1[4 * rg + 0], o1[4 * rg + 1]); w1.y = pack2(o1[4 * rg + 2], o1[4 * rg + 3]);
            *(u32x2*)(og + 8 * rg + 4 * hh) = w0; *(u32x2*)(og + 32 + 8 * rg + 4 * hh) = w1;
        }
        if (hh == 0) p.LSE[rowq * 12 + g * 4 + j] = m + __logf(z);
        __syncthreads();
    }
}

__device__ __forceinline__ void phase_attn_sample(const Params& p, int bid, int nb_, LAS unsigned char* lds) {
    int tid_ = threadIdx.x; asm volatile("" : "+v"(tid_));
    LAS float* s_sc = (LAS float*)lds;
    LAS float* s_o = s_sc + 4 * 132;
    const int wave = tid_ >> 6, lane = tid_ & 63, hd = lane >> 4;
    for (int u = bid; u < NS * 3; u += nb_) {
        const int s = u / 3, g = u % 3, d = 1 << (2 * g), W = 128 << (2 * g);
        const size_t row = (size_t)(NTP + s);
        const float* cache = (g == 0 ? p.cache128 : (g == 1 ? p.cache512 : p.cache2048)) + (size_t)s * W * 512;
        const int nk = wave == 0 ? 17 : 16;
        f32x4 kr[17];
#pragma unroll
        for (int i = 0; i < 17; ++i) {
            const int k = wave + 8 * i;
            if (i < nk) {
                if (k == 0) { const u32x2 w = *(const u32x2*)(p.QKVA + row * 2304 + 768 + g * 256 + 4 * lane); kr[i] = (f32x4){bflo(w.x), bfhi(w.x), bflo(w.y), bfhi(w.y)}; }
                else kr[i] = *(const f32x4*)(cache + ((size_t)(W - k * d) * 2 + 0) * 256 + 4 * lane);
            } else kr[i] = (f32x4){0.f, 0.f, 0.f, 0.f};
        }
        const u32x2 qw = *(const u32x2*)(p.QKVA + row * 2304 + g * 256 + 4 * lane);
        const f32x4 q4 = {bflo(qw.x), bfhi(qw.x), bflo(qw.y), bfhi(qw.y)};
        const float slope = alibi_slope(g, hd);
#pragma unroll
        for (int i = 0; i < 17; ++i) {
            const int k = wave + 8 * i;
            float dot = kr[i][0] * q4[0] + kr[i][1] * q4[1] + kr[i][2] * q4[2] + kr[i][3] * q4[3];
            dot = dpp_row_sum(dot);
            if (i < nk && (lane & 15) == 0) s_sc[hd * 132 + k] = dot * 0.125f - slope * (float)(k * d);
        }
        f32x4 vr[17];
#pragma unroll
        for (int i = 0; i < 17; ++i) {
            const int k = wave + 8 * i;
            if (i < nk) {
                if (k == 0) { const u32x2 w = *(const u32x2*)(p.QKVA + row * 2304 + 1536 + g * 256 + 4 * lane); vr[i] = (f32x4){bflo(w.x), bfhi(w.x), bflo(w.y), bfhi(w.y)}; }
                else vr[i] = *(const f32x4*)(cache + ((size_t)(W - k * d) * 2 + 1) * 256 + 4 * lane);
            } else vr[i] = (f32x4){0.f, 0.f, 0.f, 0.f};
        }
        __syncthreads();
        if (wave < 4) {
            const int h2 = wave;
            const float a0 = s_sc[h2 * 132 + lane], a1 = s_sc[h2 * 132 + 64 + lane], a2 = lane == 0 ? s_sc[h2 * 132 + 128] : -3.0e38f;
            const float m = wave_max(fmaxf(fmaxf(a0, a1), a2));
            const float e0 = __expf(a0 - m), e1 = __expf(a1 - m), e2 = lane == 0 ? __expf(a2 - m) : 0.f;
            const float z = wave_sum(e0 + e1 + e2), rz = 1.0f / z;
            s_sc[h2 * 132 + lane] = e0 * rz; s_sc[h2 * 132 + 64 + lane] = e1 * rz; if (lane == 0) { s_sc[h2 * 132 + 128] = e2 * rz; p.LSE[row * 12 + g * 4 + h2] = m + __logf(z); }
        }
        __syncthreads();
        f32x4 o = {0.f, 0.f, 0.f, 0.f};
#pragma unroll
        for (int i = 0; i < 17; ++i) { const int k = wave + 8 * i; if (i < nk) o += vr[i] * s_sc[hd * 132 + k]; }
        *(LAS f32x4*)(s_o + wave * 256 + 4 * lane) = o;
        __syncthreads();
        if (tid_ < 256) {
            float t2 = 0.f;
#pragma unroll
            for (int w = 0; w < 8; ++w) t2 += s_o[w * 256 + tid_];
            p.OG[row * 768 + g * 256 + tid_] = f2bf(t2);
        }
        __syncthreads();
    }
}

__device__ __forceinline__ void phase_merge_prep(const Params& p, int bid, int nb) {
    int tid_ = threadIdx.x; asm volatile("" : "+v"(tid_));
    const int wave = tid_ >> 6, lane = tid_ & 63;
    for (int row = bid * 8 + wave; row < NT; row += nb * 8) {
        const size_t R = (size_t)row;
        {
            const int j = lane >> 4;
            const float l0 = p.LSE[R * 12 + j], l1 = p.LSE[R * 12 + 4 + j], l2 = p.LSE[R * 12 + 8 + j];
            const float m = fmaxf(l0, fmaxf(l1, l2));
            float w0 = __expf(l0 - m), w1 = __expf(l1 - m), w2 = __expf(l2 - m);
            const float rs = 1.0f / (w0 + w1 + w2); w0 *= rs; w1 *= rs; w2 *= rs;
            const u32x2 a = *(const u32x2*)(p.OG + R * 768 + 4 * lane), b = *(const u32x2*)(p.OG + R * 768 + 256 + 4 * lane), c = *(const u32x2*)(p.OG + R * 768 + 512 + 4 * lane);
            u32x2 o;
            o.x = pack2(w0 * bflo(a.x) + w1 * bflo(b.x) + w2 * bflo(c.x), w0 * bfhi(a.x) + w1 * bfhi(b.x) + w2 * bfhi(c.x));
            o.y = pack2(w0 * bflo(a.y) + w1 * bflo(b.y) + w2 * bflo(c.y), w0 * bfhi(a.y) + w1 * bfhi(b.y) + w2 * bfhi(c.y));
            *(u32x2*)(p.OA + R * 256 + 4 * lane) = o;
        }
    }
}

template <int MODE> struct EpiGate {
    static constexpr bool PERM = true, AFTER_DRAIN = false;
    bf16_t* O; const bf16_t* G; const bf16_t* ADD; int ld;
    __device__ __forceinline__ void operator()(const pg8::f32x4 (&acc)[2][2][4][2], const pg8::Unit& u, int wr, int wc, int fr, int fq) const {
        const int row0 = u.pm * 256 + wr * 64 + fr, col0 = u.pn * 256 + wc * 32 + 8 * fq;
#pragma unroll
        for (int ai = 0; ai < 2; ++ai) {
            u32x4 gq[8], aq[8];
#pragma unroll
            for (int m = 0; m < 4; ++m)
#pragma unroll
                for (int bj = 0; bj < 2; ++bj) {
                    const size_t o = (size_t)(row0 + ai * 128 + m * 16) * ld + col0 + bj * 128;
                    if (MODE != 2) gq[m * 2 + bj] = *(const u32x4*)(G + o);
                    if (MODE == 1) aq[m * 2 + bj] = *(const u32x4*)(ADD + o);
                }
#pragma unroll
            for (int m = 0; m < 4; ++m)
#pragma unroll
                for (int bj = 0; bj < 2; ++bj) {
                    const size_t o = (size_t)(row0 + ai * 128 + m * 16) * ld + col0 + bj * 128;
                    const pg8::f32x4 v0 = acc[ai][bj][m][0], v1 = acc[ai][bj][m][1];
                    float v[8] = {v0[0], v0[1], v0[2], v0[3], v1[0], v1[1], v1[2], v1[3]};
                    if (MODE != 2) { float gg[8]; unpack8(gq[m * 2 + bj], gg);
#pragma unroll
                        for (int i = 0; i < 8; ++i) v[i] *= sigmoidf_(gg[i]); }
                    if (MODE == 1) { float aa[8]; unpack8(aq[m * 2 + bj], aa);
#pragma unroll
                        for (int i = 0; i < 8; ++i) v[i] += aa[i]; }
                    u32x4 w; w.x = pack2(v[0], v[1]); w.y = pack2(v[2], v[3]); w.z = pack2(v[4], v[5]); w.w = pack2(v[6], v[7]);
                    *(u32x4*)(O + o) = w;
                }
        }
    }
    __device__ __forceinline__ void emit16(int row, int col, const float (&vin)[16]) const {
#pragma unroll
        for (int hf = 0; hf < 2; ++hf) {
            const size_t o = (size_t)row * ld + col + 8 * hf;
            float v[8];
#pragma unroll
            for (int i = 0; i < 8; ++i) v[i] = vin[8 * hf + i];
            if (MODE != 2) { float gg[8]; unpack8(*(const u32x4*)(G + o), gg);
#pragma unroll
                for (int i = 0; i < 8; ++i) v[i] *= sigmoidf_(gg[i]); }
            if (MODE == 1) { float aa[8]; unpack8(*(const u32x4*)(ADD + o), aa);
#pragma unroll
                for (int i = 0; i < 8; ++i) v[i] += aa[i]; }
            u32x4 w; w.x = pack2(v[0], v[1]); w.y = pack2(v[2], v[3]); w.z = pack2(v[4], v[5]); w.w = pack2(v[6], v[7]);
            *(u32x4*)(O + o) = w;
        }
    }
};
struct EpiOut {
    static constexpr bool PERM = false, AFTER_DRAIN = false;
    float* Z1; const float* x_prompt; const float* x_sample; const float* MOD;
    __device__ __forceinline__ void operator()(const pg8::f32x4 (&acc)[2][2][4][2], const pg8::Unit& u, int wr, int wc, int fr, int fq) const {
        const int row0 = u.pm * 256 + wr * 64 + fr, col0 = u.pn * 256 + wc * 32 + 4 * fq;
        const float* g1 = MOD + (size_t)(row0 >> 14) * 6144 + 2048 + col0;
        pg8::f32x4 gv[2][2];
#pragma unroll
        for (int bj = 0; bj < 2; ++bj)
#pragma unroll
            for (int n = 0; n < 2; ++n) gv[bj][n] = *(const pg8::f32x4*)(g1 + bj * 128 + n * 16);
#pragma unroll
        for (int ai = 0; ai < 2; ++ai) {
            pg8::f32x4 xv[4][2][2];
#pragma unroll
            for (int m = 0; m < 4; ++m)
#pragma unroll
                for (int bj = 0; bj < 2; ++bj)
#pragma unroll
                    for (int n = 0; n < 2; ++n) xv[m][bj][n] = *(const pg8::f32x4*)(x_prompt + (size_t)(row0 + ai * 128 + m * 16) * D + col0 + bj * 128 + n * 16);
#pragma unroll
            for (int m = 0; m < 4; ++m)
#pragma unroll
                for (int bj = 0; bj < 2; ++bj)
#pragma unroll
                    for (int n = 0; n < 2; ++n)
                        *(pg8::f32x4*)(Z1 + (size_t)(row0 + ai * 128 + m * 16) * D + col0 + bj * 128 + n * 16) = xv[m][bj][n] * DN_ALPHA + gv[bj][n] * acc[ai][bj][m][n];
        }
    }
    __device__ __forceinline__ void emit16(int row, int col, const float (&v)[16]) const {
        if (row >= NT) return;
        const float* xr = row < NTP ? x_prompt + (size_t)row * D : x_sample + (size_t)(row - NTP) * D;
        const float* g1 = MOD + (size_t)seq_of(row) * 6144 + 2048;
#pragma unroll
        for (int i = 0; i < 4; ++i) {
            const f32x4 xv = *(const f32x4*)(xr + col + 4 * i), gv = *(const f32x4*)(g1 + col + 4 * i);
            *(f32x4*)(Z1 + (size_t)row * D + col + 4 * i) = xv * DN_ALPHA + gv * (f32x4){v[4 * i], v[4 * i + 1], v[4 * i + 2], v[4 * i + 3]};
        }
    }
};

__device__ __forceinline__ size_t qvf_index(int row, int c0) {
    return ((((((size_t)(row >> 5) * 8 + (c0 >> 8)) * 2 + ((c0 >> 7) & 1)) * 8 + ((c0 & 127) >> 4)) * 64) + (((c0 >> 3) & 1) * 32 + (row & 31))) * 8;
}
struct EpiQvf {
    static constexpr bool PERM = true, AFTER_DRAIN = false;
    bf16_t* O;
    __device__ __forceinline__ void operator()(const pg8::f32x4 (&acc)[2][2][4][2], const pg8::Unit& u, int wr, int wc, int fr, int fq) const {
        const int row0 = u.pm * 256 + wr * 64 + fr, col0 = u.pn * 256 + wc * 32 + 8 * fq;
#pragma unroll
        for (int ai = 0; ai < 2; ++ai)
#pragma unroll
            for (int m = 0; m < 4; ++m)
#pragma unroll
                for (int bj = 0; bj < 2; ++bj) {
                    const pg8::f32x4 v0 = acc[ai][bj][m][0], v1 = acc[ai][bj][m][1];
                    u32x4 w; w.x = pack2(v0[0], v0[1]); w.y = pack2(v0[2], v0[3]); w.z = pack2(v1[0], v1[1]); w.w = pack2(v1[2], v1[3]);
                    *(u32x4*)(O + qvf_index(row0 + ai * 128 + m * 16, col0 + bj * 128)) = w;
                }
    }
    __device__ __forceinline__ void emit16(int row, int col, const float (&v)[16]) const {
        u32x4 w0, w1;
        w0.x = pack2(v[0], v[1]); w0.y = pack2(v[2], v[3]); w0.z = pack2(v[4], v[5]); w0.w = pack2(v[6], v[7]);
        w1.x = pack2(v[8], v[9]); w1.y = pack2(v[10], v[11]); w1.z = pack2(v[12], v[13]); w1.w = pack2(v[14], v[15]);
        *(u32x4*)(O + qvf_index(row, col)) = w0; *(u32x4*)(O + qvf_index(row, col + 8)) = w1;
    }
};

__device__ __forceinline__ void phase_ln1(const Params& p, int bid, int nb) {
    int tid_ = threadIdx.x; asm volatile("" : "+v"(tid_));
    const int wave = tid_ >> 6, lane = tid_ & 63;
    float lw[16], lb[16];
    load_row16(p.ln1_w, lane, lw); load_row16(p.ln1_b, lane, lb);
    int row = bid * 8 + wave;
    float nx[16];
    if (row < NT) load_row16(p.Z1 + (size_t)row * D, lane, nx);
    for (; row < NT; row += nb * 8) {
        float v[16];
#pragma unroll
        for (int i = 0; i < 16; ++i) v[i] = nx[i];
        const int nrow = row + nb * 8;
        if (nrow < NT) load_row16(p.Z1 + (size_t)nrow * D, lane, nx);
        const float* mod = p.MOD + (size_t)seq_of(row) * 6144;
        float sh[16], sc[16];
        load_row16(mod + 3072, lane, sh); load_row16(mod + 4096, lane, sc);
        float mean, rstd; row_stats(v, mean, rstd);
        if (lane == 0) { p.LNST[(size_t)row * 2] = mean; p.LNST[(size_t)row * 2 + 1] = rstd; }
#pragma unroll
        for (int i = 0; i < 16; ++i) v[i] = (v[i] - mean) * rstd * lw[i] + lb[i];
        row_stats(v, mean, rstd);
#pragma unroll
        for (int i = 0; i < 16; ++i) v[i] = (v[i] - mean) * rstd * (1.0f + sc[i]) + sh[i];
        store_row16_bf16(p.H + (size_t)row * D, lane, v);
        float am = 0.f;
#pragma unroll
        for (int i = 0; i < 16; ++i) am = fmaxf(am, fabsf(v[i]));
        am = wave_max(am);
        const float inv = am > 0.f ? 448.0f / am : 1.0f;
        u32x4 w8;
#pragma unroll
        for (int i = 0; i < 4; ++i) {
            int d = 0;
            d = __builtin_amdgcn_cvt_pk_fp8_f32(v[4 * i] * inv, v[4 * i + 1] * inv, d, false);
            d = __builtin_amdgcn_cvt_pk_fp8_f32(v[4 * i + 2] * inv, v[4 * i + 3] * inv, d, true);
            w8[i] = (unsigned)d;
        }
        *(u32x2*)(p.H8 + (size_t)row * 1024 + 8 * lane) = (u32x2){w8[0], w8[1]};
        *(u32x2*)(p.H8 + (size_t)row * 1024 + 512 + 8 * lane) = (u32x2){w8[2], w8[3]};
        if (lane == 0) p.HS[row] = am > 0.f ? am * (1.0f / 448.0f) : 1.0f;
    }
}

__device__ __forceinline__ unsigned fkey(float f) { const unsigned u = __float_as_uint(f); return (u & 0x80000000u) ? ~u : (u | 0x80000000u); }
__device__ __forceinline__ float keyf(unsigned k) { return __uint_as_float((k & 0x80000000u) ? (k & 0x7fffffffu) : ~k); }

constexpr int CC_R0 = 128 * 127, CC_R1 = CC_R0 + 128 * 511, CC_ROWS = CC_R1 + 128 * 2047;
constexpr int CC_PER = 2, CC_STEPS = 84;
static_assert(CC_PER * CC_STEPS * 2048 >= CC_ROWS, "copy coverage");
template <int W> __device__ __forceinline__ void cc_addr_w(const float* s, float* d, int i, const float*& src, float*& dst) {
    const int seq = i / (W - 1), rr = i - seq * (W - 1);
    src = s + ((size_t)seq * W + rr + 1) * 512; dst = d + ((size_t)seq * W + rr) * 512;
}
__device__ __forceinline__ bool cc_addr(const Params& p, int row_, const float*& src, float*& dst) {
    const int rowu = __builtin_amdgcn_readfirstlane(row_);
    const bool ok = rowu < CC_ROWS;
    const int row = ok ? rowu : CC_ROWS - 1;
    if (row < CC_R0) cc_addr_w<128>(p.cache128, p.out + OFF_KVS0, row, src, dst);
    else if (row < CC_R1) cc_addr_w<512>(p.cache512, p.out + OFF_KVS1, row - CC_R0, src, dst);
    else cc_addr_w<2048>(p.cache2048, p.out + OFF_KVS2, row - CC_R1, src, dst);
    return ok;
}
struct CacheCopier {
    static constexpr int CAP = CC_PER * CC_STEPS;
    int row0, lane4, knext, kh0, kh1; f32x4 b0[2 * CC_PER], b1[2 * CC_PER];
    __device__ __forceinline__ void init(int bid, int tid) { row0 = __builtin_amdgcn_readfirstlane(bid * 8 + (tid >> 6)); lane4 = (tid & 63) * 4; knext = 0; kh0 = CAP; kh1 = CAP; }
    template <int W> __device__ __forceinline__ void store_part(const Params& p) {
        const int k0 = W ? kh1 : kh0;
#pragma unroll
        for (int j = 0; j < CC_PER; ++j) { const float* s; float* d; if (cc_addr(p, row0 + (k0 + j) * 2048, s, d)) {
            __builtin_nontemporal_store((W ? b1 : b0)[2 * j], (f32x4*)(d + lane4)); __builtin_nontemporal_store((W ? b1 : b0)[2 * j + 1], (f32x4*)(d + 256 + lane4)); } }
    }
    template <int W> __device__ __forceinline__ void load_part(const Params& p) {
        (W ? kh1 : kh0) = knext;
#pragma unroll
        for (int j = 0; j < CC_PER; ++j) { const float* s; float* d; (void)cc_addr(p, row0 + (knext + j) * 2048, s, d);
            (W ? b1 : b0)[2 * j] = __builtin_nontemporal_load((const f32x4*)(s + lane4)); (W ? b1 : b0)[2 * j + 1] = __builtin_nontemporal_load((const f32x4*)(s + 256 + lane4)); }
        knext = knext + CC_PER < CAP ? knext + CC_PER : CAP;
    }
    template <int W> __device__ __forceinline__ void step(const Params& p) { store_part<W>(p); load_part<W>(p); }
    __device__ __forceinline__ void flush(const Params& p) { while (kh0 < CAP || kh1 < CAP) { step<0>(p); step<1>(p); } }
};
constexpr int SK_PITCH = 132;
#define DPP_ROR(v, n) ((unsigned)__builtin_amdgcn_update_dpp(0, (int)(v), 0x120 + (n), 0xf, 0xf, true))
__device__ __forceinline__ unsigned row_max_u32(unsigned v) {
    v = max(v, DPP_ROR(v, 8)); v = max(v, DPP_ROR(v, 4)); v = max(v, DPP_ROR(v, 2)); v = max(v, DPP_ROR(v, 1)); return v;
}
#define CE_DESC(a, b) do { const unsigned hi_ = max(a, b), lo_ = min(a, b); a = hi_; b = lo_; } while (0)
__device__ __forceinline__ void phase_peer_select(const Params& p, int bid, int nb, LAS unsigned char* lds) {
    int tid_ = threadIdx.x; asm volatile("" : "+v"(tid_));
    LAS unsigned* s_key = (LAS unsigned*)lds;
    LAS unsigned* s_top = s_key + 256 * SK_PITCH;
    const int wave = tid_ >> 6, lane = tid_ & 63, r = lane & 31, hh = lane >> 5;
    const int li = tid_ & 15, rowid = tid_ >> 4;
    int cand_i[4], cand_j[4]; bool cand_ok[4];
#pragma unroll
    for (int s = 0; s < 4; ++s) {
        int i = 0, rem = 4 * li + s;
        while (i < 16 && rem >= 16 / (i + 1)) { rem -= 16 / (i + 1); ++i; }
        cand_ok[s] = i < 16; cand_i[s] = i < 16 ? i : 0; cand_j[s] = i < 16 ? rem : 0;
    }
    CacheCopier cc; cc.init(bid, tid_);
    for (int b = bid; b < 256; b += nb) {
        for (int tile = 0; tile < 5; ++tile) {
            const int nvalid = tile < 4 ? 32 : (b < NS ? 1 : 0);
            if (nvalid == 0) break;
            const int row0 = tile < 4 ? b * 128 + tile * 32 : NTP + b;
            for (int hq = 0; hq < 2; ++hq) {
#pragma unroll
                for (int jb = 0; jb < 4; ++jb) {
                    const int job = wave * 4 + jb, hl = job >> 3, half = (job >> 2) & 1, ni = job & 3;
                    const int h = 4 * hq + hl;
                    const int tix = tile < 4 ? b * 4 + tile : (NTP >> 5) + (b >> 5), rsel = tile < 4 ? r : (b & 31);
                    const bf16_t* A = p.QV + ((((size_t)tix * 8 + h) * 2 + half) * 8 * 64 + (hh * 32 + rsel)) * 8;
                    const bf16_t* B = p.KF + ((((size_t)h * 2 + half) * 4 + ni) * 8 * 64 + lane) * 8;
                    if (jb & 1) cc.store_part<1>(p); else cc.store_part<0>(p);
                    bf16x8 af[8], bfr[8];
#pragma unroll
                    for (int ks = 0; ks < 8; ++ks) { af[ks] = ld_frag_g(A + ks * 512); bfr[ks] = ld_frag_g(B + ks * 512); }
                    if (jb & 1) cc.load_part<1>(p); else cc.load_part<0>(p);
                    f32x16 acc = zero16();
#pragma unroll
                    for (int ks = 0; ks < 8; ++ks) acc = mfma32(af[ks], bfr[ks], acc);
                    LAS unsigned* dst = s_key + ((hl * 2 + half) * 32) * SK_PITCH + 32 * ni + r;
                    const unsigned tag = 127u - (unsigned)(32 * ni + r);
#pragma unroll
                    for (int reg = 0; reg < 16; ++reg) dst[crow(reg, hh) * SK_PITCH] = (fkey(acc[reg]) & ~127u) | tag;
                }
                __syncthreads();
                {
                    auto stage1 = [&](int it) {
                        unsigned k[2][8], res[2];
#pragma unroll
                        for (int z = 0; z < 2; ++z) {
                            const int q = (it + 4 * z) * 32 + rowid;
                            const u32x4 ka = *(const LAS u32x4*)(s_key + q * SK_PITCH + 8 * li), kb = *(const LAS u32x4*)(s_key + q * SK_PITCH + 8 * li + 4);
                            k[z][0] = ka.x; k[z][1] = ka.y; k[z][2] = ka.z; k[z][3] = ka.w; k[z][4] = kb.x; k[z][5] = kb.y; k[z][6] = kb.z; k[z][7] = kb.w; res[z] = 0u;
                        }
#pragma unroll
                        for (int z = 0; z < 2; ++z) {
                            CE_DESC(k[z][0], k[z][1]); CE_DESC(k[z][2], k[z][3]); CE_DESC(k[z][4], k[z][5]); CE_DESC(k[z][6], k[z][7]);
                            CE_DESC(k[z][0], k[z][2]); CE_DESC(k[z][1], k[z][3]); CE_DESC(k[z][4], k[z][6]); CE_DESC(k[z][5], k[z][7]);
                            CE_DESC(k[z][1], k[z][2]); CE_DESC(k[z][5], k[z][6]);
                            CE_DESC(k[z][0], k[z][4]); CE_DESC(k[z][1], k[z][5]); CE_DESC(k[z][2], k[z][6]); CE_DESC(k[z][3], k[z][7]);
                            CE_DESC(k[z][2], k[z][4]); CE_DESC(k[z][3], k[z][5]);
                            CE_DESC(k[z][1], k[z][2]); CE_DESC(k[z][3], k[z][4]); CE_DESC(k[z][5], k[z][6]);
                        }
#pragma unroll
                        for (int ps = 0; ps < 16; ++ps) {
#pragma unroll
                            for (int z = 0; z < 2; ++z) {
                                const unsigned mx = row_max_u32(k[z][0]);
                                res[z] = li == ps ? mx : res[z];
                                const bool pop = k[z][0] == mx;
#pragma unroll
                                for (int e = 0; e < 7; ++e) k[z][e] = pop ? k[z][e + 1] : k[z][e];
                                k[z][7] = pop ? 0u : k[z][7];
                            }
                        }
#pragma unroll
                        for (int z = 0; z < 2; ++z) s_top[((it + 4 * z) * 32 + rowid) * 16 + li] = res[z];
                    };
                    for (int it = 0; it < 4; it += 2) { cc.step<0>(p); if (rowid < nvalid) stage1(it); cc.step<1>(p); if (rowid < nvalid) stage1(it + 1); }
                }
                __syncthreads();
                {
                    auto stage2 = [&](int hl0) {
                        unsigned c[2][4], res[2];
#pragma unroll
                        for (int z = 0; z < 2; ++z) {
                            const int hl = hl0 + 2 * z;
                            const LAS unsigned* t1 = s_top + ((hl * 2 + 0) * 32 + rowid) * 16;
                            const LAS unsigned* t2 = s_top + ((hl * 2 + 1) * 32 + rowid) * 16;
#pragma unroll
                            for (int s = 0; s < 4; ++s) {
                                const float v = keyf(t1[cand_i[s]] & ~127u) + keyf(t2[cand_j[s]] & ~127u);
                                c[z][s] = cand_ok[s] ? ((fkey(v) & ~255u) | (255u - (unsigned)(cand_i[s] * 16 + cand_j[s]))) : 0u;
                            }
                            CE_DESC(c[z][0], c[z][1]); CE_DESC(c[z][2], c[z][3]); CE_DESC(c[z][0], c[z][2]); CE_DESC(c[z][1], c[z][3]); CE_DESC(c[z][1], c[z][2]);
                            res[z] = 0u;
                        }
#pragma unroll
                        for (int ps = 0; ps < 16; ++ps) {
#pragma unroll
                            for (int z = 0; z < 2; ++z) {
                                const unsigned mx = row_max_u32(c[z][0]);
                                res[z] = li == ps ? mx : res[z];
                                const bool pop = c[z][0] == mx;
                                c[z][0] = pop ? c[z][1] : c[z][0]; c[z][1] = pop ? c[z][2] : c[z][1]; c[z][2] = pop ? c[z][3] : c[z][2]; c[z][3] = pop ? 0u : c[z][3];
                            }
                        }
#pragma unroll
                        for (int z = 0; z < 2; ++z) {
                            const int hl = hl0 + 2 * z;
                            const LAS unsigned* t1 = s_top + ((hl * 2 + 0) * 32 + rowid) * 16;
                            const LAS unsigned* t2 = s_top + ((hl * 2 + 1) * 32 + rowid) * 16;
                            const int cidx = 255 - (int)(res[z] & 255u), i1 = cidx >> 4, i2 = cidx & 15;
                            const unsigned a1 = t1[i1], a2 = t2[i2];
                            const float sc = keyf(a1 & ~127u) + keyf(a2 & ~127u);
                            float mxs = sc;
                            mxs = fmaxf(mxs, DPP_ROR_F(mxs, 8)); mxs = fmaxf(mxs, DPP_ROR_F(mxs, 4)); mxs = fmaxf(mxs, DPP_ROR_F(mxs, 2)); mxs = fmaxf(mxs, DPP_ROR_F(mxs, 1));
                            const float ex = __expf(sc - mxs);
                            const float gw = ex / dpp_row_sum(ex);
                            const int ei = (127 - (int)(a1 & 127u)) * 128 + (127 - (int)(a2 & 127u));
                            const size_t o = (size_t)(row0 + rowid) * 128 + (4 * hq + hl) * 16 + li;
                            p.EIDX[o] = ei; p.EGW[o] = gw * p.SV[ei];
                        }
                    };
                    cc.step<0>(p); if (rowid < nvalid) stage2(0); cc.step<1>(p); if (rowid < nvalid) stage2(1);
                }
                __syncthreads();
            }
        }
    }
    cc.flush(p);
}

__device__ __forceinline__ float gelu_erf(float x) { return 0.5f * x * (1.0f + erff(x * 0.70710678118654752f)); }
__device__ __forceinline__ float wave_total_from_rows(float v) {
    return (__builtin_bit_cast(float, __builtin_amdgcn_readlane(__builtin_bit_cast(int, v), 0)) + __builtin_bit_cast(float, __builtin_amdgcn_readlane(__builtin_bit_cast(int, v), 16)))
         + (__builtin_bit_cast(float, __builtin_amdgcn_readlane(__builtin_bit_cast(int, v), 32)) + __builtin_bit_cast(float, __builtin_amdgcn_readlane(__builtin_bit_cast(int, v), 48)));
}
__device__ __forceinline__ void fp8x16_to_f32(const u32x4 w, float (&o)[16]) {
#pragma unroll
    for (int i = 0; i < 4; ++i) {
        const v2f_t lo = __builtin_amdgcn_cvt_pk_f32_fp8((int)w[i], false), hi = __builtin_amdgcn_cvt_pk_f32_fp8((int)w[i], true);
        o[4 * i] = lo.x; o[4 * i + 1] = lo.y; o[4 * i + 2] = hi.x; o[4 * i + 3] = hi.y;
    }
}
typedef long i64x2_t __attribute__((ext_vector_type(2)));
typedef int i32x2_t __attribute__((ext_vector_type(2)));
#define UP_PITCH 1040
__device__ __forceinline__ void up_tile_put(const u32x4 (&rows)[16], LAS unsigned char* tile, int lane16) {
#pragma unroll
    for (int q = 0; q < 16; ++q) *(LAS u32x4*)(tile + q * UP_PITCH + lane16) = rows[q];
}
__device__ __forceinline__ float up_tile_dots(LAS unsigned char* tile, const LAS unsigned char* hrow, int pr, int kg16) {
    f32x4 c0 = {0.f, 0.f, 0.f, 0.f}, c1 = c0;
    u32x4 hf[2][2], uf[2][2];
    auto rd = [&](int st, int s) {
#pragma unroll
        for (int i = 0; i < 2; ++i) { hf[s][i] = *(const LAS u32x4*)(hrow + 128 * st + 64 * i + kg16); uf[s][i] = *(const LAS u32x4*)(tile + pr * UP_PITCH + 128 * st + 64 * i + kg16); }
    };
    auto mm = [&](int s) {
#pragma unroll
        for (int i = 0; i < 2; ++i) {
            const i64x2_t a = __builtin_bit_cast(i64x2_t, hf[s][i]), b = __builtin_bit_cast(i64x2_t, uf[s][i]);
            c0 = __builtin_amdgcn_mfma_f32_16x16x32_fp8_fp8(a[0], b[0], c0, 0, 0, 0);
            c1 = __builtin_amdgcn_mfma_f32_16x16x32_fp8_fp8(a[1], b[1], c1, 0, 0, 0);
        }
    };
    rd(0, 0);
#pragma unroll
    for (int st = 0; st < 8; ++st) {
        if (st + 1 < 8) rd(st + 1, (st + 1) & 1);
        __builtin_amdgcn_sched_barrier(0);
        mm(st & 1);
        __builtin_amdgcn_sched_barrier(0);
    }
    return c0[0] + c1[0];
}

__device__ __forceinline__ float up_reduce8(const float (&t8)[8], int lane) {
    float t4[4], t2[2], t1;
    { const bool b = lane & 2;
#pragma unroll
      for (int j = 0; j < 4; ++j) { const float keep = b ? t8[2 * j + 1] : t8[2 * j], send = b ? t8[2 * j] : t8[2 * j + 1]; t4[j] = keep + DPP_ROR_F(send, 2); } }
    { const bool b = lane & 4;
#pragma unroll
      for (int j = 0; j < 2; ++j) { const float keep = b ? t4[2 * j + 1] : t4[2 * j], send = b ? t4[2 * j] : t4[2 * j + 1]; t2[j] = keep + DPP_ROR_F(send, 4); } }
    { const bool b = lane & 8; const float keep = b ? t2[1] : t2[0], send = b ? t2[0] : t2[1]; t1 = keep + DPP_ROR_F(send, 8); }
    t1 += __shfl_xor(t1, 16); t1 += __shfl_xor(t1, 32);
    return t1;
}
template <int V = 0>
__device__ __forceinline__ void phase_peer_upass(const Params& p, int bid, int nb, LAS unsigned char* lds, float* __restrict__ ewout) {
    int tid_ = threadIdx.x; asm volatile("" : "+v"(tid_));
    const int wave = tid_ >> 6, lane = tid_ & 63;
    constexpr int WSTR = 1024 + 2048 + 64;
    LAS int* lst = (LAS int*)(lds + wave * WSTR);
    LAS unsigned char* hb = lds + wave * WSTR + 1024;
    LAS float* hsl = (LAS float*)(lds + wave * WSTR + 3072);
    static_assert(8 * WSTR <= LDS_BYTES - 16, "LDS carve of the expert-activation phase");
    const __amdgpu_buffer_rsrc_t ures = __builtin_amdgcn_make_buffer_rsrc((void*)p.U8, 0, 16384 * 2048, 0x00020000);
    const int lane16 = lane * 16;
    const int rsel = (((lane & 15) >> 2) == (lane >> 4)) ? (lane & 3) : 4;
    unsigned dmask[4];
#pragma unroll
    for (int r = 0; r < 4; ++r) { dmask[r] = rsel == r ? 0xffffffffu : 0u; asm volatile("" : "+v"(dmask[r])); }
    constexpr int TPB = NT / 32;
    static_assert(TPB * 32 == NT, "token ranges");
    struct TokIn { u32x4 h8; int ia, ib; float hs; };
    struct Tok { int t, n, e0, e1, k0, k1; float su0, su1; };
    for (int vb = bid; vb < 256; vb += nb) {
        const int x = vb & 7, t0 = (vb >> 3) * TPB, tend = t0 + TPB;
        {
        auto fetch_tok = [&](int t2, TokIn& ti) {
            t2 = t2 < tend ? t2 : tend - 1;
            const size_t R2 = (size_t)t2;
            ti.h8 = *(const u32x4*)(p.H8 + R2 * 1024 + 16 * lane); ti.hs = p.HS[R2];
            ti.ia = p.EIDX[R2 * 128 + lane]; ti.ib = p.EIDX[R2 * 128 + 64 + lane];
        };
        auto prep = [&](int t, TokIn& in, Tok& o, u32x4 (&buf)[16], int par) {
            const int ia = in.ia, ib = in.ib;
            o.t = t;
            *(LAS u32x4*)(hb + par * 1024 + 16 * lane) = in.h8; hsl[par] = in.hs;
            const bool inA = (ia >> 11) == x, inB = (ib >> 11) == x;
            const unsigned long long mA = __builtin_amdgcn_ballot_w64(inA), mB = __builtin_amdgcn_ballot_w64(inB);
            const int cntA = __builtin_popcountll(mA), n = cntA + __builtin_popcountll(mB);
            const int rankA = (int)__builtin_amdgcn_mbcnt_hi((unsigned)(mA >> 32), __builtin_amdgcn_mbcnt_lo((unsigned)mA, 0u));
            const int rankB = cntA + (int)__builtin_amdgcn_mbcnt_hi((unsigned)(mB >> 32), __builtin_amdgcn_mbcnt_lo((unsigned)mB, 0u));
            LAS int* L = lst;
            if (inA) { L[rankA] = ia; L[128 + rankA] = lane; }
            if (inB) { L[rankB] = ib; L[128 + rankB] = 64 + lane; }
            asm volatile("s_waitcnt lgkmcnt(0)" ::: "memory");
            o.n = n;
            o.e0 = lane < n ? L[lane] : (x << 11); o.e1 = 64 + lane < n ? L[64 + lane] : (x << 11);
            o.k0 = L[128 + lane]; o.k1 = L[192 + lane];
            o.su0 = p.SU[o.e0]; o.su1 = p.SU[o.e1];
#pragma unroll
            for (int q = 0; q < 16; ++q) { const int e = __builtin_amdgcn_readlane(o.e0, q); buf[q] = __builtin_amdgcn_raw_buffer_load_b128(ures, lane16, e << 11, 0); }
            fetch_tok(t + 16, in);
        };
        auto finish = [&](Tok& c, u32x4 (&buf)[16], int par) {
            const u32x4 h8 = *(const LAS u32x4*)(hb + par * 1024 + lane16); const float hs = hsl[par];
            const i64x2_t ha = __builtin_bit_cast(i64x2_t, h8);
            __builtin_amdgcn_sched_barrier(0);
            __builtin_amdgcn_s_waitcnt(0x4F76);
            __builtin_amdgcn_sched_barrier(0);
            float dot0 = 0.f, dot1 = 0.f;
            for (int base = 0; base < 16 || base < c.n; base += 16) {
                const bool more = base + 16 < c.n;
                const int nb16 = base + 16, ev = nb16 < 64 ? c.e0 : c.e1;
                float t8[8];
#pragma unroll
                for (int bq = 0; bq < 4; ++bq) {
                    const int q0 = 4 * bq;
                    if (base + q0 < c.n) {
                        f32x4 acc[4];
#pragma unroll
                        for (int j = 0; j < 4; ++j) { const i64x2_t b = __builtin_bit_cast(i64x2_t, buf[q0 + j]); acc[j] = __builtin_amdgcn_mfma_f32_16x16x32_fp8_fp8(ha[0], b[0], (f32x4){0.f, 0.f, 0.f, 0.f}, 0, 0, 0); }
#pragma unroll
                        for (int j = 0; j < 4; ++j) { const i64x2_t b = __builtin_bit_cast(i64x2_t, buf[q0 + j]); acc[j] = __builtin_amdgcn_mfma_f32_16x16x32_fp8_fp8(ha[1], b[1], acc[j], 0, 0, 0); }
                        float sv[4];
#pragma unroll
                        for (int j = 0; j < 4; ++j) sv[j] = __uint_as_float((__float_as_uint(acc[j][0]) & dmask[0]) | (__float_as_uint(acc[j][1]) & dmask[1]) | (__float_as_uint(acc[j][2]) & dmask[2]) | (__float_as_uint(acc[j][3]) & dmask[3]));
                        const bool b1 = lane & 1;
#pragma unroll
                        for (int j = 0; j < 2; ++j) { const float keep = b1 ? sv[2 * j + 1] : sv[2 * j], send = b1 ? sv[2 * j] : sv[2 * j + 1]; t8[2 * bq + j] = keep + DPP_ROR_F(send, 1); }
                    } else { t8[2 * bq] = 0.f; t8[2 * bq + 1] = 0.f; }
                    if (nb16 + q0 < c.n) {
#pragma unroll
                        for (int j = 0; j < 4; ++j) { const int e = __builtin_amdgcn_readlane(ev, (nb16 & 63) + q0 + j); buf[q0 + j] = __builtin_amdgcn_raw_buffer_load_b128(ures, lane16, e << 11, 0); }
                    }
                }
                const float d = up_reduce8(t8, lane);
                if ((lane >> 4) == ((base >> 4) & 3)) { if (base < 64) dot0 = d; else dot1 = d; }
                if (more) {
                    __builtin_amdgcn_sched_barrier(0);
                    __builtin_amdgcn_s_waitcnt(0x0F70);
                    __builtin_amdgcn_sched_barrier(0);
                }
            }
            const size_t R = (size_t)c.t;
            if (lane < c.n) ewout[R * 128 + c.k0] = gelu_erf(c.su0 * hs * dot0);
            if (64 + lane < c.n) ewout[R * 128 + c.k1] = gelu_erf(c.su1 * hs * dot1);
        };
        TokIn iA, iB; Tok kA, kB; u32x4 bX[16], bY[16];
        fetch_tok(t0 + wave, iA); fetch_tok(t0 + wave + 8, iB);
        prep(t0 + wave, iA, kA, bX, 0);
        for (int t = t0 + wave; t < tend; t += 16) {
            prep(t + 8 < tend ? t + 8 : tend - 1, iB, kB, bY, 1);
            finish(kA, bX, 0);
            prep(t + 16 < tend ? t + 16 : tend - 1, iA, kA, bX, 0);
            finish(kB, bY, 1);
        }
        __builtin_amdgcn_s_waitcnt(0x0F70);
        }
    }
}

__device__ __forceinline__ void phase_peer_gather(const Params& p, int bid, int nb, LAS unsigned char* lds, int skip_ff = 0) {
    int tid_ = threadIdx.x; asm volatile("" : "+v"(tid_));
    const int wave = tid_ >> 6, lane = tid_ & 63;
    LAS float* s_ff = (LAS float*)lds;
    const __amdgpu_buffer_rsrc_t vres = __builtin_amdgcn_make_buffer_rsrc((void*)p.U8, 0, 16384 * 2048, 0x00020000);
    const int lane16v = lane * 16 + 1024;
    const int n_vb = (256 - bid + nb - 1) / nb;
    for (int it = 0; it < n_vb * 17; ++it) {
        const int vb = bid + (it / 17) * nb, sub = it % 17;
        const bool coop = sub == 16;
        if (coop && vb >= NS) continue;
        const int row = coop ? NTP + vb : vb * 128 + wave + 8 * sub;
        const int g0 = skip_ff ? 8 : (coop ? wave : 0), g1 = coop ? wave + 1 : 8;
        const size_t R = (size_t)row;
        v2f_t acc2[8];
#pragma unroll
        for (int i = 0; i < 8; ++i) acc2[i] = (v2f_t){0.f, 0.f};
        const int ia = p.EIDX[R * 128 + lane], ib = p.EIDX[R * 128 + 64 + lane];
        const float wa = p.EW[R * 128 + lane] * p.EGW[R * 128 + lane], wb = p.EW[R * 128 + 64 + lane] * p.EGW[R * 128 + 64 + lane];
        f32x4 zr[4];
#pragma unroll
        for (int i = 0; i < 4; ++i) zr[i] = *(const f32x4*)(p.Z1 + R * D + 16 * lane + 4 * i);
        const float mean1 = p.LNST[R * 2], rstd1 = p.LNST[R * 2 + 1];
        for (int grp = g0; grp < g1; ++grp) {
            const int iv = grp < 4 ? ia : ib; const float wv = grp < 4 ? wa : wb;
            const int l0 = (grp & 3) * 16;
            u32x4 vb16[16];
#pragma unroll
            for (int q = 0; q < 16; ++q) { const int e = __builtin_amdgcn_readlane(iv, l0 + q); vb16[q] = __builtin_amdgcn_raw_buffer_load_b128(vres, lane16v, e << 11, 0); }
#pragma unroll
            for (int q = 0; q < 16; ++q) {
                const float w = __builtin_bit_cast(float, __builtin_amdgcn_readlane(__builtin_bit_cast(int, wv), l0 + q));
                const v2f_t w2 = {w, w};
#pragma unroll
                for (int i = 0; i < 4; ++i) {
                    const v2f_t lo = __builtin_amdgcn_cvt_pk_f32_fp8((int)vb16[q][i], false), hi = __builtin_amdgcn_cvt_pk_f32_fp8((int)vb16[q][i], true);
                    acc2[2 * i] += w2 * lo; acc2[2 * i + 1] += w2 * hi;
                }
            }
        }
        float acc[16];
#pragma unroll
        for (int i = 0; i < 8; ++i) { acc[2 * i] = acc2[i].x; acc[2 * i + 1] = acc2[i].y; }
        if (coop) {
#pragma unroll
            for (int i = 0; i < 4; ++i) *(LAS f32x4*)(s_ff + wave * 1024 + 16 * lane + 4 * i) = (f32x4){acc[4 * i], acc[4 * i + 1], acc[4 * i + 2], acc[4 * i + 3]};
            __syncthreads();
            if (wave == 0) {
#pragma unroll
                for (int i = 0; i < 16; ++i) acc[i] = 0.f;
#pragma unroll
                for (int w = 0; w < 8; ++w)
#pragma unroll
                    for (int i = 0; i < 4; ++i) { const f32x4 t = *(const LAS f32x4*)(s_ff + w * 1024 + 16 * lane + 4 * i); acc[4 * i] += t[0]; acc[4 * i + 1] += t[1]; acc[4 * i + 2] += t[2]; acc[4 * i + 3] += t[3]; }
            }
        }
        if (!coop || wave == 0) {
            float x1[16], g2[16];
            const float* gr = p.MOD + (size_t)seq_of(row) * 6144 + 5120 + 16 * lane;
#pragma unroll
            for (int i = 0; i < 4; ++i) { const f32x4 a = zr[i], b = *(const f32x4*)(gr + 4 * i);
                const f32x4 lw = *(const f32x4*)(p.ln1_w + 16 * lane + 4 * i), lb = *(const f32x4*)(p.ln1_b + 16 * lane + 4 * i);
#pragma unroll
                for (int j = 0; j < 4; ++j) { x1[4 * i + j] = (a[j] - mean1) * rstd1 * lw[j] + lb[j]; g2[4 * i + j] = b[j]; } }
#pragma unroll
            for (int i = 0; i < 16; ++i) acc[i] = DN_ALPHA * x1[i] + g2[i] * acc[i];
            float mean, rstd; row_stats(acc, mean, rstd);
            float* yo = (row < NTP ? p.out + OFF_YP + R * D : p.out + OFF_YS + (size_t)(row - NTP) * D) + 16 * lane;
#pragma unroll
            for (int i = 0; i < 4; ++i) { const f32x4 w = *(const f32x4*)(p.ln2_w + 16 * lane + 4 * i), b = *(const f32x4*)(p.ln2_b + 16 * lane + 4 * i);
                f32x4 o;
#pragma unroll
                for (int j = 0; j < 4; ++j) o[j] = (acc[4 * i + j] - mean) * rstd * w[j] + b[j];
                *(f32x4*)(yo + 4 * i) = o; }
        }
        if (coop) __syncthreads();
    }
}

__device__ __forceinline__ void phase_z1_bypass(const Params& p, int bid, int nb) {
    int tid_ = threadIdx.x; asm volatile("" : "+v"(tid_));
    const int wave = tid_ >> 6, lane = tid_ & 63;
    for (int row = bid * 8 + wave; row < NT; row += nb * 8) {
        float v[16]; load_row16(x_row(p, row), lane, v);
#pragma unroll
        for (int i = 0; i < 16; ++i) v[i] *= DN_ALPHA;
        store_row16_f32(p.Z1 + (size_t)row * D, lane, v);
    }
}

#define DYN_LDS extern __shared__ __attribute__((aligned(16))) unsigned char shm_[]; LAS unsigned char* lds = (LAS unsigned char*)shm_;
template <class Epi> __device__ __forceinline__ void run_gemm(LAS unsigned char* lds, const bf16_t* A, const bf16_t* Bt, int M, int N, int K, const Epi& E) {
    int Ko = K; asm volatile("" : "+s"(Ko));
    pg8::StaticOrder S; S.init(M, N, (int)gridDim.x, (int)blockIdx.x);
    pg8::Gemm g{A, Bt, M, N, Ko};
    pg8::gemm_phase<Epi, pg8::StaticOrder, false>(lds, g, S, E, nullptr);
    __syncthreads();
}

template <class Epi> __device__ __forceinline__ void skinny_gemm(const bf16_t* __restrict__ A, const bf16_t* __restrict__ Bt, int N, int K, const Epi& E, int ushift) {
    int tid_ = threadIdx.x; asm volatile("" : "+v"(tid_));
    const int wave = tid_ >> 6, lane = tid_ & 63, r = lane & 31, hh = lane >> 5, rt = wave & 3, ct = wave >> 2;
    const int nb = (int)gridDim.x, vb = ((int)blockIdx.x + nb - (ushift % nb)) % nb;
    const int perm = 16 * ((r >> 2) & 1) + 4 * (r >> 3) + (r & 3);
    for (int u = vb; u < N / 64; u += nb) {
        int arow = NTP + 32 * rt + r; asm volatile("" : "+v"(arow));
        const bf16_t* ap = A + (size_t)arow * K + 8 * hh;
        const bf16_t* bp = Bt + (size_t)(u * 64 + 32 * ct + perm) * K + 8 * hh;
        f32x16 acc = zero16();
        for (int k0 = 0; k0 < K / 16; k0 += 8) {
            bf16x8 wa[8], xa[8];
#pragma unroll
            for (int i = 0; i < 8; ++i) { wa[i] = ld_frag_g(bp + 16 * (k0 + i)); xa[i] = ld_frag_g(ap + 16 * (k0 + i)); }
            __builtin_amdgcn_sched_barrier(0);
#pragma unroll
            for (int i = 0; i < 8; ++i) acc = mfma32(wa[i], xa[i], acc);
            __builtin_amdgcn_sched_barrier(0);
        }
        float v[16];
#pragma unroll
        for (int i = 0; i < 16; ++i) v[i] = acc[i];
        E.emit16(NTP + 32 * rt + r, u * 64 + 32 * ct + 16 * hh, v);
    }
}
__global__ void __launch_bounds__(NTHREADS, 2) k_mega(Params p) {
    DYN_LDS;
    volatile LAS unsigned* st = (volatile LAS unsigned*)(lds + LDS_BYTES - 16);
    if (threadIdx.x == 0) { st[0] = 0u; st[1] = 0u; st[2] = 0u; st[3] = 0u; }
    __syncthreads();
    const XcdBarrier bar = xcd_barrier_post(p.bar, st);
    const int bid = blockIdx.x, nb = gridDim.x;
    phase_prologue<0>(p, bid, nb, lds, 0);
    xcd_barrier(bar);
    run_gemm(lds, p.SC, p.WADA_T, 256, 6144, 1024, pg8::EpiF32{p.MOD, 6144, p.b_ada});
    phase_prologue<1>(p, bid, nb, lds, nb > 48 ? 24 : 0);
    xcd_barrier(bar);
    phase_lnmod1(p, bid, nb);
    xcd_barrier(bar);
    { const EpiProj E{p.QKVA, p.QKB, p.VBB, p.RB, p.GA, p.GB, p.GLR, p.out}; run_gemm(lds, p.H, p.WIN_T, NTP, NPROJ, 1024, E); skinny_gemm(p.H, p.WIN_T, NPROJ, 1024, E, 0); }
    xcd_barrier(bar);
    phase_gla2_passA(p, bid, nb, lds);
    phase_attn_prompt(p, bid, nb, lds);
    phase_attn_sample(p, bid, nb, lds);
    phase_gla_sample(p, bid, nb, lds);
    xcd_barrier(bar);
    phase_gla2_scan(p, bid, nb);
    xcd_barrier(bar);
    phase_gla2_passC(p, bid, nb, lds);
    phase_merge_prep(p, bid, nb);
    xcd_barrier(bar);
    { const EpiGate<0> E{p.TMP1, p.GA, nullptr, 1024}; run_gemm(lds, p.OA, p.WBRA_T, NTP, 1024, 256, E); skinny_gemm(p.OA, p.WBRA_T, 1024, 256, E, 0); }
    { const EpiGate<1> E{p.MERGED, p.GB, p.TMP1, 1024}; run_gemm(lds, p.OB, p.WBRB_T, NTP, 1024, 1024, E); skinny_gemm(p.OB, p.WBRB_T, 1024, 1024, E, 0); }
    xcd_barrier(bar);
    { const EpiOut E{p.Z1, p.x_prompt, p.x_sample, p.MOD}; run_gemm(lds, p.MERGED, p.WOUT_T, NTP, 1024, 1024, E); skinny_gemm(p.MERGED, p.WOUT_T, 1024, 1024, E, 128); }
    xcd_barrier(bar);
    phase_ln1(p, bid, nb);
    xcd_barrier(bar);
    { const EpiQvf E{p.QV}; run_gemm(lds, p.H, p.WPQ_T, NTP, 2048, 1024, E); skinny_gemm(p.H, p.WPQ_T, 2048, 1024, E, 192); }
    xcd_barrier(bar);
    phase_peer_select(p, bid, nb, lds);
    xcd_barrier(bar);
    phase_peer_upass<0>(p, bid, nb, lds, p.EW);
#ifdef UP_PROBE
    xcd_barrier(bar);
    phase_peer_upass<UP_PROBE>(p, bid, nb, lds, (float*)p.TMP1);
#endif
    xcd_barrier(bar);
    phase_peer_gather(p, bid, nb, lds);
}

static inline size_t align_up(size_t v, size_t a) { return (v + a - 1) / a * a; }

extern "C" void kernel_launch(void* const* d_in, const int* in_sizes, int n_in, void* d_out, int out_size, void* d_ws, size_t ws_size, hipStream_t stream) {
    (void)in_sizes; (void)n_in; (void)out_size;
    Params p; memset(&p, 0, sizeof(p));
    const float* const* in = (const float* const*)d_in;
    p.x_prompt = in[0]; p.x_sample = in[1]; p.c_prompt = in[2]; p.c_sample = in[3]; p.cache128 = in[4]; p.cache512 = in[5]; p.cache2048 = in[6]; p.state_gla = in[7];
    p.w_ada = in[8]; p.b_ada = in[9]; p.w_in = in[10]; p.w_gla_up = in[11]; p.b_gla = in[12]; p.gla_norm_w = in[13]; p.w_br_a = in[14]; p.w_br_b = in[15]; p.w_out = in[16];
    p.ln1_w = in[17]; p.ln1_b = in[18]; p.w_pq = in[19]; p.peer_k1 = in[20]; p.peer_k2 = in[21]; p.peer_u = in[22]; p.peer_v = in[23]; p.ln2_w = in[24]; p.ln2_b = in[25];
    p.out = (float*)d_out;
    size_t off = 0; char* ws = (char*)d_ws;
#define CARVE(field, type, count) do { p.field = (type*)(ws + off); off = align_up(off + (size_t)(count) * sizeof(type), 256); } while (0)
    CARVE(bar, unsigned, 4096);
    CARVE(MOD, float, 256 * 6144); CARVE(SC, bf16_t, 256 * 1024); CARVE(WADA_T, bf16_t, 6144 * 1024); CARVE(WIN_T, bf16_t, (size_t)NPROJ * 1024);
    CARVE(WBRA_T, bf16_t, 1024 * 256); CARVE(WBRB_T, bf16_t, 1024 * 1024); CARVE(WOUT_T, bf16_t, 1024 * 1024); CARVE(WPQ_T, bf16_t, 2048 * 1024);
    CARVE(KF, bf16_t, 2 * 8 * 128 * 128); CARVE(U8, unsigned char, (size_t)16384 * 2048); p.V8 = p.U8 + 1024; CARVE(SU, float, 16384); CARVE(SV, float, 16384);
    CARVE(H, bf16_t, (size_t)MP * 1024); CARVE(QKVA, bf16_t, (size_t)MP * 2304); CARVE(QKB, bf16_t, (size_t)MP * 1024); CARVE(VBB, bf16_t, (size_t)MP * 1024);
    CARVE(RB, bf16_t, (size_t)MP * 1024); CARVE(GA, bf16_t, (size_t)MP * 1024); CARVE(GB, bf16_t, (size_t)MP * 1024); CARVE(GLR, float, (size_t)MP * 16);
    CARVE(OG, bf16_t, (size_t)MP * 768); CARVE(LSE, float, (size_t)MP * 12);
    CARVE(LSEG, float, (size_t)256 * 32768); CARVE(SSEG, float, (size_t)256 * 32768); CARVE(DSEG, float, (size_t)256 * 128); CARVE(OGLA, bf16_t, (size_t)MP * 1024);
    CARVE(OA, bf16_t, (size_t)MP * 256); CARVE(OB, bf16_t, (size_t)MP * 1024); CARVE(TMP1, bf16_t, (size_t)MP * 1024); CARVE(MERGED, bf16_t, (size_t)MP * 1024);
    CARVE(Z1, float, (size_t)MP * 1024); CARVE(LNST, float, (size_t)MP * 2); CARVE(QV, bf16_t, (size_t)MP * 2048); CARVE(EIDX, int, (size_t)MP * 128); CARVE(EGW, float, (size_t)MP * 128); CARVE(ESU, float, (size_t)MP * 128); CARVE(EW, float, (size_t)MP * 128); CARVE(H8, unsigned char, (size_t)MP * 1024); CARVE(HS, float, (size_t)MP);
    if (off > ws_size) { fprintf(stderr, "kernel_launch: workspace too small: need %zu, have %zu\n", off, ws_size); return; }

    static int grid = 0;
    if (!grid) {
        int dev = 0, cus = 0; (void)hipGetDevice(&dev); (void)hipDeviceGetAttribute(&cus, hipDeviceAttributeMultiprocessorCount, dev);
        grid = cus > 0 ? cus : 256;
        (void)hipFuncSetAttribute((const void*)k_mega, hipFuncAttributeMaxDynamicSharedMemorySize, LDS_BYTES);
        int per_cu = 0;
        if (hipOccupancyMaxActiveBlocksPerMultiprocessor(&per_cu, (const void*)k_mega, NTHREADS, LDS_BYTES) != hipSuccess || per_cu < 1)
            fprintf(stderr, "kernel_launch: occupancy query reports %d workgroups per CU for the persistent kernel\n", per_cu);
    }
    (void)hipMemsetAsync(p.bar, 0, 4096 * sizeof(unsigned), stream);
    hipLaunchKernelGGL(k_mega, dim3(grid), dim3(NTHREADS), LDS_BYTES, stream, p);
}
```

```cpp
#include <hip/hip_runtime.h>
#include <stdint.h>
#include <stdio.h>
#include <string.h>
#include <type_traits>
namespace pg8 {
#define PG8_LAS __attribute__((address_space(3)))
typedef unsigned short bf16_t;
typedef short bf16x8 __attribute__((ext_vector_type(8)));
typedef float f32x4 __attribute__((ext_vector_type(4)));
typedef unsigned u32x4 __attribute__((ext_vector_type(4)));
constexpr int BM = 256, BK = 64, HALF = 128, HTB = HALF * BK * 2  , STAGE_BYTES = 8 * HTB, NXCD = 8, WGM = 8;

__host__ __device__ __forceinline__ int lds_byte(int r, int c) { const int st = (r >> 4) * 2 + (c >> 5), rr = r & 15, cc = c & 31, ob = rr * 64 + cc * 2; return st * 1024 + (ob ^ (((ob >> 9) & 1) << 5)); }
__host__ __device__ __forceinline__ void stage_rc(int b, int& R, int& C) { const int st = b / 1024, sb = b % 1024, swz = sb ^ (((sb >> 9) & 1) << 5); R = (st >> 1) * 16 + swz / 64; C = (st & 1) * 32 + (swz % 64) / 2; }
__host__ __device__ __forceinline__ int perm32(int rho) { const int n = rho >> 4, i = rho & 15; return 8 * (i >> 2) + 4 * n + (i & 3); }

struct Unit { int pm, pn; };
struct Gemm { const bf16_t* A; const bf16_t* Bt; int M, N, K; };

struct StaticOrder {
    int nM, nN, nwg, G, c;
    __host__ __device__ void init(int M, int N, int G_, int c_) { nM = M / BM; nN = N / BM; nwg = nM * nN; G = G_; c = c_; }
    __host__ __device__ bool next(int i, Unit& u) const {
        const long L = (long)i * G + c; if (L >= nwg) return false;
        int wgid = (int)L; { const int q = nwg / NXCD, r = nwg % NXCD, xcd = wgid % NXCD, off = wgid / NXCD; wgid = (xcd < r ? xcd * (q + 1) : r * (q + 1) + (xcd - r) * q) + off; }
        const int nig = WGM * nN, gid = wgid / nig, fm = gid * WGM, gsz = (nM - fm) < WGM ? (nM - fm) : WGM;
        u.pm = fm + ((wgid % nig) % gsz); u.pn = (wgid % nig) / gsz; return true;
    }
    __device__ __forceinline__ void a_ready(const Unit&) const {}
    __device__ __forceinline__ void done(const Unit&) const {}
};
__device__ __forceinline__ unsigned cvt_pk_bf16(float lo, float hi) { unsigned r; asm volatile("v_cvt_pk_bf16_f32 %0, %1, %2" : "=v"(r) : "v"(lo), "v"(hi)); return r; }
typedef float f32x2 __attribute__((ext_vector_type(2)));
struct EpiF32 {
    static constexpr bool PERM = false, AFTER_DRAIN = false;
    float* C; int ldc; const float* bias;
    __device__ __forceinline__ void operator()(const f32x4 (&acc)[2][2][4][2], const Unit& u, int wr, int wc, int fr, int fq) const {
        const int row0 = u.pm * BM + wr * 64 + fr, col0 = u.pn * BM + wc * 32 + 4 * fq;
        f32x4 bv[2][2];
#pragma unroll
        for (int bj = 0; bj < 2; ++bj)
#pragma unroll
            for (int n = 0; n < 2; ++n) bv[bj][n] = bias ? *(const f32x4*)(bias + col0 + bj * HALF + n * 16) : (f32x4){0.f, 0.f, 0.f, 0.f};
#pragma unroll
        for (int ai = 0; ai < 2; ++ai)
#pragma unroll
            for (int m = 0; m < 4; ++m) { float* rowp = C + (size_t)(row0 + ai * HALF + m * 16) * ldc + col0;
#pragma unroll
                for (int bj = 0; bj < 2; ++bj)
#pragma unroll
                    for (int n = 0; n < 2; ++n) *(f32x4*)(rowp + bj * HALF + n * 16) = acc[ai][bj][m][n] + bv[bj][n]; }
    }
};
template <class Epi, class Sched, bool STAMP = false>
__device__ __forceinline__ void gemm_phase(PG8_LAS unsigned char* lds, const Gemm g, const Sched& S, const Epi& E, unsigned long long* stamps) {
    int tid_o = threadIdx.x; asm volatile("" : "+v"(tid_o));
    const int tid = tid_o, wid = __builtin_amdgcn_readfirstlane(tid >> 6), lane = tid & 63, wr = wid >> 2, wc = wid & 3, fr = lane & 15, fq = lane >> 4;
    const int K = g.K, nt = K / BK;
    int ts_lo = 0, ts_hi = 0, nts = 0; const unsigned long long rt_entry = STAMP ? (unsigned long long)wall_clock64() : 0ull;
#define PG8_STAMP() do { if (STAMP && wid == 0 && nts < 64) { const unsigned long long _c = (unsigned long long)clock64(); \
        ts_lo = (lane == nts) ? (int)(unsigned)_c : ts_lo; ts_hi = (lane == nts) ? (int)(unsigned)(_c >> 32) : ts_hi; ++nts; } } while (0)
    PG8_STAMP();
    unsigned voffA[2], voffB[2];
#pragma unroll
    for (int i = 0; i < 2; ++i) { int R, C; stage_rc(tid * 16 + i * 8192, R, C); const int Rb = Epi::PERM ? ((R & ~31) + perm32(R & 31)) : R;
        voffA[i] = (unsigned)(R * K + C) * 2u; voffB[i] = (unsigned)(Rb * K + C) * 2u; }
    const size_t kstep = (size_t)(BK * 2);
    const size_t hstep = (size_t)HALF * K * 2;
    const size_t tstep = 2 * hstep;
    const unsigned ldsw = (unsigned)wid * 1024u;
    const int aoff = lds_byte(wr * 64 + fr, fq * 8), boff = lds_byte(wc * 32 + fr, fq * 8);
#define PG8_SA(b, h) (((b) * 2 + (h)) * HTB)
#define PG8_SB(b, h) ((4 + (b) * 2 + (h)) * HTB)
#define PG8_STAGE(bufoff, gbase, voff) do { _Pragma("unroll") for (int _i = 0; _i < 2; ++_i) \
        __builtin_amdgcn_global_load_lds((const unsigned*)((const char*)(gbase) + (voff)[_i]), (PG8_LAS unsigned*)(lds + (bufoff) + ldsw + _i * 8192), 16, 0, 0); } while (0)
#define PG8_LDA(dst, b, h) do { _Pragma("unroll") for (int m = 0; m < 4; ++m) _Pragma("unroll") for (int k = 0; k < 2; ++k) dst[m][k] = *(const PG8_LAS bf16x8*)(lds + PG8_SA(b, h) + aoff + m * 2048 + k * 1024); } while (0)
#define PG8_LDB(dst, b, h) do { _Pragma("unroll") for (int n = 0; n < 2; ++n) _Pragma("unroll") for (int k = 0; k < 2; ++k) dst[n][k] = *(const PG8_LAS bf16x8*)(lds + PG8_SB(b, h) + boff + n * 2048 + k * 1024); } while (0)
#define PG8_MMA(ai, bj, At, Bt) do { __builtin_amdgcn_s_setprio(1); _Pragma("unroll") for (int m = 0; m < 4; ++m) _Pragma("unroll") for (int n = 0; n < 2; ++n) _Pragma("unroll") for (int k = 0; k < 2; ++k) \
        acc[ai][bj][m][n] = __builtin_amdgcn_mfma_f32_16x16x32_bf16(Bt[n][k], At[m][k], acc[ai][bj][m][n], 0, 0, 0); __builtin_amdgcn_s_setprio(0); } while (0)
#define PG8_WAIT_V(n) asm volatile("s_waitcnt vmcnt(" #n ")" ::: "memory")
#define PG8_WAIT_L(n) asm volatile("s_waitcnt lgkmcnt(" #n ")" ::: "memory")
#define PG8_BAR __builtin_amdgcn_s_barrier()
#define PG8_SCHED __builtin_amdgcn_sched_barrier(0)
    Unit cur, nxt; int ui = 0;
    if (!S.next(0, cur)) return;
    f32x4 acc[2][2][4][2];
#pragma unroll
    for (int a = 0; a < 2; ++a)
#pragma unroll
        for (int b = 0; b < 2; ++b)
#pragma unroll
            for (int m = 0; m < 4; ++m)
#pragma unroll
                for (int n = 0; n < 2; ++n) acc[a][b][m][n] = (f32x4){0.f, 0.f, 0.f, 0.f};
    bf16x8 At[4][2], B0[2][2], B1[2][2];
    const char* cA = (const char*)g.A + (size_t)cur.pm * tstep; const char* cB = (const char*)g.Bt + (size_t)cur.pn * tstep;
    S.a_ready(cur);
    PG8_STAGE(PG8_SB(0, 0), cB, voffB); PG8_STAGE(PG8_SA(0, 0), cA, voffA); PG8_STAGE(PG8_SB(0, 1), cB + hstep, voffB); PG8_STAGE(PG8_SA(0, 1), cA + hstep, voffA);
    if (wr == 1) PG8_BAR;
    PG8_WAIT_V(4); PG8_BAR;
    PG8_STAGE(PG8_SB(1, 0), cB + kstep, voffB); PG8_STAGE(PG8_SA(1, 0), cA + kstep, voffA); PG8_STAGE(PG8_SB(1, 1), cB + hstep + kstep, voffB);
    PG8_WAIT_V(6); PG8_BAR;
    PG8_STAMP();
    for (;;) {
        const bool has_next = S.next(ui + 1, nxt);
        const char* nA = has_next ? (const char*)g.A + (size_t)nxt.pm * tstep : cA; const char* nB = has_next ? (const char*)g.Bt + (size_t)nxt.pn * tstep : cB;
        for (int t = 0; t < nt; t += 2) {
            const bool last = (t == nt - 2);
            const char* a1 = cA + (size_t)(t + 1) * kstep;
            const char* a2 = last ? nA : cA + (size_t)(t + 2) * kstep; const char* b2 = last ? nB : cB + (size_t)(t + 2) * kstep;
            const char* a3 = a2 + kstep; const char* b3 = b2 + kstep;
            if (last && has_next) S.a_ready(nxt);
            PG8_LDB(B0, 0, 0); PG8_SCHED; PG8_LDA(At, 0, 0); PG8_STAGE(PG8_SA(1, 1), a1 + hstep, voffA);
            PG8_WAIT_L(8); PG8_BAR; PG8_WAIT_L(0); PG8_MMA(0, 0, At, B0); PG8_BAR; PG8_SCHED;
            PG8_LDB(B1, 0, 1); PG8_STAGE(PG8_SB(0, 0), b2, voffB);
            PG8_BAR; PG8_WAIT_L(0); PG8_MMA(0, 1, At, B1); PG8_BAR;
            PG8_LDA(At, 0, 1); PG8_STAGE(PG8_SA(0, 0), a2, voffA);
            PG8_BAR; PG8_WAIT_L(0); PG8_MMA(1, 0, At, B0); PG8_BAR; PG8_SCHED;
            PG8_STAGE(PG8_SB(0, 1), b2 + hstep, voffB);
            PG8_WAIT_V(6); PG8_BAR; PG8_MMA(1, 1, At, B1); PG8_BAR;
            PG8_LDB(B0, 1, 0); PG8_SCHED; PG8_LDA(At, 1, 0); PG8_STAGE(PG8_SA(0, 1), a2 + hstep, voffA);
            PG8_WAIT_L(8); PG8_BAR; PG8_WAIT_L(0); PG8_MMA(0, 0, At, B0); PG8_BAR; PG8_SCHED;
            PG8_LDB(B1, 1, 1); PG8_STAGE(PG8_SB(1, 0), b3, voffB);
            PG8_BAR; PG8_WAIT_L(0); PG8_MMA(0, 1, At, B1); PG8_BAR;
            PG8_LDA(At, 1, 1); PG8_STAGE(PG8_SA(1, 0), a3, voffA);
            PG8_BAR; PG8_WAIT_L(0); PG8_MMA(1, 0, At, B0); PG8_BAR; PG8_SCHED;
            PG8_STAGE(PG8_SB(1, 1), b3 + hstep, voffB);
            PG8_WAIT_V(6); PG8_BAR; PG8_MMA(1, 1, At, B1); PG8_BAR;
        }
        PG8_STAMP();
        if constexpr (!Epi::AFTER_DRAIN) { E(acc, cur, wr, wc, fr, fq); S.done(cur); }
        PG8_STAMP();
        if (!has_next) break;
#pragma unroll
        for (int a = 0; a < 2; ++a)
#pragma unroll
            for (int b = 0; b < 2; ++b)
#pragma unroll
                for (int m = 0; m < 4; ++m)
#pragma unroll
                    for (int n = 0; n < 2; ++n) acc[a][b][m][n] = (f32x4){0.f, 0.f, 0.f, 0.f};
        cur = nxt; cA = nA; cB = nB; ++ui;
    }
    PG8_WAIT_V(0);
    if (wr == 0) PG8_BAR;
    PG8_BAR;
    if constexpr (Epi::AFTER_DRAIN) { E.fused(acc, cur, wr, wc, fr, fq, lds, wid, lane); S.done(cur); }
    PG8_STAMP();
    if (STAMP && wid == 0) { stamps[lane] = lane < nts ? (((unsigned long long)(unsigned)ts_hi << 32) | (unsigned)ts_lo) : 0ull;
        if (lane == 62) stamps[62] = rt_entry; if (lane == 63) stamps[63] = (unsigned long long)wall_clock64(); }
#undef PG8_STAMP
#undef PG8_SA
#undef PG8_SB
#undef PG8_STAGE
#undef PG8_LDA
#undef PG8_LDB
#undef PG8_MMA
#undef PG8_WAIT_V
#undef PG8_WAIT_L
#undef PG8_BAR
#undef PG8_SCHED
}
}

typedef unsigned short bf16_t;
typedef float f32x4 __attribute__((ext_vector_type(4)));
typedef float f32x16 __attribute__((ext_vector_type(16)));
typedef short bf16x8 __attribute__((ext_vector_type(8)));
typedef unsigned u32x4 __attribute__((ext_vector_type(4)));
typedef unsigned u32x2 __attribute__((ext_vector_type(2)));
#define LAS __attribute__((address_space(3)))

constexpr int D = 1024, BP = 2, T = 16384, NTP = BP * T  , NS = 128, NT = NTP + NS  , MP = 33024  ;
constexpr int NPROJ = 7680;
constexpr int NTHREADS = 512;
constexpr int LDS_BYTES = 155648;
constexpr float LN_EPS = 1e-5f;
constexpr float DN_ALPHA = 1.189207115002721f;

constexpr size_t OFF_YP = 0;
constexpr size_t OFF_YS = OFF_YP + (size_t)NTP * D;
constexpr size_t OFF_KVP0 = OFF_YS + (size_t)NS * D;
constexpr size_t OFF_KVP1 = OFF_KVP0 + (size_t)BP * 128 * 512;
constexpr size_t OFF_KVP2 = OFF_KVP1 + (size_t)BP * 512 * 512;
constexpr size_t OFF_GLAP = OFF_KVP2 + (size_t)BP * 2048 * 512;
constexpr size_t OFF_KVS0 = OFF_GLAP + (size_t)BP * 4 * 128 * 256;
constexpr size_t OFF_KVS1 = OFF_KVS0 + (size_t)NS * 128 * 512;
constexpr size_t OFF_KVS2 = OFF_KVS1 + (size_t)NS * 512 * 512;
constexpr size_t OFF_GLAS = OFF_KVS2 + (size_t)NS * 2048 * 512;
constexpr size_t OUT_TOTAL = OFF_GLAS + (size_t)NS * 4 * 128 * 256;

struct Params {
    const float *x_prompt, *x_sample, *c_prompt, *c_sample, *cache128, *cache512, *cache2048, *state_gla;
    const float *w_ada, *b_ada, *w_in, *w_gla_up, *b_gla, *gla_norm_w, *w_br_a, *w_br_b, *w_out, *ln1_w, *ln1_b;
    const float *w_pq, *peer_k1, *peer_k2, *peer_u, *peer_v, *ln2_w, *ln2_b;
    float* out;
    unsigned* bar;
    float* MOD; bf16_t* SC; bf16_t* WADA_T; bf16_t* WIN_T; bf16_t* WBRA_T; bf16_t* WBRB_T; bf16_t* WOUT_T; bf16_t* WPQ_T;
    bf16_t* KF; unsigned char* U8; unsigned char* V8; float* SU; float* SV;
    bf16_t* H; bf16_t* QKVA; bf16_t* QKB; bf16_t* VBB; bf16_t* RB; bf16_t* GA; bf16_t* GB; float* GLR;
    bf16_t* OG; float* LSE; float* LSEG; float* DSEG; float* SSEG; bf16_t* OGLA;
    bf16_t* OA; bf16_t* OB; bf16_t* TMP1; bf16_t* MERGED; float* Z1; float* LNST; bf16_t* QV; int* EIDX; float* EGW; float* ESU; float* EW; unsigned char* H8; float* HS;
};

__device__ __forceinline__ float bf2f(bf16_t v) { return __uint_as_float(((unsigned)v) << 16); }
__device__ __forceinline__ float bflo(unsigned w) { return __uint_as_float(w << 16); }
__device__ __forceinline__ float bfhi(unsigned w) { return __uint_as_float(w & 0xffff0000u); }
typedef __bf16 v2bf_t __attribute__((ext_vector_type(2)));
typedef float v2f_t __attribute__((ext_vector_type(2)));
__device__ __forceinline__ unsigned pack2(float lo, float hi) { const v2f_t f = {lo, hi}; const v2bf_t b = __builtin_convertvector(f, v2bf_t); return __builtin_bit_cast(unsigned, b); }
__device__ __forceinline__ bf16_t f2bf(float f) { return (bf16_t)(pack2(f, 0.f) & 0xffffu); }
__device__ __forceinline__ void unpack8(const u32x4 w, float (&o)[8]) { o[0] = bflo(w.x); o[1] = bfhi(w.x); o[2] = bflo(w.y); o[3] = bfhi(w.y); o[4] = bflo(w.z); o[5] = bfhi(w.z); o[6] = bflo(w.w); o[7] = bfhi(w.w); }
__device__ __forceinline__ float wave_sum(float v) {
#pragma unroll
    for (int o = 32; o >= 1; o >>= 1) v += __shfl_xor(v, o);
    return v;
}
__device__ __forceinline__ float wave_max(float v) {
#pragma unroll
    for (int o = 32; o >= 1; o >>= 1) v = fmaxf(v, __shfl_xor(v, o));
    return v;
}
#define DPP_ROR_F(v, n) __builtin_bit_cast(float, __builtin_amdgcn_update_dpp(0, __builtin_bit_cast(int, (v)), 0x120 + (n), 0xf, 0xf, true))
__device__ __forceinline__ float dpp_row_sum(float v) {
    v += DPP_ROR_F(v, 8); v += DPP_ROR_F(v, 4); v += DPP_ROR_F(v, 2); v += DPP_ROR_F(v, 1); return v;
}
__device__ __forceinline__ float sigmoidf_(float x) { return __builtin_amdgcn_rcpf(1.0f + __expf(-x)); }
__device__ __forceinline__ float siluf_(float x) { return x * __builtin_amdgcn_rcpf(1.0f + __expf(-x)); }
#define XB_TMO      128
#define XB_XCNT(j)  (256  + 64 * (j))
#define XB_XSUB(j)  (1280 + 64 * (j))
#define XB_XGEN(j)  (2304 + 64 * (j))
#define XB_TOP      3328
#define XB_TOPGEN   3392
#define XCD_BAR_WORDS 3456
#define XB_SPIN_CAP (1u << 22)

__device__ __forceinline__ unsigned xb_ld(unsigned* p)              { return __hip_atomic_load(p, __ATOMIC_RELAXED, __HIP_MEMORY_SCOPE_AGENT); }
__device__ __forceinline__ unsigned xb_add(unsigned* p, unsigned v) { return __hip_atomic_fetch_add(p, v, __ATOMIC_RELAXED, __HIP_MEMORY_SCOPE_AGENT); }
__device__ __forceinline__ unsigned xb_xcc_id() { return (unsigned)__builtin_amdgcn_s_getreg((3 << 11) | 20) & 0xFu; }
#define XB_SPIN(cond, bar) do { unsigned _sp = 0; while (cond) { __builtin_amdgcn_s_sleep(1); \
    if ((++_sp & 255u) == 0u) { if (xb_ld(&(bar)[XB_TMO])) break; if (_sp > XB_SPIN_CAP) { atomicAdd(&(bar)[XB_TMO], 1u); break; } } } } while (0)

struct XcdBarrier {
    unsigned* bar; unsigned x;
    volatile LAS unsigned* st;
};

__device__ __forceinline__ XcdBarrier xcd_barrier_post(unsigned* bar, volatile LAS unsigned* st) {
    XcdBarrier b; b.bar = bar; b.x = xb_xcc_id(); b.st = st;
    if (threadIdx.x == 0) (void)xb_add(&bar[XB_XCNT(b.x)], 1u);
    return b;
}
__device__ __forceinline__ void xcd_barrier_complete(unsigned* bar, unsigned x, unsigned& nloc, unsigned& nx) {
    const unsigned G = gridDim.x * gridDim.y * gridDim.z;
    unsigned sum, cnt, mine, sp = 0u;
    for (;;) {
        sum = 0u; cnt = 0u; mine = 0u;
#pragma unroll
        for (unsigned j = 0; j < 16; ++j) { const unsigned c = xb_ld(&bar[XB_XCNT(j)]); sum += c; cnt += (c > 0u) ? 1u : 0u; mine = (j == x) ? c : mine; }
        if (sum == G) break;
        __builtin_amdgcn_s_sleep(1);
        if ((++sp & 255u) == 0u) { if (xb_ld(&bar[XB_TMO])) break; if (sp > XB_SPIN_CAP) { atomicAdd(&bar[XB_TMO], 1u); break; } }
    }
    nloc = mine > 0u ? mine : 1u; nx = cnt > 0u ? cnt : 1u;
}

__device__ __forceinline__ void xcd_barrier(const XcdBarrier& b) {
    asm volatile("s_waitcnt vmcnt(0)" ::: "memory");
    __syncthreads();
    if (threadIdx.x == 0) {
        unsigned* bar = b.bar;
        __builtin_amdgcn_s_waitcnt(0);
        unsigned nloc = b.st[0], nx = b.st[1];
        if (nloc == 0u) { xcd_barrier_complete(bar, b.x, nloc, nx); b.st[0] = nloc; b.st[1] = nx; }
        const unsigned old = xb_add(&bar[XB_XSUB(b.x)], 1u);
        const unsigned gen = old / nloc;
        if (old + 1u == (gen + 1u) * nloc) {
            __builtin_amdgcn_fence(__ATOMIC_RELEASE, "agent");
            asm volatile("s_waitcnt vmcnt(0)" ::: "memory");
            const unsigned og = xb_add(&bar[XB_TOP], 1u);
            const unsigned tg = og / nx;
            if (og + 1u == (tg + 1u) * nx) xb_add(&bar[XB_TOPGEN], 1u);
            else XB_SPIN(xb_ld(&bar[XB_TOPGEN]) == tg, bar);
            __builtin_amdgcn_fence(__ATOMIC_ACQUIRE, "agent");
            xb_add(&bar[XB_XGEN(b.x)], 1u);
            asm volatile("s_waitcnt vmcnt(0)" ::: "memory");
        } else {
            XB_SPIN(xb_ld(&bar[XB_XGEN(b.x)]) == gen, bar);
            __builtin_amdgcn_fence(__ATOMIC_ACQUIRE, "agent");
            asm volatile("s_waitcnt vmcnt(0)" ::: "memory");
        }
    }
    __syncthreads();
}

__device__ __forceinline__ int win_cmap(int n) {
    if (n < 5376) return n;
    if (n < 6400) return n + 16;
    if (n < 7424) return n + 16;
    if (n < 7440) return n - 7424 + 5376;
    return -1;
}
__device__ __forceinline__ void tconv_tile(const float* __restrict__ src, int ldsrc, int K, bf16_t* __restrict__ dst, int tk, int tn, bool win, LAS float* tile) {
    int tid_ = threadIdx.x; asm volatile("" : "+v"(tid_));
    const int nl = tid_ & 63, kl0 = tid_ >> 6;
    const int n = tn * 64 + nl;
    const int sc = win ? win_cmap(n) : n;
#pragma unroll
    for (int i = 0; i < 8; ++i) { const int k = kl0 + 8 * i; tile[k * 65 + nl] = sc >= 0 ? src[(size_t)(tk * 64 + k) * ldsrc + sc] : 0.f; }
    __syncthreads();
    const int n2 = tid_ >> 3, kc = (tid_ & 7) * 8;
    u32x4 w;
    w.x = pack2(tile[(kc + 0) * 65 + n2], tile[(kc + 1) * 65 + n2]);
    w.y = pack2(tile[(kc + 2) * 65 + n2], tile[(kc + 3) * 65 + n2]);
    w.z = pack2(tile[(kc + 4) * 65 + n2], tile[(kc + 5) * 65 + n2]);
    w.w = pack2(tile[(kc + 6) * 65 + n2], tile[(kc + 7) * 65 + n2]);
    *(u32x4*)(dst + (size_t)(tn * 64 + n2) * K + tk * 64 + kc) = w;
    __syncthreads();
}
__device__ __forceinline__ void conv_chunk(const float* __restrict__ src, bf16_t* __restrict__ dst, size_t chunk) {
    int tid_ = threadIdx.x; asm volatile("" : "+v"(tid_));
    const size_t e = chunk * 4096 + (size_t)tid_ * 8;
    const f32x4 a = *(const f32x4*)(src + e), b = *(const f32x4*)(src + e + 4);
    u32x4 w; w.x = pack2(a[0], a[1]); w.y = pack2(a[2], a[3]); w.z = pack2(b[0], b[1]); w.w = pack2(b[2], b[3]);
    *(u32x4*)(dst + e) = w;
}

__device__ __forceinline__ void quant_rows8(const float* __restrict__ src, unsigned char* __restrict__ dst  , float* __restrict__ scl, int job) {
    int tid_ = threadIdx.x; asm volatile("" : "+v"(tid_));
    const int wave = tid_ >> 6, lane = tid_ & 63;
    const size_t row = (size_t)job * 8 + wave;
    const float* r = src + row * 1024 + 16 * lane;
    f32x4 x[4];
#pragma unroll
    for (int i = 0; i < 4; ++i) x[i] = *(const f32x4*)(r + 4 * i);
    float m = 0.f;
#pragma unroll
    for (int i = 0; i < 4; ++i) m = fmaxf(m, fmaxf(fmaxf(fabsf(x[i][0]), fabsf(x[i][1])), fmaxf(fabsf(x[i][2]), fabsf(x[i][3]))));
    m = wave_max(m);
    const float inv = m > 0.f ? 448.0f / m : 1.0f, sc = m > 0.f ? m * (1.0f / 448.0f) : 1.0f;
    u32x4 w;
#pragma unroll
    for (int i = 0; i < 4; ++i) {
        int d = 0;
        d = __builtin_amdgcn_cvt_pk_fp8_f32(x[i][0] * inv, x[i][1] * inv, d, false);
        d = __builtin_amdgcn_cvt_pk_fp8_f32(x[i][2] * inv, x[i][3] * inv, d, true);
        w[i] = (unsigned)d;
    }
    *(u32x4*)(dst + row * 2048 + 16 * lane) = w;
    if (lane == 0) scl[row] = sc;
}

__device__ __forceinline__ void kfrag_chunk(const float* __restrict__ k1, const float* __restrict__ k2, bf16_t* __restrict__ dst, int job) {
    int tid_ = threadIdx.x; asm volatile("" : "+v"(tid_));
    const int c = job * 512 + tid_, lane = c & 63, ks = (c >> 6) & 7, ni = (c >> 9) & 3, half = (c >> 11) & 1, h = c >> 12;
    const float* s = (half ? k2 : k1) + ((size_t)h * 128 + 32 * ni + (lane & 31)) * 128 + 16 * ks + 8 * (lane >> 5);
    const f32x4 a = *(const f32x4*)s, b = *(const f32x4*)(s + 4);
    u32x4 w; w.x = pack2(a[0], a[1]); w.y = pack2(a[2], a[3]); w.z = pack2(b[0], b[1]); w.w = pack2(b[2], b[3]);
    *(u32x4*)(dst + (size_t)c * 8) = w;
}
template <int STAGE> __device__ __forceinline__ void phase_prologue(const Params& p, int bid, int nb, LAS unsigned char* lds, int skip0) {
    int tid_ = threadIdx.x; asm volatile("" : "+v"(tid_));
    LAS float* tile = (LAS float*)lds;
    constexpr int J0 = 16 * 120, J1 = J0 + 16 * 96, J2 = J1 + 16 * 32, J3 = J2 + 256, J4 = J3 + 256, J5 = J4 + 64, J6 = J5 + 2048, J7 = J6 + 2048, J8 = J7 + 32, J9 = J8 + 32, J10 = J9 + 64;
    (void)J8;
    const int njobs = STAGE == 0 ? J1 + (J10 - J9) : J9 - J1;
    const int first = STAGE == 0 ? bid : bid - skip0, stride = STAGE == 0 ? nb : nb - skip0;
    if (first < 0 || stride <= 0) return;
    for (int jj = first; jj < njobs; jj += stride) {
        const int j = STAGE == 0 ? (jj < J1 ? jj : J9 + (jj - J1)) : J1 + jj;
        if (j < J0) { tconv_tile(p.w_in, 7440, 1024, p.WIN_T, j % 16, j / 16, true, tile); }
        else if (j < J1) { const int q = j - J0; tconv_tile(p.w_ada, 6144, 1024, p.WADA_T, q % 16, q / 16, false, tile); }
        else if (j < J2) { const int q = j - J1; tconv_tile(p.w_pq, 2048, 1024, p.WPQ_T, q % 16, q / 16, false, tile); }
        else if (j < J3) { const int q = j - J2; tconv_tile(p.w_br_b, 1024, 1024, p.WBRB_T, q % 16, q / 16, false, tile); }
        else if (j < J4) { const int q = j - J3; tconv_tile(p.w_out, 1024, 1024, p.WOUT_T, q % 16, q / 16, false, tile); }
        else if (j < J5) { const int q = j - J4; tconv_tile(p.w_br_a, 1024, 256, p.WBRA_T, q % 4, q / 4, false, tile); }
        else if (j < J6) { quant_rows8(p.peer_u, p.U8, p.SU, j - J5); }
        else if (j < J7) { quant_rows8(p.peer_v, p.U8 + 1024, p.SV, j - J6); }
        else if (j < J9) { kfrag_chunk(p.peer_k1, p.peer_k2, p.KF, j - J7); }
        else {
            const size_t e = (size_t)(j - J9) * 4096 + (size_t)tid_ * 8;
            const int row = (int)(e >> 10), col = (int)(e & 1023);
            float v[8];
#pragma unroll
            for (int i = 0; i < 8; ++i) v[i] = 0.f;
            if (row < 130) {
                const float* c = row < 2 ? p.c_prompt + (size_t)row * 1024 + col : p.c_sample + (size_t)(row - 2) * 1024 + col;
#pragma unroll
                for (int i = 0; i < 8; ++i) v[i] = siluf_(c[i]);
            }
            u32x4 w; w.x = pack2(v[0], v[1]); w.y = pack2(v[2], v[3]); w.z = pack2(v[4], v[5]); w.w = pack2(v[6], v[7]);
            *(u32x4*)(p.SC + e) = w;
        }
    }
}

__device__ __forceinline__ void row_stats(const float (&v)[16], float& mean, float& rstd) {
    float s = 0.f;
#pragma unroll
    for (int i = 0; i < 16; ++i) s += v[i];
    s = wave_sum(s);
    mean = s * (1.0f / 1024.0f);
    float q = 0.f;
#pragma unroll
    for (int i = 0; i < 16; ++i) { const float d = v[i] - mean; q += d * d; }
    q = wave_sum(q);
    rstd = rsqrtf(q * (1.0f / 1024.0f) + LN_EPS);
}
__device__ __forceinline__ void load_row16(const float* __restrict__ r, int lane, float (&v)[16]) {
    const f32x4 a = *(const f32x4*)(r + 8 * lane), b = *(const f32x4*)(r + 8 * lane + 4), c = *(const f32x4*)(r + 512 + 8 * lane), d = *(const f32x4*)(r + 512 + 8 * lane + 4);
#pragma unroll
    for (int i = 0; i < 4; ++i) { v[i] = a[i]; v[4 + i] = b[i]; v[8 + i] = c[i]; v[12 + i] = d[i]; }
}
__device__ __forceinline__ void store_row16_bf16(bf16_t* __restrict__ r, int lane, const float (&v)[16]) {
    u32x4 w0, w1;
    w0.x = pack2(v[0], v[1]); w0.y = pack2(v[2], v[3]); w0.z = pack2(v[4], v[5]); w0.w = pack2(v[6], v[7]);
    w1.x = pack2(v[8], v[9]); w1.y = pack2(v[10], v[11]); w1.z = pack2(v[12], v[13]); w1.w = pack2(v[14], v[15]);
    *(u32x4*)(r + 8 * lane) = w0; *(u32x4*)(r + 512 + 8 * lane) = w1;
}
__device__ __forceinline__ void store_row16_f32(float* __restrict__ r, int lane, const float (&v)[16]) {
    *(f32x4*)(r + 8 * lane) = (f32x4){v[0], v[1], v[2], v[3]}; *(f32x4*)(r + 8 * lane + 4) = (f32x4){v[4], v[5], v[6], v[7]};
    *(f32x4*)(r + 512 + 8 * lane) = (f32x4){v[8], v[9], v[10], v[11]}; *(f32x4*)(r + 512 + 8 * lane + 4) = (f32x4){v[12], v[13], v[14], v[15]};
}
__device__ __forceinline__ const float* x_row(const Params& p, int row) { return row < NTP ? p.x_prompt + (size_t)row * D : p.x_sample + (size_t)(row - NTP) * D; }
__device__ __forceinline__ int seq_of(int row) { return row < NTP ? (row >> 14) : 2 + (row - NTP); }

__device__ __forceinline__ void phase_lnmod1(const Params& p, int bid, int nb) {
    int tid_ = threadIdx.x; asm volatile("" : "+v"(tid_));
    const int wave = tid_ >> 6, lane = tid_ & 63;
    int row = bid * 8 + wave;
    float nx[16];
    if (row < NT) load_row16(x_row(p, row), lane, nx);
    for (; row < NT; row += nb * 8) {
        float v[16];
#pragma unroll
        for (int i = 0; i < 16; ++i) v[i] = nx[i];
        const int nrow = row + nb * 8;
        if (nrow < NT) load_row16(x_row(p, nrow), lane, nx);
        const float* mod = p.MOD + (size_t)seq_of(row) * 6144;
        float sh[16], sc[16];
        load_row16(mod, lane, sh); load_row16(mod + 1024, lane, sc);
        float mean, rstd; row_stats(v, mean, rstd);
#pragma unroll
        for (int i = 0; i < 16; ++i) v[i] = (v[i] - mean) * rstd * (1.0f + sc[i]) + sh[i];
        store_row16_bf16(p.H + (size_t)row * D, lane, v);
    }
}

struct EpiProj {
    static constexpr bool PERM = true, AFTER_DRAIN = false;
    bf16_t *QKVA, *QKB, *VBB, *RB, *GA, *GB; float* GLR; float* out;
    __device__ __forceinline__ void operator()(const pg8::f32x4 (&acc)[2][2][4][2], const pg8::Unit& u, int wr, int wc, int fr, int fq) const {
        const int pn = u.pn;
        bf16_t* dst; int ld = 1024, c0; float scale = 1.0f;
        if (pn < 9) { dst = QKVA; ld = 2304; c0 = pn * 256; }
        else if (pn < 13) { dst = QKB; c0 = (pn - 9) * 256; if (pn < 11) scale = 0.08838834764831845f; }
        else if (pn < 17) { dst = VBB; c0 = (pn - 13) * 256; }
        else if (pn < 21) { dst = RB; c0 = (pn - 17) * 256; }
        else if (pn < 25) { dst = GA; c0 = (pn - 21) * 256; }
        else if (pn < 29) { dst = GB; c0 = (pn - 25) * 256; }
        else { dst = nullptr; c0 = 0; }
        const bool kvt = pn >= 3 && pn < 9;
        const int g = kvt ? (pn - 3) % 3 : 0, kv = kvt ? (pn - 3) / 3 : 0;
        const int W = 128 << (2 * g);
        const size_t offp = g == 0 ? OFF_KVP0 : (g == 1 ? OFF_KVP1 : OFF_KVP2);
        const size_t offs = g == 0 ? OFF_KVS0 : (g == 1 ? OFF_KVS1 : OFF_KVS2);
        const int row0 = u.pm * 256 + wr * 64 + fr, colw = wc * 32 + 8 * fq;
#pragma unroll
        for (int ai = 0; ai < 2; ++ai)
#pragma unroll
            for (int m = 0; m < 4; ++m) {
                const int row = row0 + ai * 128 + m * 16;
#pragma unroll
                for (int bj = 0; bj < 2; ++bj) {
                    const int cc = bj * 128 + colw;
                    const pg8::f32x4 v0 = acc[ai][bj][m][0], v1 = acc[ai][bj][m][1];
                    if (dst) {
                        u32x4 w; w.x = pack2(v0[0] * scale, v0[1] * scale); w.y = pack2(v0[2] * scale, v0[3] * scale); w.z = pack2(v1[0] * scale, v1[1] * scale); w.w = pack2(v1[2] * scale, v1[3] * scale);
                        *(u32x4*)(dst + (size_t)row * ld + c0 + cc) = w;
                    } else if (cc < 16) {
                        *(pg8::f32x4*)(GLR + (size_t)row * 16 + cc) = v0; *(pg8::f32x4*)(GLR + (size_t)row * 16 + cc + 4) = v1;
                    }
                    if (kvt) {
                        if (row < NTP) {
                            const int b = row >> 14, t = row & (T - 1);
                            if (t >= T - W) { float* o = out + offp + ((size_t)(b * W + (t - (T - W))) * 2 + kv) * 256 + cc; *(pg8::f32x4*)o = v0; *(pg8::f32x4*)(o + 4) = v1; }
                        } else if (row < NT) {
                            const int s = row - NTP;
                            float* o = out + offs + ((size_t)(s * W + (W - 1)) * 2 + kv) * 256 + cc; *(pg8::f32x4*)o = v0; *(pg8::f32x4*)(o + 4) = v1;
                        }
                    }
                }
            }
    }
    __device__ __forceinline__ void emit16(int row, int col, const float (&v)[16]) const {
        const int pn = col >> 8, cc = col & 255;
        bf16_t* dst; int ld = 1024, c0; float scale = 1.0f;
        if (pn < 9) { dst = QKVA; ld = 2304; c0 = pn * 256; }
        else if (pn < 13) { dst = QKB; c0 = (pn - 9) * 256; if (pn < 11) scale = 0.08838834764831845f; }
        else if (pn < 17) { dst = VBB; c0 = (pn - 13) * 256; }
        else if (pn < 21) { dst = RB; c0 = (pn - 17) * 256; }
        else if (pn < 25) { dst = GA; c0 = (pn - 21) * 256; }
        else if (pn < 29) { dst = GB; c0 = (pn - 25) * 256; }
        else { dst = nullptr; c0 = 0; }
        if (dst) {
            u32x4 w0, w1;
            w0.x = pack2(v[0] * scale, v[1] * scale); w0.y = pack2(v[2] * scale, v[3] * scale); w0.z = pack2(v[4] * scale, v[5] * scale); w0.w = pack2(v[6] * scale, v[7] * scale);
            w1.x = pack2(v[8] * scale, v[9] * scale); w1.y = pack2(v[10] * scale, v[11] * scale); w1.z = pack2(v[12] * scale, v[13] * scale); w1.w = pack2(v[14] * scale, v[15] * scale);
            *(u32x4*)(dst + (size_t)row * ld + c0 + cc) = w0; *(u32x4*)(dst + (size_t)row * ld + c0 + cc + 8) = w1;
        } else if (cc == 0) {
#pragma unroll
            for (int i = 0; i < 4; ++i) *(f32x4*)(GLR + (size_t)row * 16 + 4 * i) = (f32x4){v[4 * i], v[4 * i + 1], v[4 * i + 2], v[4 * i + 3]};
        }
        if (pn >= 3 && pn < 9 && row >= NTP && row < NT) {
            const int g = (pn - 3) % 3, kv = (pn - 3) / 3, W = 128 << (2 * g), s = row - NTP;
            float* o = out + (g == 0 ? OFF_KVS0 : (g == 1 ? OFF_KVS1 : OFF_KVS2)) + ((size_t)(s * W + (W - 1)) * 2 + kv) * 256 + cc;
#pragma unroll
            for (int i = 0; i < 4; ++i) *(f32x4*)(o + 4 * i) = (f32x4){v[4 * i], v[4 * i + 1], v[4 * i + 2], v[4 * i + 3]};
        }
    }
};

__device__ __forceinline__ void phase_cache_copy(const Params& p, int bid, int nb) {
    int tid_ = threadIdx.x; asm volatile("" : "+v"(tid_));
    const size_t tid = (size_t)bid * NTHREADS + tid_, nth = (size_t)nb * NTHREADS;
#pragma unroll
    for (int g = 0; g < 3; ++g) {
        const int W = 128 << (2 * g);
        const float* src = g == 0 ? p.cache128 : (g == 1 ? p.cache512 : p.cache2048);
        float* dst = p.out + (g == 0 ? OFF_KVS0 : (g == 1 ? OFF_KVS1 : OFF_KVS2));
        const size_t per = (size_t)(W - 1) * 128, total = per * NS;
        for (size_t i = tid; i < total; i += nth) {
            const size_t s = i / per, rem = i - s * per;
            const f32x4 v = __builtin_nontemporal_load((const f32x4*)(src + (s * W + 1) * 512) + rem);
            __builtin_nontemporal_store(v, (f32x4*)(dst + s * W * 512) + rem);
        }
    }
}

__device__ __forceinline__ f32x16 mfma32(bf16x8 a, bf16x8 b, f32x16 c) { return __builtin_amdgcn_mfma_f32_32x32x16_bf16(a, b, c, 0, 0, 0); }
__device__ __forceinline__ f32x16 zero16() { f32x16 z; for (int i = 0; i < 16; ++i) z[i] = 0.f; return z; }
__device__ __forceinline__ bf16x8 ld_frag_g(const bf16_t* p) { return *(const bf16x8*)p; }
__device__ __forceinline__ bf16x8 ld_frag_l(const LAS bf16_t* p) { return *(const LAS bf16x8*)p; }
__device__ __forceinline__ int crow(int reg, int hh) { return (reg & 3) + 8 * (reg >> 2) + 4 * hh; }
__device__ __forceinline__ float log_sigmoidf_(float z) { return fminf(z, 0.f) - log1pf(__expf(-fabsf(z))); }

__device__ __forceinline__ void phase_gla_sample(const Params& p, int bid, int nb, LAS unsigned char* lds) {
    int tid_ = threadIdx.x; asm volatile("" : "+v"(tid_));
    LAS float* s_eg = (LAS float*)lds;
    LAS float* s_q = s_eg + 128;
    LAS float* s_k = s_q + 128;
    LAS float* s_o = s_k + 128;
    const int dv4 = tid_ & 63, kg = tid_ >> 6;
    for (int u = bid; u < NS * 4; u += nb) {
        const int s = u >> 2, h = u & 3;
        const size_t row = (size_t)(NTP + s);
        const float* S0 = p.state_gla + ((size_t)s * 4 + h) * 32768 + (size_t)(16 * kg) * 256 + 4 * dv4;
        float* Sn = p.out + OFF_GLAS + ((size_t)s * 4 + h) * 32768 + (size_t)(16 * kg) * 256 + 4 * dv4;
        f32x4 st[16];
#pragma unroll
        for (int i = 0; i < 16; ++i) st[i] = __builtin_nontemporal_load((const f32x4*)(S0 + i * 256));
        if (tid_ < 128) {
            const int kd = tid_; float z = p.b_gla[h * 128 + kd];
#pragma unroll
            for (int j = 0; j < 16; ++j) z += p.GLR[row * 16 + j] * p.w_gla_up[j * 512 + h * 128 + kd];
            s_eg[kd] = __expf(log_sigmoidf_(z) * (1.0f / 16.0f));
            s_q[kd] = bf2f(p.QKB[row * 1024 + h * 128 + kd]);
            s_k[kd] = bf2f(p.QKB[row * 1024 + 512 + h * 128 + kd]);
        }
        const u32x2 vw = *(const u32x2*)(p.VBB + row * 1024 + h * 256 + 4 * dv4);
        const f32x4 v4 = {bflo(vw.x), bfhi(vw.x), bflo(vw.y), bfhi(vw.y)};
        __syncthreads();
        f32x4 o = {0.f, 0.f, 0.f, 0.f};
#pragma unroll
        for (int i = 0; i < 16; ++i) {
            const int kd = 16 * kg + i;
            const f32x4 sv = st[i] * s_eg[kd] + v4 * s_k[kd];
            __builtin_nontemporal_store(sv, (f32x4*)(Sn + i * 256));
            o += sv * s_q[kd];
        }
        *(LAS f32x4*)(s_o + kg * 256 + 4 * dv4) = o;
        __syncthreads();
        float t = 0.f;
        if (tid_ < 256) {
#pragma unroll
            for (int w = 0; w < 8; ++w) t += s_o[w * 256 + tid_];
        }
        const float sq = wave_sum(t * t);
        __syncthreads();
        if ((tid_ & 63) == 0) s_o[tid_ >> 6] = sq;
        __syncthreads();
        if (tid_ < 256) {
            const float rn = rsqrtf((s_o[0] + s_o[1] + s_o[2] + s_o[3]) * (1.0f / 256.0f) + LN_EPS);
            p.OB[row * 1024 + h * 256 + tid_] = f2bf(t * rn * p.gla_norm_w[h * 256 + tid_] * siluf_(bf2f(p.RB[row * 1024 + h * 256 + tid_])));
        }
        __syncthreads();
    }
}

constexpr int G2_QP = 136;
constexpr int G2_TP = 72;
constexpr int G2_VP = 264;
typedef short v4s2_t __attribute__((ext_vector_type(4)));
constexpr int G2_BP = 132;
struct Gla2Lds {
    LAS float* glr; LAS float* tot; LAS float* dl; LAS float* bl; LAS float* bt; LAS bf16_t* qe; LAS bf16_t* ke; LAS bf16_t* kdt; LAS bf16_t* vt; LAS bf16_t* pp; LAS float* ss;
    __device__ __forceinline__ void carve(LAS unsigned char* lds) {
        glr = (LAS float*)lds; tot = glr + 1024; dl = tot + 512; bl = dl + 128; bt = bl + 128;
        qe = (LAS bf16_t*)(bt + 64 * G2_BP); ke = qe + 64 * G2_QP; kdt = ke + 64 * G2_QP; vt = kdt + 64 * G2_QP; pp = vt + 64 * G2_VP; ss = (LAS float*)(pp + 64 * G2_TP);
    }
};
struct Gla2Regs { f32x4 glr; u32x4 v[4], k[2], q[2]; };
__device__ __forceinline__ void gla2_load_chunk(const Params& p, Gla2Regs& R, int tid_, int b, int h, int c, bool need_qk) {
    const size_t row0 = (size_t)b * T + (size_t)c * 64;
    R.glr = *(const f32x4*)(p.GLR + row0 * 16 + (tid_ & 255) * 4);
#pragma unroll
    for (int i = 0; i < 4; ++i) { const int q = tid_ + 512 * i, t = q >> 5, dc = q & 31; R.v[i] = *(const u32x4*)(p.VBB + (row0 + t) * 1024 + h * 256 + dc * 8); }
#pragma unroll
    for (int i = 0; i < 2; ++i) { const int it = tid_ + 512 * i, t = it >> 4, kg = it & 15;
        R.k[i] = *(const u32x4*)(p.QKB + (row0 + t) * 1024 + 512 + h * 128 + kg * 8);
        if (need_qk) R.q[i] = *(const u32x4*)(p.QKB + (row0 + t) * 1024 + h * 128 + kg * 8); }
}
__device__ __forceinline__ float gla2_stage_chunk(const Gla2Lds& L, const Gla2Regs& R, int tid_, const float (&wup)[16], float bg, bool need_qk) {
    const int kd = tid_ >> 2, q4 = tid_ & 3;
    if (tid_ < 256) *(LAS f32x4*)(L.glr + tid_ * 4) = R.glr;
#pragma unroll
    for (int i = 0; i < 4; ++i) { const int q = tid_ + 512 * i, t = q >> 5, dc = q & 31; *(LAS u32x4*)(L.vt + t * G2_VP + dc * 8) = R.v[i]; }
    __syncthreads();
    float pre[16]; float run = 0.f;
#pragma unroll
    for (int i = 0; i < 16; ++i) {
        const int t = q4 * 16 + i; float z = bg;
#pragma unroll
        for (int j4 = 0; j4 < 4; ++j4) { const f32x4 gq = *(const LAS f32x4*)(L.glr + t * 16 + 4 * j4); z += gq[0] * wup[4 * j4] + gq[1] * wup[4 * j4 + 1] + gq[2] * wup[4 * j4 + 2] + gq[3] * wup[4 * j4 + 3]; }
        const float ls = fminf(z, 0.f) - __logf(1.0f + __expf(-fabsf(z)));
        run += ls * (1.0f / 16.0f); pre[i] = run;
    }
    const float t0 = __builtin_bit_cast(float, __builtin_amdgcn_update_dpp(0, __builtin_bit_cast(int, run), 0x00, 0xf, 0xf, true));
    const float t1 = __builtin_bit_cast(float, __builtin_amdgcn_update_dpp(0, __builtin_bit_cast(int, run), 0x55, 0xf, 0xf, true));
    const float t2 = __builtin_bit_cast(float, __builtin_amdgcn_update_dpp(0, __builtin_bit_cast(int, run), 0xaa, 0xf, 0xf, true));
    const float t3 = __builtin_bit_cast(float, __builtin_amdgcn_update_dpp(0, __builtin_bit_cast(int, run), 0xff, 0xf, 0xf, true));
    const float offs = (q4 > 0 ? t0 : 0.f) + (q4 > 1 ? t1 : 0.f) + (q4 > 2 ? t2 : 0.f), blast = (t0 + t1) + (t2 + t3);
#pragma unroll
    for (int i = 0; i < 16; ++i) L.bt[(q4 * 16 + i) * G2_BP + kd] = offs + pre[i];
    const float edl = __expf(blast);
    if (q4 == 0) { L.dl[kd] = edl; L.bl[kd] = blast; }
    __syncthreads();
#pragma unroll
    for (int i = 0; i < 2; ++i) {
        const int it = tid_ + 512 * i, t = it >> 4, kg = it & 15;
        const f32x4 b0 = *(const LAS f32x4*)(L.bt + t * G2_BP + 8 * kg), b1 = *(const LAS f32x4*)(L.bt + t * G2_BP + 8 * kg + 4);
        const f32x4 l0 = *(const LAS f32x4*)(L.bl + 8 * kg), l1 = *(const LAS f32x4*)(L.bl + 8 * kg + 4);
        const float bv[8] = {b0[0], b0[1], b0[2], b0[3], b1[0], b1[1], b1[2], b1[3]}, lv[8] = {l0[0], l0[1], l0[2], l0[3], l1[0], l1[1], l1[2], l1[3]};
        float k8[8]; unpack8(R.k[i], k8);
        { float kd8[8];
#pragma unroll
          for (int e = 0; e < 8; ++e) kd8[e] = k8[e] * __expf(lv[e] - bv[e]);
          u32x4 wd; wd.x = pack2(kd8[0], kd8[1]); wd.y = pack2(kd8[2], kd8[3]); wd.z = pack2(kd8[4], kd8[5]); wd.w = pack2(kd8[6], kd8[7]);
          *(LAS u32x4*)(L.kdt + t * G2_QP + 8 * kg) = wd; }
        if (need_qk) {
            float q8[8], qo[8], ko[8]; unpack8(R.q[i], q8);
#pragma unroll
            for (int e = 0; e < 8; ++e) { const float eb = __expf(bv[e]); qo[e] = q8[e] * eb; ko[e] = k8[e] * __builtin_amdgcn_rcpf(eb); }
            u32x4 wq, wk;
            wq.x = pack2(qo[0], qo[1]); wq.y = pack2(qo[2], qo[3]); wq.z = pack2(qo[4], qo[5]); wq.w = pack2(qo[6], qo[7]);
            wk.x = pack2(ko[0], ko[1]); wk.y = pack2(ko[2], ko[3]); wk.z = pack2(ko[4], ko[5]); wk.w = pack2(ko[6], ko[7]);
            *(LAS u32x4*)(L.qe + t * G2_QP + 8 * kg) = wq; *(LAS u32x4*)(L.ke + t * G2_QP + 8 * kg) = wk;
        }
    }
    __syncthreads();
    return edl;
}
__device__ __forceinline__ bf16x8 ld_frag_tr(const LAS bf16_t* img, int pitch, int row0, int col0, int lane) {
    const int i16 = lane & 15, hh = lane >> 5;
    const LAS bf16_t* ap = img + (row0 + 8 * hh + (i16 >> 2)) * pitch + col0 + 16 * ((lane >> 4) & 1) + 4 * (i16 & 3);
    union { bf16x8 v; v4s2_t h2[2]; } f;
    f.h2[0] = __builtin_amdgcn_ds_read_tr16_b64_v4i16((LAS v4s2_t*)ap);
    f.h2[1] = __builtin_amdgcn_ds_read_tr16_b64_v4i16((LAS v4s2_t*)(ap + 4 * pitch));
    return f.v;
}
__device__ __forceinline__ void gla2_update_state(const Gla2Lds& L, f32x16 (&S)[4], int wave, int lane) {
    const int hh = lane >> 5;
    bf16x8 vf[4];
#pragma unroll
    for (int ks = 0; ks < 4; ++ks) vf[ks] = ld_frag_tr(L.vt, G2_VP, 16 * ks, 32 * wave, lane);
#pragma unroll
    for (int mi = 0; mi < 4; ++mi) {
#pragma unroll
        for (int g4 = 0; g4 < 4; ++g4) {
            const f32x4 d = *(const LAS f32x4*)(L.dl + 32 * mi + 8 * g4 + 4 * hh);
#pragma unroll
            for (int j = 0; j < 4; ++j) S[mi][4 * g4 + j] *= d[j];
        }
#pragma unroll
        for (int ks = 0; ks < 4; ++ks) S[mi] = mfma32(ld_frag_tr(L.kdt, G2_QP, 16 * ks, 32 * mi, lane), vf[ks], S[mi]);
    }
}
__device__ __forceinline__ void phase_gla2_passA(const Params& p, int bid, int nb, LAS unsigned char* lds) {
    int tid_ = threadIdx.x; asm volatile("" : "+v"(tid_));
    Gla2Lds L; L.carve(lds);
    const int wave = tid_ >> 6, lane = tid_ & 63;
    for (int u = bid; u < 256; u += nb) {
        const int bh = u >> 5, seg = u & 31, b = bh >> 2, h = bh & 3;
        float wup[16];
#pragma unroll
        for (int j = 0; j < 16; ++j) wup[j] = p.w_gla_up[j * 512 + h * 128 + (tid_ >> 2)];
        const float bg = p.b_gla[h * 128 + (tid_ >> 2)];
        f32x16 S[4];
#pragma unroll
        for (int mi = 0; mi < 4; ++mi) S[mi] = zero16();
        float dprod = 1.0f;
        Gla2Regs R; gla2_load_chunk(p, R, tid_, b, h, seg * 8, false);
        for (int cc = 0; cc < 8; ++cc) {
            int tq = tid_; asm volatile("" : "+v"(tq));
            dprod *= gla2_stage_chunk(L, R, tq, wup, bg, false);
            if (cc < 7) gla2_load_chunk(p, R, tq, b, h, seg * 8 + cc + 1, false);
            gla2_update_state(L, S, wave, tq & 63);
            __syncthreads();
        }
        float* dst = p.LSEG + (size_t)u * 32768 + (size_t)wave * 4096 + lane;
#pragma unroll
        for (int mi = 0; mi < 4; ++mi)
#pragma unroll
            for (int reg = 0; reg < 16; ++reg) dst[(mi * 16 + reg) * 64] = S[mi][reg];
        if ((tid_ & 3) == 0) p.DSEG[(size_t)u * 128 + (tid_ >> 2)] = dprod;
    }
}
__device__ __forceinline__ void phase_gla2_scan(const Params& p, int bid, int nb) {
    int tid_ = threadIdx.x; asm volatile("" : "+v"(tid_));
    for (int e = bid * NTHREADS + tid_; e < 8 * 32768; e += nb * NTHREADS) {
        const int bh = e >> 15, idx = e & 32767, w = idx >> 12, rem = idx & 4095, mr = rem >> 6, ln = rem & 63, mi = mr >> 4, reg = mr & 15;
        const int kd = 32 * mi + crow(reg, ln >> 5), dv = 32 * w + (ln & 31);
        float S = 0.f;
        for (int s0 = 0; s0 < 32; s0 += 8) {
            float l[8], d[8];
#pragma unroll
            for (int i = 0; i < 8; ++i) { const size_t u = (size_t)bh * 32 + s0 + i; l[i] = p.LSEG[u * 32768 + idx]; d[i] = p.DSEG[u * 128 + kd]; }
#pragma unroll
            for (int i = 0; i < 8; ++i) { const size_t u = (size_t)bh * 32 + s0 + i; p.SSEG[u * 32768 + idx] = S; S = d[i] * S + l[i]; }
        }
        p.out[OFF_GLAP + ((size_t)bh * 128 + kd) * 256 + dv] = S;
    }
}
__device__ __forceinline__ void phase_gla2_passC(const Params& p, int bid, int nb, LAS unsigned char* lds) {
    int tid_ = threadIdx.x; asm volatile("" : "+v"(tid_));
    Gla2Lds L; L.carve(lds);
    const int wave = tid_ >> 6, lane = tid_ & 63;
    for (int u = bid; u < 256; u += nb) {
        const int bh = u >> 5, seg = u & 31, b = bh >> 2, h = bh & 3;
        float wup[16];
#pragma unroll
        for (int j = 0; j < 16; ++j) wup[j] = p.w_gla_up[j * 512 + h * 128 + (tid_ >> 2)];
        const float bg = p.b_gla[h * 128 + (tid_ >> 2)];
        Gla2Regs R; gla2_load_chunk(p, R, tid_, b, h, seg * 8, true);
        f32x16 S[4];
        {
            const float* src = p.SSEG + (size_t)u * 32768 + (size_t)wave * 4096 + lane;
#pragma unroll
            for (int mi = 0; mi < 4; ++mi)
#pragma unroll
                for (int reg = 0; reg < 16; ++reg) S[mi][reg] = src[(mi * 16 + reg) * 64];
        }
        for (int cc = 0; cc < 8; ++cc) {
            const int c = seg * 8 + cc, row0 = b * T + c * 64;
            int tq = tid_; asm volatile("" : "+v"(tq));
            const int r = tq & 31, hh = (tq >> 5) & 1;
            gla2_stage_chunk(L, R, tq, wup, bg, true);
            if (cc < 7) gla2_load_chunk(p, R, tq, b, h, c + 1, true);
            if (wave < 4) {
                const int mi = wave >> 1, ni = wave & 1;
                f32x16 acc = zero16();
#pragma unroll
                for (int ks = 0; ks < 8; ++ks) acc = mfma32(ld_frag_l(L.ke + (32 * ni + r) * G2_QP + 16 * ks + 8 * hh), ld_frag_l(L.qe + (32 * mi + r) * G2_QP + 16 * ks + 8 * hh), acc);
                const int t = 32 * mi + r;
#pragma unroll
                for (int rg = 0; rg < 4; ++rg) {
                    const int s0 = 32 * ni + 8 * rg + 4 * hh;
                    u32x2 w;
                    w.x = pack2(s0 + 0 <= t ? acc[4 * rg + 0] : 0.f, s0 + 1 <= t ? acc[4 * rg + 1] : 0.f);
                    w.y = pack2(s0 + 2 <= t ? acc[4 * rg + 2] : 0.f, s0 + 3 <= t ? acc[4 * rg + 3] : 0.f);
                    *(LAS u32x2*)(L.pp + t * G2_TP + s0) = w;
                }
            }
            union { bf16x8 v; unsigned w[4]; } sb[4][2];
#pragma unroll
            for (int mi = 0; mi < 4; ++mi)
#pragma unroll
                for (int s2 = 0; s2 < 2; ++s2)
#pragma unroll
                    for (int e = 0; e < 4; ++e) sb[mi][s2].w[e] = pack2(S[mi][8 * s2 + 2 * e], S[mi][8 * s2 + 2 * e + 1]);
            __syncthreads();
            f32x16 oacc[2];
#pragma unroll
            for (int tt = 0; tt < 2; ++tt) {
                f32x16 acc = zero16();
#pragma unroll
                for (int ks = 0; ks < 4; ++ks) acc = mfma32(ld_frag_tr(L.vt, G2_VP, 16 * ks, 32 * wave, tq & 63), ld_frag_l(L.pp + (32 * tt + r) * G2_TP + 16 * ks + 8 * hh), acc);
#pragma unroll
                for (int mi = 0; mi < 4; ++mi)
#pragma unroll
                    for (int s2 = 0; s2 < 2; ++s2) {
                        union { bf16x8 v; u32x2 h2[2]; } qa;
                        const LAS bf16_t* qp = L.qe + (32 * tt + r) * G2_QP + 32 * mi + 16 * s2 + 4 * hh;
                        qa.h2[0] = *(const LAS u32x2*)qp; qa.h2[1] = *(const LAS u32x2*)(qp + 8);
                        acc = mfma32(sb[mi][s2].v, qa.v, acc);
                    }
                float sq = 0.f;
#pragma unroll
                for (int i = 0; i < 16; ++i) sq += acc[i] * acc[i];
                sq += __shfl_xor(sq, 32);
                if (hh == 0) L.ss[wave * 64 + 32 * tt + r] = sq;
                oacc[tt] = acc;
            }
            gla2_update_state(L, S, wave, tq & 63);
            __syncthreads();
#pragma unroll
            for (int tt = 0; tt < 2; ++tt) {
                float tot = 0.f;
#pragma unroll
                for (int w = 0; w < 8; ++w) tot += L.ss[w * 64 + 32 * tt + r];
                const float rn = rsqrtf(tot * (1.0f / 256.0f) + LN_EPS);
                const size_t ro = (size_t)(row0 + 32 * tt + r) * 1024 + h * 256 + 32 * wave + 4 * hh;
                const float* gw = p.gla_norm_w + h * 256 + 32 * wave + 4 * hh;
#pragma unroll
                for (int rg = 0; rg < 4; ++rg) {
                    const u32x2 rw = *(const u32x2*)(p.RB + ro + 8 * rg);
                    const f32x4 g4 = *(const f32x4*)(gw + 8 * rg);
                    const float o0 = oacc[tt][4 * rg + 0] * rn * g4[0] * siluf_(bflo(rw.x)), o1 = oacc[tt][4 * rg + 1] * rn * g4[1] * siluf_(bfhi(rw.x));
                    const float o2 = oacc[tt][4 * rg + 2] * rn * g4[2] * siluf_(bflo(rw.y)), o3 = oacc[tt][4 * rg + 3] * rn * g4[3] * siluf_(bfhi(rw.y));
                    u32x2 w; w.x = pack2(o0, o1); w.y = pack2(o2, o3);
                    *(u32x2*)(p.OB + ro + 8 * rg) = w;
                }
            }
            __syncthreads();
        }
    }
}

constexpr int AKV_PITCH = 72;
typedef short v4s_t __attribute__((ext_vector_type(4)));
__device__ __forceinline__ float alibi_slope(int g, int j) { return exp2f(-8.0f * (float)(g * 4 + j + 1) / 12.0f); }

__device__ __forceinline__ void phase_attn_prompt(const Params& p, int bid, int nb_, LAS unsigned char* lds) {
    int tid_ = threadIdx.x; asm volatile("" : "+v"(tid_));
    LAS bf16_t* s_k = (LAS bf16_t*)lds;
    LAS bf16_t* s_v = s_k + 2 * 256 * AKV_PITCH;
    const int wave = tid_ >> 6, lane = tid_ & 63, r = lane & 31, hh = lane >> 5;
    const int jj = wave >> 2, qs = wave & 3;
    for (int u = bid; u < 1536; u += nb_) {
        const int hp = u & 1, nbq = (u >> 1) & 127, bg = u >> 8, g = bg % 3, b = bg / 3;
        const int d = 1 << (2 * g), nbk = 128 >> (2 * g);
        const int ph = nbq / nbk, nb = nbq % nbk;
#pragma unroll
        for (int half = 0; half < 2; ++half) {
            u32x4 w[8];
#pragma unroll
            for (int i = 0; i < 8; ++i) {
                const int q = tid_ + 512 * i, hj = q >> 11, key = (q >> 3) & 255, dc = q & 7;
                int lp = 128 * (nb - 1) + key; lp = lp < 0 ? 0 : lp;
                const size_t row = (size_t)b * T + (size_t)lp * d + ph;
                w[i] = *(const u32x4*)(p.QKVA + row * 2304 + (half ? 1536 : 768) + g * 256 + (2 * hp + hj) * 64 + dc * 8);
            }
#pragma unroll
            for (int i = 0; i < 8; ++i) {
                const int q = tid_ + 512 * i, hj = q >> 11, key = (q >> 3) & 255, dc = q & 7;
                *(LAS u32x4*)((half ? s_v : s_k) + (hj * 256 + key) * AKV_PITCH + dc * 8) = w[i];
            }
        }
        const int j = 2 * hp + jj;
        const float slope_d = alibi_slope(g, j) * (float)d;
        const int qi = 32 * qs + r;
        const size_t rowq = (size_t)b * T + (size_t)(128 * nb + qi) * d + ph;
        bf16x8 qf[4];
#pragma unroll
        for (int ks = 0; ks < 4; ++ks) qf[ks] = ld_frag_g(p.QKVA + rowq * 2304 + g * 256 + j * 64 + 16 * ks + 8 * hh);
        __syncthreads();
        float sc[5][16];
        const LAS bf16_t* kb = s_k + (jj * 256 + 32 * qs + r) * AKV_PITCH + 8 * hh;
#pragma unroll
        for (int kt = 0; kt < 5; ++kt) {
            f32x16 acc = zero16();
#pragma unroll
            for (int ks = 0; ks < 4; ++ks) acc = mfma32(ld_frag_l(kb + (32 * kt) * AKV_PITCH + 16 * ks), qf[ks], acc);
#pragma unroll
            for (int reg = 0; reg < 16; ++reg) sc[kt][reg] = acc[reg];
        }
        float m = -3.0e38f;
        float fb = (float)(r - 4 * hh + 128);
        asm volatile("" : "+v"(fb));
        const float fsmax = nb > 0 ? 128.0f : (float)qi;
#pragma unroll
        for (int kt = 0; kt < 5; ++kt)
#pragma unroll
            for (int reg = 0; reg < 16; ++reg) {
                const float fs = fb - (float)(32 * kt + (reg & 3) + 8 * (reg >> 2));
                const bool valid = fs >= 0.f && fs <= fsmax;
                const float v = valid ? sc[kt][reg] * 0.125f - slope_d * fs : -3.0e38f;
                sc[kt][reg] = v; m = fmaxf(m, v);
            }
        m = fmaxf(m, __shfl_xor(m, 32));
        float z = 0.f;
#pragma unroll
        for (int kt = 0; kt < 5; ++kt)
#pragma unroll
            for (int reg = 0; reg < 16; ++reg) { const float v = sc[kt][reg]; const float e = v > -1.0e38f ? __expf(v - m) : 0.f; sc[kt][reg] = e; z += e; if (reg == 15) __builtin_amdgcn_sched_barrier(0); }
        z += __shfl_xor(z, 32);
        const float rz = 1.0f / z;
        f32x16 o0 = zero16(), o1 = zero16();
        const int i16 = lane & 15;
        const LAS bf16_t* vb = s_v + (jj * 256 + 32 * qs + 4 * hh + (i16 >> 2)) * AKV_PITCH + 16 * ((lane >> 4) & 1) + 4 * (i16 & 3);
#pragma unroll
        for (int kt = 0; kt < 5; ++kt)
#pragma unroll
            for (int s2 = 0; s2 < 2; ++s2) {
                union { bf16x8 v; unsigned w[4]; } pb;
#pragma unroll
                for (int e = 0; e < 4; ++e) pb.w[e] = pack2(sc[kt][8 * s2 + 2 * e] * rz, sc[kt][8 * s2 + 2 * e + 1] * rz);
#pragma unroll
                for (int dt = 0; dt < 2; ++dt) {
                    union { bf16x8 v; v4s_t h2[2]; } va;
                    const LAS bf16_t* ap = vb + (32 * kt + 16 * s2) * AKV_PITCH + 32 * dt;
                    va.h2[0] = __builtin_amdgcn_ds_read_tr16_b64_v4i16((LAS v4s_t*)ap);
                    va.h2[1] = __builtin_amdgcn_ds_read_tr16_b64_v4i16((LAS v4s_t*)(ap + 8 * AKV_PITCH));
                    if (dt == 0) o0 = mfma32(va.v, pb.v, o0); else o1 = mfma32(va.v, pb.v, o1);
                }
                __builtin_amdgcn_sched_barrier(0);
            }
        bf16_t* og = p.OG + rowq * 768 + g * 256 + j * 64;
#pragma unroll
        for (int rg = 0; rg < 4; ++rg) {
            u32x2 w0, w1;
            w0.x = pack2(o0[4 * rg + 0], o0[4 * rg + 1]); w0.y = pack2(o0[4 * rg + 2], o0[4 * rg + 3]);
            w1.x = pack2(o1[4 * rg + 0], o1[4 * rg + 1]); w1.y = pack2(o1[4 * rg + 2], o1[4 * rg + 3]);
            *(u32x2*)(og + 8 * rg + 4 * hh) = w0; *(u32x2*)(og + 32 + 8 * rg + 4 * hh) = w1;
        }
        if (hh == 0) p.LSE[rowq * 12 + g * 4 + j] = m + __logf(z);
        __syncthreads();
    }
}

__device__ __forceinline__ void phase_attn_sample(const Params& p, int bid, int nb_, LAS unsigned char* lds) {
    int tid_ = threadIdx.x; asm volatile("" : "+v"(tid_));
    LAS float* s_sc = (LAS float*)lds;
    LAS float* s_o = s_sc + 4 * 132;
    const int wave = tid_ >> 6, lane = tid_ & 63, hd = lane >> 4;
    for (int u = bid; u < NS * 3; u += nb_) {
        const int s = u / 3, g = u % 3, d = 1 << (2 * g), W = 128 << (2 * g);
        const size_t row = (size_t)(NTP + s);
        const float* cache = (g == 0 ? p.cache128 : (g == 1 ? p.cache512 : p.cache2048)) + (size_t)s * W * 512;
        const int nk = wave == 0 ? 17 : 16;
        f32x4 kr[17];
#pragma unroll
        for (int i = 0; i < 17; ++i) {
            const int k = wave + 8 * i;
            if (i < nk) {
                if (k == 0) { const u32x2 w = *(const u32x2*)(p.QKVA + row * 2304 + 768 + g * 256 + 4 * lane); kr[i] = (f32x4){bflo(w.x), bfhi(w.x), bflo(w.y), bfhi(w.y)}; }
                else kr[i] = *(const f32x4*)(cache + ((size_t)(W - k * d) * 2 + 0) * 256 + 4 * lane);
            } else kr[i] = (f32x4){0.f, 0.f, 0.f, 0.f};
        }
        const u32x2 qw = *(const u32x2*)(p.QKVA + row * 2304 + g * 256 + 4 * lane);
        const f32x4 q4 = {bflo(qw.x), bfhi(qw.x), bflo(qw.y), bfhi(qw.y)};
        const float slope = alibi_slope(g, hd);
#pragma unroll
        for (int i = 0; i < 17; ++i) {
            const int k = wave + 8 * i;
            float dot = kr[i][0] * q4[0] + kr[i][1] * q4[1] + kr[i][2] * q4[2] + kr[i][3] * q4[3];
            dot = dpp_row_sum(dot);
            if (i < nk && (lane & 15) == 0) s_sc[hd * 132 + k] = dot * 0.125f - slope * (float)(k * d);
        }
        f32x4 vr[17];
#pragma unroll
        for (int i = 0; i < 17; ++i) {
            const int k = wave + 8 * i;
            if (i < nk) {
                if (k == 0) { const u32x2 w = *(const u32x2*)(p.QKVA + row * 2304 + 1536 + g * 256 + 4 * lane); vr[i] = (f32x4){bflo(w.x), bfhi(w.x), bflo(w.y), bfhi(w.y)}; }
                else vr[i] = *(const f32x4*)(cache + ((size_t)(W - k * d) * 2 + 1) * 256 + 4 * lane);
            } else vr[i] = (f32x4){0.f, 0.f, 0.f, 0.f};
        }
        __syncthreads();
        if (wave < 4) {
            const int h2 = wave;
            const float a0 = s_sc[h2 * 132 + lane], a1 = s_sc[h2 * 132 + 64 + lane], a2 = lane == 0 ? s_sc[h2 * 132 + 128] : -3.0e38f;
            const float m = wave_max(fmaxf(fmaxf(a0, a1), a2));
            const float e0 = __expf(a0 - m), e1 = __expf(a1 - m), e2 = lane == 0 ? __expf(a2 - m) : 0.f;
            const float z = wave_sum(e0 + e1 + e2), rz = 1.0f / z;
            s_sc[h2 * 132 + lane] = e0 * rz; s_sc[h2 * 132 + 64 + lane] = e1 * rz; if (lane == 0) { s_sc[h2 * 132 + 128] = e2 * rz; p.LSE[row * 12 + g * 4 + h2] = m + __logf(z); }
        }
        __syncthreads();
        f32x4 o = {0.f, 0.f, 0.f, 0.f};
#pragma unroll
        for (int i = 0; i < 17; ++i) { const int k = wave + 8 * i; if (i < nk) o += vr[i] * s_sc[hd * 132 + k]; }
        *(LAS f32x4*)(s_o + wave * 256 + 4 * lane) = o;
        __syncthreads();
        if (tid_ < 256) {
            float t2 = 0.f;
#pragma unroll
            for (int w = 0; w < 8; ++w) t2 += s_o[w * 256 + tid_];
            p.OG[row * 768 + g * 256 + tid_] = f2bf(t2);
        }
        __syncthreads();
    }
}

__device__ __forceinline__ void phase_merge_prep(const Params& p, int bid, int nb) {
    int tid_ = threadIdx.x; asm volatile("" : "+v"(tid_));
    const int wave = tid_ >> 6, lane = tid_ & 63;
    for (int row = bid * 8 + wave; row < NT; row += nb * 8) {
        const size_t R = (size_t)row;
        {
            const int j = lane >> 4;
            const float l0 = p.LSE[R * 12 + j], l1 = p.LSE[R * 12 + 4 + j], l2 = p.LSE[R * 12 + 8 + j];
            const float m = fmaxf(l0, fmaxf(l1, l2));
            float w0 = __expf(l0 - m), w1 = __expf(l1 - m), w2 = __expf(l2 - m);
            const float rs = 1.0f / (w0 + w1 + w2); w0 *= rs; w1 *= rs; w2 *= rs;
            const u32x2 a = *(const u32x2*)(p.OG + R * 768 + 4 * lane), b = *(const u32x2*)(p.OG + R * 768 + 256 + 4 * lane), c = *(const u32x2*)(p.OG + R * 768 + 512 + 4 * lane);
            u32x2 o;
            o.x = pack2(w0 * bflo(a.x) + w1 * bflo(b.x) + w2 * bflo(c.x), w0 * bfhi(a.x) + w1 * bfhi(b.x) + w2 * bfhi(c.x));
            o.y = pack2(w0 * bflo(a.y) + w1 * bflo(b.y) + w2 * bflo(c.y), w0 * bfhi(a.y) + w1 * bfhi(b.y) + w2 * bfhi(c.y));
            *(u32x2*)(p.OA + R * 256 + 4 * lane) = o;
        }
    }
}

template <int MODE> struct EpiGate {
    static constexpr bool PERM = true, AFTER_DRAIN = false;
    bf16_t* O; const bf16_t* G; const bf16_t* ADD; int ld;
    __device__ __forceinline__ void operator()(const pg8::f32x4 (&acc)[2][2][4][2], const pg8::Unit& u, int wr, int wc, int fr, int fq) const {
        const int row0 = u.pm * 256 + wr * 64 + fr, col0 = u.pn * 256 + wc * 32 + 8 * fq;
#pragma unroll
        for (int ai = 0; ai < 2; ++ai) {
            u32x4 gq[8], aq[8];
#pragma unroll
            for (int m = 0; m < 4; ++m)
#pragma unroll
                for (int bj = 0; bj < 2; ++bj) {
                    const size_t o = (size_t)(row0 + ai * 128 + m * 16) * ld + col0 + bj * 128;
                    if (MODE != 2) gq[m * 2 + bj] = *(const u32x4*)(G + o);
                    if (MODE == 1) aq[m * 2 + bj] = *(const u32x4*)(ADD + o);
                }
#pragma unroll
            for (int m = 0; m < 4; ++m)
#pragma unroll
                for (int bj = 0; bj < 2; ++bj) {
                    const size_t o = (size_t)(row0 + ai * 128 + m * 16) * ld + col0 + bj * 128;
                    const pg8::f32x4 v0 = acc[ai][bj][m][0], v1 = acc[ai][bj][m][1];
                    float v[8] = {v0[0], v0[1], v0[2], v0[3], v1[0], v1[1], v1[2], v1[3]};
                    if (MODE != 2) { float gg[8]; unpack8(gq[m * 2 + bj], gg);
#pragma unroll
                        for (int i = 0; i < 8; ++i) v[i] *= sigmoidf_(gg[i]); }
                    if (MODE == 1) { float aa[8]; unpack8(aq[m * 2 + bj], aa);
#pragma unroll
                        for (int i = 0; i < 8; ++i) v[i] += aa[i]; }
                    u32x4 w; w.x = pack2(v[0], v[1]); w.y = pack2(v[2], v[3]); w.z = pack2(v[4], v[5]); w.w = pack2(v[6], v[7]);
                    *(u32x4*)(O + o) = w;
                }
        }
    }
    __device__ __forceinline__ void emit16(int row, int col, const float (&vin)[16]) const {
#pragma unroll
        for (int hf = 0; hf < 2; ++hf) {
            const size_t o = (size_t)row * ld + col + 8 * hf;
            float v[8];
#pragma unroll
            for (int i = 0; i < 8; ++i) v[i] = vin[8 * hf + i];
            if (MODE != 2) { float gg[8]; unpack8(*(const u32x4*)(G + o), gg);
#pragma unroll
                for (int i = 0; i < 8; ++i) v[i] *= sigmoidf_(gg[i]); }
            if (MODE == 1) { float aa[8]; unpack8(*(const u32x4*)(ADD + o), aa);
#pragma unroll
                for (int i = 0; i < 8; ++i) v[i] += aa[i]; }
            u32x4 w; w.x = pack2(v[0], v[1]); w.y = pack2(v[2], v[3]); w.z = pack2(v[4], v[5]); w.w = pack2(v[6], v[7]);
            *(u32x4*)(O + o) = w;
        }
    }
};
struct EpiOut {
    static constexpr bool PERM = false, AFTER_DRAIN = false;
    float* Z1; const float* x_prompt; const float* x_sample; const float* MOD;
    __device__ __forceinline__ void operator()(const pg8::f32x4 (&acc)[2][2][4][2], const pg8::Unit& u, int wr, int wc, int fr, int fq) const {
        const int row0 = u.pm * 256 + wr * 64 + fr, col0 = u.pn * 256 + wc * 32 + 4 * fq;
        const float* g1 = MOD + (size_t)(row0 >> 14) * 6144 + 2048 + col0;
        pg8::f32x4 gv[2][2];
#pragma unroll
        for (int bj = 0; bj < 2; ++bj)
#pragma unroll
            for (int n = 0; n < 2; ++n) gv[bj][n] = *(const pg8::f32x4*)(g1 + bj * 128 + n * 16);
#pragma unroll
        for (int ai = 0; ai < 2; ++ai) {
            pg8::f32x4 xv[4][2][2];
#pragma unroll
            for (int m = 0; m < 4; ++m)
#pragma unroll
                for (int bj = 0; bj < 2; ++bj)
#pragma unroll
                    for (int n = 0; n < 2; ++n) xv[m][bj][n] = *(const pg8::f32x4*)(x_prompt + (size_t)(row0 + ai * 128 + m * 16) * D + col0 + bj * 128 + n * 16);
#pragma unroll
            for (int m = 0; m < 4; ++m)
#pragma unroll
                for (int bj = 0; bj < 2; ++bj)
#pragma unroll
                    for (int n = 0; n < 2; ++n)
                        *(pg8::f32x4*)(Z1 + (size_t)(row0 + ai * 128 + m * 16) * D + col0 + bj * 128 + n * 16) = xv[m][bj][n] * DN_ALPHA + gv[bj][n] * acc[ai][bj][m][n];
        }
    }
    __device__ __forceinline__ void emit16(int row, int col, const float (&v)[16]) const {
        if (row >= NT) return;
        const float* xr = row < NTP ? x_prompt + (size_t)row * D : x_sample + (size_t)(row - NTP) * D;
        const float* g1 = MOD + (size_t)seq_of(row) * 6144 + 2048;
#pragma unroll
        for (int i = 0; i < 4; ++i) {
            const f32x4 xv = *(const f32x4*)(xr + col + 4 * i), gv = *(const f32x4*)(g1 + col + 4 * i);
            *(f32x4*)(Z1 + (size_t)row * D + col + 4 * i) = xv * DN_ALPHA + gv * (f32x4){v[4 * i], v[4 * i + 1], v[4 * i + 2], v[4 * i + 3]};
        }
    }
};

__device__ __forceinline__ size_t qvf_index(int row, int c0) {
    return ((((((size_t)(row >> 5) * 8 + (c0 >> 8)) * 2 + ((c0 >> 7) & 1)) * 8 + ((c0 & 127) >> 4)) * 64) + (((c0 >> 3) & 1) * 32 + (row & 31))) * 8;
}
struct EpiQvf {
    static constexpr bool PERM = true, AFTER_DRAIN = false;
    bf16_t* O;
    __device__ __forceinline__ void operator()(const pg8::f32x4 (&acc)[2][2][4][2], const pg8::Unit& u, int wr, int wc, int fr, int fq) const {
        const int row0 = u.pm * 256 + wr * 64 + fr, col0 = u.pn * 256 + wc * 32 + 8 * fq;
#pragma unroll
        for (int ai = 0; ai < 2; ++ai)
#pragma unroll
            for (int m = 0; m < 4; ++m)
#pragma unroll
                for (int bj = 0; bj < 2; ++bj) {
                    const pg8::f32x4 v0 = acc[ai][bj][m][0], v1 = acc[ai][bj][m][1];
                    u32x4 w; w.x = pack2(v0[0], v0[1]); w.y = pack2(v0[2], v0[3]); w.z = pack2(v1[0], v1[1]); w.w = pack2(v1[2], v1[3]);
                    *(u32x4*)(O + qvf_index(row0 + ai * 128 + m * 16, col0 + bj * 128)) = w;
                }
    }
    __device__ __forceinline__ void emit16(int row, int col, const float (&v)[16]) const {
        u32x4 w0, w1;
        w0.x = pack2(v[0], v[1]); w0.y = pack2(v[2], v[3]); w0.z = pack2(v[4], v[5]); w0.w = pack2(v[6], v[7]);
        w1.x = pack2(v[8], v[9]); w1.y = pack2(v[10], v[11]); w1.z = pack2(v[12], v[13]); w1.w = pack2(v[14], v[15]);
        *(u32x4*)(O + qvf_index(row, col)) = w0; *(u32x4*)(O + qvf_index(row, col + 8)) = w1;
    }
};

__device__ __forceinline__ void phase_ln1(const Params& p, int bid, int nb) {
    int tid_ = threadIdx.x; asm volatile("" : "+v"(tid_));
    const int wave = tid_ >> 6, lane = tid_ & 63;
    float lw[16], lb[16];
    load_row16(p.ln1_w, lane, lw); load_row16(p.ln1_b, lane, lb);
    int row = bid * 8 + wave;
    float nx[16];
    if (row < NT) load_row16(p.Z1 + (size_t)row * D, lane, nx);
    for (; row < NT; row += nb * 8) {
        float v[16];
#pragma unroll
        for (int i = 0; i < 16; ++i) v[i] = nx[i];
        const int nrow = row + nb * 8;
        if (nrow < NT) load_row16(p.Z1 + (size_t)nrow * D, lane, nx);
        const float* mod = p.MOD + (size_t)seq_of(row) * 6144;
        float sh[16], sc[16];
        load_row16(mod + 3072, lane, sh); load_row16(mod + 4096, lane, sc);
        float mean, rstd; row_stats(v, mean, rstd);
        if (lane == 0) { p.LNST[(size_t)row * 2] = mean; p.LNST[(size_t)row * 2 + 1] = rstd; }
#pragma unroll
        for (int i = 0; i < 16; ++i) v[i] = (v[i] - mean) * rstd * lw[i] + lb[i];
        row_stats(v, mean, rstd);
#pragma unroll
        for (int i = 0; i < 16; ++i) v[i] = (v[i] - mean) * rstd * (1.0f + sc[i]) + sh[i];
        store_row16_bf16(p.H + (size_t)row * D, lane, v);
        float am = 0.f;
#pragma unroll
        for (int i = 0; i < 16; ++i) am = fmaxf(am, fabsf(v[i]));
        am = wave_max(am);
        const float inv = am > 0.f ? 448.0f / am : 1.0f;
        u32x4 w8;
#pragma unroll
        for (int i = 0; i < 4; ++i) {
            int d = 0;
            d = __builtin_amdgcn_cvt_pk_fp8_f32(v[4 * i] * inv, v[4 * i + 1] * inv, d, false);
            d = __builtin_amdgcn_cvt_pk_fp8_f32(v[4 * i + 2] * inv, v[4 * i + 3] * inv, d, true);
            w8[i] = (unsigned)d;
        }
        *(u32x2*)(p.H8 + (size_t)row * 1024 + 8 * lane) = (u32x2){w8[0], w8[1]};
        *(u32x2*)(p.H8 + (size_t)row * 1024 + 512 + 8 * lane) = (u32x2){w8[2], w8[3]};
        if (lane == 0) p.HS[row] = am > 0.f ? am * (1.0f / 448.0f) : 1.0f;
    }
}

__device__ __forceinline__ unsigned fkey(float f) { const unsigned u = __float_as_uint(f); return (u & 0x80000000u) ? ~u : (u | 0x80000000u); }
__device__ __forceinline__ float keyf(unsigned k) { return __uint_as_float((k & 0x80000000u) ? (k & 0x7fffffffu) : ~k); }

constexpr int CC_R0 = 128 * 127, CC_R1 = CC_R0 + 128 * 511, CC_ROWS = CC_R1 + 128 * 2047;
constexpr int CC_PER = 2, CC_STEPS = 84;
static_assert(CC_PER * CC_STEPS * 2048 >= CC_ROWS, "copy coverage");
template <int W> __device__ __forceinline__ void cc_addr_w(const float* s, float* d, int i, const float*& src, float*& dst) {
    const int seq = i / (W - 1), rr = i - seq * (W - 1);
    src = s + ((size_t)seq * W + rr + 1) * 512; dst = d + ((size_t)seq * W + rr) * 512;
}
__device__ __forceinline__ bool cc_addr(const Params& p, int row_, const float*& src, float*& dst) {
    const int rowu = __builtin_amdgcn_readfirstlane(row_);
    const bool ok = rowu < CC_ROWS;
    const int row = ok ? rowu : CC_ROWS - 1;
    if (row < CC_R0) cc_addr_w<128>(p.cache128, p.out + OFF_KVS0, row, src, dst);
    else if (row < CC_R1) cc_addr_w<512>(p.cache512, p.out + OFF_KVS1, row - CC_R0, src, dst);
    else cc_addr_w<2048>(p.cache2048, p.out + OFF_KVS2, row - CC_R1, src, dst);
    return ok;
}
struct CacheCopier {
    static constexpr int CAP = CC_PER * CC_STEPS;
    int row0, lane4, knext, kh0, kh1; f32x4 b0[2 * CC_PER], b1[2 * CC_PER];
    __device__ __forceinline__ void init(int bid, int tid) { row0 = __builtin_amdgcn_readfirstlane(bid * 8 + (tid >> 6)); lane4 = (tid & 63) * 4; knext = 0; kh0 = CAP; kh1 = CAP; }
    template <int W> __device__ __forceinline__ void store_part(const Params& p) {
        const int k0 = W ? kh1 : kh0;
#pragma unroll
        for (int j = 0; j < CC_PER; ++j) { const float* s; float* d; if (cc_addr(p, row0 + (k0 + j) * 2048, s, d)) {
            __builtin_nontemporal_store((W ? b1 : b0)[2 * j], (f32x4*)(d + lane4)); __builtin_nontemporal_store((W ? b1 : b0)[2 * j + 1], (f32x4*)(d + 256 + lane4)); } }
    }
    template <int W> __device__ __forceinline__ void load_part(const Params& p) {
        (W ? kh1 : kh0) = knext;
#pragma unroll
        for (int j = 0; j < CC_PER; ++j) { const float* s; float* d; (void)cc_addr(p, row0 + (knext + j) * 2048, s, d);
            (W ? b1 : b0)[2 * j] = __builtin_nontemporal_load((const f32x4*)(s + lane4)); (W ? b1 : b0)[2 * j + 1] = __builtin_nontemporal_load((const f32x4*)(s + 256 + lane4)); }
        knext = knext + CC_PER < CAP ? knext + CC_PER : CAP;
    }
    template <int W> __device__ __forceinline__ void step(const Params& p) { store_part<W>(p); load_part<W>(p); }
    __device__ __forceinline__ void flush(const Params& p) { while (kh0 < CAP || kh1 < CAP) { step<0>(p); step<1>(p); } }
};
constexpr int SK_PITCH = 132;
#define DPP_ROR(v, n) ((unsigned)__builtin_amdgcn_update_dpp(0, (int)(v), 0x120 + (n), 0xf, 0xf, true))
__device__ __forceinline__ unsigned row_max_u32(unsigned v) {
    v = max(v, DPP_ROR(v, 8)); v = max(v, DPP_ROR(v, 4)); v = max(v, DPP_ROR(v, 2)); v = max(v, DPP_ROR(v, 1)); return v;
}
#define CE_DESC(a, b) do { const unsigned hi_ = max(a, b), lo_ = min(a, b); a = hi_; b = lo_; } while (0)
__device__ __forceinline__ void phase_peer_select(const Params& p, int bid, int nb, LAS unsigned char* lds) {
    int tid_ = threadIdx.x; asm volatile("" : "+v"(tid_));
    LAS unsigned* s_key = (LAS unsigned*)lds;
    LAS unsigned* s_top = s_key + 256 * SK_PITCH;
    const int wave = tid_ >> 6, lane = tid_ & 63, r = lane & 31, hh = lane >> 5;
    const int li = tid_ & 15, rowid = tid_ >> 4;
    int cand_i[4], cand_j[4]; bool cand_ok[4];
#pragma unroll
    for (int s = 0; s < 4; ++s) {
        int i = 0, rem = 4 * li + s;
        while (i < 16 && rem >= 16 / (i + 1)) { rem -= 16 / (i + 1); ++i; }
        cand_ok[s] = i < 16; cand_i[s] = i < 16 ? i : 0; cand_j[s] = i < 16 ? rem : 0;
    }
    CacheCopier cc; cc.init(bid, tid_);
    for (int b = bid; b < 256; b += nb) {
        for (int tile = 0; tile < 5; ++tile) {
            const int nvalid = tile < 4 ? 32 : (b < NS ? 1 : 0);
            if (nvalid == 0) break;
            const int row0 = tile < 4 ? b * 128 + tile * 32 : NTP + b;
            for (int hq = 0; hq < 2; ++hq) {
#pragma unroll
                for (int jb = 0; jb < 4; ++jb) {
                    const int job = wave * 4 + jb, hl = job >> 3, half = (job >> 2) & 1, ni = job & 3;
                    const int h = 4 * hq + hl;
                    const int tix = tile < 4 ? b * 4 + tile : (NTP >> 5) + (b >> 5), rsel = tile < 4 ? r : (b & 31);
                    const bf16_t* A = p.QV + ((((size_t)tix * 8 + h) * 2 + half) * 8 * 64 + (hh * 32 + rsel)) * 8;
                    const bf16_t* B = p.KF + ((((size_t)h * 2 + half) * 4 + ni) * 8 * 64 + lane) * 8;
                    if (jb & 1) cc.store_part<1>(p); else cc.store_part<0>(p);
                    bf16x8 af[8], bfr[8];
#pragma unroll
                    for (int ks = 0; ks < 8; ++ks) { af[ks] = ld_frag_g(A + ks * 512); bfr[ks] = ld_frag_g(B + ks * 512); }
                    if (jb & 1) cc.load_part<1>(p); else cc.load_part<0>(p);
                    f32x16 acc = zero16();
#pragma unroll
                    for (int ks = 0; ks < 8; ++ks) acc = mfma32(af[ks], bfr[ks], acc);
                    LAS unsigned* dst = s_key + ((hl * 2 + half) * 32) * SK_PITCH + 32 * ni + r;
                    const unsigned tag = 127u - (unsigned)(32 * ni + r);
#pragma unroll
                    for (int reg = 0; reg < 16; ++reg) dst[crow(reg, hh) * SK_PITCH] = (fkey(acc[reg]) & ~127u) | tag;
                }
                __syncthreads();
                {
                    auto stage1 = [&](int it) {
                        unsigned k[2][8], res[2];
#pragma unroll
                        for (int z = 0; z < 2; ++z) {
                            const int q = (it + 4 * z) * 32 + rowid;
                            const u32x4 ka = *(const LAS u32x4*)(s_key + q * SK_PITCH + 8 * li), kb = *(const LAS u32x4*)(s_key + q * SK_PITCH + 8 * li + 4);
                            k[z][0] = ka.x; k[z][1] = ka.y; k[z][2] = ka.z; k[z][3] = ka.w; k[z][4] = kb.x; k[z][5] = kb.y; k[z][6] = kb.z; k[z][7] = kb.w; res[z] = 0u;
                        }
#pragma unroll
                        for (int z = 0; z < 2; ++z) {
                            CE_DESC(k[z][0], k[z][1]); CE_DESC(k[z][2], k[z][3]); CE_DESC(k[z][4], k[z][5]); CE_DESC(k[z][6], k[z][7]);
                            CE_DESC(k[z][0], k[z][2]); CE_DESC(k[z][1], k[z][3]); CE_DESC(k[z][4], k[z][6]); CE_DESC(k[z][5], k[z][7]);
                            CE_DESC(k[z][1], k[z][2]); CE_DESC(k[z][5], k[z][6]);
                            CE_DESC(k[z][0], k[z][4]); CE_DESC(k[z][1], k[z][5]); CE_DESC(k[z][2], k[z][6]); CE_DESC(k[z][3], k[z][7]);
                            CE_DESC(k[z][2], k[z][4]); CE_DESC(k[z][3], k[z][5]);
                            CE_DESC(k[z][1], k[z][2]); CE_DESC(k[z][3], k[z][4]); CE_DESC(k[z][5], k[z][6]);
                        }
#pragma unroll
                        for (int ps = 0; ps < 16; ++ps) {
#pragma unroll
                            for (int z = 0; z < 2; ++z) {
                                const unsigned mx = row_max_u32(k[z][0]);
                                res[z] = li == ps ? mx : res[z];
                                const bool pop = k[z][0] == mx;
#pragma unroll
                                for (int e = 0; e < 7; ++e) k[z][e] = pop ? k[z][e + 1] : k[z][e];
                                k[z][7] = pop ? 0u : k[z][7];
                            }
                        }
#pragma unroll
                        for (int z = 0; z < 2; ++z) s_top[((it + 4 * z) * 32 + rowid) * 16 + li] = res[z];
                    };
                    for (int it = 0; it < 4; it += 2) { cc.step<0>(p); if (rowid < nvalid) stage1(it); cc.step<1>(p); if (rowid < nvalid) stage1(it + 1); }
                }
                __syncthreads();
                {
                    auto stage2 = [&](int hl0) {
                        unsigned c[2][4], res[2];
#pragma unroll
                        for (int z = 0; z < 2; ++z) {
                            const int hl = hl0 + 2 * z;
                            const LAS unsigned* t1 = s_top + ((hl * 2 + 0) * 32 + rowid) * 16;
                            const LAS unsigned* t2 = s_top + ((hl * 2 + 1) * 32 + rowid) * 16;
#pragma unroll
                            for (int s = 0; s < 4; ++s) {
                                const float v = keyf(t1[cand_i[s]] & ~127u) + keyf(t2[cand_j[s]] & ~127u);
                                c[z][s] = cand_ok[s] ? ((fkey(v) & ~255u) | (255u - (unsigned)(cand_i[s] * 16 + cand_j[s]))) : 0u;
                            }
                            CE_DESC(c[z][0], c[z][1]); CE_DESC(c[z][2], c[z][3]); CE_DESC(c[z][0], c[z][2]); CE_DESC(c[z][1], c[z][3]); CE_DESC(c[z][1], c[z][2]);
                            res[z] = 0u;
                        }
#pragma unroll
                        for (int ps = 0; ps < 16; ++ps) {
#pragma unroll
                            for (int z = 0; z < 2; ++z) {
                                const unsigned mx = row_max_u32(c[z][0]);
                                res[z] = li == ps ? mx : res[z];
                                const bool pop = c[z][0] == mx;
                                c[z][0] = pop ? c[z][1] : c[z][0]; c[z][1] = pop ? c[z][2] : c[z][1]; c[z][2] = pop ? c[z][3] : c[z][2]; c[z][3] = pop ? 0u : c[z][3];
                            }
                        }
#pragma unroll
                        for (int z = 0; z < 2; ++z) {
                            const int hl = hl0 + 2 * z;
                            const LAS unsigned* t1 = s_top + ((hl * 2 + 0) * 32 + rowid) * 16;
                            const LAS unsigned* t2 = s_top + ((hl * 2 + 1) * 32 + rowid) * 16;
                            const int cidx = 255 - (int)(res[z] & 255u), i1 = cidx >> 4, i2 = cidx & 15;
                            const unsigned a1 = t1[i1], a2 = t2[i2];
                            const float sc = keyf(a1 & ~127u) + keyf(a2 & ~127u);
                            float mxs = sc;
                            mxs = fmaxf(mxs, DPP_ROR_F(mxs, 8)); mxs = fmaxf(mxs, DPP_ROR_F(mxs, 4)); mxs = fmaxf(mxs, DPP_ROR_F(mxs, 2)); mxs = fmaxf(mxs, DPP_ROR_F(mxs, 1));
                            const float ex = __expf(sc - mxs);
                            const float gw = ex / dpp_row_sum(ex);
                            const int ei = (127 - (int)(a1 & 127u)) * 128 + (127 - (int)(a2 & 127u));
                            const size_t o = (size_t)(row0 + rowid) * 128 + (4 * hq + hl) * 16 + li;
                            p.EIDX[o] = ei; p.EGW[o] = gw * p.SV[ei];
                        }
                    };
                    cc.step<0>(p); if (rowid < nvalid) stage2(0); cc.step<1>(p); if (rowid < nvalid) stage2(1);
                }
                __syncthreads();
            }
        }
    }
    cc.flush(p);
}

__device__ __forceinline__ float gelu_erf(float x) { return 0.5f * x * (1.0f + erff(x * 0.70710678118654752f)); }
__device__ __forceinline__ float wave_total_from_rows(float v) {
    return (__builtin_bit_cast(float, __builtin_amdgcn_readlane(__builtin_bit_cast(int, v), 0)) + __builtin_bit_cast(float, __builtin_amdgcn_readlane(__builtin_bit_cast(int, v), 16)))
         + (__builtin_bit_cast(float, __builtin_amdgcn_readlane(__builtin_bit_cast(int, v), 32)) + __builtin_bit_cast(float, __builtin_amdgcn_readlane(__builtin_bit_cast(int, v), 48)));
}
__device__ __forceinline__ void fp8x16_to_f32(const u32x4 w, float (&o)[16]) {
#pragma unroll
    for (int i = 0; i < 4; ++i) {
        const v2f_t lo = __builtin_amdgcn_cvt_pk_f32_fp8((int)w[i], false), hi = __builtin_amdgcn_cvt_pk_f32_fp8((int)w[i], true);
        o[4 * i] = lo.x; o[4 * i + 1] = lo.y; o[4 * i + 2] = hi.x; o[4 * i + 3] = hi.y;
    }
}
typedef long i64x2_t __attribute__((ext_vector_type(2)));
typedef int i32x2_t __attribute__((ext_vector_type(2)));
#define UP_PITCH 1040
__device__ __forceinline__ void up_tile_put(const u32x4 (&rows)[16], LAS unsigned char* tile, int lane16) {
#pragma unroll
    for (int q = 0; q < 16; ++q) *(LAS u32x4*)(tile + q * UP_PITCH + lane16) = rows[q];
}
__device__ __forceinline__ float up_tile_dots(LAS unsigned char* tile, const LAS unsigned char* hrow, int pr, int kg16) {
    f32x4 c0 = {0.f, 0.f, 0.f, 0.f}, c1 = c0;
    u32x4 hf[2][2], uf[2][2];
    auto rd = [&](int st, int s) {
#pragma unroll
        for (int i = 0; i < 2; ++i) { hf[s][i] = *(const LAS u32x4*)(hrow + 128 * st + 64 * i + kg16); uf[s][i] = *(const LAS u32x4*)(tile + pr * UP_PITCH + 128 * st + 64 * i + kg16); }
    };
    auto mm = [&](int s) {
#pragma unroll
        for (int i = 0; i < 2; ++i) {
            const i64x2_t a = __builtin_bit_cast(i64x2_t, hf[s][i]), b = __builtin_bit_cast(i64x2_t, uf[s][i]);
            c0 = __builtin_amdgcn_mfma_f32_16x16x32_fp8_fp8(a[0], b[0], c0, 0, 0, 0);
            c1 = __builtin_amdgcn_mfma_f32_16x16x32_fp8_fp8(a[1], b[1], c1, 0, 0, 0);
        }
    };
    rd(0, 0);
#pragma unroll
    for (int st = 0; st < 8; ++st) {
        if (st + 1 < 8) rd(st + 1, (st + 1) & 1);
        __builtin_amdgcn_sched_barrier(0);
        mm(st & 1);
        __builtin_amdgcn_sched_barrier(0);
    }
    return c0[0] + c1[0];
}

__device__ __forceinline__ float up_reduce8(const float (&t8)[8], int lane) {
    float t4[4], t2[2], t1;
    { const bool b = lane & 2;
#pragma unroll
      for (int j = 0; j < 4; ++j) { const float keep = b ? t8[2 * j + 1] : t8[2 * j], send = b ? t8[2 * j] : t8[2 * j + 1]; t4[j] = keep + DPP_ROR_F(send, 2); } }
    { const bool b = lane & 4;
#pragma unroll
      for (int j = 0; j < 2; ++j) { const float keep = b ? t4[2 * j + 1] : t4[2 * j], send = b ? t4[2 * j] : t4[2 * j + 1]; t2[j] = keep + DPP_ROR_F(send, 4); } }
    { const bool b = lane & 8; const float keep = b ? t2[1] : t2[0], send = b ? t2[0] : t2[1]; t1 = keep + DPP_ROR_F(send, 8); }
    t1 += __shfl_xor(t1, 16); t1 += __shfl_xor(t1, 32);
    return t1;
}
template <int V = 0>
__device__ __forceinline__ void phase_peer_upass(const Params& p, int bid, int nb, LAS unsigned char* lds, float* __restrict__ ewout) {
    int tid_ = threadIdx.x; asm volatile("" : "+v"(tid_));
    const int wave = tid_ >> 6, lane = tid_ & 63;
    constexpr int WSTR = 1024 + 2048 + 64;
    LAS int* lst = (LAS int*)(lds + wave * WSTR);
    LAS unsigned char* hb = lds + wave * WSTR + 1024;
    LAS float* hsl = (LAS float*)(lds + wave * WSTR + 3072);
    static_assert(8 * WSTR <= LDS_BYTES - 16, "LDS carve of the expert-activation phase");
    const __amdgpu_buffer_rsrc_t ures = __builtin_amdgcn_make_buffer_rsrc((void*)p.U8, 0, 16384 * 2048, 0x00020000);
    const int lane16 = lane * 16;
    const int rsel = (((lane & 15) >> 2) == (lane >> 4)) ? (lane & 3) : 4;
    unsigned dmask[4];
#pragma unroll
    for (int r = 0; r < 4; ++r) { dmask[r] = rsel == r ? 0xffffffffu : 0u; asm volatile("" : "+v"(dmask[r])); }
    constexpr int TPB = NT / 32;
    static_assert(TPB * 32 == NT, "token ranges");
    struct TokIn { u32x4 h8; int ia, ib; float hs; };
    struct Tok { int t, n, e0, e1, k0, k1; float su0, su1; };
    for (int vb = bid; vb < 256; vb += nb) {
        const int x = vb & 7, t0 = (vb >> 3) * TPB, tend = t0 + TPB;
        {
        auto fetch_tok = [&](int t2, TokIn& ti) {
            t2 = t2 < tend ? t2 : tend - 1;
            const size_t R2 = (size_t)t2;
            ti.h8 = *(const u32x4*)(p.H8 + R2 * 1024 + 16 * lane); ti.hs = p.HS[R2];
            ti.ia = p.EIDX[R2 * 128 + lane]; ti.ib = p.EIDX[R2 * 128 + 64 + lane];
        };
        auto prep = [&](int t, TokIn& in, Tok& o, u32x4 (&buf)[16], int par) {
            const int ia = in.ia, ib = in.ib;
            o.t = t;
            *(LAS u32x4*)(hb + par * 1024 + 16 * lane) = in.h8; hsl[par] = in.hs;
            const bool inA = (ia >> 11) == x, inB = (ib >> 11) == x;
            const unsigned long long mA = __builtin_amdgcn_ballot_w64(inA), mB = __builtin_amdgcn_ballot_w64(inB);
            const int cntA = __builtin_popcountll(mA), n = cntA + __builtin_popcountll(mB);
            const int rankA = (int)__builtin_amdgcn_mbcnt_hi((unsigned)(mA >> 32), __builtin_amdgcn_mbcnt_lo((unsigned)mA, 0u));
            const int rankB = cntA + (int)__builtin_amdgcn_mbcnt_hi((unsigned)(mB >> 32), __builtin_amdgcn_mbcnt_lo((unsigned)mB, 0u));
            LAS int* L = lst;
            if (inA) { L[rankA] = ia; L[128 + rankA] = lane; }
            if (inB) { L[rankB] = ib; L[128 + rankB] = 64 + lane; }
            asm volatile("s_waitcnt lgkmcnt(0)" ::: "memory");
            o.n = n;
            o.e0 = lane < n ? L[lane] : (x << 11); o.e1 = 64 + lane < n ? L[64 + lane] : (x << 11);
            o.k0 = L[128 + lane]; o.k1 = L[192 + lane];
            o.su0 = p.SU[o.e0]; o.su1 = p.SU[o.e1];
#pragma unroll
            for (int q = 0; q < 16; ++q) { const int e = __builtin_amdgcn_readlane(o.e0, q); buf[q] = __builtin_amdgcn_raw_buffer_load_b128(ures, lane16, e << 11, 0); }
            fetch_tok(t + 16, in);
        };
        auto finish = [&](Tok& c, u32x4 (&buf)[16], int par) {
            const u32x4 h8 = *(const LAS u32x4*)(hb + par * 1024 + lane16); const float hs = hsl[par];
            const i64x2_t ha = __builtin_bit_cast(i64x2_t, h8);
            __builtin_amdgcn_sched_barrier(0);
            __builtin_amdgcn_s_waitcnt(0x4F76);
            __builtin_amdgcn_sched_barrier(0);
            float dot0 = 0.f, dot1 = 0.f;
            for (int base = 0; base < 16 || base < c.n; base += 16) {
                const bool more = base + 16 < c.n;
                const int nb16 = base + 16, ev = nb16 < 64 ? c.e0 : c.e1;
                float t8[8];
#pragma unroll
                for (int bq = 0; bq < 4; ++bq) {
                    const int q0 = 4 * bq;
                    if (base + q0 < c.n) {
                        f32x4 acc[4];
#pragma unroll
                        for (int j = 0; j < 4; ++j) { const i64x2_t b = __builtin_bit_cast(i64x2_t, buf[q0 + j]); acc[j] = __builtin_amdgcn_mfma_f32_16x16x32_fp8_fp8(ha[0], b[0], (f32x4){0.f, 0.f, 0.f, 0.f}, 0, 0, 0); }
#pragma unroll
                        for (int j = 0; j < 4; ++j) { const i64x2_t b = __builtin_bit_cast(i64x2_t, buf[q0 + j]); acc[j] = __builtin_amdgcn_mfma_f32_16x16x32_fp8_fp8(ha[1], b[1], acc[j], 0, 0, 0); }
                        float sv[4];
#pragma unroll
                        for (int j = 0; j < 4; ++j) sv[j] = __uint_as_float((__float_as_uint(acc[j][0]) & dmask[0]) | (__float_as_uint(acc[j][1]) & dmask[1]) | (__float_as_uint(acc[j][2]) & dmask[2]) | (__float_as_uint(acc[j][3]) & dmask[3]));
                        const bool b1 = lane & 1;
#pragma unroll
                        for (int j = 0; j < 2; ++j) { const float keep = b1 ? sv[2 * j + 1] : sv[2 * j], send = b1 ? sv[2 * j] : sv[2 * j + 1]; t8[2 * bq + j] = keep + DPP_ROR_F(send, 1); }
                    } else { t8[2 * bq] = 0.f; t8[2 * bq + 1] = 0.f; }
                    if (nb16 + q0 < c.n) {
#pragma unroll
                        for (int j = 0; j < 4; ++j) { const int e = __builtin_amdgcn_readlane(ev, (nb16 & 63) + q0 + j); buf[q0 + j] = __builtin_amdgcn_raw_buffer_load_b128(ures, lane16, e << 11, 0); }
                    }
                }
                const float d = up_reduce8(t8, lane);
                if ((lane >> 4) == ((base >> 4) & 3)) { if (base < 64) dot0 = d; else dot1 = d; }
                if (more) {
                    __builtin_amdgcn_sched_barrier(0);
                    __builtin_amdgcn_s_waitcnt(0x0F70);
                    __builtin_amdgcn_sched_barrier(0);
                }
            }
            const size_t R = (size_t)c.t;
            if (lane < c.n) ewout[R * 128 + c.k0] = gelu_erf(c.su0 * hs * dot0);
            if (64 + lane < c.n) ewout[R * 128 + c.k1] = gelu_erf(c.su1 * hs * dot1);
        };
        TokIn iA, iB; Tok kA, kB; u32x4 bX[16], bY[16];
        fetch_tok(t0 + wave, iA); fetch_tok(t0 + wave + 8, iB);
        prep(t0 + wave, iA, kA, bX, 0);
        for (int t = t0 + wave; t < tend; t += 16) {
            prep(t + 8 < tend ? t + 8 : tend - 1, iB, kB, bY, 1);
            finish(kA, bX, 0);
            prep(t + 16 < tend ? t + 16 : tend - 1, iA, kA, bX, 0);
            finish(kB, bY, 1);
        }
        __builtin_amdgcn_s_waitcnt(0x0F70);
        }
    }
}

__device__ __forceinline__ void phase_peer_gather(const Params& p, int bid, int nb, LAS unsigned char* lds, int skip_ff = 0) {
    int tid_ = threadIdx.x; asm volatile("" : "+v"(tid_));
    const int wave = tid_ >> 6, lane = tid_ & 63;
    LAS float* s_ff = (LAS float*)lds;
    const __amdgpu_buffer_rsrc_t vres = __builtin_amdgcn_make_buffer_rsrc((void*)p.U8, 0, 16384 * 2048, 0x00020000);
    const int lane16v = lane * 16 + 1024;
    const int n_vb = (256 - bid + nb - 1) / nb;
    f32x4 l1w[4], l1b[4], l2w[4], l2b[4];
#pragma unroll
    for (int i = 0; i < 4; ++i) { l1w[i] = *(const f32x4*)(p.ln1_w + 16 * lane + 4 * i); l1b[i] = *(const f32x4*)(p.ln1_b + 16 * lane + 4 * i);
        l2w[i] = *(const f32x4*)(p.ln2_w + 16 * lane + 4 * i); l2b[i] = *(const f32x4*)(p.ln2_b + 16 * lane + 4 * i);
        asm volatile("" : "+v"(l1w[i]), "+v"(l1b[i]), "+v"(l2w[i]), "+v"(l2b[i])); }
    for (int it = 0; it < n_vb * 17; ++it) {
        const int vb = bid + (it / 17) * nb, sub = it % 17;
        const bool coop = sub == 16;
        if (coop && vb >= NS) continue;
        const int row = coop ? NTP + vb : vb * 128 + wave + 8 * sub;
        const int g0 = skip_ff ? 8 : (coop ? wave : 0), g1 = coop ? wave + 1 : 8;
        const size_t R = (size_t)row;
        v2f_t acc2[8];
#pragma unroll
        for (int i = 0; i < 8; ++i) acc2[i] = (v2f_t){0.f, 0.f};
        const int ia = p.EIDX[R * 128 + lane], ib = p.EIDX[R * 128 + 64 + lane];
        const float wa = p.EW[R * 128 + lane] * p.EGW[R * 128 + lane], wb = p.EW[R * 128 + 64 + lane] * p.EGW[R * 128 + 64 + lane];
        f32x4 zr[4];
#pragma unroll
        for (int i = 0; i < 4; ++i) zr[i] = *(const f32x4*)(p.Z1 + R * D + 16 * lane + 4 * i);
        const float mean1 = p.LNST[R * 2], rstd1 = p.LNST[R * 2 + 1];
        for (int grp = g0; grp < g1; ++grp) {
            const int iv = grp < 4 ? ia : ib; const float wv = grp < 4 ? wa : wb;
            const int l0 = (grp & 3) * 16;
            u32x4 vb16[16];
#pragma unroll
            for (int q = 0; q < 16; ++q) { const int e = __builtin_amdgcn_readlane(iv, l0 + q); vb16[q] = __builtin_amdgcn_raw_buffer_load_b128(vres, lane16v, e << 11, 0); }
#pragma unroll
            for (int q = 0; q < 16; ++q) {
                const float w = __builtin_bit_cast(float, __builtin_amdgcn_readlane(__builtin_bit_cast(int, wv), l0 + q));
                const v2f_t w2 = {w, w};
#pragma unroll
                for (int i = 0; i < 4; ++i) {
                    const v2f_t lo = __builtin_amdgcn_cvt_pk_f32_fp8((int)vb16[q][i], false), hi = __builtin_amdgcn_cvt_pk_f32_fp8((int)vb16[q][i], true);
                    acc2[2 * i] += w2 * lo; acc2[2 * i + 1] += w2 * hi;
                }
            }
        }
        float acc[16];
#pragma unroll
        for (int i = 0; i < 8; ++i) { acc[2 * i] = acc2[i].x; acc[2 * i + 1] = acc2[i].y; }
        if (coop) {
#pragma unroll
            for (int i = 0; i < 4; ++i) *(LAS f32x4*)(s_ff + wave * 1024 + 16 * lane + 4 * i) = (f32x4){acc[4 * i], acc[4 * i + 1], acc[4 * i + 2], acc[4 * i + 3]};
            __syncthreads();
            if (wave == 0) {
#pragma unroll
                for (int i = 0; i < 16; ++i) acc[i] = 0.f;
#pragma unroll
                for (int w = 0; w < 8; ++w)
#pragma unroll
                    for (int i = 0; i < 4; ++i) { const f32x4 t = *(const LAS f32x4*)(s_ff + w * 1024 + 16 * lane + 4 * i); acc[4 * i] += t[0]; acc[4 * i + 1] += t[1]; acc[4 * i + 2] += t[2]; acc[4 * i + 3] += t[3]; }
            }
        }
        if (!coop || wave == 0) {
            float x1[16], g2[16];
            const float* gr = p.MOD + (size_t)seq_of(row) * 6144 + 5120 + 16 * lane;
#pragma unroll
            for (int i = 0; i < 4; ++i) { const f32x4 a = zr[i], b = *(const f32x4*)(gr + 4 * i);
                const f32x4 lw = l1w[i], lb = l1b[i];
#pragma unroll
                for (int j = 0; j < 4; ++j) { x1[4 * i + j] = (a[j] - mean1) * rstd1 * lw[j] + lb[j]; g2[4 * i + j] = b[j]; } }
#pragma unroll
            for (int i = 0; i < 16; ++i) acc[i] = DN_ALPHA * x1[i] + g2[i] * acc[i];
            float mean, rstd; row_stats(acc, mean, rstd);
            float* yo = (row < NTP ? p.out + OFF_YP + R * D : p.out + OFF_YS + (size_t)(row - NTP) * D) + 16 * lane;
#pragma unroll
            for (int i = 0; i < 4; ++i) { const f32x4 w = l2w[i], b = l2b[i];
                f32x4 o;
#pragma unroll
                for (int j = 0; j < 4; ++j) o[j] = (acc[4 * i + j] - mean) * rstd * w[j] + b[j];
                *(f32x4*)(yo + 4 * i) = o; }
        }
        if (coop) __syncthreads();
    }
}

__device__ __forceinline__ void phase_z1_bypass(const Params& p, int bid, int nb) {
    int tid_ = threadIdx.x; asm volatile("" : "+v"(tid_));
    const int wave = tid_ >> 6, lane = tid_ & 63;
    for (int row = bid * 8 + wave; row < NT; row += nb * 8) {
        float v[16]; load_row16(x_row(p, row), lane, v);
#pragma unroll
        for (int i = 0; i < 16; ++i) v[i] *= DN_ALPHA;
        store_row16_f32(p.Z1 + (size_t)row * D, lane, v);
    }
}

#define DYN_LDS extern __shared__ __attribute__((aligned(16))) unsigned char shm_[]; LAS unsigned char* lds = (LAS unsigned char*)shm_;
template <class Epi> __device__ __forceinline__ void run_gemm(LAS unsigned char* lds, const bf16_t* A, const bf16_t* Bt, int M, int N, int K, const Epi& E) {
    int Ko = K; asm volatile("" : "+s"(Ko));
    pg8::StaticOrder S; S.init(M, N, (int)gridDim.x, (int)blockIdx.x);
    pg8::Gemm g{A, Bt, M, N, Ko};
    pg8::gemm_phase<Epi, pg8::StaticOrder, false>(lds, g, S, E, nullptr);
    __syncthreads();
}

template <class Epi> __device__ __forceinline__ void skinny_gemm(const bf16_t* __restrict__ A, const bf16_t* __restrict__ Bt, int N, int K, const Epi& E, int ushift) {
    int tid_ = threadIdx.x; asm volatile("" : "+v"(tid_));
    const int wave = tid_ >> 6, lane = tid_ & 63, r = lane & 31, hh = lane >> 5, rt = wave & 3, ct = wave >> 2;
    const int nb = (int)gridDim.x, vb = ((int)blockIdx.x + nb - (ushift % nb)) % nb;
    const int perm = 16 * ((r >> 2) & 1) + 4 * (r >> 3) + (r & 3);
    for (int u = vb; u < N / 64; u += nb) {
        int arow = NTP + 32 * rt + r; asm volatile("" : "+v"(arow));
        const bf16_t* ap = A + (size_t)arow * K + 8 * hh;
        const bf16_t* bp = Bt + (size_t)(u * 64 + 32 * ct + perm) * K + 8 * hh;
        f32x16 acc = zero16();
        for (int k0 = 0; k0 < K / 16; k0 += 8) {
            bf16x8 wa[8], xa[8];
#pragma unroll
            for (int i = 0; i < 8; ++i) { wa[i] = ld_frag_g(bp + 16 * (k0 + i)); xa[i] = ld_frag_g(ap + 16 * (k0 + i)); }
            __builtin_amdgcn_sched_barrier(0);
#pragma unroll
            for (int i = 0; i < 8; ++i) acc = mfma32(wa[i], xa[i], acc);
            __builtin_amdgcn_sched_barrier(0);
        }
        float v[16];
#pragma unroll
        for (int i = 0; i < 16; ++i) v[i] = acc[i];
        E.emit16(NTP + 32 * rt + r, u * 64 + 32 * ct + 16 * hh, v);
    }
}
__global__ void __launch_bounds__(NTHREADS, 2) k_mega(Params p) {
    DYN_LDS;
    volatile LAS unsigned* st = (volatile LAS unsigned*)(lds + LDS_BYTES - 16);
    if (threadIdx.x == 0) { st[0] = 0u; st[1] = 0u; st[2] = 0u; st[3] = 0u; }
    __syncthreads();
    const XcdBarrier bar = xcd_barrier_post(p.bar, st);
    const int bid = blockIdx.x, nb = gridDim.x;
    phase_prologue<0>(p, bid, nb, lds, 0);
    xcd_barrier(bar);
    run_gemm(lds, p.SC, p.WADA_T, 256, 6144, 1024, pg8::EpiF32{p.MOD, 6144, p.b_ada});
    phase_prologue<1>(p, bid, nb, lds, nb > 48 ? 24 : 0);
    xcd_barrier(bar);
    phase_lnmod1(p, bid, nb);
    xcd_barrier(bar);
    { const EpiProj E{p.QKVA, p.QKB, p.VBB, p.RB, p.GA, p.GB, p.GLR, p.out}; run_gemm(lds, p.H, p.WIN_T, NTP, NPROJ, 1024, E); skinny_gemm(p.H, p.WIN_T, NPROJ, 1024, E, 0); }
    xcd_barrier(bar);
    phase_gla2_passA(p, bid, nb, lds);
    phase_attn_prompt(p, bid, nb, lds);
    phase_attn_sample(p, bid, nb, lds);
    phase_gla_sample(p, bid, nb, lds);
    xcd_barrier(bar);
    phase_gla2_scan(p, bid, nb);
    phase_merge_prep(p, bid, nb);
    xcd_barrier(bar);
    phase_gla2_passC(p, bid, nb, lds);
    xcd_barrier(bar);
    { const EpiGate<0> E{p.TMP1, p.GA, nullptr, 1024}; run_gemm(lds, p.OA, p.WBRA_T, NTP, 1024, 256, E); skinny_gemm(p.OA, p.WBRA_T, 1024, 256, E, 0); }
    { const EpiGate<1> E{p.MERGED, p.GB, p.TMP1, 1024}; run_gemm(lds, p.OB, p.WBRB_T, NTP, 1024, 1024, E); skinny_gemm(p.OB, p.WBRB_T, 1024, 1024, E, 0); }
    xcd_barrier(bar);
    { const EpiOut E{p.Z1, p.x_prompt, p.x_sample, p.MOD}; run_gemm(lds, p.MERGED, p.WOUT_T, NTP, 1024, 1024, E); skinny_gemm(p.MERGED, p.WOUT_T, 1024, 1024, E, 128); }
    xcd_barrier(bar);
    phase_ln1(p, bid, nb);
    xcd_barrier(bar);
    { const EpiQvf E{p.QV}; run_gemm(lds, p.H, p.WPQ_T, NTP, 2048, 1024, E); skinny_gemm(p.H, p.WPQ_T, 2048, 1024, E, 192); }
    xcd_barrier(bar);
    phase_peer_select(p, bid, nb, lds);
    xcd_barrier(bar);
    phase_peer_upass<0>(p, bid, nb, lds, p.EW);
#ifdef UP_PROBE
    xcd_barrier(bar);
    phase_peer_upass<UP_PROBE>(p, bid, nb, lds, (float*)p.TMP1);
#endif
    xcd_barrier(bar);
    phase_peer_gather(p, bid, nb, lds);
}

static inline size_t align_up(size_t v, size_t a) { return (v + a - 1) / a * a; }

extern "C" void kernel_launch(void* const* d_in, const int* in_sizes, int n_in, void* d_out, int out_size, void* d_ws, size_t ws_size, hipStream_t stream) {
    (void)in_sizes; (void)n_in; (void)out_size;
    Params p; memset(&p, 0, sizeof(p));
    const float* const* in = (const float* const*)d_in;
    p.x_prompt = in[0]; p.x_sample = in[1]; p.c_prompt = in[2]; p.c_sample = in[3]; p.cache128 = in[4]; p.cache512 = in[5]; p.cache2048 = in[6]; p.state_gla = in[7];
    p.w_ada = in[8]; p.b_ada = in[9]; p.w_in = in[10]; p.w_gla_up = in[11]; p.b_gla = in[12]; p.gla_norm_w = in[13]; p.w_br_a = in[14]; p.w_br_b = in[15]; p.w_out = in[16];
    p.ln1_w = in[17]; p.ln1_b = in[18]; p.w_pq = in[19]; p.peer_k1 = in[20]; p.peer_k2 = in[21]; p.peer_u = in[22]; p.peer_v = in[23]; p.ln2_w = in[24]; p.ln2_b = in[25];
    p.out = (float*)d_out;
    size_t off = 0; char* ws = (char*)d_ws;
#define CARVE(field, type, count) do { p.field = (type*)(ws + off); off = align_up(off + (size_t)(count) * sizeof(type), 256); } while (0)
    CARVE(bar, unsigned, 4096);
    CARVE(MOD, float, 256 * 6144); CARVE(SC, bf16_t, 256 * 1024); CARVE(WADA_T, bf16_t, 6144 * 1024); CARVE(WIN_T, bf16_t, (size_t)NPROJ * 1024);
    CARVE(WBRA_T, bf16_t, 1024 * 256); CARVE(WBRB_T, bf16_t, 1024 * 1024); CARVE(WOUT_T, bf16_t, 1024 * 1024); CARVE(WPQ_T, bf16_t, 2048 * 1024);
    CARVE(KF, bf16_t, 2 * 8 * 128 * 128); CARVE(U8, unsigned char, (size_t)16384 * 2048); p.V8 = p.U8 + 1024; CARVE(SU, float, 16384); CARVE(SV, float, 16384);
    CARVE(H, bf16_t, (size_t)MP * 1024); CARVE(QKVA, bf16_t, (size_t)MP * 2304); CARVE(QKB, bf16_t, (size_t)MP * 1024); CARVE(VBB, bf16_t, (size_t)MP * 1024);
    CARVE(RB, bf16_t, (size_t)MP * 1024); CARVE(GA, bf16_t, (size_t)MP * 1024); CARVE(GB, bf16_t, (size_t)MP * 1024); CARVE(GLR, float, (size_t)MP * 16);
    CARVE(OG, bf16_t, (size_t)MP * 768); CARVE(LSE, float, (size_t)MP * 12);
    CARVE(LSEG, float, (size_t)256 * 32768); CARVE(SSEG, float, (size_t)256 * 32768); CARVE(DSEG, float, (size_t)256 * 128); CARVE(OGLA, bf16_t, (size_t)MP * 1024);
    CARVE(OA, bf16_t, (size_t)MP * 256); CARVE(OB, bf16_t, (size_t)MP * 1024); CARVE(TMP1, bf16_t, (size_t)MP * 1024); CARVE(MERGED, bf16_t, (size_t)MP * 1024);
    CARVE(Z1, float, (size_t)MP * 1024); CARVE(LNST, float, (size_t)MP * 2); CARVE(QV, bf16_t, (size_t)MP * 2048); CARVE(EIDX, int, (size_t)MP * 128); CARVE(EGW, float, (size_t)MP * 128); CARVE(ESU, float, (size_t)MP * 128); CARVE(EW, float, (size_t)MP * 128); CARVE(H8, unsigned char, (size_t)MP * 1024); CARVE(HS, float, (size_t)MP);
    if (off > ws_size) { fprintf(stderr, "kernel_launch: workspace too small: need %zu, have %zu\n", off, ws_size); return; }

    static int grid = 0;
    if (!grid) {
        int dev = 0, cus = 0; (void)hipGetDevice(&dev); (void)hipDeviceGetAttribute(&cus, hipDeviceAttributeMultiprocessorCount, dev);
        grid = cus > 0 ? cus : 256;
        (void)hipFuncSetAttribute((const void*)k_mega, hipFuncAttributeMaxDynamicSharedMemorySize, LDS_BYTES);
        int per_cu = 0;
        if (hipOccupancyMaxActiveBlocksPerMultiprocessor(&per_cu, (const void*)k_mega, NTHREADS, LDS_BYTES) != hipSuccess || per_cu < 1)
            fprintf(stderr, "kernel_launch: occupancy query reports %d workgroups per CU for the persistent kernel\n", per_cu);
    }
    (void)hipMemsetAsync(p.bar, 0, 4096 * sizeof(unsigned), stream);
    hipLaunchKernelGGL(k_mega, dim3(grid), dim3(NTHREADS), LDS_BYTES, stream, p);
}
```

```cpp
#include <hip/hip_runtime.h>
#include <stdint.h>
#include <stdio.h>
#include <string.h>
#include <type_traits>
namespace pg8 {
#define PG8_LAS __attribute__((address_space(3)))
typedef unsigned short bf16_t;
typedef short bf16x8 __attribute__((ext_vector_type(8)));
typedef float f32x4 __attribute__((ext_vector_type(4)));
typedef unsigned u32x4 __attribute__((ext_vector_type(4)));
constexpr int BM = 256, BK = 64, HALF = 128, HTB = HALF * BK * 2  , STAGE_BYTES = 8 * HTB, NXCD = 8, WGM = 8;

__host__ __device__ __forceinline__ int lds_byte(int r, int c) { const int st = (r >> 4) * 2 + (c >> 5), rr = r & 15, cc = c & 31, ob = rr * 64 + cc * 2; return st * 1024 + (ob ^ (((ob >> 9) & 1) << 5)); }
__host__ __device__ __forceinline__ void stage_rc(int b, int& R, int& C) { const int st = b / 1024, sb = b % 1024, swz = sb ^ (((sb >> 9) & 1) << 5); R = (st >> 1) * 16 + swz / 64; C = (st & 1) * 32 + (swz % 64) / 2; }
__host__ __device__ __forceinline__ int perm32(int rho) { const int n = rho >> 4, i = rho & 15; return 8 * (i >> 2) + 4 * n + (i & 3); }

struct Unit { int pm, pn; };
struct Gemm { const bf16_t* A; const bf16_t* Bt; int M, N, K; };

struct StaticOrder {
    int nM, nN, nwg, G, c;
    __host__ __device__ void init(int M, int N, int G_, int c_) { nM = M / BM; nN = N / BM; nwg = nM * nN; G = G_; c = c_; }
    __host__ __device__ bool next(int i, Unit& u) const {
        const long L = (long)i * G + c; if (L >= nwg) return false;
        int wgid = (int)L; { const int q = nwg / NXCD, r = nwg % NXCD, xcd = wgid % NXCD, off = wgid / NXCD; wgid = (xcd < r ? xcd * (q + 1) : r * (q + 1) + (xcd - r) * q) + off; }
        const int nig = WGM * nN, gid = wgid / nig, fm = gid * WGM, gsz = (nM - fm) < WGM ? (nM - fm) : WGM;
        u.pm = fm + ((wgid % nig) % gsz); u.pn = (wgid % nig) / gsz; return true;
    }
    __device__ __forceinline__ void a_ready(const Unit&) const {}
    __device__ __forceinline__ void done(const Unit&) const {}
};
__device__ __forceinline__ unsigned cvt_pk_bf16(float lo, float hi) { unsigned r; asm volatile("v_cvt_pk_bf16_f32 %0, %1, %2" : "=v"(r) : "v"(lo), "v"(hi)); return r; }
typedef float f32x2 __attribute__((ext_vector_type(2)));
struct EpiF32 {
    static constexpr bool PERM = false, AFTER_DRAIN = false;
    float* C; int ldc; const float* bias;
    __device__ __forceinline__ void operator()(const f32x4 (&acc)[2][2][4][2], const Unit& u, int wr, int wc, int fr, int fq) const {
        const int row0 = u.pm * BM + wr * 64 + fr, col0 = u.pn * BM + wc * 32 + 4 * fq;
        f32x4 bv[2][2];
#pragma unroll
        for (int bj = 0; bj < 2; ++bj)
#pragma unroll
            for (int n = 0; n < 2; ++n) bv[bj][n] = bias ? *(const f32x4*)(bias + col0 + bj * HALF + n * 16) : (f32x4){0.f, 0.f, 0.f, 0.f};
#pragma unroll
        for (int ai = 0; ai < 2; ++ai)
#pragma unroll
            for (int m = 0; m < 4; ++m) { float* rowp = C + (size_t)(row0 + ai * HALF + m * 16) * ldc + col0;
#pragma unroll
                for (int bj = 0; bj < 2; ++bj)
#pragma unroll
                    for (int n = 0; n < 2; ++n) *(f32x4*)(rowp + bj * HALF + n * 16) = acc[ai][bj][m][n] + bv[bj][n]; }
    }
};
template <class Epi, class Sched, bool STAMP = false>
__device__ __forceinline__ void gemm_phase(PG8_LAS unsigned char* lds, const Gemm g, const Sched& S, const Epi& E, unsigned long long* stamps) {
    int tid_o = threadIdx.x; asm volatile("" : "+v"(tid_o));
    const int tid = tid_o, wid = __builtin_amdgcn_readfirstlane(tid >> 6), lane = tid & 63, wr = wid >> 2, wc = wid & 3, fr = lane & 15, fq = lane >> 4;
    const int K = g.K, nt = K / BK;
    int ts_lo = 0, ts_hi = 0, nts = 0; const unsigned long long rt_entry = STAMP ? (unsigned long long)wall_clock64() : 0ull;
#define PG8_STAMP() do { if (STAMP && wid == 0 && nts < 64) { const unsigned long long _c = (unsigned long long)clock64(); \
        ts_lo = (lane == nts) ? (int)(unsigned)_c : ts_lo; ts_hi = (lane == nts) ? (int)(unsigned)(_c >> 32) : ts_hi; ++nts; } } while (0)
    PG8_STAMP();
    unsigned voffA[2], voffB[2];
#pragma unroll
    for (int i = 0; i < 2; ++i) { int R, C; stage_rc(tid * 16 + i * 8192, R, C); const int Rb = Epi::PERM ? ((R & ~31) + perm32(R & 31)) : R;
        voffA[i] = (unsigned)(R * K + C) * 2u; voffB[i] = (unsigned)(Rb * K + C) * 2u; }
    const size_t kstep = (size_t)(BK * 2);
    const size_t hstep = (size_t)HALF * K * 2;
    const size_t tstep = 2 * hstep;
    const unsigned ldsw = (unsigned)wid * 1024u;
    const int aoff = lds_byte(wr * 64 + fr, fq * 8), boff = lds_byte(wc * 32 + fr, fq * 8);
#define PG8_SA(b, h) (((b) * 2 + (h)) * HTB)
#define PG8_SB(b, h) ((4 + (b) * 2 + (h)) * HTB)
#define PG8_STAGE(bufoff, gbase, voff) do { _Pragma("unroll") for (int _i = 0; _i < 2; ++_i) \
        __builtin_amdgcn_global_load_lds((const unsigned*)((const char*)(gbase) + (voff)[_i]), (PG8_LAS unsigned*)(lds + (bufoff) + ldsw + _i * 8192), 16, 0, 0); } while (0)
#define PG8_LDA(dst, b, h) do { _Pragma("unroll") for (int m = 0; m < 4; ++m) _Pragma("unroll") for (int k = 0; k < 2; ++k) dst[m][k] = *(const PG8_LAS bf16x8*)(lds + PG8_SA(b, h) + aoff + m * 2048 + k * 1024); } while (0)
#define PG8_LDB(dst, b, h) do { _Pragma("unroll") for (int n = 0; n < 2; ++n) _Pragma("unroll") for (int k = 0; k < 2; ++k) dst[n][k] = *(const PG8_LAS bf16x8*)(lds + PG8_SB(b, h) + boff + n * 2048 + k * 1024); } while (0)
#define PG8_MMA(ai, bj, At, Bt) do { __builtin_amdgcn_s_setprio(1); _Pragma("unroll") for (int m = 0; m < 4; ++m) _Pragma("unroll") for (int n = 0; n < 2; ++n) _Pragma("unroll") for (int k = 0; k < 2; ++k) \
        acc[ai][bj][m][n] = __builtin_amdgcn_mfma_f32_16x16x32_bf16(Bt[n][k], At[m][k], acc[ai][bj][m][n], 0, 0, 0); __builtin_amdgcn_s_setprio(0); } while (0)
#define PG8_WAIT_V(n) asm volatile("s_waitcnt vmcnt(" #n ")" ::: "memory")
#define PG8_WAIT_L(n) asm volatile("s_waitcnt lgkmcnt(" #n ")" ::: "memory")
#define PG8_BAR __builtin_amdgcn_s_barrier()
#define PG8_SCHED __builtin_amdgcn_sched_barrier(0)
    Unit cur, nxt; int ui = 0;
    if (!S.next(0, cur)) return;
    f32x4 acc[2][2][4][2];
#pragma unroll
    for (int a = 0; a < 2; ++a)
#pragma unroll
        for (int b = 0; b < 2; ++b)
#pragma unroll
            for (int m = 0; m < 4; ++m)
#pragma unroll
                for (int n = 0; n < 2; ++n) acc[a][b][m][n] = (f32x4){0.f, 0.f, 0.f, 0.f};
    bf16x8 At[4][2], B0[2][2], B1[2][2];
    const char* cA = (const char*)g.A + (size_t)cur.pm * tstep; const char* cB = (const char*)g.Bt + (size_t)cur.pn * tstep;
    S.a_ready(cur);
    PG8_STAGE(PG8_SB(0, 0), cB, voffB); PG8_STAGE(PG8_SA(0, 0), cA, voffA); PG8_STAGE(PG8_SB(0, 1), cB + hstep, voffB); PG8_STAGE(PG8_SA(0, 1), cA + hstep, voffA);
    if (wr == 1) PG8_BAR;
    PG8_WAIT_V(4); PG8_BAR;
    PG8_STAGE(PG8_SB(1, 0), cB + kstep, voffB); PG8_STAGE(PG8_SA(1, 0), cA + kstep, voffA); PG8_STAGE(PG8_SB(1, 1), cB + hstep + kstep, voffB);
    PG8_WAIT_V(6); PG8_BAR;
    PG8_STAMP();
    for (;;) {
        const bool has_next = S.next(ui + 1, nxt);
        const char* nA = has_next ? (const char*)g.A + (size_t)nxt.pm * tstep : cA; const char* nB = has_next ? (const char*)g.Bt + (size_t)nxt.pn * tstep : cB;
        for (int t = 0; t < nt; t += 2) {
            const bool last = (t == nt - 2);
            const char* a1 = cA + (size_t)(t + 1) * kstep;
            const char* a2 = last ? nA : cA + (size_t)(t + 2) * kstep; const char* b2 = last ? nB : cB + (size_t)(t + 2) * kstep;
            const char* a3 = a2 + kstep; const char* b3 = b2 + kstep;
            if (last && has_next) S.a_ready(nxt);
            PG8_LDB(B0, 0, 0); PG8_SCHED; PG8_LDA(At, 0, 0); PG8_STAGE(PG8_SA(1, 1), a1 + hstep, voffA);
            PG8_WAIT_L(8); PG8_BAR; PG8_WAIT_L(0); PG8_MMA(0, 0, At, B0); PG8_BAR; PG8_SCHED;
            PG8_LDB(B1, 0, 1); PG8_STAGE(PG8_SB(0, 0), b2, voffB);
            PG8_BAR; PG8_WAIT_L(0); PG8_MMA(0, 1, At, B1); PG8_BAR;
            PG8_LDA(At, 0, 1); PG8_STAGE(PG8_SA(0, 0), a2, voffA);
            PG8_BAR; PG8_WAIT_L(0); PG8_MMA(1, 0, At, B0); PG8_BAR; PG8_SCHED;
            PG8_STAGE(PG8_SB(0, 1), b2 + hstep, voffB);
            PG8_WAIT_V(6); PG8_BAR; PG8_MMA(1, 1, At, B1); PG8_BAR;
            PG8_LDB(B0, 1, 0); PG8_SCHED; PG8_LDA(At, 1, 0); PG8_STAGE(PG8_SA(0, 1), a2 + hstep, voffA);
            PG8_WAIT_L(8); PG8_BAR; PG8_WAIT_L(0); PG8_MMA(0, 0, At, B0); PG8_BAR; PG8_SCHED;
            PG8_LDB(B1, 1, 1); PG8_STAGE(PG8_SB(1, 0), b3, voffB);
            PG8_BAR; PG8_WAIT_L(0); PG8_MMA(0, 1, At, B1); PG8_BAR;
            PG8_LDA(At, 1, 1); PG8_STAGE(PG8_SA(1, 0), a3, voffA);
            PG8_BAR; PG8_WAIT_L(0); PG8_MMA(1, 0, At, B0); PG8_BAR; PG8_SCHED;
            PG8_STAGE(PG8_SB(1, 1), b3 + hstep, voffB);
            PG8_WAIT_V(6); PG8_BAR; PG8_MMA(1, 1, At, B1); PG8_BAR;
        }
        PG8_STAMP();
        if constexpr (!Epi::AFTER_DRAIN) { E(acc, cur, wr, wc, fr, fq); S.done(cur); }
        PG8_STAMP();
        if (!has_next) break;
#pragma unroll
        for (int a = 0; a < 2; ++a)
#pragma unroll
            for (int b = 0; b < 2; ++b)
#pragma unroll
                for (int m = 0; m < 4; ++m)
#pragma unroll
                    for (int n = 0; n < 2; ++n) acc[a][b][m][n] = (f32x4){0.f, 0.f, 0.f, 0.f};
        cur = nxt; cA = nA; cB = nB; ++ui;
    }
    PG8_WAIT_V(0);
    if (wr == 0) PG8_BAR;
    PG8_BAR;
    if constexpr (Epi::AFTER_DRAIN) { E.fused(acc, cur, wr, wc, fr, fq, lds, wid, lane); S.done(cur); }
    PG8_STAMP();
    if (STAMP && wid == 0) { stamps[lane] = lane < nts ? (((unsigned long long)(unsigned)ts_hi << 32) | (unsigned)ts_lo) : 0ull;
        if (lane == 62) stamps[62] = rt_entry; if (lane == 63) stamps[63] = (unsigned long long)wall_clock64(); }
#undef PG8_STAMP
#undef PG8_SA
#undef PG8_SB
#undef PG8_STAGE
#undef PG8_LDA
#undef PG8_LDB
#undef PG8_MMA
#undef PG8_WAIT_V
#undef PG8_WAIT_L
#undef PG8_BAR
#undef PG8_SCHED
}
}

typedef unsigned short bf16_t;
typedef float f32x4 __attribute__((ext_vector_type(4)));
typedef float f32x16 __attribute__((ext_vector_type(16)));
typedef short bf16x8 __attribute__((ext_vector_type(8)));
typedef unsigned u32x4 __attribute__((ext_vector_type(4)));
typedef unsigned u32x2 __attribute__((ext_vector_type(2)));
#define LAS __attribute__((address_space(3)))

constexpr int D = 1024, BP = 2, T = 16384, NTP = BP * T  , NS = 128, NT = NTP + NS  , MP = 33024  ;
constexpr int NPROJ = 7680;
constexpr int NTHREADS = 512;
constexpr int LDS_BYTES = 155648;
constexpr float LN_EPS = 1e-5f;
constexpr float DN_ALPHA = 1.189207115002721f;

constexpr size_t OFF_YP = 0;
constexpr size_t OFF_YS = OFF_YP + (size_t)NTP * D;
constexpr size_t OFF_KVP0 = OFF_YS + (size_t)NS * D;
constexpr size_t OFF_KVP1 = OFF_KVP0 + (size_t)BP * 128 * 512;
constexpr size_t OFF_KVP2 = OFF_KVP1 + (size_t)BP * 512 * 512;
constexpr size_t OFF_GLAP = OFF_KVP2 + (size_t)BP * 2048 * 512;
constexpr size_t OFF_KVS0 = OFF_GLAP + (size_t)BP * 4 * 128 * 256;
constexpr size_t OFF_KVS1 = OFF_KVS0 + (size_t)NS * 128 * 512;
constexpr size_t OFF_KVS2 = OFF_KVS1 + (size_t)NS * 512 * 512;
constexpr size_t OFF_GLAS = OFF_KVS2 + (size_t)NS * 2048 * 512;
constexpr size_t OUT_TOTAL = OFF_GLAS + (size_t)NS * 4 * 128 * 256;

struct Params {
    const float *x_prompt, *x_sample, *c_prompt, *c_sample, *cache128, *cache512, *cache2048, *state_gla;
    const float *w_ada, *b_ada, *w_in, *w_gla_up, *b_gla, *gla_norm_w, *w_br_a, *w_br_b, *w_out, *ln1_w, *ln1_b;
    const float *w_pq, *peer_k1, *peer_k2, *peer_u, *peer_v, *ln2_w, *ln2_b;
    float* out;
    unsigned* bar;
    float* MOD; bf16_t* SC; bf16_t* WADA_T; bf16_t* WIN_T; bf16_t* WBRA_T; bf16_t* WBRB_T; bf16_t* WOUT_T; bf16_t* WPQ_T;
    bf16_t* KF; unsigned char* U8; unsigned char* V8; float* SU; float* SV;
    bf16_t* H; bf16_t* QKVA; bf16_t* QKB; bf16_t* VBB; bf16_t* RB; bf16_t* GA; bf16_t* GB; float* GLR;
    bf16_t* OG; float* LSE; float* LSEG; float* DSEG; float* SSEG; bf16_t* OGLA;
    bf16_t* OA; bf16_t* OB; bf16_t* TMP1; bf16_t* MERGED; float* Z1; float* LNST; bf16_t* QV; int* EIDX; float* EGW; float* ESU; float* EW; unsigned char* H8; float* HS;
};

__device__ __forceinline__ float bf2f(bf16_t v) { return __uint_as_float(((unsigned)v) << 16); }
__device__ __forceinline__ float bflo(unsigned w) { return __uint_as_float(w << 16); }
__device__ __forceinline__ float bfhi(unsigned w) { return __uint_as_float(w & 0xffff0000u); }
typedef __bf16 v2bf_t __attribute__((ext_vector_type(2)));
typedef float v2f_t __attribute__((ext_vector_type(2)));
__device__ __forceinline__ unsigned pack2(float lo, float hi) { const v2f_t f = {lo, hi}; const v2bf_t b = __builtin_convertvector(f, v2bf_t); return __builtin_bit_cast(unsigned, b); }
__device__ __forceinline__ bf16_t f2bf(float f) { return (bf16_t)(pack2(f, 0.f) & 0xffffu); }
__device__ __forceinline__ void unpack8(const u32x4 w, float (&o)[8]) { o[0] = bflo(w.x); o[1] = bfhi(w.x); o[2] = bflo(w.y); o[3] = bfhi(w.y); o[4] = bflo(w.z); o[5] = bfhi(w.z); o[6] = bflo(w.w); o[7] = bfhi(w.w); }
__device__ __forceinline__ float wave_sum(float v) {
#pragma unroll
    for (int o = 32; o >= 1; o >>= 1) v += __shfl_xor(v, o);
    return v;
}
__device__ __forceinline__ float wave_max(float v) {
#pragma unroll
    for (int o = 32; o >= 1; o >>= 1) v = fmaxf(v, __shfl_xor(v, o));
    return v;
}
#define DPP_ROR_F(v, n) __builtin_bit_cast(float, __builtin_amdgcn_update_dpp(0, __builtin_bit_cast(int, (v)), 0x120 + (n), 0xf, 0xf, true))
__device__ __forceinline__ float dpp_row_sum(float v) {
    v += DPP_ROR_F(v, 8); v += DPP_ROR_F(v, 4); v += DPP_ROR_F(v, 2); v += DPP_ROR_F(v, 1); return v;
}
__device__ __forceinline__ float sigmoidf_(float x) { return __builtin_amdgcn_rcpf(1.0f + __expf(-x)); }
__device__ __forceinline__ float siluf_(float x) { return x * __builtin_amdgcn_rcpf(1.0f + __expf(-x)); }
#define XB_TMO      128
#define XB_XCNT(j)  (256  + 64 * (j))
#define XB_XSUB(j)  (1280 + 64 * (j))
#define XB_XGEN(j)  (2304 + 64 * (j))
#define XB_TOP      3328
#define XB_TOPGEN   3392
#define XCD_BAR_WORDS 3456
#define XB_SPIN_CAP (1u << 22)

__device__ __forceinline__ unsigned xb_ld(unsigned* p)              { return __hip_atomic_load(p, __ATOMIC_RELAXED, __HIP_MEMORY_SCOPE_AGENT); }
__device__ __forceinline__ unsigned xb_add(unsigned* p, unsigned v) { return __hip_atomic_fetch_add(p, v, __ATOMIC_RELAXED, __HIP_MEMORY_SCOPE_AGENT); }
__device__ __forceinline__ unsigned xb_xcc_id() { return (unsigned)__builtin_amdgcn_s_getreg((3 << 11) | 20) & 0xFu; }
#define XB_SPIN(cond, bar) do { unsigned _sp = 0; while (cond) { __builtin_amdgcn_s_sleep(1); \
    if ((++_sp & 255u) == 0u) { if (xb_ld(&(bar)[XB_TMO])) break; if (_sp > XB_SPIN_CAP) { atomicAdd(&(bar)[XB_TMO], 1u); break; } } } } while (0)

struct XcdBarrier {
    unsigned* bar; unsigned x;
    volatile LAS unsigned* st;
};

__device__ __forceinline__ XcdBarrier xcd_barrier_post(unsigned* bar, volatile LAS unsigned* st) {
    XcdBarrier b; b.bar = bar; b.x = xb_xcc_id(); b.st = st;
    if (threadIdx.x == 0) (void)xb_add(&bar[XB_XCNT(b.x)], 1u);
    return b;
}
__device__ __forceinline__ void xcd_barrier_complete(unsigned* bar, unsigned x, unsigned& nloc, unsigned& nx) {
    const unsigned G = gridDim.x * gridDim.y * gridDim.z;
    unsigned sum, cnt, mine, sp = 0u;
    for (;;) {
        sum = 0u; cnt = 0u; mine = 0u;
#pragma unroll
        for (unsigned j = 0; j < 16; ++j) { const unsigned c = xb_ld(&bar[XB_XCNT(j)]); sum += c; cnt += (c > 0u) ? 1u : 0u; mine = (j == x) ? c : mine; }
        if (sum == G) break;
        __builtin_amdgcn_s_sleep(1);
        if ((++sp & 255u) == 0u) { if (xb_ld(&bar[XB_TMO])) break; if (sp > XB_SPIN_CAP) { atomicAdd(&bar[XB_TMO], 1u); break; } }
    }
    nloc = mine > 0u ? mine : 1u; nx = cnt > 0u ? cnt : 1u;
}

__device__ __forceinline__ void xcd_barrier(const XcdBarrier& b) {
    asm volatile("s_waitcnt vmcnt(0)" ::: "memory");
    __syncthreads();
    if (threadIdx.x == 0) {
        unsigned* bar = b.bar;
        __builtin_amdgcn_s_waitcnt(0);
        unsigned nloc = b.st[0], nx = b.st[1];
        if (nloc == 0u) { xcd_barrier_complete(bar, b.x, nloc, nx); b.st[0] = nloc; b.st[1] = nx; }
        const unsigned old = xb_add(&bar[XB_XSUB(b.x)], 1u);
        const unsigned gen = old / nloc;
        if (old + 1u == (gen + 1u) * nloc) {
            __builtin_amdgcn_fence(__ATOMIC_RELEASE, "agent");
            asm volatile("s_waitcnt vmcnt(0)" ::: "memory");
            const unsigned og = xb_add(&bar[XB_TOP], 1u);
            const unsigned tg = og / nx;
            if (og + 1u == (tg + 1u) * nx) xb_add(&bar[XB_TOPGEN], 1u);
            else XB_SPIN(xb_ld(&bar[XB_TOPGEN]) == tg, bar);
            __builtin_amdgcn_fence(__ATOMIC_ACQUIRE, "agent");
            xb_add(&bar[XB_XGEN(b.x)], 1u);
            asm volatile("s_waitcnt vmcnt(0)" ::: "memory");
        } else {
            XB_SPIN(xb_ld(&bar[XB_XGEN(b.x)]) == gen, bar);
            __builtin_amdgcn_fence(__ATOMIC_ACQUIRE, "agent");
            asm volatile("s_waitcnt vmcnt(0)" ::: "memory");
        }
    }
    __syncthreads();
}

__device__ __forceinline__ int win_cmap(int n) {
    if (n < 5376) return n;
    if (n < 6400) return n + 16;
    if (n < 7424) return n + 16;
    if (n < 7440) return n - 7424 + 5376;
    return -1;
}
__device__ __forceinline__ void tconv_tile(const float* __restrict__ src, int ldsrc, int K, bf16_t* __restrict__ dst, int tk, int tn, bool win, LAS float* tile) {
    int tid_ = threadIdx.x; asm volatile("" : "+v"(tid_));
    const int nl = tid_ & 63, kl0 = tid_ >> 6;
    const int n = tn * 64 + nl;
    const int sc = win ? win_cmap(n) : n;
#pragma unroll
    for (int i = 0; i < 8; ++i) { const int k = kl0 + 8 * i; tile[k * 65 + nl] = sc >= 0 ? src[(size_t)(tk * 64 + k) * ldsrc + sc] : 0.f; }
    __syncthreads();
    const int n2 = tid_ >> 3, kc = (tid_ & 7) * 8;
    u32x4 w;
    w.x = pack2(tile[(kc + 0) * 65 + n2], tile[(kc + 1) * 65 + n2]);
    w.y = pack2(tile[(kc + 2) * 65 + n2], tile[(kc + 3) * 65 + n2]);
    w.z = pack2(tile[(kc + 4) * 65 + n2], tile[(kc + 5) * 65 + n2]);
    w.w = pack2(tile[(kc + 6) * 65 + n2], tile[(kc + 7) * 65 + n2]);
    *(u32x4*)(dst + (size_t)(tn * 64 + n2) * K + tk * 64 + kc) = w;
    __syncthreads();
}
__device__ __forceinline__ void conv_chunk(const float* __restrict__ src, bf16_t* __restrict__ dst, size_t chunk) {
    int tid_ = threadIdx.x; asm volatile("" : "+v"(tid_));
    const size_t e = chunk * 4096 + (size_t)tid_ * 8;
    const f32x4 a = *(const f32x4*)(src + e), b = *(const f32x4*)(src + e + 4);
    u32x4 w; w.x = pack2(a[0], a[1]); w.y = pack2(a[2], a[3]); w.z = pack2(b[0], b[1]); w.w = pack2(b[2], b[3]);
    *(u32x4*)(dst + e) = w;
}

__device__ __forceinline__ void quant_rows8(const float* __restrict__ src, unsigned char* __restrict__ dst  , float* __restrict__ scl, int job) {
    int tid_ = threadIdx.x; asm volatile("" : "+v"(tid_));
    const int wave = tid_ >> 6, lane = tid_ & 63;
    const size_t row = (size_t)job * 8 + wave;
    const float* r = src + row * 1024 + 16 * lane;
    f32x4 x[4];
#pragma unroll
    for (int i = 0; i < 4; ++i) x[i] = *(const f32x4*)(r + 4 * i);
    float m = 0.f;
#pragma unroll
    for (int i = 0; i < 4; ++i) m = fmaxf(m, fmaxf(fmaxf(fabsf(x[i][0]), fabsf(x[i][1])), fmaxf(fabsf(x[i][2]), fabsf(x[i][3]))));
    m = wave_max(m);
    const float inv = m > 0.f ? 448.0f / m : 1.0f, sc = m > 0.f ? m * (1.0f / 448.0f) : 1.0f;
    u32x4 w;
#pragma unroll
    for (int i = 0; i < 4; ++i) {
        int d = 0;
        d = __builtin_amdgcn_cvt_pk_fp8_f32(x[i][0] * inv, x[i][1] * inv, d, false);
        d = __builtin_amdgcn_cvt_pk_fp8_f32(x[i][2] * inv, x[i][3] * inv, d, true);
        w[i] = (unsigned)d;
    }
    *(u32x4*)(dst + row * 2048 + 16 * lane) = w;
    if (lane == 0) scl[row] = sc;
}

__device__ __forceinline__ void kfrag_chunk(const float* __restrict__ k1, const float* __restrict__ k2, bf16_t* __restrict__ dst, int job) {
    int tid_ = threadIdx.x; asm volatile("" : "+v"(tid_));
    const int c = job * 512 + tid_, lane = c & 63, ks = (c >> 6) & 7, ni = (c >> 9) & 3, half = (c >> 11) & 1, h = c >> 12;
    const float* s = (half ? k2 : k1) + ((size_t)h * 128 + 32 * ni + (lane & 31)) * 128 + 16 * ks + 8 * (lane >> 5);
    const f32x4 a = *(const f32x4*)s, b = *(const f32x4*)(s + 4);
    u32x4 w; w.x = pack2(a[0], a[1]); w.y = pack2(a[2], a[3]); w.z = pack2(b[0], b[1]); w.w = pack2(b[2], b[3]);
    *(u32x4*)(dst + (size_t)c * 8) = w;
}
template <int STAGE> __device__ __forceinline__ void phase_prologue(const Params& p, int bid, int nb, LAS unsigned char* lds, int skip0) {
    int tid_ = threadIdx.x; asm volatile("" : "+v"(tid_));
    LAS float* tile = (LAS float*)lds;
    constexpr int J0 = 16 * 120, J1 = J0 + 16 * 96, J2 = J1 + 16 * 32, J3 = J2 + 256, J4 = J3 + 256, J5 = J4 + 64, J6 = J5 + 2048, J7 = J6 + 2048, J8 = J7 + 32, J9 = J8 + 32, J10 = J9 + 64;
    (void)J8;
    const int njobs = STAGE == 0 ? J1 + (J10 - J9) : J9 - J1;
    const int first = STAGE == 0 ? bid : bid - skip0, stride = STAGE == 0 ? nb : nb - skip0;
    if (first < 0 || stride <= 0) return;
    for (int jj = first; jj < njobs; jj += stride) {
        const int j = STAGE == 0 ? (jj < J1 ? jj : J9 + (jj - J1)) : J1 + jj;
        if (j < J0) { tconv_tile(p.w_in, 7440, 1024, p.WIN_T, j % 16, j / 16, true, tile); }
        else if (j < J1) { const int q = j - J0; tconv_tile(p.w_ada, 6144, 1024, p.WADA_T, q % 16, q / 16, false, tile); }
        else if (j < J2) { const int q = j - J1; tconv_tile(p.w_pq, 2048, 1024, p.WPQ_T, q % 16, q / 16, false, tile); }
        else if (j < J3) { const int q = j - J2; tconv_tile(p.w_br_b, 1024, 1024, p.WBRB_T, q % 16, q / 16, false, tile); }
        else if (j < J4) { const int q = j - J3; tconv_tile(p.w_out, 1024, 1024, p.WOUT_T, q % 16, q / 16, false, tile); }
        else if (j < J5) { const int q = j - J4; tconv_tile(p.w_br_a, 1024, 256, p.WBRA_T, q % 4, q / 4, false, tile); }
        else if (j < J6) { quant_rows8(p.peer_u, p.U8, p.SU, j - J5); }
        else if (j < J7) { quant_rows8(p.peer_v, p.U8 + 1024, p.SV, j - J6); }
        else if (j < J9) { kfrag_chunk(p.peer_k1, p.peer_k2, p.KF, j - J7); }
        else {
            const size_t e = (size_t)(j - J9) * 4096 + (size_t)tid_ * 8;
            const int row = (int)(e >> 10), col = (int)(e & 1023);
            float v[8];
#pragma unroll
            for (int i = 0; i < 8; ++i) v[i] = 0.f;
            if (row < 130) {
                const float* c = row < 2 ? p.c_prompt + (size_t)row * 1024 + col : p.c_sample + (size_t)(row - 2) * 1024 + col;
#pragma unroll
                for (int i = 0; i < 8; ++i) v[i] = siluf_(c[i]);
            }
            u32x4 w; w.x = pack2(v[0], v[1]); w.y = pack2(v[2], v[3]); w.z = pack2(v[4], v[5]); w.w = pack2(v[6], v[7]);
            *(u32x4*)(p.SC + e) = w;
        }
    }
}

__device__ __forceinline__ void row_stats(const float (&v)[16], float& mean, float& rstd) {
    float s = 0.f;
#pragma unroll
    for (int i = 0; i < 16; ++i) s += v[i];
    s = wave_sum(s);
    mean = s * (1.0f / 1024.0f);
    float q = 0.f;
#pragma unroll
    for (int i = 0; i < 16; ++i) { const float d = v[i] - mean; q += d * d; }
    q = wave_sum(q);
    rstd = rsqrtf(q * (1.0f / 1024.0f) + LN_EPS);
}
__device__ __forceinline__ void load_row16(const float* __restrict__ r, int lane, float (&v)[16]) {
    const f32x4 a = *(const f32x4*)(r + 8 * lane), b = *(const f32x4*)(r + 8 * lane + 4), c = *(const f32x4*)(r + 512 + 8 * lane), d = *(const f32x4*)(r + 512 + 8 * lane + 4);
#pragma unroll
    for (int i = 0; i < 4; ++i) { v[i] = a[i]; v[4 + i] = b[i]; v[8 + i] = c[i]; v[12 + i] = d[i]; }
}
__device__ __forceinline__ void store_row16_bf16(bf16_t* __restrict__ r, int lane, const float (&v)[16]) {
    u32x4 w0, w1;
    w0.x = pack2(v[0], v[1]); w0.y = pack2(v[2], v[3]); w0.z = pack2(v[4], v[5]); w0.w = pack2(v[6], v[7]);
    w1.x = pack2(v[8], v[9]); w1.y = pack2(v[10], v[11]); w1.z = pack2(v[12], v[13]); w1.w = pack2(v[14], v[15]);
    *(u32x4*)(r + 8 * lane) = w0; *(u32x4*)(r + 512 + 8 * lane) = w1;
}
__device__ __forceinline__ void store_row16_f32(float* __restrict__ r, int lane, const float (&v)[16]) {
    *(f32x4*)(r + 8 * lane) = (f32x4){v[0], v[1], v[2], v[3]}; *(f32x4*)(r + 8 * lane + 4) = (f32x4){v[4], v[5], v[6], v[7]};
    *(f32x4*)(r + 512 + 8 * lane) = (f32x4){v[8], v[9], v[10], v[11]}; *(f32x4*)(r + 512 + 8 * lane + 4) = (f32x4){v[12], v[13], v[14], v[15]};
}
__device__ __forceinline__ const float* x_row(const Params& p, int row) { return row < NTP ? p.x_prompt + (size_t)row * D : p.x_sample + (size_t)(row - NTP) * D; }
__device__ __forceinline__ int seq_of(int row) { return row < NTP ? (row >> 14) : 2 + (row - NTP); }

__device__ __forceinline__ void phase_lnmod1(const Params& p, int bid, int nb) {
    int tid_ = threadIdx.x; asm volatile("" : "+v"(tid_));
    const int wave = tid_ >> 6, lane = tid_ & 63;
    int row = bid * 8 + wave;
    float nx[16];
    if (row < NT) load_row16(x_row(p, row), lane, nx);
    for (; row < NT; row += nb * 8) {
        float v[16];
#pragma unroll
        for (int i = 0; i < 16; ++i) v[i] = nx[i];
        const int nrow = row + nb * 8;
        if (nrow < NT) load_row16(x_row(p, nrow), lane, nx);
        const float* mod = p.MOD + (size_t)seq_of(row) * 6144;
        float sh[16], sc[16];
        load_row16(mod, lane, sh); load_row16(mod + 1024, lane, sc);
        float mean, rstd; row_stats(v, mean, rstd);
#pragma unroll
        for (int i = 0; i < 16; ++i) v[i] = (v[i] - mean) * rstd * (1.0f + sc[i]) + sh[i];
        store_row16_bf16(p.H + (size_t)row * D, lane, v);
    }
}

struct EpiProj {
    static constexpr bool PERM = true, AFTER_DRAIN = false;
    bf16_t *QKVA, *QKB, *VBB, *RB, *GA, *GB; float* GLR; float* out;
    __device__ __forceinline__ void operator()(const pg8::f32x4 (&acc)[2][2][4][2], const pg8::Unit& u, int wr, int wc, int fr, int fq) const {
        const int pn = u.pn;
        bf16_t* dst; int ld = 1024, c0; float scale = 1.0f;
        if (pn < 9) { dst = QKVA; ld = 2304; c0 = pn * 256; }
        else if (pn < 13) { dst = QKB; c0 = (pn - 9) * 256; if (pn < 11) scale = 0.08838834764831845f; }
        else if (pn < 17) { dst = VBB; c0 = (pn - 13) * 256; }
        else if (pn < 21) { dst = RB; c0 = (pn - 17) * 256; }
        else if (pn < 25) { dst = GA; c0 = (pn - 21) * 256; }
        else if (pn < 29) { dst = GB; c0 = (pn - 25) * 256; }
        else { dst = nullptr; c0 = 0; }
        const bool kvt = pn >= 3 && pn < 9;
        const int g = kvt ? (pn - 3) % 3 : 0, kv = kvt ? (pn - 3) / 3 : 0;
        const int W = 128 << (2 * g);
        const size_t offp = g == 0 ? OFF_KVP0 : (g == 1 ? OFF_KVP1 : OFF_KVP2);
        const size_t offs = g == 0 ? OFF_KVS0 : (g == 1 ? OFF_KVS1 : OFF_KVS2);
        const int row0 = u.pm * 256 + wr * 64 + fr, colw = wc * 32 + 8 * fq;
#pragma unroll
        for (int ai = 0; ai < 2; ++ai)
#pragma unroll
            for (int m = 0; m < 4; ++m) {
                const int row = row0 + ai * 128 + m * 16;
#pragma unroll
                for (int bj = 0; bj < 2; ++bj) {
                    const int cc = bj * 128 + colw;
                    const pg8::f32x4 v0 = acc[ai][bj][m][0], v1 = acc[ai][bj][m][1];
                    if (dst) {
                        u32x4 w; w.x = pack2(v0[0] * scale, v0[1] * scale); w.y = pack2(v0[2] * scale, v0[3] * scale); w.z = pack2(v1[0] * scale, v1[1] * scale); w.w = pack2(v1[2] * scale, v1[3] * scale);
                        *(u32x4*)(dst + (size_t)row * ld + c0 + cc) = w;
                    } else if (cc < 16) {
                        *(pg8::f32x4*)(GLR + (size_t)row * 16 + cc) = v0; *(pg8::f32x4*)(GLR + (size_t)row * 16 + cc + 4) = v1;
                    }
                    if (kvt) {
                        if (row < NTP) {
                            const int b = row >> 14, t = row & (T - 1);
                            if (t >= T - W) { float* o = out + offp + ((size_t)(b * W + (t - (T - W))) * 2 + kv) * 256 + cc; *(pg8::f32x4*)o = v0; *(pg8::f32x4*)(o + 4) = v1; }
                        } else if (row < NT) {
                            const int s = row - NTP;
                            float* o = out + offs + ((size_t)(s * W + (W - 1)) * 2 + kv) * 256 + cc; *(pg8::f32x4*)o = v0; *(pg8::f32x4*)(o + 4) = v1;
                        }
                    }
                }
            }
    }
    __device__ __forceinline__ void emit16(int row, int col, const float (&v)[16]) const {
        const int pn = col >> 8, cc = col & 255;
        bf16_t* dst; int ld = 1024, c0; float scale = 1.0f;
        if (pn < 9) { dst = QKVA; ld = 2304; c0 = pn * 256; }
        else if (pn < 13) { dst = QKB; c0 = (pn - 9) * 256; if (pn < 11) scale = 0.08838834764831845f; }
        else if (pn < 17) { dst = VBB; c0 = (pn - 13) * 256; }
        else if (pn < 21) { dst = RB; c0 = (pn - 17) * 256; }
        else if (pn < 25) { dst = GA; c0 = (pn - 21) * 256; }
        else if (pn < 29) { dst = GB; c0 = (pn - 25) * 256; }
        else { dst = nullptr; c0 = 0; }
        if (dst) {
            u32x4 w0, w1;
            w0.x = pack2(v[0] * scale, v[1] * scale); w0.y = pack2(v[2] * scale, v[3] * scale); w0.z = pack2(v[4] * scale, v[5] * scale); w0.w = pack2(v[6] * scale, v[7] * scale);
            w1.x = pack2(v[8] * scale, v[9] * scale); w1.y = pack2(v[10] * scale, v[11] * scale); w1.z = pack2(v[12] * scale, v[13] * scale); w1.w = pack2(v[14] * scale, v[15] * scale);
            *(u32x4*)(dst + (size_t)row * ld + c0 + cc) = w0; *(u32x4*)(dst + (size_t)row * ld + c0 + cc + 8) = w1;
        } else if (cc == 0) {
#pragma unroll
            for (int i = 0; i < 4; ++i) *(f32x4*)(GLR + (size_t)row * 16 + 4 * i) = (f32x4){v[4 * i], v[4 * i + 1], v[4 * i + 2], v[4 * i + 3]};
        }
        if (pn >= 3 && pn < 9 && row >= NTP && row < NT) {
            const int g = (pn - 3) % 3, kv = (pn - 3) / 3, W = 128 << (2 * g), s = row - NTP;
            float* o = out + (g == 0 ? OFF_KVS0 : (g == 1 ? OFF_KVS1 : OFF_KVS2)) + ((size_t)(s * W + (W - 1)) * 2 + kv) * 256 + cc;
#pragma unroll
            for (int i = 0; i < 4; ++i) *(f32x4*)(o + 4 * i) = (f32x4){v[4 * i], v[4 * i + 1], v[4 * i + 2], v[4 * i + 3]};
        }
    }
};

__device__ __forceinline__ void phase_cache_copy(const Params& p, int bid, int nb) {
    int tid_ = threadIdx.x; asm volatile("" : "+v"(tid_));
    const size_t tid = (size_t)bid * NTHREADS + tid_, nth = (size_t)nb * NTHREADS;
#pragma unroll
    for (int g = 0; g < 3; ++g) {
        const int W = 128 << (2 * g);
        const float* src = g == 0 ? p.cache128 : (g == 1 ? p.cache512 : p.cache2048);
        float* dst = p.out + (g == 0 ? OFF_KVS0 : (g == 1 ? OFF_KVS1 : OFF_KVS2));
        const size_t per = (size_t)(W - 1) * 128, total = per * NS;
        for (size_t i = tid; i < total; i += nth) {
            const size_t s = i / per, rem = i - s * per;
            const f32x4 v = __builtin_nontemporal_load((const f32x4*)(src + (s * W + 1) * 512) + rem);
            __builtin_nontemporal_store(v, (f32x4*)(dst + s * W * 512) + rem);
        }
    }
}

__device__ __forceinline__ f32x16 mfma32(bf16x8 a, bf16x8 b, f32x16 c) { return __builtin_amdgcn_mfma_f32_32x32x16_bf16(a, b, c, 0, 0, 0); }
__device__ __forceinline__ f32x16 zero16() { f32x16 z; for (int i = 0; i < 16; ++i) z[i] = 0.f; return z; }
__device__ __forceinline__ bf16x8 ld_frag_g(const bf16_t* p) { return *(const bf16x8*)p; }
__device__ __forceinline__ bf16x8 ld_frag_l(const LAS bf16_t* p) { return *(const LAS bf16x8*)p; }
__device__ __forceinline__ int crow(int reg, int hh) { return (reg & 3) + 8 * (reg >> 2) + 4 * hh; }
__device__ __forceinline__ float log_sigmoidf_(float z) { return fminf(z, 0.f) - log1pf(__expf(-fabsf(z))); }

__device__ __forceinline__ void phase_gla_sample(const Params& p, int bid, int nb, LAS unsigned char* lds) {
    int tid_ = threadIdx.x; asm volatile("" : "+v"(tid_));
    LAS float* s_eg = (LAS float*)lds;
    LAS float* s_q = s_eg + 128;
    LAS float* s_k = s_q + 128;
    LAS float* s_o = s_k + 128;
    const int dv4 = tid_ & 63, kg = tid_ >> 6;
    for (int u = bid; u < NS * 4; u += nb) {
        const int s = u >> 2, h = u & 3;
        const size_t row = (size_t)(NTP + s);
        const float* S0 = p.state_gla + ((size_t)s * 4 + h) * 32768 + (size_t)(16 * kg) * 256 + 4 * dv4;
        float* Sn = p.out + OFF_GLAS + ((size_t)s * 4 + h) * 32768 + (size_t)(16 * kg) * 256 + 4 * dv4;
        f32x4 st[16];
#pragma unroll
        for (int i = 0; i < 16; ++i) st[i] = __builtin_nontemporal_load((const f32x4*)(S0 + i * 256));
        if (tid_ < 128) {
            const int kd = tid_; float z = p.b_gla[h * 128 + kd];
#pragma unroll
            for (int j = 0; j < 16; ++j) z += p.GLR[row * 16 + j] * p.w_gla_up[j * 512 + h * 128 + kd];
            s_eg[kd] = __expf(log_sigmoidf_(z) * (1.0f / 16.0f));
            s_q[kd] = bf2f(p.QKB[row * 1024 + h * 128 + kd]);
            s_k[kd] = bf2f(p.QKB[row * 1024 + 512 + h * 128 + kd]);
        }
        const u32x2 vw = *(const u32x2*)(p.VBB + row * 1024 + h * 256 + 4 * dv4);
        const f32x4 v4 = {bflo(vw.x), bfhi(vw.x), bflo(vw.y), bfhi(vw.y)};
        __syncthreads();
        f32x4 o = {0.f, 0.f, 0.f, 0.f};
#pragma unroll
        for (int i = 0; i < 16; ++i) {
            const int kd = 16 * kg + i;
            const f32x4 sv = st[i] * s_eg[kd] + v4 * s_k[kd];
            __builtin_nontemporal_store(sv, (f32x4*)(Sn + i * 256));
            o += sv * s_q[kd];
        }
        *(LAS f32x4*)(s_o + kg * 256 + 4 * dv4) = o;
        __syncthreads();
        float t = 0.f;
        if (tid_ < 256) {
#pragma unroll
            for (int w = 0; w < 8; ++w) t += s_o[w * 256 + tid_];
        }
        const float sq = wave_sum(t * t);
        __syncthreads();
        if ((tid_ & 63) == 0) s_o[tid_ >> 6] = sq;
        __syncthreads();
        if (tid_ < 256) {
            const float rn = rsqrtf((s_o[0] + s_o[1] + s_o[2] + s_o[3]) * (1.0f / 256.0f) + LN_EPS);
            p.OB[row * 1024 + h * 256 + tid_] = f2bf(t * rn * p.gla_norm_w[h * 256 + tid_] * siluf_(bf2f(p.RB[row * 1024 + h * 256 + tid_])));
        }
        __syncthreads();
    }
}

constexpr int G2_QP = 136;
constexpr int G2_TP = 72;
constexpr int G2_VP = 264;
typedef short v4s2_t __attribute__((ext_vector_type(4)));
constexpr int G2_BP = 132;
struct Gla2Lds {
    LAS float* glr; LAS float* tot; LAS float* dl; LAS float* bl; LAS float* bt; LAS bf16_t* qe; LAS bf16_t* ke; LAS bf16_t* kdt; LAS bf16_t* vt; LAS bf16_t* pp; LAS float* ss;
    __device__ __forceinline__ void carve(LAS unsigned char* lds) {
        glr = (LAS float*)lds; tot = glr + 1024; dl = tot + 512; bl = dl + 128; bt = bl + 128;
        qe = (LAS bf16_t*)(bt + 64 * G2_BP); ke = qe + 64 * G2_QP; kdt = ke + 64 * G2_QP; vt = kdt + 64 * G2_QP; pp = vt + 64 * G2_VP; ss = (LAS float*)(pp + 64 * G2_TP);
    }
};
struct Gla2Regs { f32x4 glr; u32x4 v[4], k[2], q[2]; };
__device__ __forceinline__ void gla2_load_chunk(const Params& p, Gla2Regs& R, int tid_, int b, int h, int c, bool need_qk) {
    const size_t row0 = (size_t)b * T + (size_t)c * 64;
    R.glr = *(const f32x4*)(p.GLR + row0 * 16 + (tid_ & 255) * 4);
#pragma unroll
    for (int i = 0; i < 4; ++i) { const int q = tid_ + 512 * i, t = q >> 5, dc = q & 31; R.v[i] = *(const u32x4*)(p.VBB + (row0 + t) * 1024 + h * 256 + dc * 8); }
#pragma unroll
    for (int i = 0; i < 2; ++i) { const int it = tid_ + 512 * i, t = it >> 4, kg = it & 15;
        R.k[i] = *(const u32x4*)(p.QKB + (row0 + t) * 1024 + 512 + h * 128 + kg * 8);
        if (need_qk) R.q[i] = *(const u32x4*)(p.QKB + (row0 + t) * 1024 + h * 128 + kg * 8); }
}
__device__ __forceinline__ float gla2_stage_chunk(const Gla2Lds& L, const Gla2Regs& R, int tid_, const float (&wup)[16], float bg, bool need_qk) {
    const int kd = tid_ >> 2, q4 = tid_ & 3;
    if (tid_ < 256) *(LAS f32x4*)(L.glr + tid_ * 4) = R.glr;
#pragma unroll
    for (int i = 0; i < 4; ++i) { const int q = tid_ + 512 * i, t = q >> 5, dc = q & 31; *(LAS u32x4*)(L.vt + t * G2_VP + dc * 8) = R.v[i]; }
    __syncthreads();
    float pre[16]; float run = 0.f;
#pragma unroll
    for (int i = 0; i < 16; ++i) {
        const int t = q4 * 16 + i; float z = bg;
#pragma unroll
        for (int j4 = 0; j4 < 4; ++j4) { const f32x4 gq = *(const LAS f32x4*)(L.glr + t * 16 + 4 * j4); z += gq[0] * wup[4 * j4] + gq[1] * wup[4 * j4 + 1] + gq[2] * wup[4 * j4 + 2] + gq[3] * wup[4 * j4 + 3]; }
        const float ls = fminf(z, 0.f) - __logf(1.0f + __expf(-fabsf(z)));
        run += ls * (1.0f / 16.0f); pre[i] = run;
    }
    const float t0 = __builtin_bit_cast(float, __builtin_amdgcn_update_dpp(0, __builtin_bit_cast(int, run), 0x00, 0xf, 0xf, true));
    const float t1 = __builtin_bit_cast(float, __builtin_amdgcn_update_dpp(0, __builtin_bit_cast(int, run), 0x55, 0xf, 0xf, true));
    const float t2 = __builtin_bit_cast(float, __builtin_amdgcn_update_dpp(0, __builtin_bit_cast(int, run), 0xaa, 0xf, 0xf, true));
    const float t3 = __builtin_bit_cast(float, __builtin_amdgcn_update_dpp(0, __builtin_bit_cast(int, run), 0xff, 0xf, 0xf, true));
    const float offs = (q4 > 0 ? t0 : 0.f) + (q4 > 1 ? t1 : 0.f) + (q4 > 2 ? t2 : 0.f), blast = (t0 + t1) + (t2 + t3);
#pragma unroll
    for (int i = 0; i < 16; ++i) L.bt[(q4 * 16 + i) * G2_BP + kd] = offs + pre[i];
    const float edl = __expf(blast);
    if (q4 == 0) { L.dl[kd] = edl; L.bl[kd] = blast; }
    __syncthreads();
#pragma unroll
    for (int i = 0; i < 2; ++i) {
        const int it = tid_ + 512 * i, t = it >> 4, kg = it & 15;
        const f32x4 b0 = *(const LAS f32x4*)(L.bt + t * G2_BP + 8 * kg), b1 = *(const LAS f32x4*)(L.bt + t * G2_BP + 8 * kg + 4);
        const f32x4 l0 = *(const LAS f32x4*)(L.bl + 8 * kg), l1 = *(const LAS f32x4*)(L.bl + 8 * kg + 4);
        const float bv[8] = {b0[0], b0[1], b0[2], b0[3], b1[0], b1[1], b1[2], b1[3]}, lv[8] = {l0[0], l0[1], l0[2], l0[3], l1[0], l1[1], l1[2], l1[3]};
        float k8[8]; unpack8(R.k[i], k8);
        { float kd8[8];
#pragma unroll
          for (int e = 0; e < 8; ++e) kd8[e] = k8[e] * __expf(lv[e] - bv[e]);
          u32x4 wd; wd.x = pack2(kd8[0], kd8[1]); wd.y = pack2(kd8[2], kd8[3]); wd.z = pack2(kd8[4], kd8[5]); wd.w = pack2(kd8[6], kd8[7]);
          *(LAS u32x4*)(L.kdt + t * G2_QP + 8 * kg) = wd; }
        if (need_qk) {
            float q8[8], qo[8], ko[8]; unpack8(R.q[i], q8);
#pragma unroll
            for (int e = 0; e < 8; ++e) { const float eb = __expf(bv[e]); qo[e] = q8[e] * eb; ko[e] = k8[e] * __builtin_amdgcn_rcpf(eb); }
            u32x4 wq, wk;
            wq.x = pack2(qo[0], qo[1]); wq.y = pack2(qo[2], qo[3]); wq.z = pack2(qo[4], qo[5]); wq.w = pack2(qo[6], qo[7]);
            wk.x = pack2(ko[0], ko[1]); wk.y = pack2(ko[2], ko[3]); wk.z = pack2(ko[4], ko[5]); wk.w = pack2(ko[6], ko[7]);
            *(LAS u32x4*)(L.qe + t * G2_QP + 8 * kg) = wq; *(LAS u32x4*)(L.ke + t * G2_QP + 8 * kg) = wk;
        }
    }
    __syncthreads();
    return edl;
}
__device__ __forceinline__ bf16x8 ld_frag_tr(const LAS bf16_t* img, int pitch, int row0, int col0, int lane) {
    const int i16 = lane & 15, hh = lane >> 5;
    const LAS bf16_t* ap = img + (row0 + 8 * hh + (i16 >> 2)) * pitch + col0 + 16 * ((lane >> 4) & 1) + 4 * (i16 & 3);
    union { bf16x8 v; v4s2_t h2[2]; } f;
    f.h2[0] = __builtin_amdgcn_ds_read_tr16_b64_v4i16((LAS v4s2_t*)ap);
    f.h2[1] = __builtin_amdgcn_ds_read_tr16_b64_v4i16((LAS v4s2_t*)(ap + 4 * pitch));
    return f.v;
}
__device__ __forceinline__ void gla2_update_state(const Gla2Lds& L, f32x16 (&S)[4], int wave, int lane) {
    const int hh = lane >> 5;
    bf16x8 vf[4];
#pragma unroll
    for (int ks = 0; ks < 4; ++ks) vf[ks] = ld_frag_tr(L.vt, G2_VP, 16 * ks, 32 * wave, lane);
#pragma unroll
    for (int mi = 0; mi < 4; ++mi) {
#pragma unroll
        for (int g4 = 0; g4 < 4; ++g4) {
            const f32x4 d = *(const LAS f32x4*)(L.dl + 32 * mi + 8 * g4 + 4 * hh);
#pragma unroll
            for (int j = 0; j < 4; ++j) S[mi][4 * g4 + j] *= d[j];
        }
#pragma unroll
        for (int ks = 0; ks < 4; ++ks) S[mi] = mfma32(ld_frag_tr(L.kdt, G2_QP, 16 * ks, 32 * mi, lane), vf[ks], S[mi]);
    }
}
__device__ __forceinline__ void phase_gla2_passA(const Params& p, int bid, int nb, LAS unsigned char* lds) {
    int tid_ = threadIdx.x; asm volatile("" : "+v"(tid_));
    Gla2Lds L; L.carve(lds);
    const int wave = tid_ >> 6, lane = tid_ & 63;
    for (int u = bid; u < 256; u += nb) {
        const int bh = u >> 5, seg = u & 31, b = bh >> 2, h = bh & 3;
        float wup[16];
#pragma unroll
        for (int j = 0; j < 16; ++j) wup[j] = p.w_gla_up[j * 512 + h * 128 + (tid_ >> 2)];
        const float bg = p.b_gla[h * 128 + (tid_ >> 2)];
        f32x16 S[4];
#pragma unroll
        for (int mi = 0; mi < 4; ++mi) S[mi] = zero16();
        float dprod = 1.0f;
        Gla2Regs R; gla2_load_chunk(p, R, tid_, b, h, seg * 8, false);
        for (int cc = 0; cc < 8; ++cc) {
            int tq = tid_; asm volatile("" : "+v"(tq));
            dprod *= gla2_stage_chunk(L, R, tq, wup, bg, false);
            if (cc < 7) gla2_load_chunk(p, R, tq, b, h, seg * 8 + cc + 1, false);
            gla2_update_state(L, S, wave, tq & 63);
            __syncthreads();
        }
        float* dst = p.LSEG + (size_t)u * 32768 + (size_t)wave * 4096 + lane;
#pragma unroll
        for (int mi = 0; mi < 4; ++mi)
#pragma unroll
            for (int reg = 0; reg < 16; ++reg) dst[(mi * 16 + reg) * 64] = S[mi][reg];
        if ((tid_ & 3) == 0) p.DSEG[(size_t)u * 128 + (tid_ >> 2)] = dprod;
    }
}
__device__ __forceinline__ void phase_gla2_scan(const Params& p, int bid, int nb) {
    int tid_ = threadIdx.x; asm volatile("" : "+v"(tid_));
    for (int e = bid * NTHREADS + tid_; e < 8 * 32768; e += nb * NTHREADS) {
        const int bh = e >> 15, idx = e & 32767, w = idx >> 12, rem = idx & 4095, mr = rem >> 6, ln = rem & 63, mi = mr >> 4, reg = mr & 15;
        const int kd = 32 * mi + crow(reg, ln >> 5), dv = 32 * w + (ln & 31);
        float S = 0.f;
        for (int s0 = 0; s0 < 32; s0 += 8) {
            float l[8], d[8];
#pragma unroll
            for (int i = 0; i < 8; ++i) { const size_t u = (size_t)bh * 32 + s0 + i; l[i] = p.LSEG[u * 32768 + idx]; d[i] = p.DSEG[u * 128 + kd]; }
#pragma unroll
            for (int i = 0; i < 8; ++i) { const size_t u = (size_t)bh * 32 + s0 + i; p.SSEG[u * 32768 + idx] = S; S = d[i] * S + l[i]; }
        }
        p.out[OFF_GLAP + ((size_t)bh * 128 + kd) * 256 + dv] = S;
    }
}
__device__ __forceinline__ void phase_gla2_passC(const Params& p, int bid, int nb, LAS unsigned char* lds) {
    int tid_ = threadIdx.x; asm volatile("" : "+v"(tid_));
    Gla2Lds L; L.carve(lds);
    const int wave = tid_ >> 6, lane = tid_ & 63;
    for (int u = bid; u < 256; u += nb) {
        const int bh = u >> 5, seg = u & 31, b = bh >> 2, h = bh & 3;
        float wup[16];
#pragma unroll
        for (int j = 0; j < 16; ++j) wup[j] = p.w_gla_up[j * 512 + h * 128 + (tid_ >> 2)];
        const float bg = p.b_gla[h * 128 + (tid_ >> 2)];
        Gla2Regs R; gla2_load_chunk(p, R, tid_, b, h, seg * 8, true);
        f32x16 S[4];
        {
            const float* src = p.SSEG + (size_t)u * 32768 + (size_t)wave * 4096 + lane;
#pragma unroll
            for (int mi = 0; mi < 4; ++mi)
#pragma unroll
                for (int reg = 0; reg < 16; ++reg) S[mi][reg] = src[(mi * 16 + reg) * 64];
        }
        for (int cc = 0; cc < 8; ++cc) {
            const int c = seg * 8 + cc, row0 = b * T + c * 64;
            int tq = tid_; asm volatile("" : "+v"(tq));
            const int r = tq & 31, hh = (tq >> 5) & 1;
            gla2_stage_chunk(L, R, tq, wup, bg, true);
            if (cc < 7) gla2_load_chunk(p, R, tq, b, h, c + 1, true);
            if (wave < 4) {
                const int mi = wave >> 1, ni = wave & 1;
                f32x16 acc = zero16();
#pragma unroll
                for (int ks = 0; ks < 8; ++ks) acc = mfma32(ld_frag_l(L.ke + (32 * ni + r) * G2_QP + 16 * ks + 8 * hh), ld_frag_l(L.qe + (32 * mi + r) * G2_QP + 16 * ks + 8 * hh), acc);
                const int t = 32 * mi + r;
#pragma unroll
                for (int rg = 0; rg < 4; ++rg) {
                    const int s0 = 32 * ni + 8 * rg + 4 * hh;
                    u32x2 w;
                    w.x = pack2(s0 + 0 <= t ? acc[4 * rg + 0] : 0.f, s0 + 1 <= t ? acc[4 * rg + 1] : 0.f);
                    w.y = pack2(s0 + 2 <= t ? acc[4 * rg + 2] : 0.f, s0 + 3 <= t ? acc[4 * rg + 3] : 0.f);
                    *(LAS u32x2*)(L.pp + t * G2_TP + s0) = w;
                }
            }
            union { bf16x8 v; unsigned w[4]; } sb[4][2];
#pragma unroll
            for (int mi = 0; mi < 4; ++mi)
#pragma unroll
                for (int s2 = 0; s2 < 2; ++s2)
#pragma unroll
                    for (int e = 0; e < 4; ++e) sb[mi][s2].w[e] = pack2(S[mi][8 * s2 + 2 * e], S[mi][8 * s2 + 2 * e + 1]);
            __syncthreads();
            f32x16 oacc[2];
#pragma unroll
            for (int tt = 0; tt < 2; ++tt) {
                f32x16 acc = zero16();
#pragma unroll
                for (int ks = 0; ks < 4; ++ks) acc = mfma32(ld_frag_tr(L.vt, G2_VP, 16 * ks, 32 * wave, tq & 63), ld_frag_l(L.pp + (32 * tt + r) * G2_TP + 16 * ks + 8 * hh), acc);
#pragma unroll
                for (int mi = 0; mi < 4; ++mi)
#pragma unroll
                    for (int s2 = 0; s2 < 2; ++s2) {
                        union { bf16x8 v; u32x2 h2[2]; } qa;
                        const LAS bf16_t* qp = L.qe + (32 * tt + r) * G2_QP + 32 * mi + 16 * s2 + 4 * hh;
                        qa.h2[0] = *(const LAS u32x2*)qp; qa.h2[1] = *(const LAS u32x2*)(qp + 8);
                        acc = mfma32(sb[mi][s2].v, qa.v, acc);
                    }
                float sq = 0.f;
#pragma unroll
                for (int i = 0; i < 16; ++i) sq += acc[i] * acc[i];
                sq += __shfl_xor(sq, 32);
                if (hh == 0) L.ss[wave * 64 + 32 * tt + r] = sq;
                oacc[tt] = acc;
            }
            gla2_update_state(L, S, wave, tq & 63);
            __syncthreads();
#pragma unroll
            for (int tt = 0; tt < 2; ++tt) {
                float tot = 0.f;
#pragma unroll
                for (int w = 0; w < 8; ++w) tot += L.ss[w * 64 + 32 * tt + r];
                const float rn = rsqrtf(tot * (1.0f / 256.0f) + LN_EPS);
                const size_t ro = (size_t)(row0 + 32 * tt + r) * 1024 + h * 256 + 32 * wave + 4 * hh;
                const float* gw = p.gla_norm_w + h * 256 + 32 * wave + 4 * hh;
#pragma unroll
                for (int rg = 0; rg < 4; ++rg) {
                    const u32x2 rw = *(const u32x2*)(p.RB + ro + 8 * rg);
                    const f32x4 g4 = *(const f32x4*)(gw + 8 * rg);
                    const float o0 = oacc[tt][4 * rg + 0] * rn * g4[0] * siluf_(bflo(rw.x)), o1 = oacc[tt][4 * rg + 1] * rn * g4[1] * siluf_(bfhi(rw.x));
                    const float o2 = oacc[tt][4 * rg + 2] * rn * g4[2] * siluf_(bflo(rw.y)), o3 = oacc[tt][4 * rg + 3] * rn * g4[3] * siluf_(bfhi(rw.y));
                    u32x2 w; w.x = pack2(o0, o1); w.y = pack2(o2, o3);
                    *(u32x2*)(p.OB + ro + 8 * rg) = w;
                }
            }
            __syncthreads();
        }
    }
}

constexpr int AKV_PITCH = 72;
typedef short v4s_t __attribute__((ext_vector_type(4)));
__device__ __forceinline__ float alibi_slope(int g, int j) { return exp2f(-8.0f * (float)(g * 4 + j + 1) / 12.0f); }

__device__ __forceinline__ void phase_attn_prompt(const Params& p, int bid, int nb_, LAS unsigned char* lds) {
    int tid_ = threadIdx.x; asm volatile("" : "+v"(tid_));
    LAS bf16_t* s_k = (LAS bf16_t*)lds;
    LAS bf16_t* s_v = s_k + 2 * 256 * AKV_PITCH;
    const int wave = tid_ >> 6, lane = tid_ & 63, r = lane & 31, hh = lane >> 5;
    const int jj = wave >> 2, qs = wave & 3;
    for (int u = bid; u < 1536; u += nb_) {
        const int hp = u & 1, nbq = (u >> 1) & 127, bg = u >> 8, g = bg % 3, b = bg / 3;
        const int d = 1 << (2 * g), nbk = 128 >> (2 * g);
        const int ph = nbq / nbk, nb = nbq % nbk;
#pragma unroll
        for (int half = 0; half < 2; ++half) {
            u32x4 w[8];
#pragma unroll
            for (int i = 0; i < 8; ++i) {
                const int q = tid_ + 512 * i, hj = q >> 11, key = (q >> 3) & 255, dc = q & 7;
                int lp = 128 * (nb - 1) + key; lp = lp < 0 ? 0 : lp;
                const size_t row = (size_t)b * T + (size_t)lp * d + ph;
                w[i] = *(const u32x4*)(p.QKVA + row * 2304 + (half ? 1536 : 768) + g * 256 + (2 * hp + hj) * 64 + dc * 8);
            }
#pragma unroll
            for (int i = 0; i < 8; ++i) {
                const int q = tid_ + 512 * i, hj = q >> 11, key = (q >> 3) & 255, dc = q & 7;
                *(LAS u32x4*)((half ? s_v : s_k) + (hj * 256 + key) * AKV_PITCH + dc * 8) = w[i];
            }
        }
        const int j = 2 * hp + jj;
        const float slope_d = alibi_slope(g, j) * (float)d;
        const int qi = 32 * qs + r;
        const size_t rowq = (size_t)b * T + (size_t)(128 * nb + qi) * d + ph;
        bf16x8 qf[4];
#pragma unroll
        for (int ks = 0; ks < 4; ++ks) qf[ks] = ld_frag_g(p.QKVA + rowq * 2304 + g * 256 + j * 64 + 16 * ks + 8 * hh);
        __syncthreads();
        float sc[5][16];
        const LAS bf16_t* kb = s_k + (jj * 256 + 32 * qs + r) * AKV_PITCH + 8 * hh;
#pragma unroll
        for (int kt = 0; kt < 5; ++kt) {
            f32x16 acc = zero16();
#pragma unroll
            for (int ks = 0; ks < 4; ++ks) acc = mfma32(ld_frag_l(kb + (32 * kt) * AKV_PITCH + 16 * ks), qf[ks], acc);
#pragma unroll
            for (int reg = 0; reg < 16; ++reg) sc[kt][reg] = acc[reg];
        }
        float m = -3.0e38f;
        float fb = (float)(r - 4 * hh + 128);
        asm volatile("" : "+v"(fb));
        const float fsmax = nb > 0 ? 128.0f : (float)qi;
#pragma unroll
        for (int kt = 0; kt < 5; ++kt)
#pragma unroll
            for (int reg = 0; reg < 16; ++reg) {
                const float fs = fb - (float)(32 * kt + (reg & 3) + 8 * (reg >> 2));
                const bool valid = fs >= 0.f && fs <= fsmax;
                const float v = valid ? sc[kt][reg] * 0.125f - slope_d * fs : -3.0e38f;
                sc[kt][reg] = v; m = fmaxf(m, v);
            }
        m = fmaxf(m, __shfl_xor(m, 32));
        float z = 0.f;
#pragma unroll
        for (int kt = 0; kt < 5; ++kt)
#pragma unroll
            for (int reg = 0; reg < 16; ++reg) { const float v = sc[kt][reg]; const float e = v > -1.0e38f ? __expf(v - m) : 0.f; sc[kt][reg] = e; z += e; if (reg == 15) __builtin_amdgcn_sched_barrier(0); }
        z += __shfl_xor(z, 32);
        const float rz = 1.0f / z;
        f32x16 o0 = zero16(), o1 = zero16();
        const int i16 = lane & 15;
        const LAS bf16_t* vb = s_v + (jj * 256 + 32 * qs + 4 * hh + (i16 >> 2)) * AKV_PITCH + 16 * ((lane >> 4) & 1) + 4 * (i16 & 3);
#pragma unroll
        for (int kt = 0; kt < 5; ++kt)
#pragma unroll
            for (int s2 = 0; s2 < 2; ++s2) {
                union { bf16x8 v; unsigned w[4]; } pb;
#pragma unroll
                for (int e = 0; e < 4; ++e) pb.w[e] = pack2(sc[kt][8 * s2 + 2 * e] * rz, sc[kt][8 * s2 + 2 * e + 1] * rz);
#pragma unroll
                for (int dt = 0; dt < 2; ++dt) {
                    union { bf16x8 v; v4s_t h2[2]; } va;
                    const LAS bf16_t* ap = vb + (32 * kt + 16 * s2) * AKV_PITCH + 32 * dt;
                    va.h2[0] = __builtin_amdgcn_ds_read_tr16_b64_v4i16((LAS v4s_t*)ap);
                    va.h2[1] = __builtin_amdgcn_ds_read_tr16_b64_v4i16((LAS v4s_t*)(ap + 8 * AKV_PITCH));
                    if (dt == 0) o0 = mfma32(va.v, pb.v, o0); else o1 = mfma32(va.v, pb.v, o1);
                }
                __builtin_amdgcn_sched_barrier(0);
            }
        bf16_t* og = p.OG + rowq * 768 + g * 256 + j * 64;
#pragma unroll
        for (int rg = 0; rg < 4; ++rg) {
            u32x2 w0, w1;
            w0.x = pack2(o0[4 * rg + 0], o0[4 * rg + 1]); w0.y = pack2(o0[4 * rg + 2], o0[4 * rg + 3]);
            w1.x = pack2(o1[4 * rg + 0], o1[4 * rg + 1]); w1.y = pack2(o1[4 * rg + 2], o1[4 * rg + 3]);
            *(u32x2*)(og + 8 * rg + 4 * hh) = w0; *(u32x2*)(og + 32 + 8 * rg + 4 * hh) = w1;
        }
        if (hh == 0) p.LSE[rowq * 12 + g * 4 + j] = m + __logf(z);
        __syncthreads();
    }
}

__device__ __forceinline__ void phase_attn_sample(const Params& p, int bid, int nb_, LAS unsigned char* lds) {
    int tid_ = threadIdx.x; asm volatile("" : "+v"(tid_));
    LAS float* s_sc = (LAS float*)lds;
    LAS float* s_o = s_sc + 4 * 132;
    const int wave = tid_ >> 6, lane = tid_ & 63, hd = lane >> 4;
    for (int u = bid; u < NS * 3; u += nb_) {
        const int s = u / 3, g = u % 3, d = 1 << (2 * g), W = 128 << (2 * g);
        const size_t row = (size_t)(NTP + s);
        const float* cache = (g == 0 ? p.cache128 : (g == 1 ? p.cache512 : p.cache2048)) + (size_t)s * W * 512;
        const int nk = wave == 0 ? 17 : 16;
        f32x4 kr[17];
#pragma unroll
        for (int i = 0; i < 17; ++i) {
            const int k = wave + 8 * i;
            if (i < nk) {
                if (k == 0) { const u32x2 w = *(const u32x2*)(p.QKVA + row * 2304 + 768 + g * 256 + 4 * lane); kr[i] = (f32x4){bflo(w.x), bfhi(w.x), bflo(w.y), bfhi(w.y)}; }
                else kr[i] = *(const f32x4*)(cache + ((size_t)(W - k * d) * 2 + 0) * 256 + 4 * lane);
            } else kr[i] = (f32x4){0.f, 0.f, 0.f, 0.f};
        }
        const u32x2 qw = *(const u32x2*)(p.QKVA + row * 2304 + g * 256 + 4 * lane);
        const f32x4 q4 = {bflo(qw.x), bfhi(qw.x), bflo(qw.y), bfhi(qw.y)};
        const float slope = alibi_slope(g, hd);
#pragma unroll
        for (int i = 0; i < 17; ++i) {
            const int k = wave + 8 * i;
            float dot = kr[i][0] * q4[0] + kr[i][1] * q4[1] + kr[i][2] * q4[2] + kr[i][3] * q4[3];
            dot = dpp_row_sum(dot);
            if (i < nk && (lane & 15) == 0) s_sc[hd * 132 + k] = dot * 0.125f - slope * (float)(k * d);
        }
        f32x4 vr[17];
#pragma unroll
        for (int i = 0; i < 17; ++i) {
            const int k = wave + 8 * i;
            if (i < nk) {
                if (k == 0) { const u32x2 w = *(const u32x2*)(p.QKVA + row * 2304 + 1536 + g * 256 + 4 * lane); vr[i] = (f32x4){bflo(w.x), bfhi(w.x), bflo(w.y), bfhi(w.y)}; }
                else vr[i] = *(const f32x4*)(cache + ((size_t)(W - k * d) * 2 + 1) * 256 + 4 * lane);
            } else vr[i] = (f32x4){0.f, 0.f, 0.f, 0.f};
        }
        __syncthreads();
        if (wave < 4) {
            const int h2 = wave;
            const float a0 = s_sc[h2 * 132 + lane], a1 = s_sc[h2 * 132 + 64 + lane], a2 = lane == 0 ? s_sc[h2 * 132 + 128] : -3.0e38f;
            const float m = wave_max(fmaxf(fmaxf(a0, a1), a2));
            const float e0 = __expf(a0 - m), e1 = __expf(a1 - m), e2 = lane == 0 ? __expf(a2 - m) : 0.f;
            const float z = wave_sum(e0 + e1 + e2), rz = 1.0f / z;
            s_sc[h2 * 132 + lane] = e0 * rz; s_sc[h2 * 132 + 64 + lane] = e1 * rz; if (lane == 0) { s_sc[h2 * 132 + 128] = e2 * rz; p.LSE[row * 12 + g * 4 + h2] = m + __logf(z); }
        }
        __syncthreads();
        f32x4 o = {0.f, 0.f, 0.f, 0.f};
#pragma unroll
        for (int i = 0; i < 17; ++i) { const int k = wave + 8 * i; if (i < nk) o += vr[i] * s_sc[hd * 132 + k]; }
        *(LAS f32x4*)(s_o + wave * 256 + 4 * lane) = o;
        __syncthreads();
        if (tid_ < 256) {
            float t2 = 0.f;
#pragma unroll
            for (int w = 0; w < 8; ++w) t2 += s_o[w * 256 + tid_];
            p.OG[row * 768 + g * 256 + tid_] = f2bf(t2);
        }
        __syncthreads();
    }
}

__device__ __forceinline__ void phase_merge_prep(const Params& p, int bid, int nb) {
    int tid_ = threadIdx.x; asm volatile("" : "+v"(tid_));
    const int wave = tid_ >> 6, lane = tid_ & 63;
    for (int row = bid * 8 + wave; row < NT; row += nb * 8) {
        const size_t R = (size_t)row;
        {
            const int j = lane >> 4;
            const float l0 = p.LSE[R * 12 + j], l1 = p.LSE[R * 12 + 4 + j], l2 = p.LSE[R * 12 + 8 + j];
            const float m = fmaxf(l0, fmaxf(l1, l2));
            float w0 = __expf(l0 - m), w1 = __expf(l1 - m), w2 = __expf(l2 - m);
            const float rs = 1.0f / (w0 + w1 + w2); w0 *= rs; w1 *= rs; w2 *= rs;
            const u32x2 a = *(const u32x2*)(p.OG + R * 768 + 4 * lane), b = *(const u32x2*)(p.OG + R * 768 + 256 + 4 * lane), c = *(const u32x2*)(p.OG + R * 768 + 512 + 4 * lane);
            u32x2 o;
            o.x = pack2(w0 * bflo(a.x) + w1 * bflo(b.x) + w2 * bflo(c.x), w0 * bfhi(a.x) + w1 * bfhi(b.x) + w2 * bfhi(c.x));
            o.y = pack2(w0 * bflo(a.y) + w1 * bflo(b.y) + w2 * bflo(c.y), w0 * bfhi(a.y) + w1 * bfhi(b.y) + w2 * bfhi(c.y));
            *(u32x2*)(p.OA + R * 256 + 4 * lane) = o;
        }
    }
}

template <int MODE> struct EpiGate {
    static constexpr bool PERM = true, AFTER_DRAIN = false;
    bf16_t* O; const bf16_t* G; const bf16_t* ADD; int ld;
    __device__ __forceinline__ void operator()(const pg8::f32x4 (&acc)[2][2][4][2], const pg8::Unit& u, int wr, int wc, int fr, int fq) const {
        const int row0 = u.pm * 256 + wr * 64 + fr, col0 = u.pn * 256 + wc * 32 + 8 * fq;
#pragma unroll
        for (int ai = 0; ai < 2; ++ai) {
            u32x4 gq[8], aq[8];
#pragma unroll
            for (int m = 0; m < 4; ++m)
#pragma unroll
                for (int bj = 0; bj < 2; ++bj) {
                    const size_t o = (size_t)(row0 + ai * 128 + m * 16) * ld + col0 + bj * 128;
                    if (MODE != 2) gq[m * 2 + bj] = *(const u32x4*)(G + o);
                    if (MODE == 1) aq[m * 2 + bj] = *(const u32x4*)(ADD + o);
                }
#pragma unroll
            for (int m = 0; m < 4; ++m)
#pragma unroll
                for (int bj = 0; bj < 2; ++bj) {
                    const size_t o = (size_t)(row0 + ai * 128 + m * 16) * ld + col0 + bj * 128;
                    const pg8::f32x4 v0 = acc[ai][bj][m][0], v1 = acc[ai][bj][m][1];
                    float v[8] = {v0[0], v0[1], v0[2], v0[3], v1[0], v1[1], v1[2], v1[3]};
                    if (MODE != 2) { float gg[8]; unpack8(gq[m * 2 + bj], gg);
#pragma unroll
                        for (int i = 0; i < 8; ++i) v[i] *= sigmoidf_(gg[i]); }
                    if (MODE == 1) { float aa[8]; unpack8(aq[m * 2 + bj], aa);
#pragma unroll
                        for (int i = 0; i < 8; ++i) v[i] += aa[i]; }
                    u32x4 w; w.x = pack2(v[0], v[1]); w.y = pack2(v[2], v[3]); w.z = pack2(v[4], v[5]); w.w = pack2(v[6], v[7]);
                    *(u32x4*)(O + o) = w;
                }
        }
    }
    __device__ __forceinline__ void emit16(int row, int col, const float (&vin)[16]) const {
#pragma unroll
        for (int hf = 0; hf < 2; ++hf) {
            const size_t o = (size_t)row * ld + col + 8 * hf;
            float v[8];
#pragma unroll
            for (int i = 0; i < 8; ++i) v[i] = vin[8 * hf + i];
            if (MODE != 2) { float gg[8]; unpack8(*(const u32x4*)(G + o), gg);
#pragma unroll
                for (int i = 0; i < 8; ++i) v[i] *= sigmoidf_(gg[i]); }
            if (MODE == 1) { float aa[8]; unpack8(*(const u32x4*)(ADD + o), aa);
#pragma unroll
                for (int i = 0; i < 8; ++i) v[i] += aa[i]; }
            u32x4 w; w.x = pack2(v[0], v[1]); w.y = pack2(v[2], v[3]); w.z = pack2(v[4], v[5]); w.w = pack2(v[6], v[7]);
            *(u32x4*)(O + o) = w;
        }
    }
};
struct EpiOut {
    static constexpr bool PERM = false, AFTER_DRAIN = false;
    float* Z1; const float* x_prompt; const float* x_sample; const float* MOD;
    __device__ __forceinline__ void operator()(const pg8::f32x4 (&acc)[2][2][4][2], const pg8::Unit& u, int wr, int wc, int fr, int fq) const {
        const int row0 = u.pm * 256 + wr * 64 + fr, col0 = u.pn * 256 + wc * 32 + 4 * fq;
        const float* g1 = MOD + (size_t)(row0 >> 14) * 6144 + 2048 + col0;
        pg8::f32x4 gv[2][2];
#pragma unroll
        for (int bj = 0; bj < 2; ++bj)
#pragma unroll
            for (int n = 0; n < 2; ++n) gv[bj][n] = *(const pg8::f32x4*)(g1 + bj * 128 + n * 16);
#pragma unroll
        for (int ai = 0; ai < 2; ++ai) {
            pg8::f32x4 xv[4][2][2];
#pragma unroll
            for (int m = 0; m < 4; ++m)
#pragma unroll
                for (int bj = 0; bj < 2; ++bj)
#pragma unroll
                    for (int n = 0; n < 2; ++n) xv[m][bj][n] = *(const pg8::f32x4*)(x_prompt + (size_t)(row0 + ai * 128 + m * 16) * D + col0 + bj * 128 + n * 16);
#pragma unroll
            for (int m = 0; m < 4; ++m)
#pragma unroll
                for (int bj = 0; bj < 2; ++bj)
#pragma unroll
                    for (int n = 0; n < 2; ++n)
                        *(pg8::f32x4*)(Z1 + (size_t)(row0 + ai * 128 + m * 16) * D + col0 + bj * 128 + n * 16) = xv[m][bj][n] * DN_ALPHA + gv[bj][n] * acc[ai][bj][m][n];
        }
    }
    __device__ __forceinline__ void emit16(int row, int col, const float (&v)[16]) const {
        if (row >= NT) return;
        const float* xr = row < NTP ? x_prompt + (size_t)row * D : x_sample + (size_t)(row - NTP) * D;
        const float* g1 = MOD + (size_t)seq_of(row) * 6144 + 2048;
#pragma unroll
        for (int i = 0; i < 4; ++i) {
            const f32x4 xv = *(const f32x4*)(xr + col + 4 * i), gv = *(const f32x4*)(g1 + col + 4 * i);
            *(f32x4*)(Z1 + (size_t)row * D + col + 4 * i) = xv * DN_ALPHA + gv * (f32x4){v[4 * i], v[4 * i + 1], v[4 * i + 2], v[4 * i + 3]};
        }
    }
};

__device__ __forceinline__ size_t qvf_index(int row, int c0) {
    return ((((((size_t)(row >> 5) * 8 + (c0 >> 8)) * 2 + ((c0 >> 7) & 1)) * 8 + ((c0 & 127) >> 4)) * 64) + (((c0 >> 3) & 1) * 32 + (row & 31))) * 8;
}
struct EpiQvf {
    static constexpr bool PERM = true, AFTER_DRAIN = false;
    bf16_t* O;
    __device__ __forceinline__ void operator()(const pg8::f32x4 (&acc)[2][2][4][2], const pg8::Unit& u, int wr, int wc, int fr, int fq) const {
        const int row0 = u.pm * 256 + wr * 64 + fr, col0 = u.pn * 256 + wc * 32 + 8 * fq;
#pragma unroll
        for (int ai = 0; ai < 2; ++ai)
#pragma unroll
            for (int m = 0; m < 4; ++m)
#pragma unroll
                for (int bj = 0; bj < 2; ++bj) {
                    const pg8::f32x4 v0 = acc[ai][bj][m][0], v1 = acc[ai][bj][m][1];
                    u32x4 w; w.x = pack2(v0[0], v0[1]); w.y = pack2(v0[2], v0[3]); w.z = pack2(v1[0], v1[1]); w.w = pack2(v1[2], v1[3]);
                    *(u32x4*)(O + qvf_index(row0 + ai * 128 + m * 16, col0 + bj * 128)) = w;
                }
    }
    __device__ __forceinline__ void emit16(int row, int col, const float (&v)[16]) const {
        u32x4 w0, w1;
        w0.x = pack2(v[0], v[1]); w0.y = pack2(v[2], v[3]); w0.z = pack2(v[4], v[5]); w0.w = pack2(v[6], v[7]);
        w1.x = pack2(v[8], v[9]); w1.y = pack2(v[10], v[11]); w1.z = pack2(v[12], v[13]); w1.w = pack2(v[14], v[15]);
        *(u32x4*)(O + qvf_index(row, col)) = w0; *(u32x4*)(O + qvf_index(row, col + 8)) = w1;
    }
};

__device__ __forceinline__ void phase_ln1(const Params& p, int bid, int nb) {
    int tid_ = threadIdx.x; asm volatile("" : "+v"(tid_));
    const int wave = tid_ >> 6, lane = tid_ & 63;
    float lw[16], lb[16];
    load_row16(p.ln1_w, lane, lw); load_row16(p.ln1_b, lane, lb);
    int row = bid * 8 + wave;
    float nx[16];
    if (row < NT) load_row16(p.Z1 + (size_t)row * D, lane, nx);
    for (; row < NT; row += nb * 8) {
        float v[16];
#pragma unroll
        for (int i = 0; i < 16; ++i) v[i] = nx[i];
        const int nrow = row + nb * 8;
        if (nrow < NT) load_row16(p.Z1 + (size_t)nrow * D, lane, nx);
        const float* mod = p.MOD + (size_t)seq_of(row) * 6144;
        float sh[16], sc[16];
        load_row16(mod + 3072, lane, sh); load_row16(mod + 4096, lane, sc);
        float mean, rstd; row_stats(v, mean, rstd);
        if (lane == 0) { p.LNST[(size_t)row * 2] = mean; p.LNST[(size_t)row * 2 + 1] = rstd; }
#pragma unroll
        for (int i = 0; i < 16; ++i) v[i] = (v[i] - mean) * rstd * lw[i] + lb[i];
        row_stats(v, mean, rstd);
#pragma unroll
        for (int i = 0; i < 16; ++i) v[i] = (v[i] - mean) * rstd * (1.0f + sc[i]) + sh[i];
        store_row16_bf16(p.H + (size_t)row * D, lane, v);
        float am = 0.f;
#pragma unroll
        for (int i = 0; i < 16; ++i) am = fmaxf(am, fabsf(v[i]));
        am = wave_max(am);
        const float inv = am > 0.f ? 448.0f / am : 1.0f;
        u32x4 w8;
#pragma unroll
        for (int i = 0; i < 4; ++i) {
            int d = 0;
            d = __builtin_amdgcn_cvt_pk_fp8_f32(v[4 * i] * inv, v[4 * i + 1] * inv, d, false);
            d = __builtin_amdgcn_cvt_pk_fp8_f32(v[4 * i + 2] * inv, v[4 * i + 3] * inv, d, true);
            w8[i] = (unsigned)d;
        }
        *(u32x2*)(p.H8 + (size_t)row * 1024 + 8 * lane) = (u32x2){w8[0], w8[1]};
        *(u32x2*)(p.H8 + (size_t)row * 1024 + 512 + 8 * lane) = (u32x2){w8[2], w8[3]};
        if (lane == 0) p.HS[row] = am > 0.f ? am * (1.0f / 448.0f) : 1.0f;
    }
}

__device__ __forceinline__ unsigned fkey(float f) { const unsigned u = __float_as_uint(f); return (u & 0x80000000u) ? ~u : (u | 0x80000000u); }
__device__ __forceinline__ float keyf(unsigned k) { return __uint_as_float((k & 0x80000000u) ? (k & 0x7fffffffu) : ~k); }

constexpr int CC_R0 = 128 * 127, CC_R1 = CC_R0 + 128 * 511, CC_ROWS = CC_R1 + 128 * 2047;
constexpr int CC_PER = 2, CC_STEPS = 84;
static_assert(CC_PER * CC_STEPS * 2048 >= CC_ROWS, "copy coverage");
template <int W> __device__ __forceinline__ void cc_addr_w(const float* s, float* d, int i, const float*& src, float*& dst) {
    const int seq = i / (W - 1), rr = i - seq * (W - 1);
    src = s + ((size_t)seq * W + rr + 1) * 512; dst = d + ((size_t)seq * W + rr) * 512;
}
__device__ __forceinline__ bool cc_addr(const Params& p, int row_, const float*& src, float*& dst) {
    const int rowu = __builtin_amdgcn_readfirstlane(row_);
    const bool ok = rowu < CC_ROWS;
    const int row = ok ? rowu : CC_ROWS - 1;
    if (row < CC_R0) cc_addr_w<128>(p.cache128, p.out + OFF_KVS0, row, src, dst);
    else if (row < CC_R1) cc_addr_w<512>(p.cache512, p.out + OFF_KVS1, row - CC_R0, src, dst);
    else cc_addr_w<2048>(p.cache2048, p.out + OFF_KVS2, row - CC_R1, src, dst);
    return ok;
}
struct CacheCopier {
    static constexpr int CAP = CC_PER * CC_STEPS;
    int row0, lane4, knext, kh0, kh1; f32x4 b0[2 * CC_PER], b1[2 * CC_PER];
    __device__ __forceinline__ void init(int bid, int tid) { row0 = __builtin_amdgcn_readfirstlane(bid * 8 + (tid >> 6)); lane4 = (tid & 63) * 4; knext = 0; kh0 = CAP; kh1 = CAP; }
    template <int W> __device__ __forceinline__ void store_part(const Params& p) {
        const int k0 = W ? kh1 : kh0;
#pragma unroll
        for (int j = 0; j < CC_PER; ++j) { const float* s; float* d; if (cc_addr(p, row0 + (k0 + j) * 2048, s, d)) {
            __builtin_nontemporal_store((W ? b1 : b0)[2 * j], (f32x4*)(d + lane4)); __builtin_nontemporal_store((W ? b1 : b0)[2 * j + 1], (f32x4*)(d + 256 + lane4)); } }
    }
    template <int W> __device__ __forceinline__ void load_part(const Params& p) {
        (W ? kh1 : kh0) = knext;
#pragma unroll
        for (int j = 0; j < CC_PER; ++j) { const float* s; float* d; (void)cc_addr(p, row0 + (knext + j) * 2048, s, d);
            (W ? b1 : b0)[2 * j] = __builtin_nontemporal_load((const f32x4*)(s + lane4)); (W ? b1 : b0)[2 * j + 1] = __builtin_nontemporal_load((const f32x4*)(s + 256 + lane4)); }
        knext = knext + CC_PER < CAP ? knext + CC_PER : CAP;
    }
    template <int W> __device__ __forceinline__ void step(const Params& p) { store_part<W>(p); load_part<W>(p); }
    __device__ __forceinline__ void flush(const Params& p) { while (kh0 < CAP || kh1 < CAP) { step<0>(p); step<1>(p); } }
};
constexpr int SK_PITCH = 132;
#define DPP_ROR(v, n) ((unsigned)__builtin_amdgcn_update_dpp(0, (int)(v), 0x120 + (n), 0xf, 0xf, true))
__device__ __forceinline__ unsigned row_max_u32(unsigned v) {
    v = max(v, DPP_ROR(v, 8)); v = max(v, DPP_ROR(v, 4)); v = max(v, DPP_ROR(v, 2)); v = max(v, DPP_ROR(v, 1)); return v;
}
#define CE_DESC(a, b) do { const unsigned hi_ = max(a, b), lo_ = min(a, b); a = hi_; b = lo_; } while (0)
__device__ __forceinline__ void phase_peer_select(const Params& p, int bid, int nb, LAS unsigned char* lds) {
    int tid_ = threadIdx.x; asm volatile("" : "+v"(tid_));
    LAS unsigned* s_key = (LAS unsigned*)lds;
    LAS unsigned* s_top = s_key + 256 * SK_PITCH;
    const int wave = tid_ >> 6, lane = tid_ & 63, r = lane & 31, hh = lane >> 5;
    const int li = tid_ & 15, rowid = tid_ >> 4;
    int cand_i[4], cand_j[4]; bool cand_ok[4];
#pragma unroll
    for (int s = 0; s < 4; ++s) {
        int i = 0, rem = 4 * li + s;
        while (i < 16 && rem >= 16 / (i + 1)) { rem -= 16 / (i + 1); ++i; }
        cand_ok[s] = i < 16; cand_i[s] = i < 16 ? i : 0; cand_j[s] = i < 16 ? rem : 0;
    }
    CacheCopier cc; cc.init(bid, tid_);
    for (int b = bid; b < 256; b += nb) {
        for (int tile = 0; tile < 5; ++tile) {
            const int nvalid = tile < 4 ? 32 : (b < NS ? 1 : 0);
            if (nvalid == 0) break;
            const int row0 = tile < 4 ? b * 128 + tile * 32 : NTP + b;
            for (int hq = 0; hq < 2; ++hq) {
#pragma unroll
                for (int jb = 0; jb < 4; ++jb) {
                    const int job = wave * 4 + jb, hl = job >> 3, half = (job >> 2) & 1, ni = job & 3;
                    const int h = 4 * hq + hl;
                    const int tix = tile < 4 ? b * 4 + tile : (NTP >> 5) + (b >> 5), rsel = tile < 4 ? r : (b & 31);
                    const bf16_t* A = p.QV + ((((size_t)tix * 8 + h) * 2 + half) * 8 * 64 + (hh * 32 + rsel)) * 8;
                    const bf16_t* B = p.KF + ((((size_t)h * 2 + half) * 4 + ni) * 8 * 64 + lane) * 8;
                    if (jb & 1) cc.store_part<1>(p); else cc.store_part<0>(p);
                    bf16x8 af[8], bfr[8];
#pragma unroll
                    for (int ks = 0; ks < 8; ++ks) { af[ks] = ld_frag_g(A + ks * 512); bfr[ks] = ld_frag_g(B + ks * 512); }
                    if (jb & 1) cc.load_part<1>(p); else cc.load_part<0>(p);
                    f32x16 acc = zero16();
#pragma unroll
                    for (int ks = 0; ks < 8; ++ks) acc = mfma32(af[ks], bfr[ks], acc);
                    LAS unsigned* dst = s_key + ((hl * 2 + half) * 32) * SK_PITCH + 32 * ni + r;
                    const unsigned tag = 127u - (unsigned)(32 * ni + r);
#pragma unroll
                    for (int reg = 0; reg < 16; ++reg) dst[crow(reg, hh) * SK_PITCH] = (fkey(acc[reg]) & ~127u) | tag;
                }
                __syncthreads();
                {
                    auto stage1 = [&](int it) {
                        unsigned k[2][8], res[2];
#pragma unroll
                        for (int z = 0; z < 2; ++z) {
                            const int q = (it + 4 * z) * 32 + rowid;
                            const u32x4 ka = *(const LAS u32x4*)(s_key + q * SK_PITCH + 8 * li), kb = *(const LAS u32x4*)(s_key + q * SK_PITCH + 8 * li + 4);
                            k[z][0] = ka.x; k[z][1] = ka.y; k[z][2] = ka.z; k[z][3] = ka.w; k[z][4] = kb.x; k[z][5] = kb.y; k[z][6] = kb.z; k[z][7] = kb.w; res[z] = 0u;
                        }
#pragma unroll
                        for (int z = 0; z < 2; ++z) {
                            CE_DESC(k[z][0], k[z][1]); CE_DESC(k[z][2], k[z][3]); CE_DESC(k[z][4], k[z][5]); CE_DESC(k[z][6], k[z][7]);
                            CE_DESC(k[z][0], k[z][2]); CE_DESC(k[z][1], k[z][3]); CE_DESC(k[z][4], k[z][6]); CE_DESC(k[z][5], k[z][7]);
                            CE_DESC(k[z][1], k[z][2]); CE_DESC(k[z][5], k[z][6]);
                            CE_DESC(k[z][0], k[z][4]); CE_DESC(k[z][1], k[z][5]); CE_DESC(k[z][2], k[z][6]); CE_DESC(k[z][3], k[z][7]);
                            CE_DESC(k[z][2], k[z][4]); CE_DESC(k[z][3], k[z][5]);
                            CE_DESC(k[z][1], k[z][2]); CE_DESC(k[z][3], k[z][4]); CE_DESC(k[z][5], k[z][6]);
                        }
#pragma unroll
                        for (int ps = 0; ps < 16; ++ps) {
#pragma unroll
                            for (int z = 0; z < 2; ++z) {
                                const unsigned mx = row_max_u32(k[z][0]);
                                res[z] = li == ps ? mx : res[z];
                                const bool pop = k[z][0] == mx;
#pragma unroll
                                for (int e = 0; e < 7; ++e) k[z][e] = pop ? k[z][e + 1] : k[z][e];
                                k[z][7] = pop ? 0u : k[z][7];
                            }
                        }
#pragma unroll
                        for (int z = 0; z < 2; ++z) s_top[((it + 4 * z) * 32 + rowid) * 16 + li] = res[z];
                    };
                    for (int it = 0; it < 4; it += 2) { cc.step<0>(p); if (rowid < nvalid) stage1(it); cc.step<1>(p); if (rowid < nvalid) stage1(it + 1); }
                }
                __syncthreads();
                {
                    auto stage2 = [&](int hl0) {
                        unsigned c[2][4], res[2];
#pragma unroll
                        for (int z = 0; z < 2; ++z) {
                            const int hl = hl0 + 2 * z;
                            const LAS unsigned* t1 = s_top + ((hl * 2 + 0) * 32 + rowid) * 16;
                            const LAS unsigned* t2 = s_top + ((hl * 2 + 1) * 32 + rowid) * 16;
#pragma unroll
                            for (int s = 0; s < 4; ++s) {
                                const float v = keyf(t1[cand_i[s]] & ~127u) + keyf(t2[cand_j[s]] & ~127u);
                                c[z][s] = cand_ok[s] ? ((fkey(v) & ~255u) | (255u - (unsigned)(cand_i[s] * 16 + cand_j[s]))) : 0u;
                            }
                            CE_DESC(c[z][0], c[z][1]); CE_DESC(c[z][2], c[z][3]); CE_DESC(c[z][0], c[z][2]); CE_DESC(c[z][1], c[z][3]); CE_DESC(c[z][1], c[z][2]);
                            res[z] = 0u;
                        }
#pragma unroll
                        for (int ps = 0; ps < 16; ++ps) {
#pragma unroll
                            for (int z = 0; z < 2; ++z) {
                                const unsigned mx = row_max_u32(c[z][0]);
                                res[z] = li == ps ? mx : res[z];
                                const bool pop = c[z][0] == mx;
                                c[z][0] = pop ? c[z][1] : c[z][0]; c[z][1] = pop ? c[z][2] : c[z][1]; c[z][2] = pop ? c[z][3] : c[z][2]; c[z][3] = pop ? 0u : c[z][3];
                            }
                        }
#pragma unroll
                        for (int z = 0; z < 2; ++z) {
                            const int hl = hl0 + 2 * z;
                            const LAS unsigned* t1 = s_top + ((hl * 2 + 0) * 32 + rowid) * 16;
                            const LAS unsigned* t2 = s_top + ((hl * 2 + 1) * 32 + rowid) * 16;
                            const int cidx = 255 - (int)(res[z] & 255u), i1 = cidx >> 4, i2 = cidx & 15;
                            const unsigned a1 = t1[i1], a2 = t2[i2];
                            const float sc = keyf(a1 & ~127u) + keyf(a2 & ~127u);
                            float mxs = sc;
                            mxs = fmaxf(mxs, DPP_ROR_F(mxs, 8)); mxs = fmaxf(mxs, DPP_ROR_F(mxs, 4)); mxs = fmaxf(mxs, DPP_ROR_F(mxs, 2)); mxs = fmaxf(mxs, DPP_ROR_F(mxs, 1));
                            const float ex = __expf(sc - mxs);
                            const float gw = ex / dpp_row_sum(ex);
                            const int ei = (127 - (int)(a1 & 127u)) * 128 + (127 - (int)(a2 & 127u));
                            const size_t o = (size_t)(row0 + rowid) * 128 + (4 * hq + hl) * 16 + li;
                            p.EIDX[o] = ei; p.EGW[o] = gw * p.SV[ei];
                        }
                    };
                    cc.step<0>(p); if (rowid < nvalid) stage2(0); cc.step<1>(p); if (rowid < nvalid) stage2(1);
                }
                __syncthreads();
            }
        }
    }
    cc.flush(p);
}

__device__ __forceinline__ float gelu_erf(float x) { return 0.5f * x * (1.0f + erff(x * 0.70710678118654752f)); }
__device__ __forceinline__ float wave_total_from_rows(float v) {
    return (__builtin_bit_cast(float, __builtin_amdgcn_readlane(__builtin_bit_cast(int, v), 0)) + __builtin_bit_cast(float, __builtin_amdgcn_readlane(__builtin_bit_cast(int, v), 16)))
         + (__builtin_bit_cast(float, __builtin_amdgcn_readlane(__builtin_bit_cast(int, v), 32)) + __builtin_bit_cast(float, __builtin_amdgcn_readlane(__builtin_bit_cast(int, v), 48)));
}
__device__ __forceinline__ void fp8x16_to_f32(const u32x4 w, float (&o)[16]) {
#pragma unroll
    for (int i = 0; i < 4; ++i) {
        const v2f_t lo = __builtin_amdgcn_cvt_pk_f32_fp8((int)w[i], false), hi = __builtin_amdgcn_cvt_pk_f32_fp8((int)w[i], true);
        o[4 * i] = lo.x; o[4 * i + 1] = lo.y; o[4 * i + 2] = hi.x; o[4 * i + 3] = hi.y;
    }
}
typedef long i64x2_t __attribute__((ext_vector_type(2)));
typedef int i32x2_t __attribute__((ext_vector_type(2)));
#define UP_PITCH 1040
__device__ __forceinline__ void up_tile_put(const u32x4 (&rows)[16], LAS unsigned char* tile, int lane16) {
#pragma unroll
    for (int q = 0; q < 16; ++q) *(LAS u32x4*)(tile + q * UP_PITCH + lane16) = rows[q];
}
__device__ __forceinline__ float up_tile_dots(LAS unsigned char* tile, const LAS unsigned char* hrow, int pr, int kg16) {
    f32x4 c0 = {0.f, 0.f, 0.f, 0.f}, c1 = c0;
    u32x4 hf[2][2], uf[2][2];
    auto rd = [&](int st, int s) {
#pragma unroll
        for (int i = 0; i < 2; ++i) { hf[s][i] = *(const LAS u32x4*)(hrow + 128 * st + 64 * i + kg16); uf[s][i] = *(const LAS u32x4*)(tile + pr * UP_PITCH + 128 * st + 64 * i + kg16); }
    };
    auto mm = [&](int s) {
#pragma unroll
        for (int i = 0; i < 2; ++i) {
            const i64x2_t a = __builtin_bit_cast(i64x2_t, hf[s][i]), b = __builtin_bit_cast(i64x2_t, uf[s][i]);
            c0 = __builtin_amdgcn_mfma_f32_16x16x32_fp8_fp8(a[0], b[0], c0, 0, 0, 0);
            c1 = __builtin_amdgcn_mfma_f32_16x16x32_fp8_fp8(a[1], b[1], c1, 0, 0, 0);
        }
    };
    rd(0, 0);
#pragma unroll
    for (int st = 0; st < 8; ++st) {
        if (st + 1 < 8) rd(st + 1, (st + 1) & 1);
        __builtin_amdgcn_sched_barrier(0);
        mm(st & 1);
        __builtin_amdgcn_sched_barrier(0);
    }
    return c0[0] + c1[0];
}

__device__ __forceinline__ float up_reduce8(const float (&t8)[8], int lane) {
    float t4[4], t2[2], t1;
    { const bool b = lane & 2;
#pragma unroll
      for (int j = 0; j < 4; ++j) { const float keep = b ? t8[2 * j + 1] : t8[2 * j], send = b ? t8[2 * j] : t8[2 * j + 1]; t4[j] = keep + DPP_ROR_F(send, 2); } }
    { const bool b = lane & 4;
#pragma unroll
      for (int j = 0; j < 2; ++j) { const float keep = b ? t4[2 * j + 1] : t4[2 * j], send = b ? t4[2 * j] : t4[2 * j + 1]; t2[j] = keep + DPP_ROR_F(send, 4); } }
    { const bool b = lane & 8; const float keep = b ? t2[1] : t2[0], send = b ? t2[0] : t2[1]; t1 = keep + DPP_ROR_F(send, 8); }
    { const unsigned b = __float_as_uint(t1); const auto r = __builtin_amdgcn_permlane16_swap(b, b, false, false); t1 = __uint_as_float(r[0]) + __uint_as_float(r[1]); }
    { const unsigned b = __float_as_uint(t1); const auto r = __builtin_amdgcn_permlane32_swap(b, b, false, false); t1 = __uint_as_float(r[0]) + __uint_as_float(r[1]); }
    return t1;
}
template <int V = 0>
__device__ __forceinline__ void phase_peer_upass(const Params& p, int bid, int nb, LAS unsigned char* lds, float* __restrict__ ewout) {
    int tid_ = threadIdx.x; asm volatile("" : "+v"(tid_));
    const int wave = tid_ >> 6, lane = tid_ & 63;
    constexpr int WSTR = 1024 + 2048 + 64;
    LAS int* lst = (LAS int*)(lds + wave * WSTR);
    LAS unsigned char* hb = lds + wave * WSTR + 1024;
    LAS float* hsl = (LAS float*)(lds + wave * WSTR + 3072);
    static_assert(8 * WSTR <= LDS_BYTES - 16, "LDS carve of the expert-activation phase");
    const __amdgpu_buffer_rsrc_t ures = __builtin_amdgcn_make_buffer_rsrc((void*)p.U8, 0, 16384 * 2048, 0x00020000);
    const int lane16 = lane * 16;
    const int rsel = (((lane & 15) >> 2) == (lane >> 4)) ? (lane & 3) : 4;
    unsigned dmask[4];
#pragma unroll
    for (int r = 0; r < 4; ++r) { dmask[r] = rsel == r ? 0xffffffffu : 0u; asm volatile("" : "+v"(dmask[r])); }
    constexpr int TPB = NT / 32;
    static_assert(TPB * 32 == NT, "token ranges");
    struct TokIn { u32x4 h8; int ia, ib; float hs; };
    struct Tok { int t, n, e0, e1, k0, k1; float su0, su1; };
    for (int vb = bid; vb < 256; vb += nb) {
        const int x = vb & 7, t0 = (vb >> 3) * TPB, tend = t0 + TPB;
        {
        auto fetch_tok = [&](int t2, TokIn& ti) {
            t2 = t2 < tend ? t2 : tend - 1;
            const size_t R2 = (size_t)t2;
            ti.h8 = *(const u32x4*)(p.H8 + R2 * 1024 + 16 * lane); ti.hs = p.HS[R2];
            ti.ia = p.EIDX[R2 * 128 + lane]; ti.ib = p.EIDX[R2 * 128 + 64 + lane];
        };
        auto prep = [&](int t, TokIn& in, Tok& o, u32x4 (&buf)[16], int par) {
            const int ia = in.ia, ib = in.ib;
            o.t = t;
            *(LAS u32x4*)(hb + par * 1024 + 16 * lane) = in.h8; hsl[par] = in.hs;
            const bool inA = (ia >> 11) == x, inB = (ib >> 11) == x;
            const unsigned long long mA = __builtin_amdgcn_ballot_w64(inA), mB = __builtin_amdgcn_ballot_w64(inB);
            const int cntA = __builtin_popcountll(mA), n = cntA + __builtin_popcountll(mB);
            const int rankA = (int)__builtin_amdgcn_mbcnt_hi((unsigned)(mA >> 32), __builtin_amdgcn_mbcnt_lo((unsigned)mA, 0u));
            const int rankB = cntA + (int)__builtin_amdgcn_mbcnt_hi((unsigned)(mB >> 32), __builtin_amdgcn_mbcnt_lo((unsigned)mB, 0u));
            LAS int* L = lst;
            if (inA) { L[rankA] = ia; L[128 + rankA] = lane; }
            if (inB) { L[rankB] = ib; L[128 + rankB] = 64 + lane; }
            asm volatile("s_waitcnt lgkmcnt(0)" ::: "memory");
            o.n = n;
            o.e0 = lane < n ? L[lane] : (x << 11); o.e1 = 64 + lane < n ? L[64 + lane] : (x << 11);
            o.k0 = L[128 + lane]; o.k1 = L[192 + lane];
            o.su0 = p.SU[o.e0]; o.su1 = p.SU[o.e1];
#pragma unroll
            for (int q = 0; q < 16; ++q) { const int e = __builtin_amdgcn_readlane(o.e0, q); buf[q] = __builtin_amdgcn_raw_buffer_load_b128(ures, lane16, e << 11, 0); }
            fetch_tok(t + 16, in);
        };
        auto finish = [&](Tok& c, u32x4 (&buf)[16], int par) {
            const u32x4 h8 = *(const LAS u32x4*)(hb + par * 1024 + lane16); const float hs = hsl[par];
            const i64x2_t ha = __builtin_bit_cast(i64x2_t, h8);
            __builtin_amdgcn_sched_barrier(0);
            __builtin_amdgcn_s_waitcnt(0x4F76);
            __builtin_amdgcn_sched_barrier(0);
            float dot0 = 0.f, dot1 = 0.f;
            for (int base = 0; base < 16 || base < c.n; base += 16) {
                const bool more = base + 16 < c.n;
                const int nb16 = base + 16, ev = nb16 < 64 ? c.e0 : c.e1;
                float t8[8];
#pragma unroll
                for (int bq = 0; bq < 4; ++bq) {
                    const int q0 = 4 * bq;
                    if (base + q0 < c.n) {
                        f32x4 acc[4];
#pragma unroll
                        for (int j = 0; j < 4; ++j) { const i64x2_t b = __builtin_bit_cast(i64x2_t, buf[q0 + j]); acc[j] = __builtin_amdgcn_mfma_f32_16x16x32_fp8_fp8(ha[0], b[0], (f32x4){0.f, 0.f, 0.f, 0.f}, 0, 0, 0); }
#pragma unroll
                        for (int j = 0; j < 4; ++j) { const i64x2_t b = __builtin_bit_cast(i64x2_t, buf[q0 + j]); acc[j] = __builtin_amdgcn_mfma_f32_16x16x32_fp8_fp8(ha[1], b[1], acc[j], 0, 0, 0); }
                        float sv[4];
#pragma unroll
                        for (int j = 0; j < 4; ++j) sv[j] = __uint_as_float((__float_as_uint(acc[j][0]) & dmask[0]) | (__float_as_uint(acc[j][1]) & dmask[1]) | (__float_as_uint(acc[j][2]) & dmask[2]) | (__float_as_uint(acc[j][3]) & dmask[3]));
                        const bool b1 = lane & 1;
#pragma unroll
                        for (int j = 0; j < 2; ++j) { const float keep = b1 ? sv[2 * j + 1] : sv[2 * j], send = b1 ? sv[2 * j] : sv[2 * j + 1]; t8[2 * bq + j] = keep + DPP_ROR_F(send, 1); }
                    } else { t8[2 * bq] = 0.f; t8[2 * bq + 1] = 0.f; }
                    if (nb16 + q0 < c.n) {
#pragma unroll
                        for (int j = 0; j < 4; ++j) { const int e = __builtin_amdgcn_readlane(ev, (nb16 & 63) + q0 + j); buf[q0 + j] = __builtin_amdgcn_raw_buffer_load_b128(ures, lane16, e << 11, 0); }
                    }
                }
                const float d = up_reduce8(t8, lane);
                if ((lane >> 4) == ((base >> 4) & 3)) { if (base < 64) dot0 = d; else dot1 = d; }
                if (more) {
                    __builtin_amdgcn_sched_barrier(0);
                    __builtin_amdgcn_s_waitcnt(0x0F70);
                    __builtin_amdgcn_sched_barrier(0);
                }
            }
            const size_t R = (size_t)c.t;
            if (lane < c.n) ewout[R * 128 + c.k0] = gelu_erf(c.su0 * hs * dot0);
            if (64 + lane < c.n) ewout[R * 128 + c.k1] = gelu_erf(c.su1 * hs * dot1);
        };
        TokIn iA, iB; Tok kA, kB; u32x4 bX[16], bY[16];
        fetch_tok(t0 + wave, iA); fetch_tok(t0 + wave + 8, iB);
        prep(t0 + wave, iA, kA, bX, 0);
        for (int t = t0 + wave; t < tend; t += 16) {
            prep(t + 8 < tend ? t + 8 : tend - 1, iB, kB, bY, 1);
            finish(kA, bX, 0);
            prep(t + 16 < tend ? t + 16 : tend - 1, iA, kA, bX, 0);
            finish(kB, bY, 1);
        }
        __builtin_amdgcn_s_waitcnt(0x0F70);
        }
    }
}

__device__ __forceinline__ void phase_peer_gather(const Params& p, int bid, int nb, LAS unsigned char* lds, int skip_ff = 0) {
    int tid_ = threadIdx.x; asm volatile("" : "+v"(tid_));
    const int wave = tid_ >> 6, lane = tid_ & 63;
    LAS float* s_ff = (LAS float*)lds;
    const __amdgpu_buffer_rsrc_t vres = __builtin_amdgcn_make_buffer_rsrc((void*)p.U8, 0, 16384 * 2048, 0x00020000);
    const int lane16v = lane * 16 + 1024;
    const int n_vb = (256 - bid + nb - 1) / nb;
    f32x4 l1w[4], l1b[4], l2w[4], l2b[4];
#pragma unroll
    for (int i = 0; i < 4; ++i) { l1w[i] = *(const f32x4*)(p.ln1_w + 16 * lane + 4 * i); l1b[i] = *(const f32x4*)(p.ln1_b + 16 * lane + 4 * i);
        l2w[i] = *(const f32x4*)(p.ln2_w + 16 * lane + 4 * i); l2b[i] = *(const f32x4*)(p.ln2_b + 16 * lane + 4 * i);
        asm volatile("" : "+v"(l1w[i]), "+v"(l1b[i]), "+v"(l2w[i]), "+v"(l2b[i])); }
    for (int it = 0; it < n_vb * 17; ++it) {
        const int vb = bid + (it / 17) * nb, sub = it % 17;
        const bool coop = sub == 16;
        if (coop && vb >= NS) continue;
        const int row = coop ? NTP + vb : vb * 128 + wave + 8 * sub;
        const int g0 = skip_ff ? 8 : (coop ? wave : 0), g1 = coop ? wave + 1 : 8;
        const size_t R = (size_t)row;
        v2f_t acc2[8];
#pragma unroll
        for (int i = 0; i < 8; ++i) acc2[i] = (v2f_t){0.f, 0.f};
        const int ia = p.EIDX[R * 128 + lane], ib = p.EIDX[R * 128 + 64 + lane];
        const float wa = p.EW[R * 128 + lane] * p.EGW[R * 128 + lane], wb = p.EW[R * 128 + 64 + lane] * p.EGW[R * 128 + 64 + lane];
        f32x4 zr[4];
#pragma unroll
        for (int i = 0; i < 4; ++i) zr[i] = *(const f32x4*)(p.Z1 + R * D + 16 * lane + 4 * i);
        const float mean1 = p.LNST[R * 2], rstd1 = p.LNST[R * 2 + 1];
        for (int grp = g0; grp < g1; ++grp) {
            const int iv = grp < 4 ? ia : ib; const float wv = grp < 4 ? wa : wb;
            const int l0 = (grp & 3) * 16;
            u32x4 vb16[16];
#pragma unroll
            for (int q = 0; q < 16; ++q) { const int e = __builtin_amdgcn_readlane(iv, l0 + q); vb16[q] = __builtin_amdgcn_raw_buffer_load_b128(vres, lane16v, e << 11, 0); }
#pragma unroll
            for (int q = 0; q < 16; ++q) {
                const float w = __builtin_bit_cast(float, __builtin_amdgcn_readlane(__builtin_bit_cast(int, wv), l0 + q));
                const v2f_t w2 = {w, w};
#pragma unroll
                for (int i = 0; i < 4; ++i) {
                    const v2f_t lo = __builtin_amdgcn_cvt_pk_f32_fp8((int)vb16[q][i], false), hi = __builtin_amdgcn_cvt_pk_f32_fp8((int)vb16[q][i], true);
                    acc2[2 * i] += w2 * lo; acc2[2 * i + 1] += w2 * hi;
                }
            }
        }
        float acc[16];
#pragma unroll
        for (int i = 0; i < 8; ++i) { acc[2 * i] = acc2[i].x; acc[2 * i + 1] = acc2[i].y; }
        if (coop) {
#pragma unroll
            for (int i = 0; i < 4; ++i) *(LAS f32x4*)(s_ff + wave * 1024 + 16 * lane + 4 * i) = (f32x4){acc[4 * i], acc[4 * i + 1], acc[4 * i + 2], acc[4 * i + 3]};
            __syncthreads();
            if (wave == 0) {
#pragma unroll
                for (int i = 0; i < 16; ++i) acc[i] = 0.f;
#pragma unroll
                for (int w = 0; w < 8; ++w)
#pragma unroll
                    for (int i = 0; i < 4; ++i) { const f32x4 t = *(const LAS f32x4*)(s_ff + w * 1024 + 16 * lane + 4 * i); acc[4 * i] += t[0]; acc[4 * i + 1] += t[1]; acc[4 * i + 2] += t[2]; acc[4 * i + 3] += t[3]; }
            }
        }
        if (!coop || wave == 0) {
            float x1[16], g2[16];
            const float* gr = p.MOD + (size_t)seq_of(row) * 6144 + 5120 + 16 * lane;
#pragma unroll
            for (int i = 0; i < 4; ++i) { const f32x4 a = zr[i], b = *(const f32x4*)(gr + 4 * i);
                const f32x4 lw = l1w[i], lb = l1b[i];
#pragma unroll
                for (int j = 0; j < 4; ++j) { x1[4 * i + j] = (a[j] - mean1) * rstd1 * lw[j] + lb[j]; g2[4 * i + j] = b[j]; } }
#pragma unroll
            for (int i = 0; i < 16; ++i) acc[i] = DN_ALPHA * x1[i] + g2[i] * acc[i];
            float mean, rstd; row_stats(acc, mean, rstd);
            float* yo = (row < NTP ? p.out + OFF_YP + R * D : p.out + OFF_YS + (size_t)(row - NTP) * D) + 16 * lane;
#pragma unroll
            for (int i = 0; i < 4; ++i) { const f32x4 w = l2w[i], b = l2b[i];
                f32x4 o;
#pragma unroll
                for (int j = 0; j < 4; ++j) o[j] = (acc[4 * i + j] - mean) * rstd * w[j] + b[j];
                *(f32x4*)(yo + 4 * i) = o; }
        }
        if (coop) __syncthreads();
    }
}

__device__ __forceinline__ void phase_z1_bypass(const Params& p, int bid, int nb) {
    int tid_ = threadIdx.x; asm volatile("" : "+v"(tid_));
    const int wave = tid_ >> 6, lane = tid_ & 63;
    for (int row = bid * 8 + wave; row < NT; row += nb * 8) {
        float v[16]; load_row16(x_row(p, row), lane, v);
#pragma unroll
        for (int i = 0; i < 16; ++i) v[i] *= DN_ALPHA;
        store_row16_f32(p.Z1 + (size_t)row * D, lane, v);
    }
}

#define DYN_LDS extern __shared__ __attribute__((aligned(16))) unsigned char shm_[]; LAS unsigned char* lds = (LAS unsigned char*)shm_;
template <class Epi> __device__ __forceinline__ void run_gemm(LAS unsigned char* lds, const bf16_t* A, const bf16_t* Bt, int M, int N, int K, const Epi& E) {
    int Ko = K; asm volatile("" : "+s"(Ko));
    pg8::StaticOrder S; S.init(M, N, (int)gridDim.x, (int)blockIdx.x);
    pg8::Gemm g{A, Bt, M, N, Ko};
    pg8::gemm_phase<Epi, pg8::StaticOrder, false>(lds, g, S, E, nullptr);
    __syncthreads();
}

template <class Epi> __device__ __forceinline__ void skinny_gemm(const bf16_t* __restrict__ A, const bf16_t* __restrict__ Bt, int N, int K, const Epi& E, int ushift) {
    int tid_ = threadIdx.x; asm volatile("" : "+v"(tid_));
    const int wave = tid_ >> 6, lane = tid_ & 63, r = lane & 31, hh = lane >> 5, rt = wave & 3, ct = wave >> 2;
    const int nb = (int)gridDim.x, vb = ((int)blockIdx.x + nb - (ushift % nb)) % nb;
    const int perm = 16 * ((r >> 2) & 1) + 4 * (r >> 3) + (r & 3);
    for (int u = vb; u < N / 64; u += nb) {
        int arow = NTP + 32 * rt + r; asm volatile("" : "+v"(arow));
        const bf16_t* ap = A + (size_t)arow * K + 8 * hh;
        const bf16_t* bp = Bt + (size_t)(u * 64 + 32 * ct + perm) * K + 8 * hh;
        f32x16 acc = zero16();
        for (int k0 = 0; k0 < K / 16; k0 += 8) {
            bf16x8 wa[8], xa[8];
#pragma unroll
            for (int i = 0; i < 8; ++i) { wa[i] = ld_frag_g(bp + 16 * (k0 + i)); xa[i] = ld_frag_g(ap + 16 * (k0 + i)); }
            __builtin_amdgcn_sched_barrier(0);
#pragma unroll
            for (int i = 0; i < 8; ++i) acc = mfma32(wa[i], xa[i], acc);
            __builtin_amdgcn_sched_barrier(0);
        }
        float v[16];
#pragma unroll
        for (int i = 0; i < 16; ++i) v[i] = acc[i];
        E.emit16(NTP + 32 * rt + r, u * 64 + 32 * ct + 16 * hh, v);
    }
}
__global__ void __launch_bounds__(NTHREADS, 2) k_mega(Params p) {
    DYN_LDS;
    volatile LAS unsigned* st = (volatile LAS unsigned*)(lds + LDS_BYTES - 16);
    if (threadIdx.x == 0) { st[0] = 0u; st[1] = 0u; st[2] = 0u; st[3] = 0u; }
    __syncthreads();
    const XcdBarrier bar = xcd_barrier_post(p.bar, st);
    const int bid = blockIdx.x, nb = gridDim.x;
    phase_prologue<0>(p, bid, nb, lds, 0);
    xcd_barrier(bar);
    run_gemm(lds, p.SC, p.WADA_T, 256, 6144, 1024, pg8::EpiF32{p.MOD, 6144, p.b_ada});
    phase_prologue<1>(p, bid, nb, lds, nb > 48 ? 24 : 0);
    xcd_barrier(bar);
    phase_lnmod1(p, bid, nb);
    xcd_barrier(bar);
    { const EpiProj E{p.QKVA, p.QKB, p.VBB, p.RB, p.GA, p.GB, p.GLR, p.out}; run_gemm(lds, p.H, p.WIN_T, NTP, NPROJ, 1024, E); skinny_gemm(p.H, p.WIN_T, NPROJ, 1024, E, 0); }
    xcd_barrier(bar);
    phase_gla2_passA(p, bid, nb, lds);
    phase_attn_prompt(p, bid, nb, lds);
    phase_attn_sample(p, bid, nb, lds);
    phase_gla_sample(p, bid, nb, lds);
    xcd_barrier(bar);
    phase_gla2_scan(p, bid, nb);
    phase_merge_prep(p, bid, nb);
    xcd_barrier(bar);
    phase_gla2_passC(p, bid, nb, lds);
    xcd_barrier(bar);
    { const EpiGate<0> E{p.TMP1, p.GA, nullptr, 1024}; run_gemm(lds, p.OA, p.WBRA_T, NTP, 1024, 256, E); skinny_gemm(p.OA, p.WBRA_T, 1024, 256, E, 0); }
    { const EpiGate<1> E{p.MERGED, p.GB, p.TMP1, 1024}; run_gemm(lds, p.OB, p.WBRB_T, NTP, 1024, 1024, E); skinny_gemm(p.OB, p.WBRB_T, 1024, 1024, E, 0); }
    xcd_barrier(bar);
    { const EpiOut E{p.Z1, p.x_prompt, p.x_sample, p.MOD}; run_gemm(lds, p.MERGED, p.WOUT_T, NTP, 1024, 1024, E); skinny_gemm(p.MERGED, p.WOUT_T, 1024, 1024, E, 128); }
    xcd_barrier(bar);
    phase_ln1(p, bid, nb);
    xcd_barrier(bar);
    { const EpiQvf E{p.QV}; run_gemm(lds, p.H, p.WPQ_T, NTP, 2048, 1024, E); skinny_gemm(p.H, p.WPQ_T, 2048, 1024, E, 192); }
    xcd_barrier(bar);
    phase_peer_select(p, bid, nb, lds);
    xcd_barrier(bar);
    phase_peer_upass<0>(p, bid, nb, lds, p.EW);
#ifdef UP_PROBE
    xcd_barrier(bar);
    phase_peer_upass<UP_PROBE>(p, bid, nb, lds, (float*)p.TMP1);
#endif
    xcd_barrier(bar);
    phase_peer_gather(p, bid, nb, lds);
}

static inline size_t align_up(size_t v, size_t a) { return (v + a - 1) / a * a; }

extern "C" void kernel_launch(void* const* d_in, const int* in_sizes, int n_in, void* d_out, int out_size, void* d_ws, size_t ws_size, hipStream_t stream) {
    (void)in_sizes; (void)n_in; (void)out_size;
    Params p; memset(&p, 0, sizeof(p));
    const float* const* in = (const float* const*)d_in;
    p.x_prompt = in[0]; p.x_sample = in[1]; p.c_prompt = in[2]; p.c_sample = in[3]; p.cache128 = in[4]; p.cache512 = in[5]; p.cache2048 = in[6]; p.state_gla = in[7];
    p.w_ada = in[8]; p.b_ada = in[9]; p.w_in = in[10]; p.w_gla_up = in[11]; p.b_gla = in[12]; p.gla_norm_w = in[13]; p.w_br_a = in[14]; p.w_br_b = in[15]; p.w_out = in[16];
    p.ln1_w = in[17]; p.ln1_b = in[18]; p.w_pq = in[19]; p.peer_k1 = in[20]; p.peer_k2 = in[21]; p.peer_u = in[22]; p.peer_v = in[23]; p.ln2_w = in[24]; p.ln2_b = in[25];
    p.out = (float*)d_out;
    size_t off = 0; char* ws = (char*)d_ws;
#define CARVE(field, type, count) do { p.field = (type*)(ws + off); off = align_up(off + (size_t)(count) * sizeof(type), 256); } while (0)
    CARVE(bar, unsigned, 4096);
    CARVE(MOD, float, 256 * 6144); CARVE(SC, bf16_t, 256 * 1024); CARVE(WADA_T, bf16_t, 6144 * 1024); CARVE(WIN_T, bf16_t, (size_t)NPROJ * 1024);
    CARVE(WBRA_T, bf16_t, 1024 * 256); CARVE(WBRB_T, bf16_t, 1024 * 1024); CARVE(WOUT_T, bf16_t, 1024 * 1024); CARVE(WPQ_T, bf16_t, 2048 * 1024);
    CARVE(KF, bf16_t, 2 * 8 * 128 * 128); CARVE(U8, unsigned char, (size_t)16384 * 2048); p.V8 = p.U8 + 1024; CARVE(SU, float, 16384); CARVE(SV, float, 16384);
    CARVE(H, bf16_t, (size_t)MP * 1024); CARVE(QKVA, bf16_t, (size_t)MP * 2304); CARVE(QKB, bf16_t, (size_t)MP * 1024); CARVE(VBB, bf16_t, (size_t)MP * 1024);
    CARVE(RB, bf16_t, (size_t)MP * 1024); CARVE(GA, bf16_t, (size_t)MP * 1024); CARVE(GB, bf16_t, (size_t)MP * 1024); CARVE(GLR, float, (size_t)MP * 16);
    CARVE(OG, bf16_t, (size_t)MP * 768); CARVE(LSE, float, (size_t)MP * 12);
    CARVE(LSEG, float, (size_t)256 * 32768); CARVE(SSEG, float, (size_t)256 * 32768); CARVE(DSEG, float, (size_t)256 * 128); CARVE(OGLA, bf16_t, (size_t)MP * 1024);
    CARVE(OA, bf16_t, (size_t)MP * 256); CARVE(OB, bf16_t, (size_t)MP * 1024); CARVE(TMP1, bf16_t, (size_t)MP * 1024); CARVE(MERGED, bf16_t, (size_t)MP * 1024);
    CARVE(Z1, float, (size_t)MP * 1024); CARVE(LNST, float, (size_t)MP * 2); CARVE(QV, bf16_t, (size_t)MP * 2048); CARVE(EIDX, int, (size_t)MP * 128); CARVE(EGW, float, (size_t)MP * 128); CARVE(ESU, float, (size_t)MP * 128); CARVE(EW, float, (size_t)MP * 128); CARVE(H8, unsigned char, (size_t)MP * 1024); CARVE(HS, float, (size_t)MP);
    if (off > ws_size) { fprintf(stderr, "kernel_launch: workspace too small: need %zu, have %zu\n", off, ws_size); return; }

    static int grid = 0;
    if (!grid) {
        int dev = 0, cus = 0; (void)hipGetDevice(&dev); (void)hipDeviceGetAttribute(&cus, hipDeviceAttributeMultiprocessorCount, dev);
        grid = cus > 0 ? cus : 256;
        (void)hipFuncSetAttribute((const void*)k_mega, hipFuncAttributeMaxDynamicSharedMemorySize, LDS_BYTES);
        int per_cu = 0;
        if (hipOccupancyMaxActiveBlocksPerMultiprocessor(&per_cu, (const void*)k_mega, NTHREADS, LDS_BYTES) != hipSuccess || per_cu < 1)
            fprintf(stderr, "kernel_launch: occupancy query reports %d workgroups per CU for the persistent kernel\n", per_cu);
    }
    (void)hipMemsetAsync(p.bar, 0, 4096 * sizeof(unsigned), stream);
    hipLaunchKernelGGL(k_mega, dim3(grid), dim3(NTHREADS), LDS_BYTES, stream, p);
}
```
